# Optimizing an MI355X kernel written in HIP

```python
import jax, jax.numpy as jnp
from jax import lax
import numpy as np

D_MODEL = 1024
BATCH = 8
SEQ = 2048
DEPTH = 1
DEC_BATCH = 128
DEC_SEQ = 1
PAST_LEN = 16384
PAGE_SIZE = 128

D_A = D_MODEL // 2
CHUNK = 128
N_HEADS_A = 4
HEAD_A = D_A // N_HEADS_A
D_B = D_MODEL - D_A
HEAD_B = 64
N_HEADS_B = D_B // HEAD_B
D_DECAY_LORA = 64
D_AAA_LORA = 64
D_GATE_LORA = 128
D_SHIFT = 3 * D_B + D_DECAY_LORA + D_AAA_LORA + D_GATE_LORA
D_IN = 2 * D_A + D_SHIFT
N_MEM = 256
N_HEADS_X = 4
HEAD_X = D_MODEL // N_HEADS_X
D_FF = 4 * D_MODEL
RMS_EPS = 1e-6
LN_EPS = 1e-5
GN_EPS = 64e-5

kernel_name = "hybrid_chunkgmlp_rwkv7_memxattn_step"

F32 = jnp.float32


def rmsnorm(x, g):
    x32 = x.astype(F32)
    y = x32 * lax.rsqrt(jnp.mean(x32 * x32, axis=-1, keepdims=True) + RMS_EPS)
    return (y * g.astype(F32)).astype(x.dtype)


def headnorm(x, g, b, eps):
    H, P = x.shape[-2:]
    x32 = x.astype(F32)
    mu = jnp.mean(x32, axis=-1, keepdims=True)
    xc = x32 - mu
    var = jnp.mean(xc * xc, axis=-1, keepdims=True)
    y = xc * lax.rsqrt(var + eps)
    return (y * g.astype(F32).reshape(H, P) + b.astype(F32).reshape(H, P)).astype(x.dtype)


def chunk_spatial_gate(u, vn, ws, bs):
    bsz, L, H, P = u.shape
    n_chunks = -(-L // CHUNK)
    pad = n_chunks * CHUNK - L
    vp = jnp.pad(vn, ((0, 0), (0, pad), (0, 0), (0, 0))).reshape(bsz, n_chunks, CHUNK, H, P)
    mask = jnp.tril(jnp.ones((CHUNK, CHUNK), dtype=bool))
    ws_c = jnp.where(mask[None], ws, 0).astype(vn.dtype)
    mixed = jnp.einsum('hts,bcshp->bcthp', ws_c, vp) + jnp.transpose(bs)[None, None, :, :, None]
    mixed = mixed.reshape(bsz, n_chunks * CHUNK, H, P)[:, :L]
    return u * mixed


def token_shift(p, prev_row, mu):
    prev = jnp.concatenate([prev_row[:, None].astype(p.dtype), p[:, :-1]], axis=1)
    return p + (prev - p) * mu, p[:, -1]


def wkv7_scan(r, decay, k, v, kk, a, S0):
    def step(S, inp):
        r_t, d_t, k_t, v_t, kk_t, a_t = inp
        sa = jnp.einsum('bhvk,bhk->bhv', S, -kk_t)
        S = S * d_t[:, :, None, :] + sa[..., None] * (kk_t * a_t)[:, :, None, :] + v_t[..., None] * k_t[:, :, None, :]
        y = jnp.einsum('bhvk,bhk->bhv', S, r_t)
        return S, y
    xs = tuple(jnp.swapaxes(t, 0, 1) for t in (r, decay, k, v, kk, a))
    S, ys = lax.scan(step, S0, xs)
    return jnp.swapaxes(ys, 0, 1), S


def parallel_mixer(h, shift0, wkv0, w_in, mu, gm_ln_g, gm_ln_b, gm_ws, gm_bs,
                   w0, w2, a0, a2, g2, k_k, k_a, r_k, ln_g, ln_b, w_out):
    bsz, L, _ = h.shape
    proj = h @ w_in
    z_a = jax.nn.gelu(proj[..., :2 * D_A], approximate=False)
    u = z_a[..., :D_A].reshape(bsz, L, N_HEADS_A, HEAD_A)
    vn = headnorm(z_a[..., D_A:].reshape(bsz, L, N_HEADS_A, HEAD_A), gm_ln_g, gm_ln_b, LN_EPS)
    out_a = chunk_spatial_gate(u, vn, gm_ws, gm_bs).reshape(bsz, L, D_A)
    chunk_start = ((L - 1) // CHUNK) * CHUNK
    chunk_v = vn[:, chunk_start:]
    pb, shift_new = token_shift(proj[..., 2 * D_A:], shift0, mu)
    pb = pb.astype(F32)
    offs = [D_B, 2 * D_B, 3 * D_B, 3 * D_B + D_DECAY_LORA, 3 * D_B + D_DECAY_LORA + D_AAA_LORA]
    r, k, v, wl, al, gl = jnp.split(pb, offs, axis=-1)
    heads = lambda t: t.reshape(bsz, L, N_HEADS_B, HEAD_B)
    w = -jax.nn.softplus(-(w0 + jnp.tanh(wl) @ w2)) - 0.5
    decay = jnp.exp(-jnp.exp(w))
    a = jax.nn.sigmoid(a0 + al @ a2)
    g = jax.nn.sigmoid(gl) @ g2
    kk = heads(k * k_k)
    kk = kk / jnp.maximum(jnp.sqrt(jnp.sum(kk * kk, axis=-1, keepdims=True)), 1e-12)
    k = k * (1.0 + (a - 1.0) * k_a)
    r_h, k_h, v_h = heads(r), heads(k), heads(v)
    yb, wkv_new = wkv7_scan(r_h, heads(decay), k_h, v_h, kk, heads(a), wkv0.astype(F32))
    yb = headnorm(yb, ln_g, ln_b, GN_EPS)
    bonus = jnp.sum(r_h * k_h * r_k.astype(F32), axis=-1, keepdims=True) * v_h
    out_b = ((yb + bonus).reshape(bsz, L, D_B) * g).astype(h.dtype)
    y = jnp.concatenate([out_a, out_b], axis=-1) @ w_out
    return y, chunk_v, shift_new, wkv_new


def memory_kv(mem, g, w_k, w_v):
    bsz = mem.shape[0]
    mn = rmsnorm(mem, g)
    mk = (mn @ w_k).reshape(bsz, N_MEM, N_HEADS_X, HEAD_X)
    mv = (mn @ w_v).reshape(bsz, N_MEM, N_HEADS_X, HEAD_X)
    return mk, mv


def cross_attn(h, mem_k, mem_v, w_q, w_o):
    bsz, L, _ = h.shape
    q = (h @ w_q).reshape(bsz, L, N_HEADS_X, HEAD_X)
    s = jnp.einsum('blhd,bmhd->bhlm', q.astype(F32), mem_k.astype(F32)) * (HEAD_X ** -0.5)
    p = jax.nn.softmax(s, axis=-1)
    o = jnp.einsum('bhlm,bmhd->blhd', p, mem_v.astype(F32)).astype(h.dtype)
    return o.reshape(bsz, L, D_MODEL) @ w_o


def sq_relu_ffn(h, w_up, w_down):
    return jnp.square(jax.nn.relu(h @ w_up)) @ w_down


def setup_inputs(seed: int = 0) -> dict:
    key = jax.random.key(seed)
    ks = iter(jax.random.split(key, 48))
    nrm = lambda shape, scale: scale * jax.random.normal(next(ks), shape, F32)
    L = DEPTH
    return {
        "x_prompt": nrm((BATCH, SEQ, D_MODEL), 1.0),
        "x_sample": nrm((DEC_BATCH, DEC_SEQ, D_MODEL), 1.0),
        "mem_prompt": nrm((BATCH, N_MEM, D_MODEL), 1.0),
        "cache_mem_k": nrm((L, DEC_BATCH, N_MEM, N_HEADS_X, HEAD_X), 1.0),
        "cache_mem_v": nrm((L, DEC_BATCH, N_MEM, N_HEADS_X, HEAD_X), 1.0),
        "state_shift": nrm((L, DEC_BATCH, D_SHIFT), 1.0),
        "state_wkv": nrm((L, DEC_BATCH, N_HEADS_B, HEAD_B, HEAD_B), 0.5),
        "norm_mix_g": 1.0 + nrm((L, D_MODEL), 0.1),
        "w_in": nrm((L, D_MODEL, D_IN), D_MODEL ** -0.5),
        "tshift_mu": jax.random.uniform(next(ks), (L, D_SHIFT), F32),
        "gm_ln_g": 1.0 + nrm((L, D_A), 0.1),
        "gm_ln_b": nrm((L, D_A), 0.01),
        "gm_ws": nrm((L, N_HEADS_A, CHUNK, CHUNK), CHUNK ** -0.5),
        "gm_bs": 1.0 + nrm((L, N_HEADS_A, CHUNK), 0.1),
        "rw_w0": -1.0 + nrm((L, D_B), 0.5),
        "rw_w2": nrm((L, D_DECAY_LORA, D_B), 0.1 * D_DECAY_LORA ** -0.5),
        "rw_a0": nrm((L, D_B), 0.1),
        "rw_a2": nrm((L, D_AAA_LORA, D_B), D_AAA_LORA ** -0.5),
        "rw_g2": nrm((L, D_GATE_LORA, D_B), D_GATE_LORA ** -0.5),
        "rw_kk": 0.85 + nrm((L, D_B), 0.05),
        "rw_ka": 1.0 + nrm((L, D_B), 0.05),
        "rw_rk": nrm((L, N_HEADS_B, HEAD_B), 0.1),
        "rw_ln_g": 1.0 + nrm((L, D_B), 0.1),
        "rw_ln_b": nrm((L, D_B), 0.01),
        "w_out": nrm((L, D_MODEL, D_MODEL), D_MODEL ** -0.5),
        "norm_x_g": 1.0 + nrm((L, D_MODEL), 0.1),
        "norm_mem_g": 1.0 + nrm((L, D_MODEL), 0.1),
        "w_xq": nrm((L, D_MODEL, D_MODEL), D_MODEL ** -0.5),
        "w_xk": nrm((L, D_MODEL, D_MODEL), D_MODEL ** -0.5),
        "w_xv": nrm((L, D_MODEL, D_MODEL), D_MODEL ** -0.5),
        "w_xo": nrm((L, D_MODEL, D_MODEL), D_MODEL ** -0.5),
        "norm_ffn_g": 1.0 + nrm((L, D_MODEL), 0.1),
        "w_up": nrm((L, D_MODEL, D_FF), D_MODEL ** -0.5),
        "w_down": nrm((L, D_FF, D_MODEL), D_FF ** -0.5),
        "final_g": 1.0 + nrm((D_MODEL,), 0.1),
    }


def reference(x_prompt, x_sample, mem_prompt, cache_mem_k, cache_mem_v, state_shift, state_wkv,
              norm_mix_g, w_in, tshift_mu, gm_ln_g, gm_ln_b, gm_ws, gm_bs,
              rw_w0, rw_w2, rw_a0, rw_a2, rw_g2, rw_kk, rw_ka, rw_rk, rw_ln_g, rw_ln_b, w_out,
              norm_x_g, norm_mem_g, w_xq, w_xk, w_xv, w_xo, norm_ffn_g, w_up, w_down, final_g):

    def layer(l, x, mem_k, mem_v, shift0, wkv0):
        y_mix, chunk_v, shift_new, wkv_new = parallel_mixer(
            rmsnorm(x, norm_mix_g[l]), shift0, wkv0, w_in[l], tshift_mu[l],
            gm_ln_g[l], gm_ln_b[l], gm_ws[l], gm_bs[l],
            rw_w0[l], rw_w2[l], rw_a0[l], rw_a2[l], rw_g2[l], rw_kk[l], rw_ka[l], rw_rk[l],
            rw_ln_g[l], rw_ln_b[l], w_out[l])
        x = x + y_mix
        x = x + cross_attn(rmsnorm(x, norm_x_g[l]), mem_k, mem_v, w_xq[l], w_xo[l])
        x = x + sq_relu_ffn(rmsnorm(x, norm_ffn_g[l]), w_up[l], w_down[l])
        return x, chunk_v, shift_new, wkv_new

    bp = x_prompt.shape[0]
    xp = x_prompt
    mk_p, mv_p, sh_p, wk_p, cv_p = [], [], [], [], []
    for l in range(DEPTH):
        mk, mv = memory_kv(mem_prompt, norm_mem_g[l], w_xk[l], w_xv[l])
        shift0 = jnp.zeros((bp, D_SHIFT), x_prompt.dtype)
        wkv0 = jnp.zeros((bp, N_HEADS_B, HEAD_B, HEAD_B), F32)
        xp, cv, sh, wk = layer(l, xp, mk, mv, shift0, wkv0)
        mk_p.append(mk); mv_p.append(mv); sh_p.append(sh); wk_p.append(wk); cv_p.append(cv)

    xs = x_sample
    sh_s, wk_s, cv_s = [], [], []
    for l in range(DEPTH):
        xs, cv, sh, wk = layer(l, xs, cache_mem_k[l], cache_mem_v[l], state_shift[l], state_wkv[l])
        sh_s.append(sh); wk_s.append(wk); cv_s.append(cv)

    y_prompt = rmsnorm(xp, final_g)
    y_sample = rmsnorm(xs, final_g)
    return (y_prompt, y_sample,
            jnp.stack(mk_p), jnp.stack(mv_p), jnp.stack(sh_p), jnp.stack(wk_p), jnp.stack(cv_p),
            jnp.stack(sh_s), jnp.stack(wk_s), jnp.stack(cv_s))
```

```cpp
#include <hip/hip_runtime.h>
#include <cstdio>
#include <cstdint>

namespace pg8 {
#define PG8_LAS __attribute__((address_space(3)))
typedef unsigned short bf16_t;
typedef short bf16x8 __attribute__((ext_vector_type(8)));
typedef float f32x4 __attribute__((ext_vector_type(4)));
typedef float f32x2 __attribute__((ext_vector_type(2)));
typedef unsigned u32x4 __attribute__((ext_vector_type(4)));
typedef unsigned u32x2 __attribute__((ext_vector_type(2)));
constexpr int BM = 256, BK = 64, HALF = 128, HTB = HALF * BK * 2  , STAGE_BYTES = 8 * HTB;

__host__ __device__ __forceinline__ int lds_byte(int r, int c) { const int st = (r >> 4) * 2 + (c >> 5), rr = r & 15, cc = c & 31, ob = rr * 64 + cc * 2; return st * 1024 + (ob ^ (((ob >> 9) & 1) << 5)); }
__host__ __device__ __forceinline__ void stage_rc(int b, int& R, int& C) { const int st = b / 1024, sb = b % 1024, swz = sb ^ (((sb >> 9) & 1) << 5); R = (st >> 1) * 16 + swz / 64; C = (st & 1) * 32 + (swz % 64) / 2; }
__host__ __device__ __forceinline__ int perm32(int rho) { const int n = rho >> 4, i = rho & 15; return 8 * (i >> 2) + 4 * n + (i & 3); }

struct Unit { int pm, pn; };

__device__ __forceinline__ unsigned cvt_pk_bf16(float lo, float hi) { unsigned r; asm volatile("v_cvt_pk_bf16_f32 %0, %1, %2" : "=v"(r) : "v"(lo), "v"(hi)); return r; }
__device__ __forceinline__ f32x2 gelu_pk(f32x2 v) {
    const f32x2 av = __builtin_elementwise_abs(v), d = av * 0.2316418882f + 1.0f;
    f32x2 t; t.x = __builtin_amdgcn_rcpf(d.x); t.y = __builtin_amdgcn_rcpf(d.y);
    f32x2 q = t * 0.5307027145f + (-0.7265760135f); q = q * t + 0.7107068705f; q = q * t + (-0.142248368f); q = q * t + 0.127414796f; q = q * t;
    const f32x2 s = (v * v) * (-0.72134752044f);
    f32x2 e; e.x = __builtin_amdgcn_exp2f(s.x); e.y = __builtin_amdgcn_exp2f(s.y);
    const f32x2 m = v * (q * e), r = v - m;
    f32x2 o; o.x = v.x < 0.f ? m.x : r.x; o.y = v.y < 0.f ? m.y : r.y; return o;
}

template <class Epi, class Sched, bool ALIGN_EPI = false>
__device__ __forceinline__ void gemm_phase(PG8_LAS unsigned char* lds, const int K, const int lda, const int ldb, const Sched& S, const Epi& E) {
    int tid_ = threadIdx.x; asm volatile("" : "+v"(tid_));
    const int tid = tid_, wid = __builtin_amdgcn_readfirstlane(tid >> 6), lane = tid & 63, wr = wid >> 2, wc = wid & 3, fr = lane & 15, fq = lane >> 4;
    const int nt = K / BK;
    unsigned voffA[2], voffB[2];
#pragma unroll
    for (int i = 0; i < 2; ++i) { int R, C; stage_rc(tid * 16 + i * 8192, R, C); const int Rb = Epi::PERM ? ((R & ~31) + perm32(R & 31)) : R;
        voffA[i] = (unsigned)(R * lda + C) * 2u; voffB[i] = (unsigned)(Rb * ldb + C) * 2u; }
    const size_t kstep = (size_t)(BK * 2);
    const size_t hstepA = (size_t)HALF * lda * 2, hstepB = (size_t)HALF * ldb * 2;
    const unsigned ldsw = (unsigned)wid * 1024u;
    const int aoff = lds_byte(wr * 64 + fr, fq * 8), boff = lds_byte(wc * 32 + fr, fq * 8);
#define PG8_SA(b, h) (((b) * 2 + (h)) * HTB)
#define PG8_SB(b, h) ((4 + (b) * 2 + (h)) * HTB)
#define PG8_STAGE(bufoff, gbase, voff) do { _Pragma("unroll") for (int _i = 0; _i < 2; ++_i) \
        __builtin_amdgcn_global_load_lds((const unsigned*)((const char*)(gbase) + (voff)[_i]), (PG8_LAS unsigned*)(lds + (bufoff) + ldsw + _i * 8192), 16, 0, 0); } while (0)
#define PG8_LDA(dst, b, h) do { _Pragma("unroll") for (int m = 0; m < 4; ++m) _Pragma("unroll") for (int k = 0; k < 2; ++k) dst[m][k] = *(const PG8_LAS bf16x8*)(lds + PG8_SA(b, h) + aoff + m * 2048 + k * 1024); } while (0)
#define PG8_LDB(dst, b, h) do { _Pragma("unroll") for (int n = 0; n < 2; ++n) _Pragma("unroll") for (int k = 0; k < 2; ++k) dst[n][k] = *(const PG8_LAS bf16x8*)(lds + PG8_SB(b, h) + boff + n * 2048 + k * 1024); } while (0)
#define PG8_MMA(ai, bj, At, Bt) do { __builtin_amdgcn_s_setprio(1); _Pragma("unroll") for (int m = 0; m < 4; ++m) _Pragma("unroll") for (int n = 0; n < 2; ++n) _Pragma("unroll") for (int k = 0; k < 2; ++k) \
        acc[ai][bj][m][n] = __builtin_amdgcn_mfma_f32_16x16x32_bf16(Bt[n][k], At[m][k], acc[ai][bj][m][n], 0, 0, 0); __builtin_amdgcn_s_setprio(0); } while (0)
#define PG8_WAIT_V(n) asm volatile("s_waitcnt vmcnt(" #n ")" ::: "memory")
#define PG8_WAIT_L(n) asm volatile("s_waitcnt lgkmcnt(" #n ")" ::: "memory")
#define PG8_BAR __builtin_amdgcn_s_barrier()
#define PG8_SCHED __builtin_amdgcn_sched_barrier(0)
    Unit cur, nxt; int ui = 0;
    if (!S.next(0, cur)) return;
    f32x4 acc[2][2][4][2];
#pragma unroll
    for (int a = 0; a < 2; ++a)
#pragma unroll
        for (int b = 0; b < 2; ++b)
#pragma unroll
            for (int m = 0; m < 4; ++m)
#pragma unroll
                for (int n = 0; n < 2; ++n) acc[a][b][m][n] = (f32x4){0.f, 0.f, 0.f, 0.f};
    bf16x8 At[4][2], B0[2][2], B1[2][2];
    const char* cA = S.pa(cur); const char* cB = S.pb(cur);
    PG8_STAGE(PG8_SB(0, 0), cB, voffB); PG8_STAGE(PG8_SB(0, 1), cB + hstepB, voffB); PG8_STAGE(PG8_SA(0, 0), cA, voffA); PG8_STAGE(PG8_SA(0, 1), cA + hstepA, voffA);
    if (wr == 1) PG8_BAR;
    PG8_WAIT_V(2); PG8_BAR;
    PG8_STAGE(PG8_SB(1, 0), cB + kstep, voffB); PG8_STAGE(PG8_SA(1, 0), cA + kstep, voffA); PG8_STAGE(PG8_SB(1, 1), cB + hstepB + kstep, voffB);
    PG8_WAIT_V(6); PG8_BAR;
    for (;;) {
        const bool has_next = S.next(ui + 1, nxt);
        const char* nA = has_next ? S.pa(nxt) : cA; const char* nB = has_next ? S.pb(nxt) : cB;
#pragma unroll 1
        for (int t = 0; t < nt; t += 2) {
            const bool last = (t == nt - 2);
            const char* a1 = cA + (size_t)(t + 1) * kstep;
            const char* a2 = last ? nA : cA + (size_t)(t + 2) * kstep; const char* b2 = last ? nB : cB + (size_t)(t + 2) * kstep;
            const char* a3 = a2 + kstep; const char* b3 = b2 + kstep;
            PG8_LDB(B0, 0, 0); PG8_LDB(B1, 0, 1); PG8_SCHED; PG8_LDA(At, 0, 0); PG8_STAGE(PG8_SA(1, 1), a1 + hstepA, voffA);
            PG8_WAIT_V(8); PG8_WAIT_L(0); PG8_BAR; PG8_MMA(0, 0, At, B0); PG8_MMA(0, 1, At, B1); PG8_BAR; PG8_SCHED;
            PG8_LDA(At, 0, 1); PG8_STAGE(PG8_SB(0, 0), b2, voffB); PG8_STAGE(PG8_SB(0, 1), b2 + hstepB, voffB); PG8_STAGE(PG8_SA(0, 0), a2, voffA);
            PG8_WAIT_V(8); PG8_WAIT_L(0); PG8_BAR; PG8_MMA(1, 0, At, B0); PG8_MMA(1, 1, At, B1); PG8_BAR; PG8_SCHED;
            PG8_LDB(B0, 1, 0); PG8_LDB(B1, 1, 1); PG8_SCHED; PG8_LDA(At, 1, 0); PG8_STAGE(PG8_SA(0, 1), a2 + hstepA, voffA);
            PG8_WAIT_V(8); PG8_WAIT_L(0); PG8_BAR; PG8_MMA(0, 0, At, B0); PG8_MMA(0, 1, At, B1); PG8_BAR; PG8_SCHED;
            PG8_LDA(At, 1, 1); PG8_STAGE(PG8_SB(1, 0), b3, voffB); PG8_STAGE(PG8_SB(1, 1), b3 + hstepB, voffB); PG8_STAGE(PG8_SA(1, 0), a3, voffA);
            PG8_WAIT_V(8); PG8_WAIT_L(0); PG8_BAR; PG8_MMA(1, 0, At, B0); PG8_MMA(1, 1, At, B1); PG8_BAR; PG8_SCHED;
        }
        if constexpr (ALIGN_EPI) { if (wr == 0) PG8_BAR; }
        if constexpr (!Epi::AFTER_DRAIN) { E(acc, cur, wr, wc, fr, fq); }
        if (!has_next) break;
#pragma unroll
        for (int a = 0; a < 2; ++a)
#pragma unroll
            for (int b = 0; b < 2; ++b)
#pragma unroll
                for (int m = 0; m < 4; ++m)
#pragma unroll
                    for (int n = 0; n < 2; ++n) acc[a][b][m][n] = (f32x4){0.f, 0.f, 0.f, 0.f};
        cur = nxt; cA = nA; cB = nB; ++ui;
        if constexpr (ALIGN_EPI) { if (wr == 1) PG8_BAR; }
    }
    PG8_WAIT_V(0);
    if constexpr (!ALIGN_EPI) { if (wr == 0) PG8_BAR; }
    PG8_BAR;
    if constexpr (Epi::AFTER_DRAIN) { E.fused(acc, cur, wr, wc, fr, fq, lds, wid, lane); }
#undef PG8_SA
#undef PG8_SB
#undef PG8_STAGE
#undef PG8_LDA
#undef PG8_LDB
#undef PG8_MMA
#undef PG8_WAIT_V
#undef PG8_WAIT_L
#undef PG8_BAR
#undef PG8_SCHED
}
}

#define GAS __attribute__((address_space(1)))
#define LAS __attribute__((address_space(3)))
typedef unsigned short bf16;
typedef float f32x4 __attribute__((ext_vector_type(4)));
typedef float f32x2 __attribute__((ext_vector_type(2)));
typedef short bf16x8 __attribute__((ext_vector_type(8)));
typedef unsigned u32x4 __attribute__((ext_vector_type(4)));
typedef unsigned u32x2 __attribute__((ext_vector_type(2)));
typedef GAS unsigned gu32;
#define RLX_AGENT __ATOMIC_RELAXED, __HIP_MEMORY_SCOPE_AGENT
#define LDS_WAIT() asm volatile("s_waitcnt lgkmcnt(0)" ::: "memory")
#define VM_WAIT() asm volatile("s_waitcnt vmcnt(0)" ::: "memory")

constexpr int NWAVES = 8;
constexpr int D = 1024, M = 16384, SEQ = 2048, NBATCH = 8, MS = 128, DIN = 2816, DSH = 1792, DB = 512, FF = 4096, NMEM = 256;
constexpr float RMS_EPS = 1e-6f, LN_EPS = 1e-5f, GN_EPS = 64e-5f;
constexpr size_t O_Y = 0, O_YS = 16777216, O_MK = 16908288, O_MV = 19005440, O_SHP = 21102592, O_WKVP = 21116928, O_CVP = 21379072, O_SHS = 21903360, O_WKVS = 22132736, O_CVS = 26327040, O_END = 26392576;
constexpr size_t MiB = 1u << 20, KiB = 1024;
constexpr size_t WS_CTL = 0, CTL_ZERO_BYTES = 1 * MiB;
constexpr size_t WS_WCAT = 2 * MiB;
constexpr size_t WS_WOUT = 12 * MiB, WS_WQ = 14 * MiB, WS_WO = 16 * MiB, WS_WUP = 18 * MiB, WS_WDN = 26 * MiB;
constexpr size_t WS_SMALL = 34 * MiB;
constexpr size_t WS_ACAT = 36 * MiB;
constexpr size_t WS_ZA = 73 * MiB;
constexpr size_t WS_PB = 105 * MiB;
constexpr size_t WS_Q = 105 * MiB, WS_OB = 137 * MiB;
constexpr size_t WS_SCN = 161 * MiB;
constexpr size_t WS_PSCR = 169 * MiB, WS_HID = 201 * MiB;
constexpr size_t WS_G = 353 * MiB;
constexpr size_t WS_MIX = 369 * MiB;
constexpr size_t WS_KB = 401 * MiB, WS_VT = 405 * MiB;
constexpr size_t WS_SMP = 409 * MiB;
constexpr size_t SM_ZA = 0, SM_MIX = 256 * KiB, SM_X1 = 512 * KiB, SM_X1B = 1024 * KiB, SM_Q = 1280 * KiB, SM_O = 1792 * KiB, SM_X2 = 2048 * KiB, SM_X2B = 2560 * KiB, SM_HID = 3072 * KiB, SM_X3 = 4096 * KiB;
constexpr size_t WS_END = 416 * MiB;
constexpr int CW_TMO = 0, CW_CODE = 1, CW_BAR = 4096, CW_SUB = 8192;
constexpr int RS_OFF = 65536, RS_STRIDE = 16640;
constexpr int RING_BYTES = 131072, LDSCTL_OFF = RING_BYTES, MISC_OFF = LDSCTL_OFF + 320, LDS_BYTES = 147456;

__device__ __forceinline__ float bf_lo(unsigned u) { return __uint_as_float(u << 16); }
__device__ __forceinline__ float bf_hi(unsigned u) { return __uint_as_float(u & 0xffff0000u); }
__device__ __forceinline__ float bf1(bf16 v) { return __uint_as_float(((unsigned)v) << 16); }
__device__ __forceinline__ unsigned pk2(float lo, float hi) { return pg8::cvt_pk_bf16(lo, hi); }
__device__ __forceinline__ f32x4 bf4(u32x2 v) { return (f32x4){bf_lo(v.x), bf_hi(v.x), bf_lo(v.y), bf_hi(v.y)}; }
__device__ __forceinline__ u32x2 pk4(f32x4 v) { u32x2 r; r.x = pk2(v.x, v.y); r.y = pk2(v.z, v.w); return r; }
__device__ __forceinline__ float fast_exp(float x) { return __builtin_amdgcn_exp2f(x * 1.44269504089f); }
__device__ __forceinline__ float fast_log(float x) { return __builtin_amdgcn_logf(x) * 0.69314718056f; }
__device__ __forceinline__ float fast_sigmoid(float x) { return __builtin_amdgcn_rcpf(1.0f + fast_exp(-x)); }
__device__ __forceinline__ float fast_tanh(float x) { return 1.0f - 2.0f * __builtin_amdgcn_rcpf(fast_exp(2.0f * x) + 1.0f); }
template <int CTRL> __device__ __forceinline__ float dpp_mov(float x) { return __builtin_bit_cast(float, __builtin_amdgcn_mov_dpp(__builtin_bit_cast(int, x), CTRL, 0xf, 0xf, true)); }
__device__ __forceinline__ float red4(float x) { x += dpp_mov<0xB1>(x); x += dpp_mov<0x4E>(x); return x; }
__device__ __forceinline__ float red8(float x) { x = red4(x); x += dpp_mov<0x141>(x); return x; }
__device__ __forceinline__ float red16(float x) { x = red8(x); x += dpp_mov<0x128>(x); return x; }
__device__ __forceinline__ float wave_sum(float v) {
#pragma unroll
    for (int o = 1; o < 64; o <<= 1) v += __shfl_xor(v, o);
    return v;
}
__device__ __forceinline__ float wave_max(float v) {
#pragma unroll
    for (int o = 1; o < 64; o <<= 1) v = fmaxf(v, __shfl_xor(v, o));
    return v;
}

#define XB_TMO      128
#define XB_XCNT(j)  (256  + 64 * (j))
#define XB_XSUB(j)  (1280 + 64 * (j))
#define XB_XGEN(j)  (2304 + 64 * (j))
#define XB_TOP      3328
#define XB_TOPGEN   3392
#define XCD_BAR_WORDS 3456
#define XB_SPIN_CAP (1u << 18)
__device__ __forceinline__ unsigned xb_ld(unsigned* p)              { return __hip_atomic_load(p, __ATOMIC_RELAXED, __HIP_MEMORY_SCOPE_AGENT); }
__device__ __forceinline__ unsigned xb_add(unsigned* p, unsigned v) { return __hip_atomic_fetch_add(p, v, __ATOMIC_RELAXED, __HIP_MEMORY_SCOPE_AGENT); }
__device__ __forceinline__ unsigned xb_xcc_id() { return (unsigned)__builtin_amdgcn_s_getreg((3 << 11) | 20) & 0xFu; }
#define XB_SPIN(cond, bar) do { unsigned _sp = 0; while (cond) { __builtin_amdgcn_s_sleep(1); \
    if ((++_sp & 255u) == 0u) { if (xb_ld(&(bar)[XB_TMO])) break; if (_sp > XB_SPIN_CAP) { atomicAdd(&(bar)[XB_TMO], 1u); break; } } } } while (0)
struct XcdBarrier { unsigned* bar; unsigned x; volatile LAS unsigned* st; };
__device__ __forceinline__ XcdBarrier xcd_barrier_post(unsigned* bar, volatile LAS unsigned* st) {
    XcdBarrier b; b.bar = bar; b.x = xb_xcc_id(); b.st = st;
    if (threadIdx.x == 0) (void)xb_add(&bar[XB_XCNT(b.x)], 1u);
    return b;
}
__device__ __forceinline__ void xcd_barrier_complete(unsigned* bar, unsigned x, unsigned& nloc, unsigned& nx) {
    const unsigned G = gridDim.x * gridDim.y * gridDim.z;
    unsigned sum, cnt, mine, sp = 0u;
    for (;;) {
        sum = 0u; cnt = 0u; mine = 0u;
#pragma unroll
        for (unsigned j = 0; j < 16; ++j) { const unsigned c = xb_ld(&bar[XB_XCNT(j)]); sum += c; cnt += (c > 0u) ? 1u : 0u; mine = (j == x) ? c : mine; }
        if (sum == G) break;
        __builtin_amdgcn_s_sleep(1);
        if ((++sp & 255u) == 0u) { if (xb_ld(&bar[XB_TMO])) break; if (sp > XB_SPIN_CAP) { atomicAdd(&bar[XB_TMO], 1u); break; } }
    }
    nloc = mine > 0u ? mine : 1u; nx = cnt > 0u ? cnt : 1u;
}
__device__ __forceinline__ void xcd_barrier(const XcdBarrier& b) {
    asm volatile("s_waitcnt vmcnt(0)" ::: "memory");
    __syncthreads();
    if (threadIdx.x == 0) {
        unsigned* bar = b.bar;
        __builtin_amdgcn_s_waitcnt(0);
        unsigned nloc = b.st[0], nx = b.st[1];
        if (nloc == 0u) { xcd_barrier_complete(bar, b.x, nloc, nx); b.st[0] = nloc; b.st[1] = nx; }
        const unsigned old = xb_add(&bar[XB_XSUB(b.x)], 1u);
        const unsigned gen = old / nloc;
        if (old + 1u == (gen + 1u) * nloc) {
            __builtin_amdgcn_fence(__ATOMIC_RELEASE, "agent");
            asm volatile("s_waitcnt vmcnt(0)" ::: "memory");
            const unsigned og = xb_add(&bar[XB_TOP], 1u);
            const unsigned tg = og / nx;
            if (og + 1u == (tg + 1u) * nx) xb_add(&bar[XB_TOPGEN], 1u);
            else XB_SPIN(xb_ld(&bar[XB_TOPGEN]) == tg, bar);
            __builtin_amdgcn_fence(__ATOMIC_ACQUIRE, "agent");
            xb_add(&bar[XB_XGEN(b.x)], 1u);
            asm volatile("s_waitcnt vmcnt(0)" ::: "memory");
        } else {
            XB_SPIN(xb_ld(&bar[XB_XGEN(b.x)]) == gen, bar);
            __builtin_amdgcn_fence(__ATOMIC_ACQUIRE, "agent");
            asm volatile("s_waitcnt vmcnt(0)" ::: "memory");
        }
    }
    __syncthreads();
}
__device__ __forceinline__ void sub_barrier(unsigned* cnt, unsigned* tmo, unsigned target) {
    asm volatile("s_waitcnt vmcnt(0)" ::: "memory");
    __syncthreads();
    if (threadIdx.x == 0) {
        __builtin_amdgcn_fence(__ATOMIC_RELEASE, "agent");
        asm volatile("s_waitcnt vmcnt(0)" ::: "memory");
        (void)xb_add(cnt, 1u);
        unsigned sp = 0;
        while (xb_ld(cnt) < target) { __builtin_amdgcn_s_sleep(1); if ((++sp & 255u) == 0u) { if (xb_ld(tmo)) break; if (sp > (1u << 20)) { atomicAdd(tmo, 1u); break; } } }
        __builtin_amdgcn_fence(__ATOMIC_ACQUIRE, "agent");
        asm volatile("s_waitcnt vmcnt(0)" ::: "memory");
    }
    __syncthreads();
}

__device__ __forceinline__ void p0_transpose_item(const float* W, int K, int N, bf16* WT, int row_off, const float* gk, LAS float* scr, int item, int lane) {
    const int nblk = N / 32, kb = item / nblk, nb = item % nblk, k0 = 64 * kb, n0 = 32 * nb;
#pragma unroll 8
    for (int i = 0; i < 32; ++i) { const int kk = 2 * i + (lane >> 5); float v = W[(size_t)(k0 + kk) * N + n0 + (lane & 31)]; if (gk) v *= gk[k0 + kk]; scr[kk * 33 + (lane & 31)] = v; }
    LDS_WAIT(); asm volatile("" ::: "memory");
    const int c = lane & 7;
#pragma unroll
    for (int j = 0; j < 4; ++j) { const int n = (lane >> 3) + 8 * j; const LAS float* s = scr + (8 * c) * 33 + n;
        u32x4 o; o.x = pk2(s[0 * 33], s[1 * 33]); o.y = pk2(s[2 * 33], s[3 * 33]); o.z = pk2(s[4 * 33], s[5 * 33]); o.w = pk2(s[6 * 33], s[7 * 33]);
        *(u32x4*)(WT + (size_t)(row_off + n0 + n) * K + k0 + 8 * c) = o; }
    LDS_WAIT(); asm volatile("" ::: "memory");
}
__device__ __forceinline__ void rms_row_to_bf16(const float* xrow, const float* g, bf16* orow, int lane) {
    const f32x4* xr = (const f32x4*)xrow + lane; const f32x4* gr = (const f32x4*)g + lane;
    f32x4 v[4]; float s = 0.f;
#pragma unroll
    for (int j = 0; j < 4; ++j) { v[j] = xr[64 * j]; s += (v[j].x * v[j].x + v[j].y * v[j].y) + (v[j].z * v[j].z + v[j].w * v[j].w); }
    const float rstd = 1.f / sqrtf(wave_sum(s) * (1.f / D) + RMS_EPS);
    unsigned long long* o8 = (unsigned long long*)orow + lane;
#pragma unroll
    for (int j = 0; j < 4; ++j) { const f32x4 gg = gr[64 * j]; o8[64 * j] = (unsigned long long)pk2(v[j].x * rstd * gg.x, v[j].y * rstd * gg.y) | ((unsigned long long)pk2(v[j].z * rstd * gg.z, v[j].w * rstd * gg.w) << 32); }
}

using pg8::Unit;
struct SchedMN {
    int nM, nN, nwg, G, c; const char* A; const char* Bt; size_t ta, tb;
    __device__ __forceinline__ void init(int M_, int N_, int G_, int c_, const void* A_, size_t lda, const void* Bt_, size_t ldb) { nM = M_ / 256; nN = N_ / 256; nwg = nM * nN; G = G_; c = c_; A = (const char*)A_; Bt = (const char*)Bt_; ta = 256 * lda * 2; tb = 256 * ldb * 2; }
    __device__ __forceinline__ bool next(int i, Unit& u) const {
        const long L = (long)i * G + c; if (L >= nwg) return false;
        int wgid = (int)L; { const int q = nwg / 8, r = nwg % 8, xcd = wgid % 8, off = wgid / 8; wgid = (xcd < r ? xcd * (q + 1) : r * (q + 1) + (xcd - r) * q) + off; }
        const int nig = 8 * nN, gid = wgid / nig, fm = gid * 8, gsz = (nM - fm) < 8 ? (nM - fm) : 8;
        u.pm = fm + ((wgid % nig) % gsz); u.pn = (wgid % nig) / gsz; return true;
    }
    __device__ __forceinline__ const char* pa(const Unit& u) const { return A + (size_t)u.pm * ta; }
    __device__ __forceinline__ const char* pb(const Unit& u) const { return Bt + (size_t)u.pn * tb; }
};
struct SchedP1 {
    int G, c; const char* A; const char* Bt;
    __device__ __forceinline__ bool next(int i, Unit& u) const {
        const int L = i * G + c; if (L >= 768) return false;
        const int wgid = (L % 8) * 96 + L / 8;
        if (wgid < 704) { const int nig = 88, gid = wgid / nig, w = wgid % nig; u.pm = gid * 8 + (w & 7); u.pn = w >> 3; }
        else { const int w = wgid - 704; u.pm = 65 + (w & 7); u.pn = 11 + (w >> 3); }
        return true;
    }
    __device__ __forceinline__ const char* pa(const Unit& u) const { return A + (size_t)u.pm * (256 * 1024 * 2); }
    __device__ __forceinline__ const char* pb(const Unit& u) const { return Bt + (size_t)u.pn * (256 * 1024 * 2); }
};
struct SchedOne {
    const char* A; const char* B;
    __device__ __forceinline__ bool next(int i, Unit& u) const { if (i) return false; u.pm = 0; u.pn = 0; return true; }
    __device__ __forceinline__ const char* pa(const Unit&) const { return A; }
    __device__ __forceinline__ const char* pb(const Unit&) const { return B; }
};

typedef GAS bf16 gbf16; typedef GAS float gf32;
__device__ __forceinline__ void st16(gbf16* p, f32x4 v0, f32x4 v1) { u32x4 w; w.x = pk2(v0[0], v0[1]); w.y = pk2(v0[2], v0[3]); w.z = pk2(v1[0], v1[1]); w.w = pk2(v1[2], v1[3]); *(GAS u32x4*)p = w; }
struct EpiP1 {
    static constexpr bool PERM = true, AFTER_DRAIN = false;
    bf16* ZA; bf16* PB; float* outK; float* outV; bf16* KB;
    __device__ __forceinline__ void operator()(const f32x4 (&acc)[2][2][4][2], const Unit& u, int wr, int wc, int fr, int fq) const {
        if (u.pm < 64) {
            const int row0 = u.pm * 256 + wr * 64 + fr; const bool act = u.pn < 4;
            gbf16* base = act ? (gbf16*)ZA : (gbf16*)PB; const int ldc = act ? 1024 : DSH; const int col0 = (act ? u.pn : u.pn - 4) * 256 + wc * 32 + 8 * fq;
#pragma unroll
            for (int ai = 0; ai < 2; ++ai)
#pragma unroll
                for (int m = 0; m < 4; ++m) { gbf16* rowp = base + (size_t)(row0 + ai * 128 + m * 16) * ldc + col0;
#pragma unroll
                    for (int bj = 0; bj < 2; ++bj) { f32x4 v0 = acc[ai][bj][m][0], v1 = acc[ai][bj][m][1];
                        if (act) { f32x2 a = pg8::gelu_pk((f32x2){v0[0], v0[1]}), b = pg8::gelu_pk((f32x2){v0[2], v0[3]}), c = pg8::gelu_pk((f32x2){v1[0], v1[1]}), d = pg8::gelu_pk((f32x2){v1[2], v1[3]});
                            v0 = (f32x4){a.x, a.y, b.x, b.y}; v1 = (f32x4){c.x, c.y, d.x, d.y}; }
                        st16(rowp + bj * 128, v0, v1); } }
        } else {
            const int row0 = (u.pm - 65) * 256 + wr * 64 + fr; const int ct = u.pn - 11; const bool isK = ct < 4; const int col0 = (ct & 3) * 256 + wc * 32 + 8 * fq;
            gf32* o = isK ? (gf32*)outK : (gf32*)outV;
#pragma unroll
            for (int ai = 0; ai < 2; ++ai)
#pragma unroll
                for (int m = 0; m < 4; ++m) { const size_t off = (size_t)(row0 + ai * 128 + m * 16) * 1024 + col0;
#pragma unroll
                    for (int bj = 0; bj < 2; ++bj) { const f32x4 v0 = acc[ai][bj][m][0], v1 = acc[ai][bj][m][1];
                        *(GAS f32x4*)(o + off + bj * 128) = v0; *(GAS f32x4*)(o + off + bj * 128 + 4) = v1;
                        if (isK) st16((gbf16*)KB + off + bj * 128, v0, v1); } }
        }
    }
};
template <bool WB> struct EpiRes {
    static constexpr bool PERM = true, AFTER_DRAIN = false;
    const float* base; float* out; bf16* outb; float* rowss;
    __device__ __forceinline__ void operator()(const f32x4 (&acc)[2][2][4][2], const Unit& u, int wr, int wc, int fr, int fq) const {
        const int row0 = u.pm * 256 + wr * 64 + fr, col0 = u.pn * 256 + wc * 32 + 8 * fq;
#pragma unroll
        for (int ai = 0; ai < 2; ++ai)
#pragma unroll
            for (int m = 0; m < 4; ++m) { const int r = row0 + ai * 128 + m * 16; const size_t off = (size_t)r * 1024 + col0; float ss = 0.f;
#pragma unroll
                for (int bj = 0; bj < 2; ++bj) { const f32x4 b0 = *(const GAS f32x4*)((const gf32*)base + off + bj * 128), b1 = *(const GAS f32x4*)((const gf32*)base + off + bj * 128 + 4);
                    const f32x4 v0 = acc[ai][bj][m][0] + b0, v1 = acc[ai][bj][m][1] + b1;
                    *(GAS f32x4*)((gf32*)out + off + bj * 128) = v0; *(GAS f32x4*)((gf32*)out + off + bj * 128 + 4) = v1;
                    if (WB) st16((gbf16*)outb + off + bj * 128, v0, v1);
                    ss += (v0[0] * v0[0] + v0[1] * v0[1]) + (v0[2] * v0[2] + v0[3] * v0[3]) + (v1[0] * v1[0] + v1[1] * v1[1]) + (v1[2] * v1[2] + v1[3] * v1[3]); }
                ss += __shfl_xor(ss, 16); ss += __shfl_xor(ss, 32);
                if (fq == 0) (void)__hip_atomic_fetch_add(rowss + r, ss, __ATOMIC_RELAXED, __HIP_MEMORY_SCOPE_AGENT); }
    }
};
template <int MODE> struct EpiScale {
    static constexpr bool PERM = true, AFTER_DRAIN = false;
    bf16* O; int ldc; const float* rowss;
    __device__ __forceinline__ void operator()(const f32x4 (&acc)[2][2][4][2], const Unit& u, int wr, int wc, int fr, int fq) const {
        const int row0 = u.pm * 256 + wr * 64 + fr, col0 = u.pn * 256 + wc * 32 + 8 * fq;
#pragma unroll
        for (int ai = 0; ai < 2; ++ai)
#pragma unroll
            for (int m = 0; m < 4; ++m) { const int r = row0 + ai * 128 + m * 16;
                float sc = 1.f / sqrtf(__hip_atomic_load(rowss + r, __ATOMIC_RELAXED, __HIP_MEMORY_SCOPE_AGENT) * (1.f / D) + RMS_EPS); if (MODE == 0) sc *= 0.0625f;
                gbf16* rowp = (gbf16*)O + (size_t)r * ldc + col0;
#pragma unroll
                for (int bj = 0; bj < 2; ++bj) { f32x4 v0 = acc[ai][bj][m][0] * sc, v1 = acc[ai][bj][m][1] * sc;
                    if (MODE == 1) {
#pragma unroll
                        for (int j = 0; j < 4; ++j) { const float a = fmaxf(v0[j], 0.f), b = fmaxf(v1[j], 0.f); v0[j] = a * a; v1[j] = b * b; } }
                    st16(rowp + bj * 128, v0, v1); } }
    }
};
struct EpiSoftmax {
    static constexpr bool PERM = true, AFTER_DRAIN = true;
    bf16* P;
    __device__ __forceinline__ void fused(f32x4 (&acc)[2][2][4][2], const Unit&, int wr, int wc, int fr, int fq, PG8_LAS unsigned char* lds, int, int) const {
        PG8_LAS float* T1 = (PG8_LAS float*)lds; PG8_LAS float* T2 = (PG8_LAS float*)(lds + 4096);
#pragma unroll
        for (int ai = 0; ai < 2; ++ai)
#pragma unroll
            for (int m = 0; m < 4; ++m) { float mx = -3.0e38f;
#pragma unroll
                for (int bj = 0; bj < 2; ++bj)
#pragma unroll
                    for (int n = 0; n < 2; ++n) { const f32x4 x = acc[ai][bj][m][n]; mx = fmaxf(mx, fmaxf(fmaxf(x[0], x[1]), fmaxf(x[2], x[3]))); }
                mx = fmaxf(mx, __shfl_xor(mx, 16)); mx = fmaxf(mx, __shfl_xor(mx, 32));
                if (fq == 0) T1[(ai * 128 + wr * 64 + m * 16 + fr) * 4 + wc] = mx; }
        asm volatile("s_waitcnt lgkmcnt(0)" ::: "memory"); __builtin_amdgcn_s_barrier(); asm volatile("" ::: "memory");
#pragma unroll
        for (int ai = 0; ai < 2; ++ai)
#pragma unroll
            for (int m = 0; m < 4; ++m) { const int row = ai * 128 + wr * 64 + m * 16 + fr; const f32x4 t = *(const PG8_LAS f32x4*)(T1 + row * 4);
                const float mxr = fmaxf(fmaxf(t[0], t[1]), fmaxf(t[2], t[3])) * 1.44269504089f; float sum = 0.f;
#pragma unroll
                for (int bj = 0; bj < 2; ++bj)
#pragma unroll
                    for (int n = 0; n < 2; ++n) { f32x4 x = acc[ai][bj][m][n];
#pragma unroll
                        for (int j = 0; j < 4; ++j) { x[j] = __builtin_amdgcn_exp2f(x[j] * 1.44269504089f - mxr); sum += x[j]; }
                        acc[ai][bj][m][n] = x; }
                sum += __shfl_xor(sum, 16); sum += __shfl_xor(sum, 32);
                if (fq == 0) T2[row * 4 + wc] = sum; }
        asm volatile("s_waitcnt lgkmcnt(0)" ::: "memory"); __builtin_amdgcn_s_barrier(); asm volatile("" ::: "memory");
#pragma unroll
        for (int ai = 0; ai < 2; ++ai)
#pragma unroll
            for (int m = 0; m < 4; ++m) { const int row = ai * 128 + wr * 64 + m * 16 + fr; const f32x4 t = *(const PG8_LAS f32x4*)(T2 + row * 4);
                const float inv = 1.f / ((t[0] + t[1]) + (t[2] + t[3]));
                gbf16* rowp = (gbf16*)P + (size_t)row * 256 + wc * 32 + 8 * fq;
#pragma unroll
                for (int bj = 0; bj < 2; ++bj) st16(rowp + bj * 128, acc[ai][bj][m][0] * inv, acc[ai][bj][m][1] * inv); }
        asm volatile("s_waitcnt vmcnt(0) lgkmcnt(0)" ::: "memory"); __builtin_amdgcn_s_barrier(); asm volatile("" ::: "memory");
    }
};
struct EpiAttnO {
    static constexpr bool PERM = true, AFTER_DRAIN = false;
    bf16* O;
    __device__ __forceinline__ void operator()(const f32x4 (&acc)[2][2][4][2], const Unit&, int wr, int wc, int fr, int fq) const {
#pragma unroll
        for (int ai = 0; ai < 2; ++ai)
#pragma unroll
            for (int m = 0; m < 4; ++m) { gbf16* rowp = (gbf16*)O + (size_t)(ai * 128 + wr * 64 + m * 16 + fr) * 1024 + wc * 32 + 8 * fq;
#pragma unroll
                for (int bj = 0; bj < 2; ++bj) st16(rowp + bj * 128, acc[ai][bj][m][0], acc[ai][bj][m][1]); }
    }
};

__device__ __forceinline__ f32x4 shift4(const bf16* p, const bf16* q, const float* mu) {
    const f32x4 a = bf4(*(const u32x2*)p), b = bf4(*(const u32x2*)q), m = *(const f32x4*)mu; return a + (b - a) * m;
}
__device__ __forceinline__ void rwkv_prep_tile(LAS unsigned char* lds, int tile, const bf16* PB, const bf16* ZROW, const float* mu, const bf16* W2T, const bf16* A2T, const bf16* G2T,
                                               const float* w0, const float* a0, const float* k_k, const float* k_a, float* SCN, bf16* G, int tid, int wave, int lane) {
    const int m0 = tile * 64, fr = lane & 15, fq = lane >> 4, h = wave;
    LAS bf16* LA = (LAS bf16*)lds;
    {   const int r = tid >> 3, cg = (tid & 7) * 32, m = m0 + r;
        const bf16* prow = PB + (size_t)m * DSH + 1536 + cg; const bf16* qrow = ((m & (SEQ - 1)) == 0) ? ZROW : (PB + (size_t)(m - 1) * DSH + 1536 + cg);
        const int mode = cg < 64 ? 0 : (cg < 128 ? 1 : 2);
#pragma unroll
        for (int j = 0; j < 4; ++j) {
            const u32x4 pv = *(const u32x4*)(prow + 8 * j), qv = *(const u32x4*)(qrow + 8 * j);
            const f32x4 m0v = *(const f32x4*)(mu + 1536 + cg + 8 * j), m1v = *(const f32x4*)(mu + 1536 + cg + 8 * j + 4);
            float x[8];
            { const float p0 = bf_lo(pv.x), p1 = bf_hi(pv.x), p2 = bf_lo(pv.y), p3 = bf_hi(pv.y), p4 = bf_lo(pv.z), p5 = bf_hi(pv.z), p6 = bf_lo(pv.w), p7 = bf_hi(pv.w);
              const float q0 = bf_lo(qv.x), q1 = bf_hi(qv.x), q2 = bf_lo(qv.y), q3 = bf_hi(qv.y), q4 = bf_lo(qv.z), q5 = bf_hi(qv.z), q6 = bf_lo(qv.w), q7 = bf_hi(qv.w);
              x[0] = p0 + (q0 - p0) * m0v[0]; x[1] = p1 + (q1 - p1) * m0v[1]; x[2] = p2 + (q2 - p2) * m0v[2]; x[3] = p3 + (q3 - p3) * m0v[3];
              x[4] = p4 + (q4 - p4) * m1v[0]; x[5] = p5 + (q5 - p5) * m1v[1]; x[6] = p6 + (q6 - p6) * m1v[2]; x[7] = p7 + (q7 - p7) * m1v[3]; }
#pragma unroll
            for (int e = 0; e < 8; ++e) x[e] = mode == 0 ? fast_tanh(x[e]) : (mode == 1 ? x[e] : fast_sigmoid(x[e]));
            u32x4 o; o.x = pk2(x[0], x[1]); o.y = pk2(x[2], x[3]); o.z = pk2(x[4], x[5]); o.w = pk2(x[6], x[7]);
            *(LAS u32x4*)(LA + r * 264 + cg + 8 * j) = o;
        }
    }
    __syncthreads();
#pragma unroll 1
    for (int mt = 0; mt < 4; ++mt) {
        f32x4 aw[4], aa[4], ag[4];
#pragma unroll
        for (int n = 0; n < 4; ++n) { aw[n] = (f32x4){0.f, 0.f, 0.f, 0.f}; aa[n] = aw[n]; ag[n] = aw[n]; }
        const LAS bf16* arow = LA + (16 * mt + fr) * 264 + 8 * fq;
#pragma unroll
        for (int ks = 0; ks < 2; ++ks) {
            const bf16x8 bw = *(const LAS bf16x8*)(arow + 32 * ks), ba = *(const LAS bf16x8*)(arow + 64 + 32 * ks);
#pragma unroll
            for (int n = 0; n < 4; ++n) {
                const bf16x8 ww = *(const bf16x8*)(W2T + (size_t)(64 * h + 16 * n + fr) * 64 + 32 * ks + 8 * fq), wa = *(const bf16x8*)(A2T + (size_t)(64 * h + 16 * n + fr) * 64 + 32 * ks + 8 * fq);
                aw[n] = __builtin_amdgcn_mfma_f32_16x16x32_bf16(ww, bw, aw[n], 0, 0, 0); aa[n] = __builtin_amdgcn_mfma_f32_16x16x32_bf16(wa, ba, aa[n], 0, 0, 0); }
        }
#pragma unroll
        for (int ks = 0; ks < 4; ++ks) {
            const bf16x8 bg = *(const LAS bf16x8*)(arow + 128 + 32 * ks);
#pragma unroll
            for (int n = 0; n < 4; ++n) { const bf16x8 wg = *(const bf16x8*)(G2T + (size_t)(64 * h + 16 * n + fr) * 128 + 32 * ks + 8 * fq);
                ag[n] = __builtin_amdgcn_mfma_f32_16x16x32_bf16(wg, bg, ag[n], 0, 0, 0); }
        }
        const int m = m0 + 16 * mt + fr; const bool first = (m & (SEQ - 1)) == 0;
        const bf16* prow = PB + (size_t)m * DSH; const bf16* qrow = first ? ZROW : (PB + (size_t)(m - 1) * DSH);
        f32x4 ksv[4], kkv[4]; float ssq = 0.f;
#pragma unroll
        for (int n = 0; n < 4; ++n) { const int c = 64 * h + 16 * n + 4 * fq;
            ksv[n] = shift4(prow + 512 + c, first ? ZROW : (qrow + 512 + c), mu + 512 + c);
            kkv[n] = ksv[n] * *(const f32x4*)(k_k + c);
            ssq += (kkv[n][0] * kkv[n][0] + kkv[n][1] * kkv[n][1]) + (kkv[n][2] * kkv[n][2] + kkv[n][3] * kkv[n][3]); }
        ssq += __shfl_xor(ssq, 16); ssq += __shfl_xor(ssq, 32);
        const float inv = 1.f / fmaxf(sqrtf(ssq), 1e-12f);
        float* sc = SCN + ((size_t)((m >> 11) * 8 + h) * SEQ + (m & (SEQ - 1))) * 384;
#pragma unroll
        for (int n = 0; n < 4; ++n) { const int c = 64 * h + 16 * n + 4 * fq, cl = 16 * n + 4 * fq;
            const f32x4 rs = shift4(prow + c, first ? ZROW : (qrow + c), mu + c), vs = shift4(prow + 1024 + c, first ? ZROW : (qrow + 1024 + c), mu + 1024 + c);
            const f32x4 wl = *(const f32x4*)(w0 + c) + aw[n], al = *(const f32x4*)(a0 + c) + aa[n], ka = *(const f32x4*)(k_a + c);
            f32x4 dec, av, kp;
#pragma unroll
            for (int j = 0; j < 4; ++j) { const float z = -wl[j]; const float sp = fmaxf(z, 0.f) + fast_log(1.f + fast_exp(-fabsf(z))); const float w = -sp - 0.5f;
                dec[j] = fast_exp(-fast_exp(w)); av[j] = fast_sigmoid(al[j]); kp[j] = ksv[n][j] * (1.f + (av[j] - 1.f) * ka[j]); }
            const f32x4 kk = kkv[n] * inv;
            *(f32x4*)(sc + 0 + cl) = rs; *(f32x4*)(sc + 64 + cl) = dec; *(f32x4*)(sc + 128 + cl) = kp; *(f32x4*)(sc + 192 + cl) = -kk; *(f32x4*)(sc + 256 + cl) = kk * av; *(f32x4*)(sc + 320 + cl) = vs;
            *(u32x2*)(G + (size_t)m * DB + c) = pk4(ag[n]); }
    }
    __syncthreads();
}

__device__ __forceinline__ void scan_block(LAS unsigned char* lds, int bh, const float* SCN, const bf16* G, const float* ln_g, const float* ln_b, const float* r_k, bf16* MIX, float* out_wkv, int tid, int wave, int lane) {
    const int b = bh >> 3, h = bh & 7;
    LAS float* BUF = (LAS float*)lds;
    LAS float* YB = (LAS float*)(lds + 98304);
    const float* src = SCN + (size_t)bh * SEQ * 384;
    f32x4 st[6];
#pragma unroll
    for (int j = 0; j < 6; ++j) st[j] = *(const f32x4*)(src + (size_t)(j * 512 + tid) * 4);
#pragma unroll
    for (int j = 0; j < 6; ++j) *(LAS f32x4*)(BUF + (j * 512 + tid) * 4) = st[j];
    __syncthreads();
    const int rr = lane >> 3, kq = lane & 7, v = 8 * wave + rr;
    float S[8];
#pragma unroll
    for (int j = 0; j < 8; ++j) S[j] = 0.f;
    const int tt = tid >> 4, l16 = tid & 15;
    const f32x4 lg4 = *(const f32x4*)(ln_g + 64 * h + 4 * l16), lb4 = *(const f32x4*)(ln_b + 64 * h + 4 * l16), rk4 = *(const f32x4*)(r_k + 64 * h + 4 * l16);
#pragma unroll 1
    for (int c = 0; c < 64; ++c) {
        const LAS float* B = BUF + (c & 1) * 12288;
        if (c + 1 < 64) {
#pragma unroll
            for (int j = 0; j < 6; ++j) st[j] = *(const f32x4*)(src + (size_t)(c + 1) * 12288 + (size_t)(j * 512 + tid) * 4); }
        f32x4 nr0, nr1, nd0, nd1, nk0, nk1, na0, na1, nb0, nb1; float nv;
        { const LAS float* P = B + 8 * kq; nr0 = *(const LAS f32x4*)(P); nr1 = *(const LAS f32x4*)(P + 4); nd0 = *(const LAS f32x4*)(P + 64); nd1 = *(const LAS f32x4*)(P + 68); nk0 = *(const LAS f32x4*)(P + 128); nk1 = *(const LAS f32x4*)(P + 132);
          na0 = *(const LAS f32x4*)(P + 192); na1 = *(const LAS f32x4*)(P + 196); nb0 = *(const LAS f32x4*)(P + 256); nb1 = *(const LAS f32x4*)(P + 260); nv = B[320 + v]; }
#pragma unroll 2
        for (int t = 0; t < 32; ++t) {
            const f32x4 r0 = nr0, r1 = nr1, d0 = nd0, d1 = nd1, k0 = nk0, k1 = nk1, a0 = na0, a1 = na1, b0 = nb0, b1 = nb1; const float vv = nv;
            { const int tn = t < 31 ? t + 1 : 31; const LAS float* P = B + tn * 384 + 8 * kq; nr0 = *(const LAS f32x4*)(P); nr1 = *(const LAS f32x4*)(P + 4); nd0 = *(const LAS f32x4*)(P + 64); nd1 = *(const LAS f32x4*)(P + 68); nk0 = *(const LAS f32x4*)(P + 128); nk1 = *(const LAS f32x4*)(P + 132);
              na0 = *(const LAS f32x4*)(P + 192); na1 = *(const LAS f32x4*)(P + 196); nb0 = *(const LAS f32x4*)(P + 256); nb1 = *(const LAS f32x4*)(P + 260); nv = B[tn * 384 + 320 + v]; }
            float sa = (S[0] * a0[0] + S[1] * a0[1]) + (S[2] * a0[2] + S[3] * a0[3]) + ((S[4] * a1[0] + S[5] * a1[1]) + (S[6] * a1[2] + S[7] * a1[3]));
            sa = red8(sa);
#pragma unroll
            for (int j = 0; j < 4; ++j) { S[j] = S[j] * d0[j] + (sa * b0[j] + vv * k0[j]); S[4 + j] = S[4 + j] * d1[j] + (sa * b1[j] + vv * k1[j]); }
            float y = (S[0] * r0[0] + S[1] * r0[1]) + (S[2] * r0[2] + S[3] * r0[3]) + ((S[4] * r1[0] + S[5] * r1[1]) + (S[6] * r1[2] + S[7] * r1[3]));
            y = red8(y);
            if (kq == 0) YB[t * 64 + v] = y;
        }
        __syncthreads();
        {
            const LAS float* P = B + tt * 384; const int m = b * SEQ + c * 32 + tt;
            const f32x4 y4 = *(const LAS f32x4*)(YB + tt * 64 + 4 * l16);
            const float mean = red16((y4[0] + y4[1]) + (y4[2] + y4[3])) * (1.f / 64.f);
            const f32x4 d4 = y4 - mean;
            const float var = red16((d4[0] * d4[0] + d4[1] * d4[1]) + (d4[2] * d4[2] + d4[3] * d4[3])) * (1.f / 64.f);
            const float rstd = 1.f / sqrtf(var + GN_EPS);
            const f32x4 r4 = *(const LAS f32x4*)(P + 4 * l16), k4 = *(const LAS f32x4*)(P + 128 + 4 * l16), v4 = *(const LAS f32x4*)(P + 320 + 4 * l16);
            const f32x4 rk = r4 * k4 * rk4;
            const float bon = red16((rk[0] + rk[1]) + (rk[2] + rk[3]));
            const f32x4 g4 = bf4(*(const u32x2*)(G + (size_t)m * DB + 64 * h + 4 * l16));
            const f32x4 o = ((d4 * rstd) * lg4 + lb4 + v4 * bon) * g4;
            *(u32x2*)(MIX + (size_t)m * 1024 + 512 + 64 * h + 4 * l16) = pk4(o);
        }
        if (c + 1 < 64) {
            LAS float* Bn = BUF + ((c + 1) & 1) * 12288;
#pragma unroll
            for (int j = 0; j < 6; ++j) *(LAS f32x4*)(Bn + (j * 512 + tid) * 4) = st[j]; }
        __syncthreads();
    }
    float* o = out_wkv + ((size_t)bh * 64 + v) * 64 + 8 * kq;
    *(f32x4*)o = (f32x4){S[0], S[1], S[2], S[3]}; *(f32x4*)(o + 4) = (f32x4){S[4], S[5], S[6], S[7]};
}

__device__ __forceinline__ void mixer_a_tile(LAS unsigned char* lds, int tile, const bf16* ZA, const bf16* WSB, const float* gm_ln_g, const float* gm_ln_b, const float* gm_bs, bf16* MIX, float* out_cv, int tid, int wave, int lane) {
    const int h = tile & 3, bc = tile >> 2, m0 = bc * 128, fr = lane & 15, fq = lane >> 4; const bool lastc = (bc & 15) == 15;
    LAS bf16* VT = (LAS bf16*)lds;
    {   const int r = 16 * wave + (lane >> 2), cq = (lane & 3) * 32; const bf16* src = ZA + (size_t)(m0 + r) * 1024 + 512 + h * 128 + cq;
        float x[32]; float s = 0.f;
#pragma unroll
        for (int j = 0; j < 4; ++j) { const u32x4 pv = *(const u32x4*)(src + 8 * j);
            x[8 * j + 0] = bf_lo(pv.x); x[8 * j + 1] = bf_hi(pv.x); x[8 * j + 2] = bf_lo(pv.y); x[8 * j + 3] = bf_hi(pv.y); x[8 * j + 4] = bf_lo(pv.z); x[8 * j + 5] = bf_hi(pv.z); x[8 * j + 6] = bf_lo(pv.w); x[8 * j + 7] = bf_hi(pv.w); }
#pragma unroll
        for (int j = 0; j < 32; ++j) s += x[j];
        const float mean = red4(s) * (1.f / 128.f); float q = 0.f;
#pragma unroll
        for (int j = 0; j < 32; ++j) { x[j] -= mean; q += x[j] * x[j]; }
        const float rstd = 1.f / sqrtf(red4(q) * (1.f / 128.f) + LN_EPS);
#pragma unroll
        for (int j = 0; j < 8; ++j) { const f32x4 g = *(const f32x4*)(gm_ln_g + h * 128 + cq + 4 * j), bb = *(const f32x4*)(gm_ln_b + h * 128 + cq + 4 * j);
#pragma unroll
            for (int e = 0; e < 4; ++e) x[4 * j + e] = x[4 * j + e] * rstd * g[e] + bb[e]; }
        if (lastc) { float* o = out_cv + ((size_t)((bc >> 4) * 128 + r) * 4 + h) * 128 + cq;
#pragma unroll
            for (int j = 0; j < 8; ++j) *(f32x4*)(o + 4 * j) = (f32x4){x[4 * j], x[4 * j + 1], x[4 * j + 2], x[4 * j + 3]}; }
#pragma unroll
        for (int j = 0; j < 32; j += 2) { const unsigned w = pk2(x[j], x[j + 1]); VT[(cq + j) * 136 + r] = (bf16)(w & 0xffffu); VT[(cq + j + 1) * 136 + r] = (bf16)(w >> 16); }
    }
    __syncthreads();
    f32x4 acc[8];
#pragma unroll
    for (int n = 0; n < 8; ++n) acc[n] = (f32x4){0.f, 0.f, 0.f, 0.f};
    const int nks = (wave >> 1) + 1;
    for (int ks = 0; ks < nks; ++ks) {
        const bf16x8 wsf = *(const bf16x8*)(WSB + (size_t)(h * 128 + 16 * wave + fr) * 128 + 32 * ks + 8 * fq);
#pragma unroll
        for (int n = 0; n < 8; ++n) { const bf16x8 vf = *(const LAS bf16x8*)(VT + (16 * n + fr) * 136 + 32 * ks + 8 * fq); acc[n] = __builtin_amdgcn_mfma_f32_16x16x32_bf16(vf, wsf, acc[n], 0, 0, 0); }
    }
    {   const int t = 16 * wave + fr; const float bsv = gm_bs[h * 128 + t]; const size_t rowo = (size_t)(m0 + t) * 1024 + h * 128;
#pragma unroll
        for (int n = 0; n < 8; ++n) { const int p0 = 16 * n + 4 * fq; const f32x4 u4 = bf4(*(const u32x2*)(ZA + rowo + p0)); *(u32x2*)(MIX + rowo + p0) = pk4(u4 * (acc[n] + bsv)); }
    }
    __syncthreads();
}

template <class EpiF>
__device__ __forceinline__ void small_gemm(LAS unsigned char* lds, const bf16* A, int lda, const bf16* Bt, int N, int K, int gb, int GB, const EpiF& epi, int tid, int wave, int lane) {
    const int fr = lane & 15, fq = lane >> 4, kw = K >> 3;
    LAS float* part = (LAS float*)lds;
    for (int strip = gb; strip < (N >> 4); strip += GB) {
        f32x4 acc[8];
#pragma unroll
        for (int i = 0; i < 8; ++i) acc[i] = (f32x4){0.f, 0.f, 0.f, 0.f};
        const bf16* brow = Bt + (size_t)(16 * strip + fr) * K + wave * kw + 8 * fq;
        const bf16* arow = A + (size_t)fr * lda + wave * kw + 8 * fq;
#pragma unroll 2
        for (int ks = 0; ks < (kw >> 5); ++ks) {
            const bf16x8 wf = *(const bf16x8*)(brow + 32 * ks);
#pragma unroll
            for (int mt = 0; mt < 8; ++mt) { const bf16x8 af = *(const bf16x8*)(arow + (size_t)(16 * mt) * lda + 32 * ks); acc[mt] = __builtin_amdgcn_mfma_f32_16x16x32_bf16(wf, af, acc[mt], 0, 0, 0); }
        }
#pragma unroll
        for (int mt = 0; mt < 8; ++mt) *(LAS f32x4*)(part + ((wave * 128 + 16 * mt + fr) * 16 + 4 * fq)) = acc[mt];
        __syncthreads();
        {   const int token = tid >> 2, cg = tid & 3; f32x4 s = (f32x4){0.f, 0.f, 0.f, 0.f};
#pragma unroll
            for (int w = 0; w < 8; ++w) s += *(const LAS f32x4*)(part + ((w * 128 + token) * 16 + 4 * cg));
            epi(token, 16 * strip + 4 * cg, s); }
        __syncthreads();
    }
}
struct SEpiProj { bf16* ZAs; float* PBs;
    __device__ __forceinline__ void operator()(int t, int c, f32x4 s) const {
        if (c < 1024) { const f32x2 a = pg8::gelu_pk((f32x2){s[0], s[1]}), b = pg8::gelu_pk((f32x2){s[2], s[3]}); *(u32x2*)(ZAs + (size_t)t * 1024 + c) = pk4((f32x4){a.x, a.y, b.x, b.y}); }
        else *(f32x4*)(PBs + (size_t)t * DSH + (c - 1024)) = s; } };
template <bool WB> struct SEpiRes { const float* base; float* out; bf16* outb; float* rowss;
    __device__ __forceinline__ void operator()(int t, int c, f32x4 s) const {
        const f32x4 v = *(const f32x4*)(base + (size_t)t * 1024 + c) + s; *(f32x4*)(out + (size_t)t * 1024 + c) = v; if (WB) *(u32x2*)(outb + (size_t)t * 1024 + c) = pk4(v);
        float ss = (v[0] * v[0] + v[1] * v[1]) + (v[2] * v[2] + v[3] * v[3]); ss = red4(ss);
        if ((threadIdx.x & 3) == 0) (void)__hip_atomic_fetch_add(rowss + t, ss, __ATOMIC_RELAXED, __HIP_MEMORY_SCOPE_AGENT); } };
struct SEpiQ { float* Q; const float* rowss;
    __device__ __forceinline__ void operator()(int t, int c, f32x4 s) const {
        const float sc = 0.0625f / sqrtf(__hip_atomic_load(rowss + t, __ATOMIC_RELAXED, __HIP_MEMORY_SCOPE_AGENT) * (1.f / D) + RMS_EPS); *(f32x4*)(Q + (size_t)t * 1024 + c) = s * sc; } };
struct SEpiUp { bf16* H; const float* rowss;
    __device__ __forceinline__ void operator()(int t, int c, f32x4 s) const {
        const float sc = 1.f / sqrtf(__hip_atomic_load(rowss + t, __ATOMIC_RELAXED, __HIP_MEMORY_SCOPE_AGENT) * (1.f / D) + RMS_EPS); f32x4 v = s * sc;
#pragma unroll
        for (int j = 0; j < 4; ++j) { const float a = fmaxf(v[j], 0.f); v[j] = a * a; }
        *(u32x2*)(H + (size_t)t * FF + c) = pk4(v); } };

struct KArgs { const float* in[35]; float* out; unsigned char* ws; };
struct SampleCtx { unsigned* subcnt; unsigned* tmo; float* rs1; float* rs2; float* rs3; };
__device__ __forceinline__ void sample_mixer_token(LAS unsigned char* lds, int tok, const KArgs& KA, const bf16* ZAs, const float* PBs, bf16* MIXs, int tid, int wave, int lane) {
    const float* const (&in)[35] = KA.in; float* out = KA.out;
    LAS float* red = (LAS float*)lds;
    LAS float* lin = (LAS float*)(lds + 256);
    LAS float* vec = (LAS float*)(lds + 2048);
    const int c = tid;
    {   const int hA = c >> 7; const float vz = bf1(ZAs[(size_t)tok * 1024 + 512 + c]), uz = bf1(ZAs[(size_t)tok * 1024 + c]);
        const float s1 = wave_sum(vz); if (lane == 0) red[wave] = s1;
        __syncthreads();
        const float mean = (red[2 * hA] + red[2 * hA + 1]) * (1.f / 128.f); const float dv = vz - mean;
        const float s2 = wave_sum(dv * dv); if (lane == 0) red[8 + wave] = s2;
        __syncthreads();
        const float var = (red[8 + 2 * hA] + red[8 + 2 * hA + 1]) * (1.f / 128.f);
        const float vn = dv * (1.f / sqrtf(var + LN_EPS)) * in[10][c] + in[11][c];
        out[O_CVS + (size_t)tok * 512 + c] = vn;
        const float mixed = in[12][(size_t)hA * 128 * 128] * vn + in[13][hA * 128];
        MIXs[(size_t)tok * 1024 + c] = (bf16)(pk2(uz * mixed, 0.f) & 0xffffu);
    }
    const float* pb = PBs + (size_t)tok * DSH; const float* pv = in[5] + (size_t)tok * DSH; const float* mu = in[9];
    if (tid < 256) { const int i = 1536 + tid; const float x = pb[i] + (pv[i] - pb[i]) * mu[i]; lin[tid] = tid < 64 ? fast_tanh(x) : (tid < 128 ? x : fast_sigmoid(x)); }
    __syncthreads();
    const float rs = pb[c] + (pv[c] - pb[c]) * mu[c], ks = pb[512 + c] + (pv[512 + c] - pb[512 + c]) * mu[512 + c], vs = pb[1024 + c] + (pv[1024 + c] - pb[1024 + c]) * mu[1024 + c];
    float wl = in[14][c], al = in[16][c], g = 0.f;
    { const float* w2 = in[15] + c; const float* a2 = in[17] + c; const float* g2 = in[18] + c;
#pragma unroll 8
      for (int j = 0; j < 64; ++j) { wl += lin[j] * w2[(size_t)j * DB]; al += lin[64 + j] * a2[(size_t)j * DB]; }
#pragma unroll 8
      for (int j = 0; j < 128; ++j) g += lin[128 + j] * g2[(size_t)j * DB]; }
    const float z = -wl, sp = fmaxf(z, 0.f) + fast_log(1.f + fast_exp(-fabsf(z))), w = -sp - 0.5f, dec = fast_exp(-fast_exp(w)), av = fast_sigmoid(al);
    const float kkr = ks * in[19][c]; const float nrm = sqrtf(wave_sum(kkr * kkr)); const float kk = kkr / fmaxf(nrm, 1e-12f); const float kp = ks * (1.f + (av - 1.f) * in[20][c]);
    LAS float* hv = vec + wave * 320;
    hv[lane] = dec; hv[64 + lane] = -kk; hv[128 + lane] = kk * av; hv[192 + lane] = kp; hv[256 + lane] = rs;
    __syncthreads();
    {   const size_t so = ((size_t)(tok * 8 + wave) * 64 + lane) * 64; const float* s0 = in[6] + so; float* s1o = out + O_WKVS + so;
        f32x4 Sx[16]; float sa = 0.f;
#pragma unroll
        for (int j = 0; j < 16; ++j) { Sx[j] = *(const f32x4*)(s0 + 4 * j); const f32x4 a4 = *(const LAS f32x4*)(hv + 64 + 4 * j); sa += (Sx[j][0] * a4[0] + Sx[j][1] * a4[1]) + (Sx[j][2] * a4[2] + Sx[j][3] * a4[3]); }
        float y = 0.f;
#pragma unroll
        for (int j = 0; j < 16; ++j) { const f32x4 d4 = *(const LAS f32x4*)(hv + 4 * j), b4 = *(const LAS f32x4*)(hv + 128 + 4 * j), k4 = *(const LAS f32x4*)(hv + 192 + 4 * j), r4 = *(const LAS f32x4*)(hv + 256 + 4 * j);
            const f32x4 sn = Sx[j] * d4 + (b4 * sa + k4 * vs); *(f32x4*)(s1o + 4 * j) = sn; y += (sn[0] * r4[0] + sn[1] * r4[1]) + (sn[2] * r4[2] + sn[3] * r4[3]); }
        const float mean = wave_sum(y) * (1.f / 64.f), dy = y - mean, var = wave_sum(dy * dy) * (1.f / 64.f);
        const float yn = dy * (1.f / sqrtf(var + GN_EPS)) * in[22][c] + in[23][c];
        const float bon = wave_sum(rs * kp * in[21][c]) * vs;
        MIXs[(size_t)tok * 1024 + 512 + c] = (bf16)(pk2((yn + bon) * g, 0.f) & 0xffffu);
    }
    __syncthreads();
}
__device__ __forceinline__ void sample_attn_pair(LAS unsigned char* lds, int pair, const float* Qs, const float* Kc, const float* Vc, bf16* Os, int tid, int wave, int lane) {
    const int b = pair >> 2, h = pair & 3;
    LAS float* sc = (LAS float*)lds;
    LAS float* part = (LAS float*)(lds + 1024);
    const f32x4 q4 = *(const f32x4*)(Qs + (size_t)b * 1024 + h * 256 + 4 * lane);
    const float* kb = Kc + ((size_t)b * 256 * 4 + h) * 256 + 4 * lane; const float* vb = Vc + ((size_t)b * 256 * 4 + h) * 256 + 4 * lane;
#pragma unroll 4
    for (int i = 0; i < 32; ++i) { const int mm = 32 * wave + i; const f32x4 k4 = *(const f32x4*)(kb + (size_t)mm * 1024);
        const float p = wave_sum((q4[0] * k4[0] + q4[1] * k4[1]) + (q4[2] * k4[2] + q4[3] * k4[3])); if (lane == 0) sc[mm] = p; }
    __syncthreads();
    {   const f32x4 s4 = *(const LAS f32x4*)(sc + 4 * lane); const float mx = wave_max(fmaxf(fmaxf(s4[0], s4[1]), fmaxf(s4[2], s4[3])));
        f32x4 e; float sum = 0.f;
#pragma unroll
        for (int j = 0; j < 4; ++j) { e[j] = fast_exp(s4[j] - mx); sum += e[j]; }
        sum = wave_sum(sum); const float inv = 1.f / sum;
        __syncthreads();
        if (wave == 0) *(LAS f32x4*)(sc + 4 * lane) = e * inv;
    }
    __syncthreads();
    f32x4 o = (f32x4){0.f, 0.f, 0.f, 0.f};
#pragma unroll 4
    for (int i = 0; i < 32; ++i) { const int mm = 32 * wave + i; const f32x4 v4 = *(const f32x4*)(vb + (size_t)mm * 1024); o += v4 * sc[mm]; }
    *(LAS f32x4*)(part + wave * 256 + 4 * lane) = o;
    __syncthreads();
    if (tid < 256) { float s = 0.f;
#pragma unroll
        for (int w = 0; w < 8; ++w) s += part[w * 256 + tid];
        Os[(size_t)b * 1024 + h * 256 + tid] = (bf16)(pk2(s, 0.f) & 0xffffu); }
    __syncthreads();
}
__device__ __forceinline__ void sample_path(LAS unsigned char* lds, const KArgs& KA, const SampleCtx& C, int gb, int GB, int tid, int wave, int lane) {
    unsigned char* ws = KA.ws; unsigned char* sm = ws + WS_SMP; const float* const (&in)[35] = KA.in; float* out = KA.out;
    const bf16* XN0s = (const bf16*)(ws + WS_ACAT) + (size_t)M * 1024;
    bf16* ZAs = (bf16*)(sm + SM_ZA); bf16* MIXs = (bf16*)(sm + SM_MIX); float* X1s = (float*)(sm + SM_X1); bf16* X1Bs = (bf16*)(sm + SM_X1B); float* Qs = (float*)(sm + SM_Q); bf16* Os = (bf16*)(sm + SM_O);
    float* X2s = (float*)(sm + SM_X2); bf16* X2Bs = (bf16*)(sm + SM_X2B); bf16* HIDs = (bf16*)(sm + SM_HID); float* X3s = (float*)(sm + SM_X3);
    float* PBs = out + O_SHS;
    unsigned gen = 0;
#define SUBBAR() do { ++gen; sub_barrier(C.subcnt, C.tmo, gen * (unsigned)GB); } while (0)
    { SEpiProj e{ZAs, PBs}; small_gemm(lds, XN0s, 1024, (const bf16*)(ws + WS_WCAT), DIN, 1024, gb, GB, e, tid, wave, lane); }
    SUBBAR();
    for (int tok = gb; tok < MS; tok += GB) sample_mixer_token(lds, tok, KA, ZAs, PBs, MIXs, tid, wave, lane);
    SUBBAR();
    { SEpiRes<true> e{in[1], X1s, X1Bs, C.rs1 + M}; small_gemm(lds, MIXs, 1024, (const bf16*)(ws + WS_WOUT), 1024, 1024, gb, GB, e, tid, wave, lane); }
    SUBBAR();
    { SEpiQ e{Qs, C.rs1 + M}; small_gemm(lds, X1Bs, 1024, (const bf16*)(ws + WS_WQ), 1024, 1024, gb, GB, e, tid, wave, lane); }
    SUBBAR();
    for (int pair = gb; pair < MS * 4; pair += GB) sample_attn_pair(lds, pair, Qs, in[3], in[4], Os, tid, wave, lane);
    SUBBAR();
    { SEpiRes<true> e{X1s, X2s, X2Bs, C.rs2 + M}; small_gemm(lds, Os, 1024, (const bf16*)(ws + WS_WO), 1024, 1024, gb, GB, e, tid, wave, lane); }
    SUBBAR();
    { SEpiUp e{HIDs, C.rs2 + M}; small_gemm(lds, X2Bs, 1024, (const bf16*)(ws + WS_WUP), FF, 1024, gb, GB, e, tid, wave, lane); }
    SUBBAR();
    { SEpiRes<false> e{X2s, X3s, nullptr, C.rs3 + M}; small_gemm(lds, HIDs, FF, (const bf16*)(ws + WS_WDN), 1024, FF, gb, GB, e, tid, wave, lane); }
    SUBBAR();
    for (int r = gb * 8 + wave; r < MS; r += GB * 8) {
        const float sc = 1.f / sqrtf(__hip_atomic_load(C.rs3 + M + r, __ATOMIC_RELAXED, __HIP_MEMORY_SCOPE_AGENT) * (1.f / D) + RMS_EPS);
#pragma unroll
        for (int j = 0; j < 4; ++j) { const int cc = 256 * j + 4 * lane; *(f32x4*)(out + O_YS + (size_t)r * 1024 + cc) = *(const f32x4*)(X3s + (size_t)r * 1024 + cc) * sc * *(const f32x4*)(in[34] + cc); } }
#undef SUBBAR
}

__global__ void __launch_bounds__(NWAVES * 64, 2) mk_fwd(KArgs a) {
    extern __shared__ __attribute__((aligned(16))) unsigned char lds_raw[];
    LAS unsigned char* lds = (LAS unsigned char*)lds_raw;
    volatile LAS unsigned* MISC = (volatile LAS unsigned*)(lds + MISC_OFF);
    const int tid = threadIdx.x, lane = tid & 63, wave = __builtin_amdgcn_readfirstlane(tid >> 6);
    const int G = gridDim.x, bx = blockIdx.x; const int vcu = (G % 8 == 0) ? (bx % 8) * (G / 8) + bx / 8 : bx;
    unsigned char* ws = a.ws; float* out = a.out;
    gu32* ctl = (gu32*)(ws + WS_CTL);
    for (int u = tid; u < (LDS_BYTES - LDSCTL_OFF) / 4; u += NWAVES * 64) ((LAS unsigned*)(lds + LDSCTL_OFF))[u] = 0u;
    __syncthreads();
    XcdBarrier bar = xcd_barrier_post((unsigned*)ctl + CW_BAR, MISC + 8);
#define GRID_BAR() xcd_barrier(bar)
#define RS1 ((float*)ws + RS_OFF)
#define RS2 ((float*)ws + RS_OFF + RS_STRIDE)
#define RS3 ((float*)ws + RS_OFF + 2 * RS_STRIDE)
#define WCAT ((bf16*)(ws + WS_WCAT))
#define WOUT ((bf16*)(ws + WS_WOUT))
#define WQ ((bf16*)(ws + WS_WQ))
#define WO ((bf16*)(ws + WS_WO))
#define WUP ((bf16*)(ws + WS_WUP))
#define WDN ((bf16*)(ws + WS_WDN))
#define W2T ((bf16*)(ws + WS_SMALL))
#define A2T ((bf16*)(ws + WS_SMALL + 64 * KiB))
#define G2T ((bf16*)(ws + WS_SMALL + 128 * KiB))
#define WSB ((bf16*)(ws + WS_SMALL + 256 * KiB))
#define ZROW ((bf16*)(ws + WS_SMALL + 384 * KiB))
#define ACAT ((bf16*)(ws + WS_ACAT))
#define ZA ((bf16*)(ws + WS_ZA))
#define PB ((bf16*)(ws + WS_PB))
#define SCN ((float*)(ws + WS_SCN))
#define GB_ ((bf16*)(ws + WS_G))
#define MIX ((bf16*)(ws + WS_MIX))
#define KB ((bf16*)(ws + WS_KB))
#define VT ((bf16*)(ws + WS_VT))
#define X1B ((bf16*)(ws + WS_ZA))
#define Q ((bf16*)(ws + WS_Q))
#define OB ((bf16*)(ws + WS_OB))
#define PSCR ((bf16*)(ws + WS_PSCR))
#define X2B ((bf16*)(ws + WS_MIX))
#define HID ((bf16*)(ws + WS_HID))
    const int gw = vcu * NWAVES + wave, NGW = G * NWAVES;

    #ifndef NOP0
    ws = a.ws; asm volatile("" : "+s"(ws));
    {
        LAS float* scr = (LAS float*)(lds + wave * 16384);
        constexpr int I_IN = 16 * 88, I_SQ = 16 * 32, I_UP = 16 * 128, I_DN = 64 * 32, I_L = 16, I_G = 32;
        constexpr int NITEMS = I_IN + 5 * I_SQ + I_UP + I_DN + 2 * I_L + I_G;
        for (int it = gw; it < NITEMS; it += NGW) {
            int r = it;
            if (r < I_IN) { p0_transpose_item(a.in[8], 1024, DIN, WCAT, 0, nullptr, scr, r, lane); continue; } r -= I_IN;
            if (r < I_SQ) { p0_transpose_item(a.in[28], 1024, 1024, WCAT, DIN, nullptr, scr, r, lane); continue; } r -= I_SQ;
            if (r < I_SQ) { p0_transpose_item(a.in[29], 1024, 1024, WCAT, DIN + 1024, nullptr, scr, r, lane); continue; } r -= I_SQ;
            if (r < I_SQ) { p0_transpose_item(a.in[24], 1024, 1024, WOUT, 0, nullptr, scr, r, lane); continue; } r -= I_SQ;
            if (r < I_SQ) { p0_transpose_item(a.in[27], 1024, 1024, WQ, 0, a.in[25], scr, r, lane); continue; } r -= I_SQ;
            if (r < I_SQ) { p0_transpose_item(a.in[30], 1024, 1024, WO, 0, nullptr, scr, r, lane); continue; } r -= I_SQ;
            if (r < I_UP) { p0_transpose_item(a.in[32], 1024, FF, WUP, 0, a.in[31], scr, r, lane); continue; } r -= I_UP;
            if (r < I_DN) { p0_transpose_item(a.in[33], FF, 1024, WDN, 0, nullptr, scr, r, lane); continue; } r -= I_DN;
            if (r < I_L) { p0_transpose_item(a.in[15], 64, DB, W2T, 0, nullptr, scr, r, lane); continue; } r -= I_L;
            if (r < I_L) { p0_transpose_item(a.in[17], 64, DB, A2T, 0, nullptr, scr, r, lane); continue; } r -= I_L;
            p0_transpose_item(a.in[18], 128, DB, G2T, 0, nullptr, scr, r, lane);
        }
        for (int m = gw; m < M + MS + NBATCH * NMEM; m += NGW) {
            if (m < M) rms_row_to_bf16(a.in[0] + (size_t)m * D, a.in[7], ACAT + (size_t)m * D, lane);
            else if (m < M + MS) rms_row_to_bf16(a.in[1] + (size_t)(m - M) * D, a.in[7], ACAT + (size_t)m * D, lane);
            else rms_row_to_bf16(a.in[2] + (size_t)(m - M - MS) * D, a.in[26], ACAT + (size_t)(16640 + (m - M - MS)) * D, lane);
        }
        const int gt = bx * (NWAVES * 64) + tid, NGT = G * NWAVES * 64;
        for (int i = gt; i < 4 * 128 * 128; i += NGT) { const int t = (i >> 7) & 127, s = i & 127; WSB[i] = (bf16)(pk2(s <= t ? a.in[12][i] : 0.f, 0.f) & 0xffffu); }
        for (int i = gt; i < 2048; i += NGT) ZROW[i] = 0;
    }
#endif
    GRID_BAR();

    #ifndef NOP1
    ws = a.ws; asm volatile("" : "+s"(ws));
    {
        SchedP1 S{G, bx, (const char*)ACAT, (const char*)WCAT};
        EpiP1 E{ZA, PB, out + O_MK, out + O_MV, KB};
        pg8::gemm_phase<EpiP1, SchedP1, true>(lds, 1024, 1024, 1024, S, E);
    }
#endif
    GRID_BAR();

    #ifndef NOP2
    ws = a.ws; asm volatile("" : "+s"(ws));
    {
        LAS float* scr = (LAS float*)(lds + wave * 16384);
        for (int it = gw; it < NBATCH * 128; it += NGW) { const int b = it >> 7; p0_transpose_item(out + O_MV + (size_t)b * NMEM * 1024, NMEM, 1024, VT + (size_t)b * 1024 * NMEM, 0, nullptr, scr, it & 127, lane); }
        const int gt = bx * (NWAVES * 64) + tid, NGT = G * NWAVES * 64;
        for (int i = gt; i < NBATCH * DSH; i += NGT) { const int b = i / DSH, c = i % DSH; out[O_SHP + i] = bf1(PB[(size_t)(b * SEQ + SEQ - 1) * DSH + c]); }
        __syncthreads();
        for (int tile = bx; tile < M / 64; tile += G)
            rwkv_prep_tile(lds, tile, PB, ZROW, a.in[9], W2T, A2T, G2T, a.in[14], a.in[16], a.in[19], a.in[20], SCN, GB_, tid, wave, lane);
    }
#endif
    GRID_BAR();

    #ifndef NOP3
    ws = a.ws; asm volatile("" : "+s"(ws));
    if (bx < 64) {
        scan_block(lds, bx, SCN, GB_, a.in[22], a.in[23], a.in[21], MIX, out + O_WKVP, tid, wave, lane);
    } else if (bx < 192) {
        for (int tile = bx - 64; tile < 512; tile += 128) mixer_a_tile(lds, tile, ZA, WSB, a.in[10], a.in[11], a.in[13], MIX, out + O_CVP, tid, wave, lane);
    } else {
        SampleCtx C; C.subcnt = (unsigned*)ctl + CW_SUB; C.tmo = (unsigned*)ctl + CW_TMO; C.rs1 = RS1; C.rs2 = RS2; C.rs3 = RS3;
        sample_path(lds, a, C, bx - 192, 64, tid, wave, lane);
    }
#endif
    GRID_BAR();

    #ifndef NOP4
    ws = a.ws; asm volatile("" : "+s"(ws));
    {
        SchedMN S; S.init(M, 1024, G, bx, MIX, 1024, WOUT, 1024);
        EpiRes<true> E{a.in[0], out + O_Y, X1B, RS1};
        pg8::gemm_phase<EpiRes<true>, SchedMN, true>(lds, 1024, 1024, 1024, S, E);
    }
#endif
    GRID_BAR();

    #ifndef NOP5
    ws = a.ws; asm volatile("" : "+s"(ws));
    {
        SchedMN S; S.init(M, 1024, G, bx, X1B, 1024, WQ, 1024);
        EpiScale<0> E{Q, 1024, RS1};
        pg8::gemm_phase<EpiScale<0>, SchedMN, true>(lds, 1024, 1024, 1024, S, E);
    }
#endif
    GRID_BAR();

    #ifndef NOP6
    ws = a.ws; asm volatile("" : "+s"(ws));
    {
        bf16* P = PSCR + (size_t)bx * 65536;
        for (int u = bx; u < 64 * 4; u += G) {
            const int pm = u >> 2, h = u & 3, b = pm >> 3;
#ifndef P6_NO_S
            { SchedOne S{(const char*)(Q + (size_t)pm * 256 * 1024 + h * 256), (const char*)(KB + (size_t)b * NMEM * 1024 + h * 256)}; EpiSoftmax E{P};
              pg8::gemm_phase<EpiSoftmax, SchedOne, false>(lds, 256, 1024, 1024, S, E); }
#endif
#ifndef P6_NO_O
            { SchedOne S{(const char*)P, (const char*)(VT + ((size_t)b * 1024 + h * 256) * NMEM)}; EpiAttnO E{OB + (size_t)pm * 256 * 1024 + h * 256};
              pg8::gemm_phase<EpiAttnO, SchedOne, false>(lds, 256, 256, 256, S, E); }
#endif
        }
    }
#endif
    GRID_BAR();

    #ifndef NOP7
    ws = a.ws; asm volatile("" : "+s"(ws));
    {
        SchedMN S; S.init(M, 1024, G, bx, OB, 1024, WO, 1024);
        EpiRes<true> E{out + O_Y, out + O_Y, X2B, RS2};
        pg8::gemm_phase<EpiRes<true>, SchedMN, true>(lds, 1024, 1024, 1024, S, E);
    }
#endif
    GRID_BAR();

    #ifndef NOP8
    ws = a.ws; asm volatile("" : "+s"(ws));
    {
        SchedMN S; S.init(M, FF, G, bx, X2B, 1024, WUP, 1024);
        EpiScale<1> E{HID, FF, RS2};
        pg8::gemm_phase<EpiScale<1>, SchedMN, true>(lds, 1024, 1024, 1024, S, E);
    }
#endif
    GRID_BAR();

    #ifndef NOP9
    ws = a.ws; asm volatile("" : "+s"(ws));
    {
        SchedMN S; S.init(M, 1024, G, bx, HID, FF, WDN, FF);
        EpiRes<false> E{out + O_Y, out + O_Y, nullptr, RS3};
        pg8::gemm_phase<EpiRes<false>, SchedMN, true>(lds, FF, FF, FF, S, E);
    }
#endif
    GRID_BAR();

    #ifndef NOP10
    ws = a.ws; asm volatile("" : "+s"(ws));
    for (int m = gw; m < M; m += NGW) {
        const float sc = 1.f / sqrtf(__hip_atomic_load(RS3 + m, __ATOMIC_RELAXED, __HIP_MEMORY_SCOPE_AGENT) * (1.f / D) + RMS_EPS);
        f32x4* row = (f32x4*)(out + O_Y + (size_t)m * D) + lane; const f32x4* gr = (const f32x4*)a.in[34] + lane;
#pragma unroll
        for (int j = 0; j < 4; ++j) row[64 * j] = row[64 * j] * sc * gr[64 * j];
    }
#endif
}

extern "C" void kernel_launch(void* const* d_in, const int* in_sizes, int n_in, void* d_out, int out_size, void* d_ws, size_t ws_size, hipStream_t stream) {
    static int grid = 0;
    if (grid == 0) {
        if (n_in != 35 || out_size != (int)O_END || ws_size < WS_END) { fprintf(stderr, "kernel_launch: unexpected shapes (n_in %d, out %d, ws %zu); nothing launched\n", n_in, out_size, ws_size); grid = -1; return; }
        int dev = 0, cus = 0, per_cu = 0;
        if (hipGetDevice(&dev) != hipSuccess || hipDeviceGetAttribute(&cus, hipDeviceAttributeMultiprocessorCount, dev) != hipSuccess) { fprintf(stderr, "kernel_launch: device query failed\n"); grid = -1; return; }
        if (hipFuncSetAttribute((const void*)mk_fwd, hipFuncAttributeMaxDynamicSharedMemorySize, LDS_BYTES) != hipSuccess) { fprintf(stderr, "kernel_launch: hipFuncSetAttribute failed\n"); grid = -1; return; }
        if (hipOccupancyMaxActiveBlocksPerMultiprocessor(&per_cu, (const void*)mk_fwd, NWAVES * 64, LDS_BYTES) != hipSuccess || per_cu < 1)
            fprintf(stderr, "kernel_launch: note: occupancy query reports %d workgroups per CU\n", per_cu);
        (void)hipGetLastError();
        grid = cus;
        if (grid != 256) { fprintf(stderr, "kernel_launch: built for a 256-CU device (got %d)\n", grid); grid = -1; return; }
    }
    if (grid < 0) return;
    if (hipMemsetAsync((char*)d_ws + WS_CTL, 0, CTL_ZERO_BYTES, stream) != hipSuccess) { fprintf(stderr, "kernel_launch: hipMemsetAsync failed\n"); return; }
    KArgs a{};
    for (int i = 0; i < 35; ++i) a.in[i] = (const float*)d_in[i];
    a.out = (float*)d_out; a.ws = (unsigned char*)d_ws;
    hipLaunchKernelGGL(mk_fwd, dim3(grid), dim3(NWAVES * 64), LDS_BYTES, stream, a);
    const hipError_t le = hipPeekAtLastError();
    if (le != hipSuccess) fprintf(stderr, "kernel_launch: launch failed: %s\n", hipGetErrorName(le));
}
```

```cpp
#include <hip/hip_runtime.h>
#include <cstdio>
#include <cstdint>

namespace pg8 {
#define PG8_LAS __attribute__((address_space(3)))
typedef unsigned short bf16_t;
typedef short bf16x8 __attribute__((ext_vector_type(8)));
typedef float f32x4 __attribute__((ext_vector_type(4)));
typedef float f32x2 __attribute__((ext_vector_type(2)));
typedef unsigned u32x4 __attribute__((ext_vector_type(4)));
typedef unsigned u32x2 __attribute__((ext_vector_type(2)));
constexpr int BM = 256, BK = 64, HALF = 128, HTB = HALF * BK * 2  , STAGE_BYTES = 8 * HTB;

__host__ __device__ __forceinline__ int lds_byte(int r, int c) { const int st = (r >> 4) * 2 + (c >> 5), rr = r & 15, cc = c & 31, ob = rr * 64 + cc * 2; return st * 1024 + (ob ^ (((ob >> 9) & 1) << 5)); }
__host__ __device__ __forceinline__ void stage_rc(int b, int& R, int& C) { const int st = b / 1024, sb = b % 1024, swz = sb ^ (((sb >> 9) & 1) << 5); R = (st >> 1) * 16 + swz / 64; C = (st & 1) * 32 + (swz % 64) / 2; }
__host__ __device__ __forceinline__ int perm32(int rho) { const int n = rho >> 4, i = rho & 15; return 8 * (i >> 2) + 4 * n + (i & 3); }

struct Unit { int pm, pn; };

typedef __bf16 nbf16x2 __attribute__((ext_vector_type(2)));
__device__ __forceinline__ unsigned cvt_pk_bf16(float lo, float hi) { const nbf16x2 r = __builtin_convertvector((f32x2){lo, hi}, nbf16x2); return __builtin_bit_cast(unsigned, r); }
__device__ __forceinline__ f32x2 gelu_pk(f32x2 v) {
    const f32x2 av = __builtin_elementwise_abs(v), d = av * 0.2316418882f + 1.0f;
    f32x2 t; t.x = __builtin_amdgcn_rcpf(d.x); t.y = __builtin_amdgcn_rcpf(d.y);
    f32x2 q = t * 0.5307027145f + (-0.7265760135f); q = q * t + 0.7107068705f; q = q * t + (-0.142248368f); q = q * t + 0.127414796f; q = q * t;
    const f32x2 s = (v * v) * (-0.72134752044f);
    f32x2 e; e.x = __builtin_amdgcn_exp2f(s.x); e.y = __builtin_amdgcn_exp2f(s.y);
    const f32x2 m = v * (q * e), r = v - m;
    f32x2 o; o.x = v.x < 0.f ? m.x : r.x; o.y = v.y < 0.f ? m.y : r.y; return o;
}

template <class Epi, class Sched, bool ALIGN_EPI = false>
__device__ __forceinline__ void gemm_phase(PG8_LAS unsigned char* lds, const int K, const int lda, const int ldb, const Sched& S, const Epi& E) {
    int tid_ = threadIdx.x; asm volatile("" : "+v"(tid_));
    const int tid = tid_, wid = __builtin_amdgcn_readfirstlane(tid >> 6), lane = tid & 63, wr = wid >> 2, wc = wid & 3, fr = lane & 15, fq = lane >> 4;
    const int nt = K / BK;
    unsigned voffA[2], voffB[2];
#pragma unroll
    for (int i = 0; i < 2; ++i) { int R, C; stage_rc(tid * 16 + i * 8192, R, C); const int Rb = Epi::PERM ? ((R & ~31) + perm32(R & 31)) : R;
        voffA[i] = (unsigned)(R * lda + C) * 2u; voffB[i] = (unsigned)(Rb * ldb + C) * 2u; }
    const size_t kstep = (size_t)(BK * 2);
    const size_t hstepA = (size_t)HALF * lda * 2, hstepB = (size_t)HALF * ldb * 2;
    const unsigned ldsw = (unsigned)wid * 1024u;
    const int aoff = lds_byte(wr * 64 + fr, fq * 8), boff = lds_byte(wc * 32 + fr, fq * 8);
#define PG8_SA(b, h) (((b) * 2 + (h)) * HTB)
#define PG8_SB(b, h) ((4 + (b) * 2 + (h)) * HTB)
#define PG8_STAGE(bufoff, gbase, voff) do { _Pragma("unroll") for (int _i = 0; _i < 2; ++_i) \
        __builtin_amdgcn_global_load_lds((const unsigned*)((const char*)(gbase) + (voff)[_i]), (PG8_LAS unsigned*)(lds + (bufoff) + ldsw + _i * 8192), 16, 0, 0); } while (0)
#define PG8_LDA(dst, b, h) do { _Pragma("unroll") for (int m = 0; m < 4; ++m) _Pragma("unroll") for (int k = 0; k < 2; ++k) dst[m][k] = *(const PG8_LAS bf16x8*)(lds + PG8_SA(b, h) + aoff + m * 2048 + k * 1024); } while (0)
#define PG8_LDB(dst, b, h) do { _Pragma("unroll") for (int n = 0; n < 2; ++n) _Pragma("unroll") for (int k = 0; k < 2; ++k) dst[n][k] = *(const PG8_LAS bf16x8*)(lds + PG8_SB(b, h) + boff + n * 2048 + k * 1024); } while (0)
#define PG8_MMA(ai, bj, At, Bt) do { __builtin_amdgcn_s_setprio(1); _Pragma("unroll") for (int m = 0; m < 4; ++m) _Pragma("unroll") for (int n = 0; n < 2; ++n) _Pragma("unroll") for (int k = 0; k < 2; ++k) \
        acc[ai][bj][m][n] = __builtin_amdgcn_mfma_f32_16x16x32_bf16(Bt[n][k], At[m][k], acc[ai][bj][m][n], 0, 0, 0); __builtin_amdgcn_s_setprio(0); } while (0)
#define PG8_WAIT_V(n) asm volatile("s_waitcnt vmcnt(" #n ")" ::: "memory")
#define PG8_WAIT_L(n) asm volatile("s_waitcnt lgkmcnt(" #n ")" ::: "memory")
#define PG8_BAR __builtin_amdgcn_s_barrier()
#define PG8_SCHED __builtin_amdgcn_sched_barrier(0)
    Unit cur, nxt; int ui = 0;
    if (!S.next(0, cur)) return;
    f32x4 acc[2][2][4][2];
#pragma unroll
    for (int a = 0; a < 2; ++a)
#pragma unroll
        for (int b = 0; b < 2; ++b)
#pragma unroll
            for (int m = 0; m < 4; ++m)
#pragma unroll
                for (int n = 0; n < 2; ++n) acc[a][b][m][n] = (f32x4){0.f, 0.f, 0.f, 0.f};
    bf16x8 At[4][2], B0[2][2], B1[2][2];
    const char* cA = S.pa(cur); const char* cB = S.pb(cur);
    PG8_STAGE(PG8_SB(0, 0), cB, voffB); PG8_STAGE(PG8_SB(0, 1), cB + hstepB, voffB); PG8_STAGE(PG8_SA(0, 0), cA, voffA); PG8_STAGE(PG8_SA(0, 1), cA + hstepA, voffA);
    if (wr == 1) PG8_BAR;
    PG8_WAIT_V(2); PG8_BAR;
    PG8_STAGE(PG8_SB(1, 0), cB + kstep, voffB); PG8_STAGE(PG8_SA(1, 0), cA + kstep, voffA); PG8_STAGE(PG8_SB(1, 1), cB + hstepB + kstep, voffB);
    PG8_WAIT_V(6); PG8_BAR;
    for (;;) {
        const bool has_next = S.next(ui + 1, nxt);
        const char* nA = has_next ? S.pa(nxt) : cA; const char* nB = has_next ? S.pb(nxt) : cB;
#pragma unroll 1
        for (int t = 0; t < nt; t += 2) {
            const bool last = (t == nt - 2);
            const char* a1 = cA + (size_t)(t + 1) * kstep;
            const char* a2 = last ? nA : cA + (size_t)(t + 2) * kstep; const char* b2 = last ? nB : cB + (size_t)(t + 2) * kstep;
            const char* a3 = a2 + kstep; const char* b3 = b2 + kstep;
            PG8_LDB(B0, 0, 0); PG8_LDB(B1, 0, 1); PG8_SCHED; PG8_LDA(At, 0, 0); PG8_STAGE(PG8_SA(1, 1), a1 + hstepA, voffA);
            PG8_WAIT_V(8); PG8_WAIT_L(0); PG8_BAR; PG8_MMA(0, 0, At, B0); PG8_MMA(0, 1, At, B1); PG8_BAR; PG8_SCHED;
            PG8_LDA(At, 0, 1); PG8_STAGE(PG8_SB(0, 0), b2, voffB); PG8_STAGE(PG8_SB(0, 1), b2 + hstepB, voffB); PG8_STAGE(PG8_SA(0, 0), a2, voffA);
            PG8_WAIT_V(8); PG8_WAIT_L(0); PG8_BAR; PG8_MMA(1, 0, At, B0); PG8_MMA(1, 1, At, B1); PG8_BAR; PG8_SCHED;
            PG8_LDB(B0, 1, 0); PG8_LDB(B1, 1, 1); PG8_SCHED; PG8_LDA(At, 1, 0); PG8_STAGE(PG8_SA(0, 1), a2 + hstepA, voffA);
            PG8_WAIT_V(8); PG8_WAIT_L(0); PG8_BAR; PG8_MMA(0, 0, At, B0); PG8_MMA(0, 1, At, B1); PG8_BAR; PG8_SCHED;
            PG8_LDA(At, 1, 1); PG8_STAGE(PG8_SB(1, 0), b3, voffB); PG8_STAGE(PG8_SB(1, 1), b3 + hstepB, voffB); PG8_STAGE(PG8_SA(1, 0), a3, voffA);
            PG8_WAIT_V(8); PG8_WAIT_L(0); PG8_BAR; PG8_MMA(1, 0, At, B0); PG8_MMA(1, 1, At, B1); PG8_BAR; PG8_SCHED;
        }
        if constexpr (ALIGN_EPI) { if (wr == 0) PG8_BAR; }
        if constexpr (!Epi::AFTER_DRAIN) { E(acc, cur, wr, wc, fr, fq); }
        if (!has_next) break;
#pragma unroll
        for (int a = 0; a < 2; ++a)
#pragma unroll
            for (int b = 0; b < 2; ++b)
#pragma unroll
                for (int m = 0; m < 4; ++m)
#pragma unroll
                    for (int n = 0; n < 2; ++n) acc[a][b][m][n] = (f32x4){0.f, 0.f, 0.f, 0.f};
        cur = nxt; cA = nA; cB = nB; ++ui;
        if constexpr (ALIGN_EPI) { if (wr == 1) PG8_BAR; }
    }
    PG8_WAIT_V(0);
    if constexpr (!ALIGN_EPI) { if (wr == 0) PG8_BAR; }
    PG8_BAR;
    if constexpr (Epi::AFTER_DRAIN) { E.fused(acc, cur, wr, wc, fr, fq, lds, wid, lane); }
#undef PG8_SA
#undef PG8_SB
#undef PG8_STAGE
#undef PG8_LDA
#undef PG8_LDB
#undef PG8_MMA
#undef PG8_WAIT_V
#undef PG8_WAIT_L
#undef PG8_BAR
#undef PG8_SCHED
}
}

#define GAS __attribute__((address_space(1)))
#define LAS __attribute__((address_space(3)))
typedef unsigned short bf16;
typedef float f32x4 __attribute__((ext_vector_type(4)));
typedef float f32x2 __attribute__((ext_vector_type(2)));
typedef short bf16x8 __attribute__((ext_vector_type(8)));
typedef unsigned u32x4 __attribute__((ext_vector_type(4)));
typedef unsigned u32x2 __attribute__((ext_vector_type(2)));
typedef GAS unsigned gu32;
#define RLX_AGENT __ATOMIC_RELAXED, __HIP_MEMORY_SCOPE_AGENT
#define LDS_WAIT() asm volatile("s_waitcnt lgkmcnt(0)" ::: "memory")
#define VM_WAIT() asm volatile("s_waitcnt vmcnt(0)" ::: "memory")

constexpr int NWAVES = 8;
constexpr int D = 1024, M = 16384, SEQ = 2048, NBATCH = 8, MS = 128, DIN = 2816, DSH = 1792, DB = 512, FF = 4096, NMEM = 256;
constexpr float RMS_EPS = 1e-6f, LN_EPS = 1e-5f, GN_EPS = 64e-5f;
constexpr size_t O_Y = 0, O_YS = 16777216, O_MK = 16908288, O_MV = 19005440, O_SHP = 21102592, O_WKVP = 21116928, O_CVP = 21379072, O_SHS = 21903360, O_WKVS = 22132736, O_CVS = 26327040, O_END = 26392576;
constexpr size_t MiB = 1u << 20, KiB = 1024;
constexpr size_t WS_CTL = 0, CTL_ZERO_BYTES = 1 * MiB;
constexpr size_t WS_WCAT = 2 * MiB;
constexpr size_t WS_WOUT = 12 * MiB, WS_WQ = 14 * MiB, WS_WO = 16 * MiB, WS_WUP = 18 * MiB, WS_WDN = 26 * MiB;
constexpr size_t WS_SMALL = 34 * MiB;
constexpr size_t WS_ACAT = 36 * MiB;
constexpr size_t WS_ZA = 73 * MiB;
constexpr size_t WS_PB = 105 * MiB;
constexpr size_t WS_Q = 105 * MiB, WS_OB = 137 * MiB;
constexpr size_t WS_SCN = 161 * MiB;
constexpr size_t WS_PSCR = 169 * MiB, WS_HID = 201 * MiB;
constexpr size_t WS_G = 353 * MiB;
constexpr size_t WS_MIX = 369 * MiB;
constexpr size_t WS_KB = 401 * MiB, WS_VT = 405 * MiB;
constexpr size_t WS_SMP = 409 * MiB;
constexpr size_t SM_ZA = 0, SM_MIX = 256 * KiB, SM_X1 = 512 * KiB, SM_X1B = 1024 * KiB, SM_Q = 1280 * KiB, SM_O = 1792 * KiB, SM_X2 = 2048 * KiB, SM_X2B = 2560 * KiB, SM_HID = 3072 * KiB, SM_X3 = 4096 * KiB;
constexpr size_t WS_NEW = 416 * MiB;
constexpr size_t WS_END = 505 * MiB;
constexpr int CW_TMO = 0, CW_CODE = 1, CW_BAR = 4096, CW_SUB = 8192;
constexpr int RS_OFF = 65536, RS_STRIDE = 16640;
constexpr int RING_BYTES = 131072, LDSCTL_OFF = RING_BYTES, MISC_OFF = LDSCTL_OFF + 320, LDS_BYTES = 147456;

__device__ __forceinline__ float bf_lo(unsigned u) { return __uint_as_float(u << 16); }
__device__ __forceinline__ float bf_hi(unsigned u) { return __uint_as_float(u & 0xffff0000u); }
__device__ __forceinline__ float bf1(bf16 v) { return __uint_as_float(((unsigned)v) << 16); }
__device__ __forceinline__ unsigned pk2(float lo, float hi) { return pg8::cvt_pk_bf16(lo, hi); }
__device__ __forceinline__ f32x4 bf4(u32x2 v) { return (f32x4){bf_lo(v.x), bf_hi(v.x), bf_lo(v.y), bf_hi(v.y)}; }
__device__ __forceinline__ u32x2 pk4(f32x4 v) { u32x2 r; r.x = pk2(v.x, v.y); r.y = pk2(v.z, v.w); return r; }
__device__ __forceinline__ float fast_exp(float x) { return __builtin_amdgcn_exp2f(x * 1.44269504089f); }
__device__ __forceinline__ float fast_log(float x) { return __builtin_amdgcn_logf(x) * 0.69314718056f; }
__device__ __forceinline__ float fast_sigmoid(float x) { return __builtin_amdgcn_rcpf(1.0f + fast_exp(-x)); }
__device__ __forceinline__ float fast_tanh(float x) { return 1.0f - 2.0f * __builtin_amdgcn_rcpf(fast_exp(2.0f * x) + 1.0f); }
template <int CTRL> __device__ __forceinline__ float dpp_mov(float x) { return __builtin_bit_cast(float, __builtin_amdgcn_mov_dpp(__builtin_bit_cast(int, x), CTRL, 0xf, 0xf, true)); }
__device__ __forceinline__ float red4(float x) { x += dpp_mov<0xB1>(x); x += dpp_mov<0x4E>(x); return x; }
__device__ __forceinline__ float red8(float x) { x = red4(x); x += dpp_mov<0x141>(x); return x; }
__device__ __forceinline__ float red16(float x) { x = red8(x); x += dpp_mov<0x128>(x); return x; }
__device__ __forceinline__ float wave_sum(float v) {
#pragma unroll
    for (int o = 1; o < 64; o <<= 1) v += __shfl_xor(v, o);
    return v;
}
__device__ __forceinline__ float wave_max(float v) {
#pragma unroll
    for (int o = 1; o < 64; o <<= 1) v = fmaxf(v, __shfl_xor(v, o));
    return v;
}

#define XB_TMO      128
#define XB_XCNT(j)  (256  + 64 * (j))
#define XB_XSUB(j)  (1280 + 64 * (j))
#define XB_XGEN(j)  (2304 + 64 * (j))
#define XB_TOP      3328
#define XB_TOPGEN   3392
#define XCD_BAR_WORDS 3456
#define XB_SPIN_CAP (1u << 18)
__device__ __forceinline__ unsigned xb_ld(unsigned* p)              { return __hip_atomic_load(p, __ATOMIC_RELAXED, __HIP_MEMORY_SCOPE_AGENT); }
__device__ __forceinline__ unsigned xb_add(unsigned* p, unsigned v) { return __hip_atomic_fetch_add(p, v, __ATOMIC_RELAXED, __HIP_MEMORY_SCOPE_AGENT); }
__device__ __forceinline__ unsigned xb_xcc_id() { return (unsigned)__builtin_amdgcn_s_getreg((3 << 11) | 20) & 0xFu; }
#define XB_SPIN(cond, bar) do { unsigned _sp = 0; while (cond) { __builtin_amdgcn_s_sleep(1); \
    if ((++_sp & 255u) == 0u) { if (xb_ld(&(bar)[XB_TMO])) break; if (_sp > XB_SPIN_CAP) { atomicAdd(&(bar)[XB_TMO], 1u); break; } } } } while (0)
struct XcdBarrier { unsigned* bar; unsigned x; volatile LAS unsigned* st; };
__device__ __forceinline__ XcdBarrier xcd_barrier_post(unsigned* bar, volatile LAS unsigned* st) {
    XcdBarrier b; b.bar = bar; b.x = xb_xcc_id(); b.st = st;
    if (threadIdx.x == 0) (void)xb_add(&bar[XB_XCNT(b.x)], 1u);
    return b;
}
__device__ __forceinline__ void xcd_barrier_complete(unsigned* bar, unsigned x, unsigned& nloc, unsigned& nx) {
    const unsigned G = gridDim.x * gridDim.y * gridDim.z;
    unsigned sum, cnt, mine, sp = 0u;
    for (;;) {
        sum = 0u; cnt = 0u; mine = 0u;
#pragma unroll
        for (unsigned j = 0; j < 16; ++j) { const unsigned c = xb_ld(&bar[XB_XCNT(j)]); sum += c; cnt += (c > 0u) ? 1u : 0u; mine = (j == x) ? c : mine; }
        if (sum == G) break;
        __builtin_amdgcn_s_sleep(1);
        if ((++sp & 255u) == 0u) { if (xb_ld(&bar[XB_TMO])) break; if (sp > XB_SPIN_CAP) { atomicAdd(&bar[XB_TMO], 1u); break; } }
    }
    nloc = mine > 0u ? mine : 1u; nx = cnt > 0u ? cnt : 1u;
}
__device__ __forceinline__ void xcd_barrier(const XcdBarrier& b) {
    asm volatile("s_waitcnt vmcnt(0)" ::: "memory");
    __syncthreads();
    if (threadIdx.x == 0) {
        unsigned* bar = b.bar;
        __builtin_amdgcn_s_waitcnt(0);
        unsigned nloc = b.st[0], nx = b.st[1];
        if (nloc == 0u) { xcd_barrier_complete(bar, b.x, nloc, nx); b.st[0] = nloc; b.st[1] = nx; }
        const unsigned old = xb_add(&bar[XB_XSUB(b.x)], 1u);
        const unsigned gen = old / nloc;
        if (old + 1u == (gen + 1u) * nloc) {
            __builtin_amdgcn_fence(__ATOMIC_RELEASE, "agent");
            asm volatile("s_waitcnt vmcnt(0)" ::: "memory");
            const unsigned og = xb_add(&bar[XB_TOP], 1u);
            const unsigned tg = og / nx;
            if (og + 1u == (tg + 1u) * nx) xb_add(&bar[XB_TOPGEN], 1u);
            else XB_SPIN(xb_ld(&bar[XB_TOPGEN]) == tg, bar);
            __builtin_amdgcn_fence(__ATOMIC_ACQUIRE, "agent");
            xb_add(&bar[XB_XGEN(b.x)], 1u);
            asm volatile("s_waitcnt vmcnt(0)" ::: "memory");
        } else {
            XB_SPIN(xb_ld(&bar[XB_XGEN(b.x)]) == gen, bar);
            __builtin_amdgcn_fence(__ATOMIC_ACQUIRE, "agent");
            asm volatile("s_waitcnt vmcnt(0)" ::: "memory");
        }
    }
    __syncthreads();
}
__device__ __forceinline__ void sub_barrier(unsigned* cnt, unsigned* tmo, unsigned target) {
    asm volatile("s_waitcnt vmcnt(0)" ::: "memory");
    __syncthreads();
    if (threadIdx.x == 0) {
        __builtin_amdgcn_fence(__ATOMIC_RELEASE, "agent");
        asm volatile("s_waitcnt vmcnt(0)" ::: "memory");
        (void)xb_add(cnt, 1u);
        unsigned sp = 0;
        while (xb_ld(cnt) < target) { __builtin_amdgcn_s_sleep(1); if ((++sp & 255u) == 0u) { if (xb_ld(tmo)) break; if (sp > (1u << 20)) { atomicAdd(tmo, 1u); break; } } }
        __builtin_amdgcn_fence(__ATOMIC_ACQUIRE, "agent");
        asm volatile("s_waitcnt vmcnt(0)" ::: "memory");
    }
    __syncthreads();
}

__device__ __forceinline__ void p0_transpose_item(const float* W, int K, int N, bf16* WT, int row_off, const float* gk, LAS float* scr, int item, int lane) {
    const int nblk = N / 32, kb = item / nblk, nb = item % nblk, k0 = 64 * kb, n0 = 32 * nb;
#pragma unroll 8
    for (int i = 0; i < 32; ++i) { const int kk = 2 * i + (lane >> 5); float v = W[(size_t)(k0 + kk) * N + n0 + (lane & 31)]; if (gk) v *= gk[k0 + kk]; scr[kk * 33 + (lane & 31)] = v; }
    LDS_WAIT(); asm volatile("" ::: "memory");
    const int c = lane & 7;
#pragma unroll
    for (int j = 0; j < 4; ++j) { const int n = (lane >> 3) + 8 * j; const LAS float* s = scr + (8 * c) * 33 + n;
        u32x4 o; o.x = pk2(s[0 * 33], s[1 * 33]); o.y = pk2(s[2 * 33], s[3 * 33]); o.z = pk2(s[4 * 33], s[5 * 33]); o.w = pk2(s[6 * 33], s[7 * 33]);
        *(u32x4*)(WT + (size_t)(row_off + n0 + n) * K + k0 + 8 * c) = o; }
    LDS_WAIT(); asm volatile("" ::: "memory");
}
__device__ __forceinline__ void rms_row_to_bf16(const float* xrow, const float* g, bf16* orow, int lane) {
    const f32x4* xr = (const f32x4*)xrow + lane; const f32x4* gr = (const f32x4*)g + lane;
    f32x4 v[4]; float s = 0.f;
#pragma unroll
    for (int j = 0; j < 4; ++j) { v[j] = xr[64 * j]; s += (v[j].x * v[j].x + v[j].y * v[j].y) + (v[j].z * v[j].z + v[j].w * v[j].w); }
    const float rstd = 1.f / sqrtf(wave_sum(s) * (1.f / D) + RMS_EPS);
    unsigned long long* o8 = (unsigned long long*)orow + lane;
#pragma unroll
    for (int j = 0; j < 4; ++j) { const f32x4 gg = gr[64 * j]; o8[64 * j] = (unsigned long long)pk2(v[j].x * rstd * gg.x, v[j].y * rstd * gg.y) | ((unsigned long long)pk2(v[j].z * rstd * gg.z, v[j].w * rstd * gg.w) << 32); }
}

using pg8::Unit;
struct SchedMN {
    int nM, nN, nwg, G, c; const char* A; const char* Bt; size_t ta, tb;
    __device__ __forceinline__ void init(int M_, int N_, int G_, int c_, const void* A_, size_t lda, const void* Bt_, size_t ldb) { nM = M_ / 256; nN = N_ / 256; nwg = nM * nN; G = G_; c = c_; A = (const char*)A_; Bt = (const char*)Bt_; ta = 256 * lda * 2; tb = 256 * ldb * 2; }
    __device__ __forceinline__ bool next(int i, Unit& u) const {
        const long L = (long)i * G + c; if (L >= nwg) return false;
        int wgid = (int)L; { const int q = nwg / 8, r = nwg % 8, xcd = wgid % 8, off = wgid / 8; wgid = (xcd < r ? xcd * (q + 1) : r * (q + 1) + (xcd - r) * q) + off; }
        const int nig = 8 * nN, gid = wgid / nig, fm = gid * 8, gsz = (nM - fm) < 8 ? (nM - fm) : 8;
        u.pm = fm + ((wgid % nig) % gsz); u.pn = (wgid % nig) / gsz; return true;
    }
    __device__ __forceinline__ const char* pa(const Unit& u) const { return A + (size_t)u.pm * ta; }
    __device__ __forceinline__ const char* pb(const Unit& u) const { return Bt + (size_t)u.pn * tb; }
};
struct SchedP1 {
    int G, c; const char* A; const char* Bt;
    __device__ __forceinline__ bool next(int i, Unit& u) const {
        const int L = i * G + c; if (L >= 768) return false;
        const int wgid = (L % 8) * 96 + L / 8;
        if (wgid < 704) { const int nig = 88, gid = wgid / nig, w = wgid % nig; u.pm = gid * 8 + (w & 7); u.pn = w >> 3; }
        else { const int w = wgid - 704; u.pm = 65 + (w & 7); u.pn = 11 + (w >> 3); }
        return true;
    }
    __device__ __forceinline__ const char* pa(const Unit& u) const { return A + (size_t)u.pm * (256 * 1024 * 2); }
    __device__ __forceinline__ const char* pb(const Unit& u) const { return Bt + (size_t)u.pn * (256 * 1024 * 2); }
};
struct SchedOne {
    const char* A; const char* B;
    __device__ __forceinline__ bool next(int i, Unit& u) const { if (i) return false; u.pm = 0; u.pn = 0; return true; }
    __device__ __forceinline__ const char* pa(const Unit&) const { return A; }
    __device__ __forceinline__ const char* pb(const Unit&) const { return B; }
};

typedef GAS bf16 gbf16; typedef GAS float gf32;
__device__ __forceinline__ void st16(gbf16* p, f32x4 v0, f32x4 v1) { u32x4 w; w.x = pk2(v0[0], v0[1]); w.y = pk2(v0[2], v0[3]); w.z = pk2(v1[0], v1[1]); w.w = pk2(v1[2], v1[3]); *(GAS u32x4*)p = w; }
struct EpiP1 {
    static constexpr bool PERM = true, AFTER_DRAIN = false;
    bf16* ZA; bf16* PB; float* outK; float* outV; bf16* KB;
    __device__ __forceinline__ void operator()(const f32x4 (&acc)[2][2][4][2], const Unit& u, int wr, int wc, int fr, int fq) const {
        if (u.pm < 64) {
            const int row0 = u.pm * 256 + wr * 64 + fr; const bool act = u.pn < 4;
            gbf16* base = act ? (gbf16*)ZA : (gbf16*)PB; const int ldc = act ? 1024 : DSH; const int col0 = (act ? u.pn : u.pn - 4) * 256 + wc * 32 + 8 * fq;
#pragma unroll
            for (int ai = 0; ai < 2; ++ai)
#pragma unroll
                for (int m = 0; m < 4; ++m) { gbf16* rowp = base + (size_t)(row0 + ai * 128 + m * 16) * ldc + col0;
#pragma unroll
                    for (int bj = 0; bj < 2; ++bj) { f32x4 v0 = acc[ai][bj][m][0], v1 = acc[ai][bj][m][1];
                        if (act) { f32x2 a = pg8::gelu_pk((f32x2){v0[0], v0[1]}), b = pg8::gelu_pk((f32x2){v0[2], v0[3]}), c = pg8::gelu_pk((f32x2){v1[0], v1[1]}), d = pg8::gelu_pk((f32x2){v1[2], v1[3]});
                            v0 = (f32x4){a.x, a.y, b.x, b.y}; v1 = (f32x4){c.x, c.y, d.x, d.y}; }
                        st16(rowp + bj * 128, v0, v1); } }
        } else {
            const int row0 = (u.pm - 65) * 256 + wr * 64 + fr; const int ct = u.pn - 11; const bool isK = ct < 4; const int col0 = (ct & 3) * 256 + wc * 32 + 8 * fq;
            gf32* o = isK ? (gf32*)outK : (gf32*)outV;
#pragma unroll
            for (int ai = 0; ai < 2; ++ai)
#pragma unroll
                for (int m = 0; m < 4; ++m) { const size_t off = (size_t)(row0 + ai * 128 + m * 16) * 1024 + col0;
#pragma unroll
                    for (int bj = 0; bj < 2; ++bj) { const f32x4 v0 = acc[ai][bj][m][0], v1 = acc[ai][bj][m][1];
                        *(GAS f32x4*)(o + off + bj * 128) = v0; *(GAS f32x4*)(o + off + bj * 128 + 4) = v1;
                        if (isK) st16((gbf16*)KB + off + bj * 128, v0, v1); } }
        }
    }
};
template <bool WB> struct EpiRes {
    static constexpr bool PERM = true, AFTER_DRAIN = false;
    const float* base; float* out; bf16* outb; float* rowss;
    __device__ __forceinline__ void operator()(const f32x4 (&acc)[2][2][4][2], const Unit& u, int wr, int wc, int fr, int fq) const {
        const int row0 = u.pm * 256 + wr * 64 + fr, col0 = u.pn * 256 + wc * 32 + 8 * fq;
#pragma unroll
        for (int ai = 0; ai < 2; ++ai)
#pragma unroll
            for (int m = 0; m < 4; ++m) { const int r = row0 + ai * 128 + m * 16; const size_t off = (size_t)r * 1024 + col0; float ss = 0.f;
#pragma unroll
                for (int bj = 0; bj < 2; ++bj) { const f32x4 b0 = *(const GAS f32x4*)((const gf32*)base + off + bj * 128), b1 = *(const GAS f32x4*)((const gf32*)base + off + bj * 128 + 4);
                    const f32x4 v0 = acc[ai][bj][m][0] + b0, v1 = acc[ai][bj][m][1] + b1;
                    *(GAS f32x4*)((gf32*)out + off + bj * 128) = v0; *(GAS f32x4*)((gf32*)out + off + bj * 128 + 4) = v1;
                    if (WB) st16((gbf16*)outb + off + bj * 128, v0, v1);
                    ss += (v0[0] * v0[0] + v0[1] * v0[1]) + (v0[2] * v0[2] + v0[3] * v0[3]) + (v1[0] * v1[0] + v1[1] * v1[1]) + (v1[2] * v1[2] + v1[3] * v1[3]); }
                ss += __shfl_xor(ss, 16); ss += __shfl_xor(ss, 32);
                if (fq == 0) (void)__hip_atomic_fetch_add(rowss + r, ss, __ATOMIC_RELAXED, __HIP_MEMORY_SCOPE_AGENT); }
    }
};
template <int MODE> struct EpiScale {
    static constexpr bool PERM = true, AFTER_DRAIN = false;
    bf16* O; int ldc; const float* rowss;
    __device__ __forceinline__ void operator()(const f32x4 (&acc)[2][2][4][2], const Unit& u, int wr, int wc, int fr, int fq) const {
        const int row0 = u.pm * 256 + wr * 64 + fr, col0 = u.pn * 256 + wc * 32 + 8 * fq;
#pragma unroll
        for (int ai = 0; ai < 2; ++ai)
#pragma unroll
            for (int m = 0; m < 4; ++m) { const int r = row0 + ai * 128 + m * 16;
                float sc = 1.f / sqrtf(__hip_atomic_load(rowss + r, __ATOMIC_RELAXED, __HIP_MEMORY_SCOPE_AGENT) * (1.f / D) + RMS_EPS); if (MODE == 0) sc *= 0.0625f;
                gbf16* rowp = (gbf16*)O + (size_t)r * ldc + col0;
#pragma unroll
                for (int bj = 0; bj < 2; ++bj) { f32x4 v0 = acc[ai][bj][m][0] * sc, v1 = acc[ai][bj][m][1] * sc;
                    if (MODE == 1) {
#pragma unroll
                        for (int j = 0; j < 4; ++j) { const float a = fmaxf(v0[j], 0.f), b = fmaxf(v1[j], 0.f); v0[j] = a * a; v1[j] = b * b; } }
                    st16(rowp + bj * 128, v0, v1); } }
    }
};
struct EpiSoftmax {
    static constexpr bool PERM = true, AFTER_DRAIN = true;
    bf16* P;
    __device__ __forceinline__ void fused(f32x4 (&acc)[2][2][4][2], const Unit&, int wr, int wc, int fr, int fq, PG8_LAS unsigned char* lds, int, int) const {
        PG8_LAS float* T1 = (PG8_LAS float*)lds; PG8_LAS float* T2 = (PG8_LAS float*)(lds + 4096);
#pragma unroll
        for (int ai = 0; ai < 2; ++ai)
#pragma unroll
            for (int m = 0; m < 4; ++m) { float mx = -3.0e38f;
#pragma unroll
                for (int bj = 0; bj < 2; ++bj)
#pragma unroll
                    for (int n = 0; n < 2; ++n) { const f32x4 x = acc[ai][bj][m][n]; mx = fmaxf(mx, fmaxf(fmaxf(x[0], x[1]), fmaxf(x[2], x[3]))); }
                mx = fmaxf(mx, __shfl_xor(mx, 16)); mx = fmaxf(mx, __shfl_xor(mx, 32));
                if (fq == 0) T1[(ai * 128 + wr * 64 + m * 16 + fr) * 4 + wc] = mx; }
        asm volatile("s_waitcnt lgkmcnt(0)" ::: "memory"); __builtin_amdgcn_s_barrier(); asm volatile("" ::: "memory");
#pragma unroll
        for (int ai = 0; ai < 2; ++ai)
#pragma unroll
            for (int m = 0; m < 4; ++m) { const int row = ai * 128 + wr * 64 + m * 16 + fr; const f32x4 t = *(const PG8_LAS f32x4*)(T1 + row * 4);
                const float mxr = fmaxf(fmaxf(t[0], t[1]), fmaxf(t[2], t[3])) * 1.44269504089f; float sum = 0.f;
#pragma unroll
                for (int bj = 0; bj < 2; ++bj)
#pragma unroll
                    for (int n = 0; n < 2; ++n) { f32x4 x = acc[ai][bj][m][n];
#pragma unroll
                        for (int j = 0; j < 4; ++j) { x[j] = __builtin_amdgcn_exp2f(x[j] * 1.44269504089f - mxr); sum += x[j]; }
                        acc[ai][bj][m][n] = x; }
                sum += __shfl_xor(sum, 16); sum += __shfl_xor(sum, 32);
                if (fq == 0) T2[row * 4 + wc] = sum; }
        asm volatile("s_waitcnt lgkmcnt(0)" ::: "memory"); __builtin_amdgcn_s_barrier(); asm volatile("" ::: "memory");
#pragma unroll
        for (int ai = 0; ai < 2; ++ai)
#pragma unroll
            for (int m = 0; m < 4; ++m) { const int row = ai * 128 + wr * 64 + m * 16 + fr; const f32x4 t = *(const PG8_LAS f32x4*)(T2 + row * 4);
                const float inv = 1.f / ((t[0] + t[1]) + (t[2] + t[3]));
                gbf16* rowp = (gbf16*)P + (size_t)row * 256 + wc * 32 + 8 * fq;
#pragma unroll
                for (int bj = 0; bj < 2; ++bj) st16(rowp + bj * 128, acc[ai][bj][m][0] * inv, acc[ai][bj][m][1] * inv); }
        asm volatile("s_waitcnt vmcnt(0) lgkmcnt(0)" ::: "memory"); __builtin_amdgcn_s_barrier(); asm volatile("" ::: "memory");
    }
};
struct EpiAttnO {
    static constexpr bool PERM = true, AFTER_DRAIN = false;
    bf16* O;
    __device__ __forceinline__ void operator()(const f32x4 (&acc)[2][2][4][2], const Unit&, int wr, int wc, int fr, int fq) const {
#pragma unroll
        for (int ai = 0; ai < 2; ++ai)
#pragma unroll
            for (int m = 0; m < 4; ++m) { gbf16* rowp = (gbf16*)O + (size_t)(ai * 128 + wr * 64 + m * 16 + fr) * 1024 + wc * 32 + 8 * fq;
#pragma unroll
                for (int bj = 0; bj < 2; ++bj) st16(rowp + bj * 128, acc[ai][bj][m][0], acc[ai][bj][m][1]); }
    }
};

__device__ __forceinline__ f32x4 shift4(const bf16* p, const bf16* q, const float* mu) {
    const f32x4 a = bf4(*(const u32x2*)p), b = bf4(*(const u32x2*)q), m = *(const f32x4*)mu; return a + (b - a) * m;
}
__device__ __forceinline__ void rwkv_prep_tile(LAS unsigned char* lds, int tile, const bf16* PB, const bf16* ZROW, const float* mu, const bf16* W2T, const bf16* A2T, const bf16* G2T,
                                               const float* w0, const float* a0, const float* k_k, const float* k_a, float* SCN, bf16* G, int tid, int wave, int lane) {
    const int m0 = tile * 64, fr = lane & 15, fq = lane >> 4, h = wave;
    LAS bf16* LA = (LAS bf16*)lds;
    {   const int r = tid >> 3, cg = (tid & 7) * 32, m = m0 + r;
        const bf16* prow = PB + (size_t)m * DSH + 1536 + cg; const bf16* qrow = ((m & (SEQ - 1)) == 0) ? ZROW : (PB + (size_t)(m - 1) * DSH + 1536 + cg);
        const int mode = cg < 64 ? 0 : (cg < 128 ? 1 : 2);
#pragma unroll
        for (int j = 0; j < 4; ++j) {
            const u32x4 pv = *(const u32x4*)(prow + 8 * j), qv = *(const u32x4*)(qrow + 8 * j);
            const f32x4 m0v = *(const f32x4*)(mu + 1536 + cg + 8 * j), m1v = *(const f32x4*)(mu + 1536 + cg + 8 * j + 4);
            float x[8];
            { const float p0 = bf_lo(pv.x), p1 = bf_hi(pv.x), p2 = bf_lo(pv.y), p3 = bf_hi(pv.y), p4 = bf_lo(pv.z), p5 = bf_hi(pv.z), p6 = bf_lo(pv.w), p7 = bf_hi(pv.w);
              const float q0 = bf_lo(qv.x), q1 = bf_hi(qv.x), q2 = bf_lo(qv.y), q3 = bf_hi(qv.y), q4 = bf_lo(qv.z), q5 = bf_hi(qv.z), q6 = bf_lo(qv.w), q7 = bf_hi(qv.w);
              x[0] = p0 + (q0 - p0) * m0v[0]; x[1] = p1 + (q1 - p1) * m0v[1]; x[2] = p2 + (q2 - p2) * m0v[2]; x[3] = p3 + (q3 - p3) * m0v[3];
              x[4] = p4 + (q4 - p4) * m1v[0]; x[5] = p5 + (q5 - p5) * m1v[1]; x[6] = p6 + (q6 - p6) * m1v[2]; x[7] = p7 + (q7 - p7) * m1v[3]; }
#pragma unroll
            for (int e = 0; e < 8; ++e) x[e] = mode == 0 ? fast_tanh(x[e]) : (mode == 1 ? x[e] : fast_sigmoid(x[e]));
            u32x4 o; o.x = pk2(x[0], x[1]); o.y = pk2(x[2], x[3]); o.z = pk2(x[4], x[5]); o.w = pk2(x[6], x[7]);
            *(LAS u32x4*)(LA + r * 264 + cg + 8 * j) = o;
        }
    }
    __syncthreads();
#pragma unroll 1
    for (int mt = 0; mt < 4; ++mt) {
        f32x4 aw[4], aa[4], ag[4];
#pragma unroll
        for (int n = 0; n < 4; ++n) { aw[n] = (f32x4){0.f, 0.f, 0.f, 0.f}; aa[n] = aw[n]; ag[n] = aw[n]; }
        const LAS bf16* arow = LA + (16 * mt + fr) * 264 + 8 * fq;
#pragma unroll
        for (int ks = 0; ks < 2; ++ks) {
            const bf16x8 bw = *(const LAS bf16x8*)(arow + 32 * ks), ba = *(const LAS bf16x8*)(arow + 64 + 32 * ks);
#pragma unroll
            for (int n = 0; n < 4; ++n) {
                const bf16x8 ww = *(const bf16x8*)(W2T + (size_t)(64 * h + 16 * n + fr) * 64 + 32 * ks + 8 * fq), wa = *(const bf16x8*)(A2T + (size_t)(64 * h + 16 * n + fr) * 64 + 32 * ks + 8 * fq);
                aw[n] = __builtin_amdgcn_mfma_f32_16x16x32_bf16(ww, bw, aw[n], 0, 0, 0); aa[n] = __builtin_amdgcn_mfma_f32_16x16x32_bf16(wa, ba, aa[n], 0, 0, 0); }
        }
#pragma unroll
        for (int ks = 0; ks < 4; ++ks) {
            const bf16x8 bg = *(const LAS bf16x8*)(arow + 128 + 32 * ks);
#pragma unroll
            for (int n = 0; n < 4; ++n) { const bf16x8 wg = *(const bf16x8*)(G2T + (size_t)(64 * h + 16 * n + fr) * 128 + 32 * ks + 8 * fq);
                ag[n] = __builtin_amdgcn_mfma_f32_16x16x32_bf16(wg, bg, ag[n], 0, 0, 0); }
        }
        const int m = m0 + 16 * mt + fr; const bool first = (m & (SEQ - 1)) == 0;
        const bf16* prow = PB + (size_t)m * DSH; const bf16* qrow = first ? ZROW : (PB + (size_t)(m - 1) * DSH);
        f32x4 ksv[4], kkv[4]; float ssq = 0.f;
#pragma unroll
        for (int n = 0; n < 4; ++n) { const int c = 64 * h + 16 * n + 4 * fq;
            ksv[n] = shift4(prow + 512 + c, first ? ZROW : (qrow + 512 + c), mu + 512 + c);
            kkv[n] = ksv[n] * *(const f32x4*)(k_k + c);
            ssq += (kkv[n][0] * kkv[n][0] + kkv[n][1] * kkv[n][1]) + (kkv[n][2] * kkv[n][2] + kkv[n][3] * kkv[n][3]); }
        ssq += __shfl_xor(ssq, 16); ssq += __shfl_xor(ssq, 32);
        const float inv = 1.f / fmaxf(sqrtf(ssq), 1e-12f);
        float* sc = SCN + ((size_t)((m >> 11) * 8 + h) * SEQ + (m & (SEQ - 1))) * 384;
#pragma unroll
        for (int n = 0; n < 4; ++n) { const int c = 64 * h + 16 * n + 4 * fq, cl = 16 * n + 4 * fq;
            const f32x4 rs = shift4(prow + c, first ? ZROW : (qrow + c), mu + c), vs = shift4(prow + 1024 + c, first ? ZROW : (qrow + 1024 + c), mu + 1024 + c);
            const f32x4 wl = *(const f32x4*)(w0 + c) + aw[n], al = *(const f32x4*)(a0 + c) + aa[n], ka = *(const f32x4*)(k_a + c);
            f32x4 dec, av, kp;
#pragma unroll
            for (int j = 0; j < 4; ++j) { const float z = -wl[j]; const float sp = fmaxf(z, 0.f) + fast_log(1.f + fast_exp(-fabsf(z))); const float w = -sp - 0.5f;
                dec[j] = fast_exp(-fast_exp(w)); av[j] = fast_sigmoid(al[j]); kp[j] = ksv[n][j] * (1.f + (av[j] - 1.f) * ka[j]); }
            const f32x4 kk = kkv[n] * inv;
            *(f32x4*)(sc + 0 + cl) = rs; *(f32x4*)(sc + 64 + cl) = dec; *(f32x4*)(sc + 128 + cl) = kp; *(f32x4*)(sc + 192 + cl) = -kk; *(f32x4*)(sc + 256 + cl) = kk * av; *(f32x4*)(sc + 320 + cl) = vs;
            *(u32x2*)(G + (size_t)m * DB + c) = pk4(ag[n]); }
    }
    __syncthreads();
}

__device__ __forceinline__ void scan_block(LAS unsigned char* lds, int bh, const float* SCN, const bf16* G, const float* ln_g, const float* ln_b, const float* r_k, bf16* MIX, float* out_wkv, int tid, int wave, int lane) {
    const int b = bh >> 3, h = bh & 7;
    LAS float* BUF = (LAS float*)lds;
    LAS float* YB = (LAS float*)(lds + 98304);
    const float* src = SCN + (size_t)bh * SEQ * 384;
    f32x4 st[6];
#pragma unroll
    for (int j = 0; j < 6; ++j) st[j] = *(const f32x4*)(src + (size_t)(j * 512 + tid) * 4);
#pragma unroll
    for (int j = 0; j < 6; ++j) *(LAS f32x4*)(BUF + (j * 512 + tid) * 4) = st[j];
    __syncthreads();
    const int rr = lane >> 3, kq = lane & 7, v = 8 * wave + rr;
    float S[8];
#pragma unroll
    for (int j = 0; j < 8; ++j) S[j] = 0.f;
    const int tt = tid >> 4, l16 = tid & 15;
    const f32x4 lg4 = *(const f32x4*)(ln_g + 64 * h + 4 * l16), lb4 = *(const f32x4*)(ln_b + 64 * h + 4 * l16), rk4 = *(const f32x4*)(r_k + 64 * h + 4 * l16);
#pragma unroll 1
    for (int c = 0; c < 64; ++c) {
        const LAS float* B = BUF + (c & 1) * 12288;
        if (c + 1 < 64) {
#pragma unroll
            for (int j = 0; j < 6; ++j) st[j] = *(const f32x4*)(src + (size_t)(c + 1) * 12288 + (size_t)(j * 512 + tid) * 4); }
        f32x4 nr0, nr1, nd0, nd1, nk0, nk1, na0, na1, nb0, nb1; float nv;
        { const LAS float* P = B + 8 * kq; nr0 = *(const LAS f32x4*)(P); nr1 = *(const LAS f32x4*)(P + 4); nd0 = *(const LAS f32x4*)(P + 64); nd1 = *(const LAS f32x4*)(P + 68); nk0 = *(const LAS f32x4*)(P + 128); nk1 = *(const LAS f32x4*)(P + 132);
          na0 = *(const LAS f32x4*)(P + 192); na1 = *(const LAS f32x4*)(P + 196); nb0 = *(const LAS f32x4*)(P + 256); nb1 = *(const LAS f32x4*)(P + 260); nv = B[320 + v]; }
#pragma unroll 2
        for (int t = 0; t < 32; ++t) {
            const f32x4 r0 = nr0, r1 = nr1, d0 = nd0, d1 = nd1, k0 = nk0, k1 = nk1, a0 = na0, a1 = na1, b0 = nb0, b1 = nb1; const float vv = nv;
            { const int tn = t < 31 ? t + 1 : 31; const LAS float* P = B + tn * 384 + 8 * kq; nr0 = *(const LAS f32x4*)(P); nr1 = *(const LAS f32x4*)(P + 4); nd0 = *(const LAS f32x4*)(P + 64); nd1 = *(const LAS f32x4*)(P + 68); nk0 = *(const LAS f32x4*)(P + 128); nk1 = *(const LAS f32x4*)(P + 132);
              na0 = *(const LAS f32x4*)(P + 192); na1 = *(const LAS f32x4*)(P + 196); nb0 = *(const LAS f32x4*)(P + 256); nb1 = *(const LAS f32x4*)(P + 260); nv = B[tn * 384 + 320 + v]; }
            float sa = (S[0] * a0[0] + S[1] * a0[1]) + (S[2] * a0[2] + S[3] * a0[3]) + ((S[4] * a1[0] + S[5] * a1[1]) + (S[6] * a1[2] + S[7] * a1[3]));
            sa = red8(sa);
#pragma unroll
            for (int j = 0; j < 4; ++j) { S[j] = S[j] * d0[j] + (sa * b0[j] + vv * k0[j]); S[4 + j] = S[4 + j] * d1[j] + (sa * b1[j] + vv * k1[j]); }
            float y = (S[0] * r0[0] + S[1] * r0[1]) + (S[2] * r0[2] + S[3] * r0[3]) + ((S[4] * r1[0] + S[5] * r1[1]) + (S[6] * r1[2] + S[7] * r1[3]));
            y = red8(y);
            if (kq == 0) YB[t * 64 + v] = y;
        }
        __syncthreads();
        {
            const LAS float* P = B + tt * 384; const int m = b * SEQ + c * 32 + tt;
            const f32x4 y4 = *(const LAS f32x4*)(YB + tt * 64 + 4 * l16);
            const float mean = red16((y4[0] + y4[1]) + (y4[2] + y4[3])) * (1.f / 64.f);
            const f32x4 d4 = y4 - mean;
            const float var = red16((d4[0] * d4[0] + d4[1] * d4[1]) + (d4[2] * d4[2] + d4[3] * d4[3])) * (1.f / 64.f);
            const float rstd = 1.f / sqrtf(var + GN_EPS);
            const f32x4 r4 = *(const LAS f32x4*)(P + 4 * l16), k4 = *(const LAS f32x4*)(P + 128 + 4 * l16), v4 = *(const LAS f32x4*)(P + 320 + 4 * l16);
            const f32x4 rk = r4 * k4 * rk4;
            const float bon = red16((rk[0] + rk[1]) + (rk[2] + rk[3]));
            const f32x4 g4 = bf4(*(const u32x2*)(G + (size_t)m * DB + 64 * h + 4 * l16));
            const f32x4 o = ((d4 * rstd) * lg4 + lb4 + v4 * bon) * g4;
            *(u32x2*)(MIX + (size_t)m * 1024 + 512 + 64 * h + 4 * l16) = pk4(o);
        }
        if (c + 1 < 64) {
            LAS float* Bn = BUF + ((c + 1) & 1) * 12288;
#pragma unroll
            for (int j = 0; j < 6; ++j) *(LAS f32x4*)(Bn + (j * 512 + tid) * 4) = st[j]; }
        __syncthreads();
    }
    float* o = out_wkv + ((size_t)bh * 64 + v) * 64 + 8 * kq;
    *(f32x4*)o = (f32x4){S[0], S[1], S[2], S[3]}; *(f32x4*)(o + 4) = (f32x4){S[4], S[5], S[6], S[7]};
}

__device__ __forceinline__ void mixer_a_tile(LAS unsigned char* lds, int tile, const bf16* ZA, const bf16* WSB, const float* gm_ln_g, const float* gm_ln_b, const float* gm_bs, bf16* MIX, float* out_cv, int tid, int wave, int lane) {
    const int h = tile & 3, bc = tile >> 2, m0 = bc * 128, fr = lane & 15, fq = lane >> 4; const bool lastc = (bc & 15) == 15;
    LAS bf16* VT = (LAS bf16*)lds;
    {   const int r = 16 * wave + (lane >> 2), cq = (lane & 3) * 32; const bf16* src = ZA + (size_t)(m0 + r) * 1024 + 512 + h * 128 + cq;
        float x[32]; float s = 0.f;
#pragma unroll
        for (int j = 0; j < 4; ++j) { const u32x4 pv = *(const u32x4*)(src + 8 * j);
            x[8 * j + 0] = bf_lo(pv.x); x[8 * j + 1] = bf_hi(pv.x); x[8 * j + 2] = bf_lo(pv.y); x[8 * j + 3] = bf_hi(pv.y); x[8 * j + 4] = bf_lo(pv.z); x[8 * j + 5] = bf_hi(pv.z); x[8 * j + 6] = bf_lo(pv.w); x[8 * j + 7] = bf_hi(pv.w); }
#pragma unroll
        for (int j = 0; j < 32; ++j) s += x[j];
        const float mean = red4(s) * (1.f / 128.f); float q = 0.f;
#pragma unroll
        for (int j = 0; j < 32; ++j) { x[j] -= mean; q += x[j] * x[j]; }
        const float rstd = 1.f / sqrtf(red4(q) * (1.f / 128.f) + LN_EPS);
#pragma unroll
        for (int j = 0; j < 8; ++j) { const f32x4 g = *(const f32x4*)(gm_ln_g + h * 128 + cq + 4 * j), bb = *(const f32x4*)(gm_ln_b + h * 128 + cq + 4 * j);
#pragma unroll
            for (int e = 0; e < 4; ++e) x[4 * j + e] = x[4 * j + e] * rstd * g[e] + bb[e]; }
        if (lastc) { float* o = out_cv + ((size_t)((bc >> 4) * 128 + r) * 4 + h) * 128 + cq;
#pragma unroll
            for (int j = 0; j < 8; ++j) *(f32x4*)(o + 4 * j) = (f32x4){x[4 * j], x[4 * j + 1], x[4 * j + 2], x[4 * j + 3]}; }
#pragma unroll
        for (int j = 0; j < 32; j += 2) { const unsigned w = pk2(x[j], x[j + 1]); VT[(cq + j) * 136 + r] = (bf16)(w & 0xffffu); VT[(cq + j + 1) * 136 + r] = (bf16)(w >> 16); }
    }
    __syncthreads();
    f32x4 acc[8];
#pragma unroll
    for (int n = 0; n < 8; ++n) acc[n] = (f32x4){0.f, 0.f, 0.f, 0.f};
    const int nks = (wave >> 1) + 1;
    for (int ks = 0; ks < nks; ++ks) {
        const bf16x8 wsf = *(const bf16x8*)(WSB + (size_t)(h * 128 + 16 * wave + fr) * 128 + 32 * ks + 8 * fq);
#pragma unroll
        for (int n = 0; n < 8; ++n) { const bf16x8 vf = *(const LAS bf16x8*)(VT + (16 * n + fr) * 136 + 32 * ks + 8 * fq); acc[n] = __builtin_amdgcn_mfma_f32_16x16x32_bf16(vf, wsf, acc[n], 0, 0, 0); }
    }
    {   const int t = 16 * wave + fr; const float bsv = gm_bs[h * 128 + t]; const size_t rowo = (size_t)(m0 + t) * 1024 + h * 128;
#pragma unroll
        for (int n = 0; n < 8; ++n) { const int p0 = 16 * n + 4 * fq; const f32x4 u4 = bf4(*(const u32x2*)(ZA + rowo + p0)); *(u32x2*)(MIX + rowo + p0) = pk4(u4 * (acc[n] + bsv)); }
    }
    __syncthreads();
}


typedef short bf16x4 __attribute__((ext_vector_type(4)));
#define MFMA32(a, b, c) __builtin_amdgcn_mfma_f32_16x16x32_bf16(a, b, c, 0, 0, 0)
#define MFMA16(a, b, c) __builtin_amdgcn_mfma_f32_16x16x16bf16_1k(a, b, c, 0, 0, 0)
constexpr int CP = 72;
constexpr int L_LW = 0, L_LA = 17408, L_LG = 34816;
constexpr int L_LAB = 0, L_LAK = 9216, L_MRB = 18432, L_MRK = 27648, L_TDD = 36864;
constexpr int L_AT = 52224, L_BT = 61440, L_KT = 70656, L_RT = 79872;
constexpr int L_WT = 52224, L_APT = 61440;
constexpr int L_ATT = 89088, L_VTT = 98304, L_BHT = 107520, L_KHT = 116736;
constexpr int L_EXCH = 125952, L_PC = 128000;
constexpr size_t TASK_BYTES = 32768;

__device__ __forceinline__ float wave_sum_dpp(float x) {
    x = red16(x); const int xi = __builtin_bit_cast(int, x);
    const float a = __builtin_bit_cast(float, __builtin_amdgcn_readlane(xi, 0)), b = __builtin_bit_cast(float, __builtin_amdgcn_readlane(xi, 16)), c = __builtin_bit_cast(float, __builtin_amdgcn_readlane(xi, 32)), d = __builtin_bit_cast(float, __builtin_amdgcn_readlane(xi, 48));
    return (a + b) + (c + d);
}
__device__ __forceinline__ bf16x4 pack4(f32x4 v) { const u32x2 r = pk4(v); return __builtin_bit_cast(bf16x4, r); }
__device__ __forceinline__ bf16x8 ldsfrag(const LAS unsigned char* lds, int off, int row, int col) { return *(const LAS bf16x8*)(lds + off + (row * CP + col) * 2); }

__device__ __forceinline__ void rwkv_chunk_prep(LAS unsigned char* lds, int bc, const bf16* PB, const bf16* ZROW, const float* mu, const bf16* W2T, const bf16* A2T, const bf16* G2T,
                                                const float* w0, const float* a0, const float* k_k, const float* k_a, const float* r_k, bf16* LAIN, unsigned char* TASKS, bf16* G, bf16* VS, float* BON,
                                                int tid, int wave, int lane) {
    const int b = bc >> 5, c = bc & 31, m0 = b * SEQ + c * 64, fr = lane & 15, fq = lane >> 4;
    {   const int r = tid >> 3, cg = (tid & 7) * 32, m = m0 + r;
        const bf16* prow = PB + (size_t)m * DSH + 1536 + cg; const bf16* qrow = ((m & (SEQ - 1)) == 0) ? ZROW : (PB + (size_t)(m - 1) * DSH + 1536 + cg);
        const int mode = cg < 64 ? 0 : (cg < 128 ? 1 : 2);
#pragma unroll
        for (int j = 0; j < 4; ++j) {
            const u32x4 pv = *(const u32x4*)(prow + 8 * j), qv = *(const u32x4*)(qrow + 8 * j);
            const f32x4 m0v = *(const f32x4*)(mu + 1536 + cg + 8 * j), m1v = *(const f32x4*)(mu + 1536 + cg + 8 * j + 4);
            float x[8];
            { const float p0 = bf_lo(pv.x), p1 = bf_hi(pv.x), p2 = bf_lo(pv.y), p3 = bf_hi(pv.y), p4 = bf_lo(pv.z), p5 = bf_hi(pv.z), p6 = bf_lo(pv.w), p7 = bf_hi(pv.w);
              const float q0 = bf_lo(qv.x), q1 = bf_hi(qv.x), q2 = bf_lo(qv.y), q3 = bf_hi(qv.y), q4 = bf_lo(qv.z), q5 = bf_hi(qv.z), q6 = bf_lo(qv.w), q7 = bf_hi(qv.w);
              x[0] = p0 + (q0 - p0) * m0v[0]; x[1] = p1 + (q1 - p1) * m0v[1]; x[2] = p2 + (q2 - p2) * m0v[2]; x[3] = p3 + (q3 - p3) * m0v[3];
              x[4] = p4 + (q4 - p4) * m1v[0]; x[5] = p5 + (q5 - p5) * m1v[1]; x[6] = p6 + (q6 - p6) * m1v[2]; x[7] = p7 + (q7 - p7) * m1v[3]; }
#pragma unroll
            for (int e = 0; e < 8; ++e) x[e] = mode == 0 ? fast_tanh(x[e]) : (mode == 1 ? x[e] : fast_sigmoid(x[e]));
            u32x4 o; o.x = pk2(x[0], x[1]); o.y = pk2(x[2], x[3]); o.z = pk2(x[4], x[5]); o.w = pk2(x[6], x[7]);
            *(u32x4*)(LAIN + r * 256 + cg + 8 * j) = o;
        }
    }
    VM_WAIT(); __syncthreads();
#pragma unroll 1
    for (int h = 0; h < 8; ++h) {
        {   const int mt = wave >> 1;
#pragma unroll
            for (int q = 0; q < 2; ++q) { const int nt = (wave & 1) * 2 + q;
                f32x4 aw = (f32x4){0.f, 0.f, 0.f, 0.f}, aa = aw, ag = aw;
                const bf16* arow = LAIN + (16 * mt + fr) * 256 + 8 * fq; const int wrow = 64 * h + 16 * nt + fr;
#pragma unroll
                for (int ks = 0; ks < 2; ++ks) { aw = MFMA32(*(const bf16x8*)(W2T + (size_t)wrow * 64 + 32 * ks + 8 * fq), *(const bf16x8*)(arow + 32 * ks), aw);
                                                 aa = MFMA32(*(const bf16x8*)(A2T + (size_t)wrow * 64 + 32 * ks + 8 * fq), *(const bf16x8*)(arow + 64 + 32 * ks), aa); }
#pragma unroll
                for (int ks = 0; ks < 4; ++ks) ag = MFMA32(*(const bf16x8*)(G2T + (size_t)wrow * 128 + 32 * ks + 8 * fq), *(const bf16x8*)(arow + 128 + 32 * ks), ag);
                const int o = ((16 * mt + fr) * 68 + 16 * nt + 4 * fq) * 4;
                *(LAS f32x4*)(lds + L_LW + o) = aw; *(LAS f32x4*)(lds + L_LA + o) = aa; *(LAS f32x4*)(lds + L_LG + o) = ag; }
        }
        __syncthreads();
        {   const int ch = 64 * h + lane;
            const float mur = mu[ch], muk = mu[512 + ch], muv = mu[1024 + ch], w0c = w0[ch], a0c = a0[ch], kkc = k_k[ch], kac = k_a[ch], rkc = r_k[ch];
            float rs[8], kp[8], vs[8], av[8], bv[8], wd[8], cwl[8]; float run = 0.f;
#pragma unroll
            for (int i = 0; i < 8; ++i) { const int p = 8 * wave + i, m = m0 + p; const bf16* prow = PB + (size_t)m * DSH + ch; const bool first = (m & (SEQ - 1)) == 0; const bf16* qrow = first ? ZROW : (prow - DSH);
                const float pr = bf1(prow[0]), pk = bf1(prow[512]), pvv = bf1(prow[1024]); const float qr = bf1(qrow[0]), qk = bf1(first ? qrow[0] : qrow[512]), qv = bf1(first ? qrow[0] : qrow[1024]);
                rs[i] = pr + (qr - pr) * mur; const float ks = pk + (qk - pk) * muk; vs[i] = pvv + (qv - pvv) * muv;
                const float lw = *(const LAS float*)(lds + L_LW + (p * 68 + lane) * 4), la = *(const LAS float*)(lds + L_LA + (p * 68 + lane) * 4), lg = *(const LAS float*)(lds + L_LG + (p * 68 + lane) * 4);
                const float z = -(w0c + lw), sp = fmaxf(z, 0.f) + fast_log(1.f + fast_exp(-fabsf(z)));
                wd[i] = -fast_exp(-sp - 0.5f);
                const float as = fast_sigmoid(a0c + la);
                const float kkr = ks * kkc; const float n2 = wave_sum_dpp(kkr * kkr); const float kk = kkr / fmaxf(sqrtf(n2), 1e-12f);
                kp[i] = ks * (1.f + (as - 1.f) * kac); av[i] = -kk; bv[i] = kk * as;
                const float bon = wave_sum_dpp(rs[i] * kp[i] * rkc);
                run += wd[i]; cwl[i] = run;
                G[(size_t)m * DB + ch] = (bf16)(pk2(lg, 0.f) & 0xffffu); VS[(size_t)m * DB + ch] = (bf16)(pk2(vs[i], 0.f) & 0xffffu);
                if (lane == 0) BON[(size_t)m * 8 + h] = bon; }
            *(LAS float*)(lds + L_EXCH + (wave * 64 + lane) * 4) = run;
            __syncthreads();
            float base = 0.f, tot = 0.f;
#pragma unroll
            for (int w2 = 0; w2 < 8; ++w2) { const float t = *(const LAS float*)(lds + L_EXCH + (w2 * 64 + lane) * 4); tot += t; if (w2 < wave) base += t; }
            float oA[8], oV[8], oBh[8], oKh[8];
#pragma unroll
            for (int i = 0; i < 8; ++i) { const int p = 8 * wave + i; const float cw = base + cwl[i];
                const float e1 = fast_exp(cw - wd[i]), e2 = fast_exp(cw), e3 = fast_exp(-cw), e4 = fast_exp(tot - cw);
                const float At = av[i] * e1, Rt = rs[i] * e2, Bt = bv[i] * e3, Kt = kp[i] * e3;
                oA[i] = At; oV[i] = vs[i]; oBh[i] = bv[i] * e4; oKh[i] = kp[i] * e4;
                *(LAS bf16*)(lds + L_AT + (p * CP + lane) * 2) = (bf16)(pk2(At, 0.f) & 0xffffu); *(LAS bf16*)(lds + L_BT + (p * CP + lane) * 2) = (bf16)(pk2(Bt, 0.f) & 0xffffu);
                *(LAS bf16*)(lds + L_KT + (p * CP + lane) * 2) = (bf16)(pk2(Kt, 0.f) & 0xffffu); *(LAS bf16*)(lds + L_RT + (p * CP + lane) * 2) = (bf16)(pk2(Rt, 0.f) & 0xffffu); }
            { u32x4 o; const int off = (lane * CP + 8 * wave) * 2;
              o.x = pk2(oA[0], oA[1]); o.y = pk2(oA[2], oA[3]); o.z = pk2(oA[4], oA[5]); o.w = pk2(oA[6], oA[7]); *(LAS u32x4*)(lds + L_ATT + off) = o;
              o.x = pk2(oV[0], oV[1]); o.y = pk2(oV[2], oV[3]); o.z = pk2(oV[4], oV[5]); o.w = pk2(oV[6], oV[7]); *(LAS u32x4*)(lds + L_VTT + off) = o;
              o.x = pk2(oBh[0], oBh[1]); o.y = pk2(oBh[2], oBh[3]); o.z = pk2(oBh[4], oBh[5]); o.w = pk2(oBh[6], oBh[7]); *(LAS u32x4*)(lds + L_BHT + off) = o;
              o.x = pk2(oKh[0], oKh[1]); o.y = pk2(oKh[2], oKh[3]); o.z = pk2(oKh[4], oKh[5]); o.w = pk2(oKh[6], oKh[7]); *(LAS u32x4*)(lds + L_KHT + off) = o; }
            if (wave == 0) *(LAS float*)(lds + L_PC + lane * 4) = fast_exp(tot);
        }
        __syncthreads();
        {   const int ty = wave >> 1;
#pragma unroll
            for (int prod = 0; prod < 4; ++prod) { const int xo = (prod & 1) ? L_KT : L_BT, yo = prod < 2 ? L_AT : L_RT, oo = prod == 0 ? L_LAB : (prod == 1 ? L_LAK : (prod == 2 ? L_MRB : L_MRK)); const bool incl = prod >= 2;
#pragma unroll
                for (int q = 0; q < 2; ++q) { const int tx = (wave & 1) * 2 + q; f32x4 acc = (f32x4){0.f, 0.f, 0.f, 0.f};
                    if (tx <= ty) {
#pragma unroll
                        for (int ks = 0; ks < 2; ++ks) acc = MFMA32(ldsfrag(lds, xo, 16 * tx + fr, 32 * ks + 8 * fq), ldsfrag(lds, yo, 16 * ty + fr, 32 * ks + 8 * fq), acc); }
                    const int i = 16 * ty + fr, j0 = 16 * tx + 4 * fq;
#pragma unroll
                    for (int e = 0; e < 4; ++e) { const int j = j0 + e; if (!(incl ? (j <= i) : (j < i))) acc[e] = 0.f; }
                    *(LAS u32x2*)(lds + oo + (i * CP + j0) * 2) = pk4(acc); } }
        }
        __syncthreads();
        if (wave < 4) { const int d = wave; float t[16];
#pragma unroll
            for (int i = 0; i < 16; ++i) { const u32x4 r0 = *(const LAS u32x4*)(lds + L_LAB + ((16 * d + i) * CP + 16 * d) * 2), r1 = *(const LAS u32x4*)(lds + L_LAB + ((16 * d + i) * CP + 16 * d + 8) * 2);
                const float l[16] = {bf_lo(r0.x), bf_hi(r0.x), bf_lo(r0.y), bf_hi(r0.y), bf_lo(r0.z), bf_hi(r0.z), bf_lo(r0.w), bf_hi(r0.w), bf_lo(r1.x), bf_hi(r1.x), bf_lo(r1.y), bf_hi(r1.y), bf_lo(r1.z), bf_hi(r1.z), bf_lo(r1.w), bf_hi(r1.w)};
                float s = (i == lane) ? 1.f : 0.f;
#pragma unroll
                for (int mm = 0; mm < i; ++mm) s += l[mm] * t[mm];
                t[i] = s; }
            if (lane < 16) {
#pragma unroll
                for (int i = 0; i < 16; ++i) *(LAS bf16*)(lds + L_TDD + ((d * 16 + i) * 24 + lane) * 2) = (bf16)(pk2(t[i], 0.f) & 0xffffu); }
        }
        __syncthreads();
        {   const int s = wave & 3; const bool isW = wave < 4; f32x4 acc[4];
            if (isW) {
#pragma unroll
                for (int d = 0; d < 4; ++d) { acc[d] = (f32x4){0.f, 0.f, 0.f, 0.f};
#pragma unroll
                    for (int ks = 0; ks < 2; ++ks) if (32 * ks <= 16 * d + 15) acc[d] = MFMA32(ldsfrag(lds, L_LAK, 16 * d + fr, 32 * ks + 8 * fq), ldsfrag(lds, L_VTT, 16 * s + fr, 32 * ks + 8 * fq), acc[d]); }
            } else {
#pragma unroll
                for (int d = 0; d < 4; ++d) acc[d] = bf4(*(const LAS u32x2*)(lds + L_ATT + ((16 * s + fr) * CP + 16 * d + 4 * fq) * 2));
            }
            bf16x4 xf[4]; const int oo = isW ? L_WT : L_APT;
#pragma unroll
            for (int d = 0; d < 4; ++d) {
#pragma unroll
                for (int mm = 0; mm < d; ++mm) acc[d] = MFMA16(*(const LAS bf16x4*)(lds + L_LAB + ((16 * d + fr) * CP + 16 * mm + 4 * fq) * 2), xf[mm], acc[d]);
                const f32x4 x = MFMA16(*(const LAS bf16x4*)(lds + L_TDD + ((d * 16 + fr) * 24 + 4 * fq) * 2), pack4(acc[d]), ((f32x4){0.f, 0.f, 0.f, 0.f}));
                xf[d] = pack4(x);
                *(LAS bf16x4*)(lds + oo + ((16 * s + fr) * CP + 16 * d + 4 * fq) * 2) = xf[d]; }
        }
        __syncthreads();
        {   unsigned char* task = TASKS + (size_t)((b * 8 + h) * 32 + c) * TASK_BYTES; const int ty = wave >> 1;
#pragma unroll
            for (int q = 0; q < 2; ++q) { const int tx = (wave & 1) * 2 + q; const int yr = 16 * ty + fr, xc = 16 * tx + 4 * fq;
                f32x4 aM = (f32x4){0.f, 0.f, 0.f, 0.f}, aN = aM, aR = aM, aY = aM;
#pragma unroll
                for (int ks = 0; ks < 2; ++ks) { const int kc = 32 * ks + 8 * fq;
                    const bf16x8 fAP = ldsfrag(lds, L_APT, 16 * tx + fr, kc), fBHx = ldsfrag(lds, L_BHT, 16 * tx + fr, kc), fKHx = ldsfrag(lds, L_KHT, 16 * tx + fr, kc), fMRBx = ldsfrag(lds, L_MRB, 16 * tx + fr, kc), fMRKx = ldsfrag(lds, L_MRK, 16 * tx + fr, kc);
                    const bf16x8 fBHy = ldsfrag(lds, L_BHT, 16 * ty + fr, kc), fWTy = ldsfrag(lds, L_WT, 16 * ty + fr, kc), fVTy = ldsfrag(lds, L_VTT, 16 * ty + fr, kc), fMRBy = ldsfrag(lds, L_MRB, 16 * ty + fr, kc);
                    aM = MFMA32(fAP, fBHy, aM);
                    aN = MFMA32(fBHx, fWTy, aN); aN = MFMA32(fKHx, fVTy, aN);
                    aR = MFMA32(fAP, fMRBy, aR);
                    aY = MFMA32(fMRBx, fWTy, aY); aY = MFMA32(fMRKx, fVTy, aY); }
                const float pc = *(const LAS float*)(lds + L_PC + yr * 4);
#pragma unroll
                for (int e = 0; e < 4; ++e) if (xc + e == yr) aM[e] += pc;
                aR += bf4(*(const LAS u32x2*)(lds + L_RT + (yr * CP + xc) * 2));
                const size_t o = (size_t)(yr * 64 + xc) * 2;
                *(u32x2*)(task + o) = pk4(aM); *(u32x2*)(task + 8192 + o) = pk4(aN); *(u32x2*)(task + 16384 + o) = pk4(aR); *(u32x2*)(task + 24576 + o) = pk4(aY); }
        }
        __syncthreads();
    }
}

#ifndef SB_NSTEP
#define SB_NSTEP 32
#endif
__device__ __forceinline__ void scanB_block(LAS unsigned char* lds, int blk, const unsigned char* TASKS, const bf16* G, const bf16* VS, const float* BON, const float* ln_g, const float* ln_b, bf16* MIX, float* out_wkv, int tid, int wave, int lane) {
    const int pair = wave >> 2, s = wave & 3, bh = 2 * blk + pair, b = bh >> 3, h = bh & 7, fr = lane & 15, fq = lane >> 4;
    LAS float* YB = (LAS float*)lds + pair * 8192;
    const unsigned char* tk = TASKS + (size_t)bh * 32 * TASK_BYTES;
    bf16x4 Mf[4][4], Rf[4][4], Nf[4], Yf[4], xf[4];
    f32x4 accX[4];
#pragma unroll
    for (int t = 0; t < 4; ++t) { xf[t] = (bf16x4){0, 0, 0, 0}; accX[t] = (f32x4){0.f, 0.f, 0.f, 0.f}; }
#define LOADTASK(cc) do { const unsigned char* tp_ = tk + (size_t)(cc) * TASK_BYTES; _Pragma("unroll") for (int t = 0; t < 4; ++t) { _Pragma("unroll") for (int kb = 0; kb < 4; ++kb) { \
        Mf[t][kb] = *(const bf16x4*)(tp_ + ((16 * t + fr) * 64 + 16 * kb + 4 * fq) * 2); Rf[t][kb] = *(const bf16x4*)(tp_ + 16384 + ((16 * t + fr) * 64 + 16 * kb + 4 * fq) * 2); } \
        Nf[t] = *(const bf16x4*)(tp_ + 8192 + ((16 * s + fr) * 64 + 16 * t + 4 * fq) * 2); Yf[t] = *(const bf16x4*)(tp_ + 24576 + ((16 * s + fr) * 64 + 16 * t + 4 * fq) * 2); } } while (0)
#ifndef SB_NOLOAD
    LOADTASK(0);
#else
    _Pragma("unroll") for (int t = 0; t < 4; ++t) { _Pragma("unroll") for (int kb = 0; kb < 4; ++kb) { Mf[t][kb] = (bf16x4){1, 2, 3, 4}; Rf[t][kb] = (bf16x4){1, 2, 3, 4}; } Nf[t] = (bf16x4){1, 2, 3, 4}; Yf[t] = (bf16x4){1, 2, 3, 4}; }
#endif
    const int tp = tid & 255, l16 = tp & 15;
    const f32x4 lg4 = *(const f32x4*)(ln_g + 64 * h + 4 * l16), lb4 = *(const f32x4*)(ln_b + 64 * h + 4 * l16);
#pragma unroll 1
    for (int c = 0; c < SB_NSTEP; ++c) {
        f32x4 accY[4];
#pragma unroll
        for (int t = 0; t < 4; ++t) { accY[t] = bf4(__builtin_bit_cast(u32x2, Yf[t])); accX[t] = bf4(__builtin_bit_cast(u32x2, Nf[t]));
#pragma unroll
            for (int kb = 0; kb < 4; ++kb) { accY[t] = MFMA16(Rf[t][kb], xf[kb], accY[t]); accX[t] = MFMA16(Mf[t][kb], xf[kb], accX[t]); } }
#ifndef SB_NOLOAD
        if (c + 1 < 32) LOADTASK(c + 1);
#endif
#pragma unroll
        for (int t = 0; t < 4; ++t) xf[t] = pack4(accX[t]);
#ifndef SB_NOEPI
        LAS float* yb = YB + (c & 1) * 4096;
#pragma unroll
        for (int t = 0; t < 4; ++t)
#pragma unroll
            for (int e = 0; e < 4; ++e) yb[(16 * t + 4 * fq + e) * 64 + 16 * s + fr] = accY[t][e];
        __syncthreads();
#pragma unroll
        for (int it = 0; it < 4; ++it) { const int tt = it * 16 + (tp >> 4); const int m = b * SEQ + c * 64 + tt;
            const f32x4 y4 = *(const LAS f32x4*)(yb + tt * 64 + 4 * l16);
            const float mean = red16((y4[0] + y4[1]) + (y4[2] + y4[3])) * (1.f / 64.f);
            const f32x4 d4 = y4 - mean;
            const float var = red16((d4[0] * d4[0] + d4[1] * d4[1]) + (d4[2] * d4[2] + d4[3] * d4[3])) * (1.f / 64.f);
            const float rstd = 1.f / sqrtf(var + GN_EPS);
            const f32x4 g4 = bf4(*(const u32x2*)(G + (size_t)m * DB + 64 * h + 4 * l16)), v4 = bf4(*(const u32x2*)(VS + (size_t)m * DB + 64 * h + 4 * l16));
            const float bon = BON[(size_t)m * 8 + h];
            const f32x4 o = ((d4 * rstd) * lg4 + lb4 + v4 * bon) * g4;
            *(u32x2*)(MIX + (size_t)m * 1024 + 512 + 64 * h + 4 * l16) = pk4(o); }
#else
        asm volatile("" :: "v"(accY[0]), "v"(accY[1]), "v"(accY[2]), "v"(accY[3]));
#endif
    }
#undef LOADTASK
#pragma unroll
    for (int t = 0; t < 4; ++t) *(f32x4*)(out_wkv + ((size_t)bh * 64 + 16 * s + fr) * 64 + 16 * t + 4 * fq) = accX[t];
}

template <class EpiF>
__device__ __forceinline__ void small_gemm(LAS unsigned char* lds, const bf16* A, int lda, const bf16* Bt, int N, int K, int gb, int GB, const EpiF& epi, int tid, int wave, int lane) {
    const int fr = lane & 15, fq = lane >> 4, kw = K >> 3;
    LAS float* part = (LAS float*)lds;
    for (int strip = gb; strip < (N >> 4); strip += GB) {
        f32x4 acc[8];
#pragma unroll
        for (int i = 0; i < 8; ++i) acc[i] = (f32x4){0.f, 0.f, 0.f, 0.f};
        const bf16* brow = Bt + (size_t)(16 * strip + fr) * K + wave * kw + 8 * fq;
        const bf16* arow = A + (size_t)fr * lda + wave * kw + 8 * fq;
#pragma unroll 2
        for (int ks = 0; ks < (kw >> 5); ++ks) {
            const bf16x8 wf = *(const bf16x8*)(brow + 32 * ks);
#pragma unroll
            for (int mt = 0; mt < 8; ++mt) { const bf16x8 af = *(const bf16x8*)(arow + (size_t)(16 * mt) * lda + 32 * ks); acc[mt] = __builtin_amdgcn_mfma_f32_16x16x32_bf16(wf, af, acc[mt], 0, 0, 0); }
        }
#pragma unroll
        for (int mt = 0; mt < 8; ++mt) *(LAS f32x4*)(part + ((wave * 128 + 16 * mt + fr) * 16 + 4 * fq)) = acc[mt];
        __syncthreads();
        {   const int token = tid >> 2, cg = tid & 3; f32x4 s = (f32x4){0.f, 0.f, 0.f, 0.f};
#pragma unroll
            for (int w = 0; w < 8; ++w) s += *(const LAS f32x4*)(part + ((w * 128 + token) * 16 + 4 * cg));
            epi(token, 16 * strip + 4 * cg, s); }
        __syncthreads();
    }
}
struct SEpiProj { bf16* ZAs; float* PBs;
    __device__ __forceinline__ void operator()(int t, int c, f32x4 s) const {
        if (c < 1024) { const f32x2 a = pg8::gelu_pk((f32x2){s[0], s[1]}), b = pg8::gelu_pk((f32x2){s[2], s[3]}); *(u32x2*)(ZAs + (size_t)t * 1024 + c) = pk4((f32x4){a.x, a.y, b.x, b.y}); }
        else *(f32x4*)(PBs + (size_t)t * DSH + (c - 1024)) = s; } };
template <bool WB> struct SEpiRes { const float* base; float* out; bf16* outb; float* rowss;
    __device__ __forceinline__ void operator()(int t, int c, f32x4 s) const {
        const f32x4 v = *(const f32x4*)(base + (size_t)t * 1024 + c) + s; *(f32x4*)(out + (size_t)t * 1024 + c) = v; if (WB) *(u32x2*)(outb + (size_t)t * 1024 + c) = pk4(v);
        float ss = (v[0] * v[0] + v[1] * v[1]) + (v[2] * v[2] + v[3] * v[3]); ss = red4(ss);
        if ((threadIdx.x & 3) == 0) (void)__hip_atomic_fetch_add(rowss + t, ss, __ATOMIC_RELAXED, __HIP_MEMORY_SCOPE_AGENT); } };
struct SEpiQ { float* Q; const float* rowss;
    __device__ __forceinline__ void operator()(int t, int c, f32x4 s) const {
        const float sc = 0.0625f / sqrtf(__hip_atomic_load(rowss + t, __ATOMIC_RELAXED, __HIP_MEMORY_SCOPE_AGENT) * (1.f / D) + RMS_EPS); *(f32x4*)(Q + (size_t)t * 1024 + c) = s * sc; } };
struct SEpiUp { bf16* H; const float* rowss;
    __device__ __forceinline__ void operator()(int t, int c, f32x4 s) const {
        const float sc = 1.f / sqrtf(__hip_atomic_load(rowss + t, __ATOMIC_RELAXED, __HIP_MEMORY_SCOPE_AGENT) * (1.f / D) + RMS_EPS); f32x4 v = s * sc;
#pragma unroll
        for (int j = 0; j < 4; ++j) { const float a = fmaxf(v[j], 0.f); v[j] = a * a; }
        *(u32x2*)(H + (size_t)t * FF + c) = pk4(v); } };

struct KArgs { const float* in[35]; float* out; unsigned char* ws; };
struct SampleCtx { unsigned* subcnt; unsigned* tmo; float* rs1; float* rs2; float* rs3; };
__device__ __forceinline__ void sample_mixer_token(LAS unsigned char* lds, int tok, const KArgs& KA, const bf16* ZAs, const float* PBs, bf16* MIXs, int tid, int wave, int lane) {
    const float* const (&in)[35] = KA.in; float* out = KA.out;
    LAS float* red = (LAS float*)lds;
    LAS float* lin = (LAS float*)(lds + 256);
    LAS float* vec = (LAS float*)(lds + 2048);
    const int c = tid;
    {   const int hA = c >> 7; const float vz = bf1(ZAs[(size_t)tok * 1024 + 512 + c]), uz = bf1(ZAs[(size_t)tok * 1024 + c]);
        const float s1 = wave_sum(vz); if (lane == 0) red[wave] = s1;
        __syncthreads();
        const float mean = (red[2 * hA] + red[2 * hA + 1]) * (1.f / 128.f); const float dv = vz - mean;
        const float s2 = wave_sum(dv * dv); if (lane == 0) red[8 + wave] = s2;
        __syncthreads();
        const float var = (red[8 + 2 * hA] + red[8 + 2 * hA + 1]) * (1.f / 128.f);
        const float vn = dv * (1.f / sqrtf(var + LN_EPS)) * in[10][c] + in[11][c];
        out[O_CVS + (size_t)tok * 512 + c] = vn;
        const float mixed = in[12][(size_t)hA * 128 * 128] * vn + in[13][hA * 128];
        MIXs[(size_t)tok * 1024 + c] = (bf16)(pk2(uz * mixed, 0.f) & 0xffffu);
    }
    const float* pb = PBs + (size_t)tok * DSH; const float* pv = in[5] + (size_t)tok * DSH; const float* mu = in[9];
    if (tid < 256) { const int i = 1536 + tid; const float x = pb[i] + (pv[i] - pb[i]) * mu[i]; lin[tid] = tid < 64 ? fast_tanh(x) : (tid < 128 ? x : fast_sigmoid(x)); }
    __syncthreads();
    const float rs = pb[c] + (pv[c] - pb[c]) * mu[c], ks = pb[512 + c] + (pv[512 + c] - pb[512 + c]) * mu[512 + c], vs = pb[1024 + c] + (pv[1024 + c] - pb[1024 + c]) * mu[1024 + c];
    float wl = in[14][c], al = in[16][c], g = 0.f;
    { const float* w2 = in[15] + c; const float* a2 = in[17] + c; const float* g2 = in[18] + c;
#pragma unroll 8
      for (int j = 0; j < 64; ++j) { wl += lin[j] * w2[(size_t)j * DB]; al += lin[64 + j] * a2[(size_t)j * DB]; }
#pragma unroll 8
      for (int j = 0; j < 128; ++j) g += lin[128 + j] * g2[(size_t)j * DB]; }
    const float z = -wl, sp = fmaxf(z, 0.f) + fast_log(1.f + fast_exp(-fabsf(z))), w = -sp - 0.5f, dec = fast_exp(-fast_exp(w)), av = fast_sigmoid(al);
    const float kkr = ks * in[19][c]; const float nrm = sqrtf(wave_sum(kkr * kkr)); const float kk = kkr / fmaxf(nrm, 1e-12f); const float kp = ks * (1.f + (av - 1.f) * in[20][c]);
    LAS float* hv = vec + wave * 320;
    hv[lane] = dec; hv[64 + lane] = -kk; hv[128 + lane] = kk * av; hv[192 + lane] = kp; hv[256 + lane] = rs;
    __syncthreads();
    {   const size_t so = ((size_t)(tok * 8 + wave) * 64 + lane) * 64; const float* s0 = in[6] + so; float* s1o = out + O_WKVS + so;
        f32x4 Sx[16]; float sa = 0.f;
#pragma unroll
        for (int j = 0; j < 16; ++j) { Sx[j] = *(const f32x4*)(s0 + 4 * j); const f32x4 a4 = *(const LAS f32x4*)(hv + 64 + 4 * j); sa += (Sx[j][0] * a4[0] + Sx[j][1] * a4[1]) + (Sx[j][2] * a4[2] + Sx[j][3] * a4[3]); }
        float y = 0.f;
#pragma unroll
        for (int j = 0; j < 16; ++j) { const f32x4 d4 = *(const LAS f32x4*)(hv + 4 * j), b4 = *(const LAS f32x4*)(hv + 128 + 4 * j), k4 = *(const LAS f32x4*)(hv + 192 + 4 * j), r4 = *(const LAS f32x4*)(hv + 256 + 4 * j);
            const f32x4 sn = Sx[j] * d4 + (b4 * sa + k4 * vs); *(f32x4*)(s1o + 4 * j) = sn; y += (sn[0] * r4[0] + sn[1] * r4[1]) + (sn[2] * r4[2] + sn[3] * r4[3]); }
        const float mean = wave_sum(y) * (1.f / 64.f), dy = y - mean, var = wave_sum(dy * dy) * (1.f / 64.f);
        const float yn = dy * (1.f / sqrtf(var + GN_EPS)) * in[22][c] + in[23][c];
        const float bon = wave_sum(rs * kp * in[21][c]) * vs;
        MIXs[(size_t)tok * 1024 + 512 + c] = (bf16)(pk2((yn + bon) * g, 0.f) & 0xffffu);
    }
    __syncthreads();
}
__device__ __forceinline__ void sample_attn_pair(LAS unsigned char* lds, int pair, const float* Qs, const float* Kc, const float* Vc, bf16* Os, int tid, int wave, int lane) {
    const int b = pair >> 2, h = pair & 3;
    LAS float* sc = (LAS float*)lds;
    LAS float* part = (LAS float*)(lds + 1024);
    const f32x4 q4 = *(const f32x4*)(Qs + (size_t)b * 1024 + h * 256 + 4 * lane);
    const float* kb = Kc + ((size_t)b * 256 * 4 + h) * 256 + 4 * lane; const float* vb = Vc + ((size_t)b * 256 * 4 + h) * 256 + 4 * lane;
#pragma unroll 4
    for (int i = 0; i < 32; ++i) { const int mm = 32 * wave + i; const f32x4 k4 = *(const f32x4*)(kb + (size_t)mm * 1024);
        const float p = wave_sum((q4[0] * k4[0] + q4[1] * k4[1]) + (q4[2] * k4[2] + q4[3] * k4[3])); if (lane == 0) sc[mm] = p; }
    __syncthreads();
    {   const f32x4 s4 = *(const LAS f32x4*)(sc + 4 * lane); const float mx = wave_max(fmaxf(fmaxf(s4[0], s4[1]), fmaxf(s4[2], s4[3])));
        f32x4 e; float sum = 0.f;
#pragma unroll
        for (int j = 0; j < 4; ++j) { e[j] = fast_exp(s4[j] - mx); sum += e[j]; }
        sum = wave_sum(sum); const float inv = 1.f / sum;
        __syncthreads();
        if (wave == 0) *(LAS f32x4*)(sc + 4 * lane) = e * inv;
    }
    __syncthreads();
    f32x4 o = (f32x4){0.f, 0.f, 0.f, 0.f};
#pragma unroll 4
    for (int i = 0; i < 32; ++i) { const int mm = 32 * wave + i; const f32x4 v4 = *(const f32x4*)(vb + (size_t)mm * 1024); o += v4 * sc[mm]; }
    *(LAS f32x4*)(part + wave * 256 + 4 * lane) = o;
    __syncthreads();
    if (tid < 256) { float s = 0.f;
#pragma unroll
        for (int w = 0; w < 8; ++w) s += part[w * 256 + tid];
        Os[(size_t)b * 1024 + h * 256 + tid] = (bf16)(pk2(s, 0.f) & 0xffffu); }
    __syncthreads();
}
__device__ __forceinline__ void sample_path(LAS unsigned char* lds, const KArgs& KA, const SampleCtx& C, int gb, int GB, int tid, int wave, int lane) {
    unsigned char* ws = KA.ws; unsigned char* sm = ws + WS_SMP; const float* const (&in)[35] = KA.in; float* out = KA.out;
    const bf16* XN0s = (const bf16*)(ws + WS_ACAT) + (size_t)M * 1024;
    bf16* ZAs = (bf16*)(sm + SM_ZA); bf16* MIXs = (bf16*)(sm + SM_MIX); float* X1s = (float*)(sm + SM_X1); bf16* X1Bs = (bf16*)(sm + SM_X1B); float* Qs = (float*)(sm + SM_Q); bf16* Os = (bf16*)(sm + SM_O);
    float* X2s = (float*)(sm + SM_X2); bf16* X2Bs = (bf16*)(sm + SM_X2B); bf16* HIDs = (bf16*)(sm + SM_HID); float* X3s = (float*)(sm + SM_X3);
    float* PBs = out + O_SHS;
    unsigned gen = 0;
#define SUBBAR() do { ++gen; sub_barrier(C.subcnt, C.tmo, gen * (unsigned)GB); } while (0)
    { SEpiProj e{ZAs, PBs}; small_gemm(lds, XN0s, 1024, (const bf16*)(ws + WS_WCAT), DIN, 1024, gb, GB, e, tid, wave, lane); }
    SUBBAR();
    for (int tok = gb; tok < MS; tok += GB) sample_mixer_token(lds, tok, KA, ZAs, PBs, MIXs, tid, wave, lane);
    SUBBAR();
    { SEpiRes<true> e{in[1], X1s, X1Bs, C.rs1 + M}; small_gemm(lds, MIXs, 1024, (const bf16*)(ws + WS_WOUT), 1024, 1024, gb, GB, e, tid, wave, lane); }
    SUBBAR();
    { SEpiQ e{Qs, C.rs1 + M}; small_gemm(lds, X1Bs, 1024, (const bf16*)(ws + WS_WQ), 1024, 1024, gb, GB, e, tid, wave, lane); }
    SUBBAR();
    for (int pair = gb; pair < MS * 4; pair += GB) sample_attn_pair(lds, pair, Qs, in[3], in[4], Os, tid, wave, lane);
    SUBBAR();
    { SEpiRes<true> e{X1s, X2s, X2Bs, C.rs2 + M}; small_gemm(lds, Os, 1024, (const bf16*)(ws + WS_WO), 1024, 1024, gb, GB, e, tid, wave, lane); }
    SUBBAR();
    { SEpiUp e{HIDs, C.rs2 + M}; small_gemm(lds, X2Bs, 1024, (const bf16*)(ws + WS_WUP), FF, 1024, gb, GB, e, tid, wave, lane); }
    SUBBAR();
    { SEpiRes<false> e{X2s, X3s, nullptr, C.rs3 + M}; small_gemm(lds, HIDs, FF, (const bf16*)(ws + WS_WDN), 1024, FF, gb, GB, e, tid, wave, lane); }
    SUBBAR();
    for (int r = gb * 8 + wave; r < MS; r += GB * 8) {
        const float sc = 1.f / sqrtf(__hip_atomic_load(C.rs3 + M + r, __ATOMIC_RELAXED, __HIP_MEMORY_SCOPE_AGENT) * (1.f / D) + RMS_EPS);
#pragma unroll
        for (int j = 0; j < 4; ++j) { const int cc = 256 * j + 4 * lane; *(f32x4*)(out + O_YS + (size_t)r * 1024 + cc) = *(const f32x4*)(X3s + (size_t)r * 1024 + cc) * sc * *(const f32x4*)(in[34] + cc); } }
#undef SUBBAR
}

#ifndef REP0
#define REP0 1
#endif
#ifndef REP1
#define REP1 1
#endif
#ifndef REP2
#define REP2 1
#endif
#ifndef REP3
#define REP3 1
#endif
#ifndef REP5
#define REP5 1
#endif
#ifndef REP6
#define REP6 1
#endif
#ifndef REP8
#define REP8 1
#endif
__global__ void __launch_bounds__(NWAVES * 64, 2) mk_fwd(KArgs a) {
    extern __shared__ __attribute__((aligned(16))) unsigned char lds_raw[];
    LAS unsigned char* lds = (LAS unsigned char*)lds_raw;
    volatile LAS unsigned* MISC = (volatile LAS unsigned*)(lds + MISC_OFF);
    const int tid = threadIdx.x, lane = tid & 63, wave = __builtin_amdgcn_readfirstlane(tid >> 6);
    const int G = gridDim.x, bx = blockIdx.x; const int vcu = (G % 8 == 0) ? (bx % 8) * (G / 8) + bx / 8 : bx;
    unsigned char* ws = a.ws; float* out = a.out;
    gu32* ctl = (gu32*)(ws + WS_CTL);
    for (int u = tid; u < (LDS_BYTES - LDSCTL_OFF) / 4; u += NWAVES * 64) ((LAS unsigned*)(lds + LDSCTL_OFF))[u] = 0u;
    __syncthreads();
    XcdBarrier bar = xcd_barrier_post((unsigned*)ctl + CW_BAR, MISC + 8);
#define GRID_BAR() xcd_barrier(bar)
#define RS1 ((float*)ws + RS_OFF)
#define RS2 ((float*)ws + RS_OFF + RS_STRIDE)
#define RS3 ((float*)ws + RS_OFF + 2 * RS_STRIDE)
#define WCAT ((bf16*)(ws + WS_WCAT))
#define WOUT ((bf16*)(ws + WS_WOUT))
#define WQ ((bf16*)(ws + WS_WQ))
#define WO ((bf16*)(ws + WS_WO))
#define WUP ((bf16*)(ws + WS_WUP))
#define WDN ((bf16*)(ws + WS_WDN))
#define W2T ((bf16*)(ws + WS_SMALL))
#define A2T ((bf16*)(ws + WS_SMALL + 64 * KiB))
#define G2T ((bf16*)(ws + WS_SMALL + 128 * KiB))
#define WSB ((bf16*)(ws + WS_SMALL + 256 * KiB))
#define ZROW ((bf16*)(ws + WS_SMALL + 384 * KiB))
#define ACAT ((bf16*)(ws + WS_ACAT))
#define ZA ((bf16*)(ws + WS_ZA))
#define PB ((bf16*)(ws + WS_PB))
#define SCN ((float*)(ws + WS_SCN))
#define LAIN ((bf16*)(ws + WS_NEW))
#define TASKS (ws + WS_NEW + 8 * MiB)
#define VSB ((bf16*)(ws + WS_NEW + 72 * MiB))
#define BON ((float*)(ws + WS_NEW + 88 * MiB))
#define GB_ ((bf16*)(ws + WS_G))
#define MIX ((bf16*)(ws + WS_MIX))
#define KB ((bf16*)(ws + WS_KB))
#define VT ((bf16*)(ws + WS_VT))
#define X1B ((bf16*)(ws + WS_ZA))
#define Q ((bf16*)(ws + WS_Q))
#define OB ((bf16*)(ws + WS_OB))
#define PSCR ((bf16*)(ws + WS_PSCR))
#define X2B ((bf16*)(ws + WS_MIX))
#define HID ((bf16*)(ws + WS_HID))
    const int gw = vcu * NWAVES + wave, NGW = G * NWAVES;

    #ifndef NOP0
    ws = a.ws; asm volatile("" : "+s"(ws));
    for (int rep_ = 0; rep_ < REP0; ++rep_)
    {
        LAS float* scr = (LAS float*)(lds + wave * 16384);
        constexpr int I_IN = 16 * 88, I_SQ = 16 * 32, I_UP = 16 * 128, I_DN = 64 * 32, I_L = 16, I_G = 32;
        constexpr int NITEMS = I_IN + 5 * I_SQ + I_UP + I_DN + 2 * I_L + I_G;
        for (int it = gw; it < NITEMS; it += NGW) {
            int r = it;
            if (r < I_IN) { p0_transpose_item(a.in[8], 1024, DIN, WCAT, 0, nullptr, scr, r, lane); continue; } r -= I_IN;
            if (r < I_SQ) { p0_transpose_item(a.in[28], 1024, 1024, WCAT, DIN, nullptr, scr, r, lane); continue; } r -= I_SQ;
            if (r < I_SQ) { p0_transpose_item(a.in[29], 1024, 1024, WCAT, DIN + 1024, nullptr, scr, r, lane); continue; } r -= I_SQ;
            if (r < I_SQ) { p0_transpose_item(a.in[24], 1024, 1024, WOUT, 0, nullptr, scr, r, lane); continue; } r -= I_SQ;
            if (r < I_SQ) { p0_transpose_item(a.in[27], 1024, 1024, WQ, 0, a.in[25], scr, r, lane); continue; } r -= I_SQ;
            if (r < I_SQ) { p0_transpose_item(a.in[30], 1024, 1024, WO, 0, nullptr, scr, r, lane); continue; } r -= I_SQ;
            if (r < I_UP) { p0_transpose_item(a.in[32], 1024, FF, WUP, 0, a.in[31], scr, r, lane); continue; } r -= I_UP;
            if (r < I_DN) { p0_transpose_item(a.in[33], FF, 1024, WDN, 0, nullptr, scr, r, lane); continue; } r -= I_DN;
            if (r < I_L) { p0_transpose_item(a.in[15], 64, DB, W2T, 0, nullptr, scr, r, lane); continue; } r -= I_L;
            if (r < I_L) { p0_transpose_item(a.in[17], 64, DB, A2T, 0, nullptr, scr, r, lane); continue; } r -= I_L;
            p0_transpose_item(a.in[18], 128, DB, G2T, 0, nullptr, scr, r, lane);
        }
        for (int m = gw; m < M + MS + NBATCH * NMEM; m += NGW) {
            if (m < M) rms_row_to_bf16(a.in[0] + (size_t)m * D, a.in[7], ACAT + (size_t)m * D, lane);
            else if (m < M + MS) rms_row_to_bf16(a.in[1] + (size_t)(m - M) * D, a.in[7], ACAT + (size_t)m * D, lane);
            else rms_row_to_bf16(a.in[2] + (size_t)(m - M - MS) * D, a.in[26], ACAT + (size_t)(16640 + (m - M - MS)) * D, lane);
        }
        const int gt = bx * (NWAVES * 64) + tid, NGT = G * NWAVES * 64;
        for (int i = gt; i < 4 * 128 * 128; i += NGT) { const int t = (i >> 7) & 127, s = i & 127; WSB[i] = (bf16)(pk2(s <= t ? a.in[12][i] : 0.f, 0.f) & 0xffffu); }
        for (int i = gt; i < 2048; i += NGT) ZROW[i] = 0;
    }
#endif
    GRID_BAR();

    #ifndef NOP1
    ws = a.ws; asm volatile("" : "+s"(ws));
    for (int rep_ = 0; rep_ < REP1; ++rep_)
    {
        SchedP1 S{G, bx, (const char*)ACAT, (const char*)WCAT};
        EpiP1 E{ZA, PB, out + O_MK, out + O_MV, KB};
        pg8::gemm_phase<EpiP1, SchedP1, true>(lds, 1024, 1024, 1024, S, E);
    }
#endif
    GRID_BAR();

    #ifndef NOP2
    ws = a.ws; asm volatile("" : "+s"(ws));
    for (int rep_ = 0; rep_ < REP2; ++rep_)
    {
        LAS float* scr = (LAS float*)(lds + wave * 16384);
        for (int it = gw; it < NBATCH * 128; it += NGW) { const int b = it >> 7; p0_transpose_item(out + O_MV + (size_t)b * NMEM * 1024, NMEM, 1024, VT + (size_t)b * 1024 * NMEM, 0, nullptr, scr, it & 127, lane); }
        const int gt = bx * (NWAVES * 64) + tid, NGT = G * NWAVES * 64;
        for (int i = gt; i < NBATCH * DSH; i += NGT) { const int b = i / DSH, c = i % DSH; out[O_SHP + i] = bf1(PB[(size_t)(b * SEQ + SEQ - 1) * DSH + c]); }
        __syncthreads();
#ifdef DBG_BOTH
        for (int tile = bx; tile < M / 64; tile += G)
            rwkv_prep_tile(lds, tile, PB, ZROW, a.in[9], W2T, A2T, G2T, a.in[14], a.in[16], a.in[19], a.in[20], SCN, GB_, tid, wave, lane);
#endif
#ifndef DBG_NO_NEWPREP
        for (int bc = bx; bc < M / 64; bc += G)
            rwkv_chunk_prep(lds, bc, PB, ZROW, a.in[9], W2T, A2T, G2T, a.in[14], a.in[16], a.in[19], a.in[20], a.in[21], LAIN + (size_t)bx * 16384, TASKS, GB_, VSB, BON, tid, wave, lane);
#endif
    }
#endif
    GRID_BAR();

    #ifndef NOP3
    ws = a.ws; asm volatile("" : "+s"(ws));
#ifdef DBG_BOTH
    if (bx < 64) scan_block(lds, bx, SCN, GB_, a.in[22], a.in[23], a.in[21], MIX, out + O_WKVP, tid, wave, lane);
    __syncthreads();
#ifndef DBG_NO_SCANB
    if (bx < 32) scanB_block(lds, bx, TASKS, GB_, VSB, BON, a.in[22], a.in[23], HID, (float*)(ws + WS_SMP + 5 * MiB), tid, wave, lane);
#endif
    if (bx < 32) {} else if (bx < 160) {
#else
    if (bx < 32) {
        for (int rep_ = 0; rep_ < REP3; ++rep_) scanB_block(lds, bx, TASKS, GB_, VSB, BON, a.in[22], a.in[23], MIX, out + O_WKVP, tid, wave, lane);
    } else if (bx < 160) {
#endif
        for (int tile = bx - 32; tile < 512; tile += 128) mixer_a_tile(lds, tile, ZA, WSB, a.in[10], a.in[11], a.in[13], MIX, out + O_CVP, tid, wave, lane);
    }
#ifndef SAMPLE_SEPARATE
    else if (bx >= 192) {
        SampleCtx C; C.subcnt = (unsigned*)ctl + CW_SUB; C.tmo = (unsigned*)ctl + CW_TMO; C.rs1 = RS1; C.rs2 = RS2; C.rs3 = RS3;
        sample_path(lds, a, C, bx - 192, 64, tid, wave, lane);
    }
#endif
#endif
    GRID_BAR();
#ifdef SAMPLE_SEPARATE
    if (bx >= 192) {
        SampleCtx C; C.subcnt = (unsigned*)ctl + CW_SUB; C.tmo = (unsigned*)ctl + CW_TMO; C.rs1 = RS1; C.rs2 = RS2; C.rs3 = RS3;
        sample_path(lds, a, C, bx - 192, 64, tid, wave, lane);
    }
    GRID_BAR();
#endif

    #ifndef NOP4
    ws = a.ws; asm volatile("" : "+s"(ws));
    {
        SchedMN S; S.init(M, 1024, G, bx, MIX, 1024, WOUT, 1024);
        EpiRes<true> E{a.in[0], out + O_Y, X1B, RS1};
        pg8::gemm_phase<EpiRes<true>, SchedMN, true>(lds, 1024, 1024, 1024, S, E);
    }
#endif
    GRID_BAR();

    #ifndef NOP5
    ws = a.ws; asm volatile("" : "+s"(ws));
    for (int rep_ = 0; rep_ < REP5; ++rep_)
    {
        SchedMN S; S.init(M, 1024, G, bx, X1B, 1024, WQ, 1024);
        EpiScale<0> E{Q, 1024, RS1};
        pg8::gemm_phase<EpiScale<0>, SchedMN, true>(lds, 1024, 1024, 1024, S, E);
    }
#endif
    GRID_BAR();

    #ifndef NOP6
    ws = a.ws; asm volatile("" : "+s"(ws));
    for (int rep_ = 0; rep_ < REP6; ++rep_)
    {
        bf16* P = PSCR + (size_t)bx * 65536;
        for (int u = bx; u < 64 * 4; u += G) {
            const int pm = u >> 2, h = u & 3, b = pm >> 3;
#ifndef P6_NO_S
            { SchedOne S{(const char*)(Q + (size_t)pm * 256 * 1024 + h * 256), (const char*)(KB + (size_t)b * NMEM * 1024 + h * 256)}; EpiSoftmax E{P};
              pg8::gemm_phase<EpiSoftmax, SchedOne, false>(lds, 256, 1024, 1024, S, E); }
#endif
#ifndef P6_NO_O
            { SchedOne S{(const char*)P, (const char*)(VT + ((size_t)b * 1024 + h * 256) * NMEM)}; EpiAttnO E{OB + (size_t)pm * 256 * 1024 + h * 256};
              pg8::gemm_phase<EpiAttnO, SchedOne, false>(lds, 256, 256, 256, S, E); }
#endif
        }
    }
#endif
    GRID_BAR();

    #ifndef NOP7
    ws = a.ws; asm volatile("" : "+s"(ws));
    {
        SchedMN S; S.init(M, 1024, G, bx, OB, 1024, WO, 1024);
        EpiRes<true> E{out + O_Y, out + O_Y, X2B, RS2};
        pg8::gemm_phase<EpiRes<true>, SchedMN, true>(lds, 1024, 1024, 1024, S, E);
    }
#endif
    GRID_BAR();

    #ifndef NOP8
    ws = a.ws; asm volatile("" : "+s"(ws));
    for (int rep_ = 0; rep_ < REP8; ++rep_)
    {
        SchedMN S; S.init(M, FF, G, bx, X2B, 1024, WUP, 1024);
        EpiScale<1> E{HID, FF, RS2};
        pg8::gemm_phase<EpiScale<1>, SchedMN, true>(lds, 1024, 1024, 1024, S, E);
    }
#endif
    GRID_BAR();

    #ifndef NOP9
    ws = a.ws; asm volatile("" : "+s"(ws));
    {
        SchedMN S; S.init(M, 1024, G, bx, HID, FF, WDN, FF);
        EpiRes<false> E{out + O_Y, out + O_Y, nullptr, RS3};
        pg8::gemm_phase<EpiRes<false>, SchedMN, true>(lds, FF, FF, FF, S, E);
    }
#endif
    GRID_BAR();

    #ifndef NOP10
    ws = a.ws; asm volatile("" : "+s"(ws));
    for (int m = gw; m < M; m += NGW) {
        const float sc = 1.f / sqrtf(__hip_atomic_load(RS3 + m, __ATOMIC_RELAXED, __HIP_MEMORY_SCOPE_AGENT) * (1.f / D) + RMS_EPS);
        f32x4* row = (f32x4*)(out + O_Y + (size_t)m * D) + lane; const f32x4* gr = (const f32x4*)a.in[34] + lane;
#pragma unroll
        for (int j = 0; j < 4; ++j) row[64 * j] = row[64 * j] * sc * gr[64 * j];
    }
#endif
#ifdef TEST_SCANB
    __syncthreads();
    ws = a.ws; asm volatile("" : "+s"(ws));
    if (bx < 32) scanB_block(lds, bx, TASKS, GB_, VSB, BON, a.in[22], a.in[23], HID, (float*)(ws + WS_SMP + 5 * MiB), tid, wave, lane);
#endif
}

extern "C" void kernel_launch(void* const* d_in, const int* in_sizes, int n_in, void* d_out, int out_size, void* d_ws, size_t ws_size, hipStream_t stream) {
    static int grid = 0;
    if (grid == 0) {
        if (n_in != 35 || out_size != (int)O_END || ws_size < WS_END) { fprintf(stderr, "kernel_launch: unexpected shapes (n_in %d, out %d, ws %zu); nothing launched\n", n_in, out_size, ws_size); grid = -1; return; }
        int dev = 0, cus = 0, per_cu = 0;
        if (hipGetDevice(&dev) != hipSuccess || hipDeviceGetAttribute(&cus, hipDeviceAttributeMultiprocessorCount, dev) != hipSuccess) { fprintf(stderr, "kernel_launch: device query failed\n"); grid = -1; return; }
        if (hipFuncSetAttribute((const void*)mk_fwd, hipFuncAttributeMaxDynamicSharedMemorySize, LDS_BYTES) != hipSuccess) { fprintf(stderr, "kernel_launch: hipFuncSetAttribute failed\n"); grid = -1; return; }
        if (hipOccupancyMaxActiveBlocksPerMultiprocessor(&per_cu, (const void*)mk_fwd, NWAVES * 64, LDS_BYTES) != hipSuccess || per_cu < 1)
            fprintf(stderr, "kernel_launch: note: occupancy query reports %d workgroups per CU\n", per_cu);
        (void)hipGetLastError();
        grid = cus;
        if (grid != 256) { fprintf(stderr, "kernel_launch: built for a 256-CU device (got %d)\n", grid); grid = -1; return; }
    }
    if (grid < 0) return;
    if (hipMemsetAsync((char*)d_ws + WS_CTL, 0, CTL_ZERO_BYTES, stream) != hipSuccess) { fprintf(stderr, "kernel_launch: hipMemsetAsync failed\n"); return; }
    KArgs a{};
    for (int i = 0; i < 35; ++i) a.in[i] = (const float*)d_in[i];
    a.out = (float*)d_out; a.ws = (unsigned char*)d_ws;
    hipLaunchKernelGGL(mk_fwd, dim3(grid), dim3(NWAVES * 64), LDS_BYTES, stream, a);
    const hipError_t le = hipPeekAtLastError();
    if (le != hipSuccess) fprintf(stderr, "kernel_launch: launch failed: %s\n", hipGetErrorName(le));
}
```

```cpp
#include <hip/hip_runtime.h>
#include <cstdio>
#include <cstdint>

namespace pg8 {
#define PG8_LAS __attribute__((address_space(3)))
typedef unsigned short bf16_t;
typedef short bf16x8 __attribute__((ext_vector_type(8)));
typedef float f32x4 __attribute__((ext_vector_type(4)));
typedef float f32x2 __attribute__((ext_vector_type(2)));
typedef unsigned u32x4 __attribute__((ext_vector_type(4)));
typedef unsigned u32x2 __attribute__((ext_vector_type(2)));
constexpr int BM = 256, BK = 64, HALF = 128, HTB = HALF * BK * 2  , STAGE_BYTES = 8 * HTB;

__host__ __device__ __forceinline__ int lds_byte(int r, int c) { const int st = (r >> 4) * 2 + (c >> 5), rr = r & 15, cc = c & 31, ob = rr * 64 + cc * 2; return st * 1024 + (ob ^ (((ob >> 9) & 1) << 5)); }
__host__ __device__ __forceinline__ void stage_rc(int b, int& R, int& C) { const int st = b / 1024, sb = b % 1024, swz = sb ^ (((sb >> 9) & 1) << 5); R = (st >> 1) * 16 + swz / 64; C = (st & 1) * 32 + (swz % 64) / 2; }
__host__ __device__ __forceinline__ int perm32(int rho) { const int n = rho >> 4, i = rho & 15; return 8 * (i >> 2) + 4 * n + (i & 3); }

struct Unit { int pm, pn; };

typedef __bf16 nbf16x2 __attribute__((ext_vector_type(2)));
__device__ __forceinline__ unsigned cvt_pk_bf16(float lo, float hi) { const nbf16x2 r = __builtin_convertvector((f32x2){lo, hi}, nbf16x2); return __builtin_bit_cast(unsigned, r); }
__device__ __forceinline__ f32x2 gelu_pk(f32x2 v) {
    const f32x2 av = __builtin_elementwise_abs(v), d = av * 0.2316418882f + 1.0f;
    f32x2 t; t.x = __builtin_amdgcn_rcpf(d.x); t.y = __builtin_amdgcn_rcpf(d.y);
    f32x2 q = t * 0.5307027145f + (-0.7265760135f); q = q * t + 0.7107068705f; q = q * t + (-0.142248368f); q = q * t + 0.127414796f; q = q * t;
    const f32x2 s = (v * v) * (-0.72134752044f);
    f32x2 e; e.x = __builtin_amdgcn_exp2f(s.x); e.y = __builtin_amdgcn_exp2f(s.y);
    const f32x2 m = v * (q * e), r = v - m;
    f32x2 o; o.x = v.x < 0.f ? m.x : r.x; o.y = v.y < 0.f ? m.y : r.y; return o;
}

template <class Epi, class Sched, bool ALIGN_EPI = false>
__device__ __forceinline__ void gemm_phase(PG8_LAS unsigned char* lds, const int K, const int lda, const int ldb, const Sched& S, const Epi& E) {
    int tid_ = threadIdx.x; asm volatile("" : "+v"(tid_));
    const int tid = tid_, wid = __builtin_amdgcn_readfirstlane(tid >> 6), lane = tid & 63, wr = wid >> 2, wc = wid & 3, fr = lane & 15, fq = lane >> 4;
    const int nt = K / BK;
    unsigned voffA[2], voffB[2];
#pragma unroll
    for (int i = 0; i < 2; ++i) { int R, C; stage_rc(tid * 16 + i * 8192, R, C); const int Rb = Epi::PERM ? ((R & ~31) + perm32(R & 31)) : R;
        voffA[i] = (unsigned)(R * lda + C) * 2u; voffB[i] = (unsigned)(Rb * ldb + C) * 2u; }
    const size_t kstep = (size_t)(BK * 2);
    const size_t hstepA = (size_t)HALF * lda * 2, hstepB = (size_t)HALF * ldb * 2;
    const unsigned ldsw = (unsigned)wid * 1024u;
    const int aoff = lds_byte(wr * 64 + fr, fq * 8), boff = lds_byte(wc * 32 + fr, fq * 8);
#define PG8_SA(b, h) (((b) * 2 + (h)) * HTB)
#define PG8_SB(b, h) ((4 + (b) * 2 + (h)) * HTB)
#define PG8_STAGE(bufoff, gbase, voff) do { _Pragma("unroll") for (int _i = 0; _i < 2; ++_i) \
        __builtin_amdgcn_global_load_lds((const unsigned*)((const char*)(gbase) + (voff)[_i]), (PG8_LAS unsigned*)(lds + (bufoff) + ldsw + _i * 8192), 16, 0, 0); } while (0)
#define PG8_LDA(dst, b, h) do { _Pragma("unroll") for (int m = 0; m < 4; ++m) _Pragma("unroll") for (int k = 0; k < 2; ++k) dst[m][k] = *(const PG8_LAS bf16x8*)(lds + PG8_SA(b, h) + aoff + m * 2048 + k * 1024); } while (0)
#define PG8_LDB(dst, b, h) do { _Pragma("unroll") for (int n = 0; n < 2; ++n) _Pragma("unroll") for (int k = 0; k < 2; ++k) dst[n][k] = *(const PG8_LAS bf16x8*)(lds + PG8_SB(b, h) + boff + n * 2048 + k * 1024); } while (0)
#define PG8_MMA(ai, bj, At, Bt) do { __builtin_amdgcn_s_setprio(1); _Pragma("unroll") for (int m = 0; m < 4; ++m) _Pragma("unroll") for (int n = 0; n < 2; ++n) _Pragma("unroll") for (int k = 0; k < 2; ++k) \
        acc[ai][bj][m][n] = __builtin_amdgcn_mfma_f32_16x16x32_bf16(Bt[n][k], At[m][k], acc[ai][bj][m][n], 0, 0, 0); __builtin_amdgcn_s_setprio(0); } while (0)
#define PG8_WAIT_V(n) asm volatile("s_waitcnt vmcnt(" #n ")" ::: "memory")
#define PG8_WAIT_L(n) asm volatile("s_waitcnt lgkmcnt(" #n ")" ::: "memory")
#define PG8_BAR __builtin_amdgcn_s_barrier()
#define PG8_SCHED __builtin_amdgcn_sched_barrier(0)
    Unit cur, nxt; int ui = 0;
    if (!S.next(0, cur)) return;
    f32x4 acc[2][2][4][2];
#pragma unroll
    for (int a = 0; a < 2; ++a)
#pragma unroll
        for (int b = 0; b < 2; ++b)
#pragma unroll
            for (int m = 0; m < 4; ++m)
#pragma unroll
                for (int n = 0; n < 2; ++n) acc[a][b][m][n] = (f32x4){0.f, 0.f, 0.f, 0.f};
    bf16x8 At[4][2], B0[2][2], B1[2][2];
    const char* cA = S.pa(cur); const char* cB = S.pb(cur);
    PG8_STAGE(PG8_SB(0, 0), cB, voffB); PG8_STAGE(PG8_SB(0, 1), cB + hstepB, voffB); PG8_STAGE(PG8_SA(0, 0), cA, voffA); PG8_STAGE(PG8_SA(0, 1), cA + hstepA, voffA);
    if (wr == 1) PG8_BAR;
    PG8_WAIT_V(2); PG8_BAR;
    PG8_STAGE(PG8_SB(1, 0), cB + kstep, voffB); PG8_STAGE(PG8_SA(1, 0), cA + kstep, voffA); PG8_STAGE(PG8_SB(1, 1), cB + hstepB + kstep, voffB);
    PG8_WAIT_V(6); PG8_BAR;
    for (;;) {
        const bool has_next = S.next(ui + 1, nxt);
        const char* nA = has_next ? S.pa(nxt) : cA; const char* nB = has_next ? S.pb(nxt) : cB;
#pragma unroll 1
        for (int t = 0; t < nt; t += 2) {
            const bool last = (t == nt - 2);
            const char* a1 = cA + (size_t)(t + 1) * kstep;
            const char* a2 = last ? nA : cA + (size_t)(t + 2) * kstep; const char* b2 = last ? nB : cB + (size_t)(t + 2) * kstep;
            const char* a3 = a2 + kstep; const char* b3 = b2 + kstep;
            PG8_LDB(B0, 0, 0); PG8_LDB(B1, 0, 1); PG8_SCHED; PG8_LDA(At, 0, 0); PG8_STAGE(PG8_SA(1, 1), a1 + hstepA, voffA);
            PG8_WAIT_V(8); PG8_WAIT_L(0); PG8_BAR; PG8_MMA(0, 0, At, B0); PG8_MMA(0, 1, At, B1); PG8_BAR; PG8_SCHED;
            PG8_LDA(At, 0, 1); PG8_STAGE(PG8_SB(0, 0), b2, voffB); PG8_STAGE(PG8_SB(0, 1), b2 + hstepB, voffB); PG8_STAGE(PG8_SA(0, 0), a2, voffA);
            PG8_WAIT_V(8); PG8_WAIT_L(0); PG8_BAR; PG8_MMA(1, 0, At, B0); PG8_MMA(1, 1, At, B1); PG8_BAR; PG8_SCHED;
            PG8_LDB(B0, 1, 0); PG8_LDB(B1, 1, 1); PG8_SCHED; PG8_LDA(At, 1, 0); PG8_STAGE(PG8_SA(0, 1), a2 + hstepA, voffA);
            PG8_WAIT_V(8); PG8_WAIT_L(0); PG8_BAR; PG8_MMA(0, 0, At, B0); PG8_MMA(0, 1, At, B1); PG8_BAR; PG8_SCHED;
            PG8_LDA(At, 1, 1); PG8_STAGE(PG8_SB(1, 0), b3, voffB); PG8_STAGE(PG8_SB(1, 1), b3 + hstepB, voffB); PG8_STAGE(PG8_SA(1, 0), a3, voffA);
            PG8_WAIT_V(8); PG8_WAIT_L(0); PG8_BAR; PG8_MMA(1, 0, At, B0); PG8_MMA(1, 1, At, B1); PG8_BAR; PG8_SCHED;
        }
        if constexpr (ALIGN_EPI) { if (wr == 0) PG8_BAR; }
        if constexpr (!Epi::AFTER_DRAIN) { E(acc, cur, wr, wc, fr, fq); }
        if (!has_next) break;
#pragma unroll
        for (int a = 0; a < 2; ++a)
#pragma unroll
            for (int b = 0; b < 2; ++b)
#pragma unroll
                for (int m = 0; m < 4; ++m)
#pragma unroll
                    for (int n = 0; n < 2; ++n) acc[a][b][m][n] = (f32x4){0.f, 0.f, 0.f, 0.f};
        cur = nxt; cA = nA; cB = nB; ++ui;
        if constexpr (ALIGN_EPI) { if (wr == 1) PG8_BAR; }
    }
    PG8_WAIT_V(0);
    if constexpr (!ALIGN_EPI) { if (wr == 0) PG8_BAR; }
    PG8_BAR;
    if constexpr (Epi::AFTER_DRAIN) { E.fused(acc, cur, wr, wc, fr, fq, lds, wid, lane); }
#undef PG8_SA
#undef PG8_SB
#undef PG8_STAGE
#undef PG8_LDA
#undef PG8_LDB
#undef PG8_MMA
#undef PG8_WAIT_V
#undef PG8_WAIT_L
#undef PG8_BAR
#undef PG8_SCHED
}
}

#define GAS __attribute__((address_space(1)))
#define LAS __attribute__((address_space(3)))
typedef unsigned short bf16;
typedef float f32x4 __attribute__((ext_vector_type(4)));
typedef float f32x2 __attribute__((ext_vector_type(2)));
typedef short bf16x8 __attribute__((ext_vector_type(8)));
typedef unsigned u32x4 __attribute__((ext_vector_type(4)));
typedef unsigned u32x2 __attribute__((ext_vector_type(2)));
typedef GAS unsigned gu32;
#define RLX_AGENT __ATOMIC_RELAXED, __HIP_MEMORY_SCOPE_AGENT
#define LDS_WAIT() asm volatile("s_waitcnt lgkmcnt(0)" ::: "memory")
#define VM_WAIT() asm volatile("s_waitcnt vmcnt(0)" ::: "memory")

constexpr int NWAVES = 8;
constexpr int D = 1024, M = 16384, SEQ = 2048, NBATCH = 8, MS = 128, DIN = 2816, DSH = 1792, DB = 512, FF = 4096, NMEM = 256;
constexpr float RMS_EPS = 1e-6f, LN_EPS = 1e-5f, GN_EPS = 64e-5f;
constexpr size_t O_Y = 0, O_YS = 16777216, O_MK = 16908288, O_MV = 19005440, O_SHP = 21102592, O_WKVP = 21116928, O_CVP = 21379072, O_SHS = 21903360, O_WKVS = 22132736, O_CVS = 26327040, O_END = 26392576;
constexpr size_t MiB = 1u << 20, KiB = 1024;
constexpr size_t WS_CTL = 0, CTL_ZERO_BYTES = 1 * MiB;
constexpr size_t WS_WCAT = 2 * MiB;
constexpr size_t WS_WOUT = 12 * MiB, WS_WQ = 14 * MiB, WS_WO = 16 * MiB, WS_WUP = 18 * MiB, WS_WDN = 26 * MiB;
constexpr size_t WS_SMALL = 34 * MiB;
constexpr size_t WS_ACAT = 36 * MiB;
constexpr size_t WS_ZA = 73 * MiB;
constexpr size_t WS_PB = 105 * MiB;
constexpr size_t WS_Q = 105 * MiB, WS_OB = 137 * MiB;
constexpr size_t WS_SCN = 161 * MiB;
constexpr size_t WS_PSCR = 169 * MiB, WS_HID = 201 * MiB;
constexpr size_t WS_G = 353 * MiB;
constexpr size_t WS_MIX = 369 * MiB;
constexpr size_t WS_KB = 401 * MiB, WS_VT = 405 * MiB;
constexpr size_t WS_SMP = 409 * MiB;
constexpr size_t SM_ZA = 0, SM_MIX = 256 * KiB, SM_X1 = 512 * KiB, SM_X1B = 1024 * KiB, SM_Q = 1280 * KiB, SM_O = 1792 * KiB, SM_X2 = 2048 * KiB, SM_X2B = 2560 * KiB, SM_HID = 3072 * KiB, SM_X3 = 4096 * KiB;
constexpr size_t WS_NEW = 416 * MiB;
constexpr size_t WS_END = 505 * MiB;
constexpr int CW_TMO = 0, CW_CODE = 1, CW_BAR = 4096, CW_SUB = 8192, CW_QATT = 8256, CW_QMIX = 8320, CW_PAN = 12288;
constexpr int RS_OFF = 65536, RS_STRIDE = 16640;
constexpr int RING_BYTES = 131072, LDSCTL_OFF = RING_BYTES, MISC_OFF = LDSCTL_OFF + 320, LDS_BYTES = 147456;

__device__ __forceinline__ float bf_lo(unsigned u) { return __uint_as_float(u << 16); }
__device__ __forceinline__ float bf_hi(unsigned u) { return __uint_as_float(u & 0xffff0000u); }
__device__ __forceinline__ float bf1(bf16 v) { return __uint_as_float(((unsigned)v) << 16); }
__device__ __forceinline__ unsigned pk2(float lo, float hi) { return pg8::cvt_pk_bf16(lo, hi); }
__device__ __forceinline__ f32x4 bf4(u32x2 v) { return (f32x4){bf_lo(v.x), bf_hi(v.x), bf_lo(v.y), bf_hi(v.y)}; }
__device__ __forceinline__ u32x2 pk4(f32x4 v) { u32x2 r; r.x = pk2(v.x, v.y); r.y = pk2(v.z, v.w); return r; }
__device__ __forceinline__ float fast_exp(float x) { return __builtin_amdgcn_exp2f(x * 1.44269504089f); }
__device__ __forceinline__ float fast_log(float x) { return __builtin_amdgcn_logf(x) * 0.69314718056f; }
__device__ __forceinline__ float fast_sigmoid(float x) { return __builtin_amdgcn_rcpf(1.0f + fast_exp(-x)); }
__device__ __forceinline__ float fast_tanh(float x) { return 1.0f - 2.0f * __builtin_amdgcn_rcpf(fast_exp(2.0f * x) + 1.0f); }
template <int CTRL> __device__ __forceinline__ float dpp_mov(float x) { return __builtin_bit_cast(float, __builtin_amdgcn_mov_dpp(__builtin_bit_cast(int, x), CTRL, 0xf, 0xf, true)); }
__device__ __forceinline__ float red4(float x) { x += dpp_mov<0xB1>(x); x += dpp_mov<0x4E>(x); return x; }
__device__ __forceinline__ float red8(float x) { x = red4(x); x += dpp_mov<0x141>(x); return x; }
__device__ __forceinline__ float red16(float x) { x = red8(x); x += dpp_mov<0x128>(x); return x; }
__device__ __forceinline__ float wave_sum(float v) {
#pragma unroll
    for (int o = 1; o < 64; o <<= 1) v += __shfl_xor(v, o);
    return v;
}
__device__ __forceinline__ float wave_max(float v) {
#pragma unroll
    for (int o = 1; o < 64; o <<= 1) v = fmaxf(v, __shfl_xor(v, o));
    return v;
}

#define XB_TMO      128
#define XB_XCNT(j)  (256  + 64 * (j))
#define XB_XSUB(j)  (1280 + 64 * (j))
#define XB_XGEN(j)  (2304 + 64 * (j))
#define XB_TOP      3328
#define XB_TOPGEN   3392
#define XCD_BAR_WORDS 3456
#define XB_SPIN_CAP (1u << 18)
__device__ __forceinline__ unsigned xb_ld(unsigned* p)              { return __hip_atomic_load(p, __ATOMIC_RELAXED, __HIP_MEMORY_SCOPE_AGENT); }
__device__ __forceinline__ unsigned xb_add(unsigned* p, unsigned v) { return __hip_atomic_fetch_add(p, v, __ATOMIC_RELAXED, __HIP_MEMORY_SCOPE_AGENT); }
__device__ __forceinline__ unsigned xb_xcc_id() { return (unsigned)__builtin_amdgcn_s_getreg((3 << 11) | 20) & 0xFu; }
#define XB_SPIN(cond, bar) do { unsigned _sp = 0; while (cond) { __builtin_amdgcn_s_sleep(1); \
    if ((++_sp & 255u) == 0u) { if (xb_ld(&(bar)[XB_TMO])) break; if (_sp > XB_SPIN_CAP) { atomicAdd(&(bar)[XB_TMO], 1u); break; } } } } while (0)
struct XcdBarrier { unsigned* bar; unsigned x; volatile LAS unsigned* st; };
__device__ __forceinline__ XcdBarrier xcd_barrier_post(unsigned* bar, volatile LAS unsigned* st) {
    XcdBarrier b; b.bar = bar; b.x = xb_xcc_id(); b.st = st;
    if (threadIdx.x == 0) (void)xb_add(&bar[XB_XCNT(b.x)], 1u);
    return b;
}
__device__ __forceinline__ void xcd_barrier_complete(unsigned* bar, unsigned x, unsigned& nloc, unsigned& nx) {
    const unsigned G = gridDim.x * gridDim.y * gridDim.z;
    unsigned sum, cnt, mine, sp = 0u;
    for (;;) {
        sum = 0u; cnt = 0u; mine = 0u;
#pragma unroll
        for (unsigned j = 0; j < 16; ++j) { const unsigned c = xb_ld(&bar[XB_XCNT(j)]); sum += c; cnt += (c > 0u) ? 1u : 0u; mine = (j == x) ? c : mine; }
        if (sum == G) break;
        __builtin_amdgcn_s_sleep(1);
        if ((++sp & 255u) == 0u) { if (xb_ld(&bar[XB_TMO])) break; if (sp > XB_SPIN_CAP) { atomicAdd(&bar[XB_TMO], 1u); break; } }
    }
    nloc = mine > 0u ? mine : 1u; nx = cnt > 0u ? cnt : 1u;
}
__device__ __forceinline__ void xcd_barrier(const XcdBarrier& b) {
    asm volatile("s_waitcnt vmcnt(0)" ::: "memory");
    __syncthreads();
    if (threadIdx.x == 0) {
        unsigned* bar = b.bar;
        __builtin_amdgcn_s_waitcnt(0);
        unsigned nloc = b.st[0], nx = b.st[1];
        if (nloc == 0u) { xcd_barrier_complete(bar, b.x, nloc, nx); b.st[0] = nloc; b.st[1] = nx; }
        const unsigned old = xb_add(&bar[XB_XSUB(b.x)], 1u);
        const unsigned gen = old / nloc;
        if (old + 1u == (gen + 1u) * nloc) {
            __builtin_amdgcn_fence(__ATOMIC_RELEASE, "agent");
            asm volatile("s_waitcnt vmcnt(0)" ::: "memory");
            const unsigned og = xb_add(&bar[XB_TOP], 1u);
            const unsigned tg = og / nx;
            if (og + 1u == (tg + 1u) * nx) xb_add(&bar[XB_TOPGEN], 1u);
            else XB_SPIN(xb_ld(&bar[XB_TOPGEN]) == tg, bar);
            __builtin_amdgcn_fence(__ATOMIC_ACQUIRE, "agent");
            xb_add(&bar[XB_XGEN(b.x)], 1u);
            asm volatile("s_waitcnt vmcnt(0)" ::: "memory");
        } else {
            XB_SPIN(xb_ld(&bar[XB_XGEN(b.x)]) == gen, bar);
            __builtin_amdgcn_fence(__ATOMIC_ACQUIRE, "agent");
            asm volatile("s_waitcnt vmcnt(0)" ::: "memory");
        }
    }
    __syncthreads();
}
__device__ __forceinline__ void sub_barrier(unsigned* cnt, unsigned* tmo, unsigned target) {
    asm volatile("s_waitcnt vmcnt(0)" ::: "memory");
    __syncthreads();
    if (threadIdx.x == 0) {
        __builtin_amdgcn_fence(__ATOMIC_RELEASE, "agent");
        asm volatile("s_waitcnt vmcnt(0)" ::: "memory");
        (void)xb_add(cnt, 1u);
        unsigned sp = 0;
        while (xb_ld(cnt) < target) { __builtin_amdgcn_s_sleep(1); if ((++sp & 255u) == 0u) { if (xb_ld(tmo)) break; if (sp > (1u << 20)) { atomicAdd(tmo, 1u); break; } } }
        __builtin_amdgcn_fence(__ATOMIC_ACQUIRE, "agent");
        asm volatile("s_waitcnt vmcnt(0)" ::: "memory");
    }
    __syncthreads();
}

__device__ __forceinline__ void p0_transpose_item(const float* W, int K, int N, bf16* WT, int row_off, const float* gk, LAS float* scr, int item, int lane) {
    const int nblk = N / 32, kb = item / nblk, nb = item % nblk, k0 = 64 * kb, n0 = 32 * nb;
    f32x4 vv[8];
#pragma unroll
    for (int i = 0; i < 8; ++i) vv[i] = *(const f32x4*)(W + (size_t)(k0 + 8 * i + (lane >> 3)) * N + n0 + 4 * (lane & 7));
    if (gk) {
#pragma unroll
        for (int i = 0; i < 8; ++i) vv[i] = vv[i] * gk[k0 + 8 * i + (lane >> 3)]; }
#pragma unroll
    for (int i = 0; i < 8; ++i) { LAS float* d = scr + (8 * i + (lane >> 3)) * 33 + 4 * (lane & 7); d[0] = vv[i][0]; d[1] = vv[i][1]; d[2] = vv[i][2]; d[3] = vv[i][3]; }
    LDS_WAIT(); asm volatile("" ::: "memory");
    const int c = lane & 7;
#pragma unroll
    for (int j = 0; j < 4; ++j) { const int n = (lane >> 3) + 8 * j; const LAS float* s = scr + (8 * c) * 33 + n;
        u32x4 o; o.x = pk2(s[0 * 33], s[1 * 33]); o.y = pk2(s[2 * 33], s[3 * 33]); o.z = pk2(s[4 * 33], s[5 * 33]); o.w = pk2(s[6 * 33], s[7 * 33]);
        *(u32x4*)(WT + (size_t)(row_off + n0 + n) * K + k0 + 8 * c) = o; }
    LDS_WAIT(); asm volatile("" ::: "memory");
}
__device__ __forceinline__ void rms_row_to_bf16(const float* xrow, const float* g, bf16* orow, int lane) {
    const f32x4* xr = (const f32x4*)xrow + lane; const f32x4* gr = (const f32x4*)g + lane;
    f32x4 v[4]; float s = 0.f;
#pragma unroll
    for (int j = 0; j < 4; ++j) { v[j] = xr[64 * j]; s += (v[j].x * v[j].x + v[j].y * v[j].y) + (v[j].z * v[j].z + v[j].w * v[j].w); }
    const float rstd = 1.f / sqrtf(wave_sum(s) * (1.f / D) + RMS_EPS);
    unsigned long long* o8 = (unsigned long long*)orow + lane;
#pragma unroll
    for (int j = 0; j < 4; ++j) { const f32x4 gg = gr[64 * j]; o8[64 * j] = (unsigned long long)pk2(v[j].x * rstd * gg.x, v[j].y * rstd * gg.y) | ((unsigned long long)pk2(v[j].z * rstd * gg.z, v[j].w * rstd * gg.w) << 32); }
}

using pg8::Unit;
struct SchedMN {
    int nM, nN, nwg, G, c; const char* A; const char* Bt; size_t ta, tb;
    __device__ __forceinline__ void init(int M_, int N_, int G_, int c_, const void* A_, size_t lda, const void* Bt_, size_t ldb) { nM = M_ / 256; nN = N_ / 256; nwg = nM * nN; G = G_; c = c_; A = (const char*)A_; Bt = (const char*)Bt_; ta = 256 * lda * 2; tb = 256 * ldb * 2; }
    __device__ __forceinline__ bool next(int i, Unit& u) const {
        const long L = (long)i * G + c; if (L >= nwg) return false;
        int wgid = (int)L; { const int q = nwg / 8, r = nwg % 8, xcd = wgid % 8, off = wgid / 8; wgid = (xcd < r ? xcd * (q + 1) : r * (q + 1) + (xcd - r) * q) + off; }
        const int nig = 8 * nN, gid = wgid / nig, fm = gid * 8, gsz = (nM - fm) < 8 ? (nM - fm) : 8;
        u.pm = fm + ((wgid % nig) % gsz); u.pn = (wgid % nig) / gsz; return true;
    }
    __device__ __forceinline__ const char* pa(const Unit& u) const { return A + (size_t)u.pm * ta; }
    __device__ __forceinline__ const char* pb(const Unit& u) const { return Bt + (size_t)u.pn * tb; }
};
struct SchedP1 {
    int G, c; const char* A; const char* Bt;
    __device__ __forceinline__ bool next(int i, Unit& u) const {
        const int L = i * G + c; if (L >= 768) return false;
        const int wgid = (L % 8) * 96 + L / 8;
        if (wgid < 704) { const int nig = 88, gid = wgid / nig, w = wgid % nig; u.pm = gid * 8 + (w & 7); u.pn = w >> 3; }
        else { const int w = wgid - 704; u.pm = 65 + (w & 7); u.pn = 11 + (w >> 3); }
        return true;
    }
    __device__ __forceinline__ const char* pa(const Unit& u) const { return A + (size_t)u.pm * (256 * 1024 * 2); }
    __device__ __forceinline__ const char* pb(const Unit& u) const { return Bt + (size_t)u.pn * (256 * 1024 * 2); }
};
struct SchedOne {
    const char* A; const char* B;
    __device__ __forceinline__ bool next(int i, Unit& u) const { if (i) return false; u.pm = 0; u.pn = 0; return true; }
    __device__ __forceinline__ const char* pa(const Unit&) const { return A; }
    __device__ __forceinline__ const char* pb(const Unit&) const { return B; }
};

typedef GAS bf16 gbf16; typedef GAS float gf32;
__device__ __forceinline__ void st16(gbf16* p, f32x4 v0, f32x4 v1) { u32x4 w; w.x = pk2(v0[0], v0[1]); w.y = pk2(v0[2], v0[3]); w.z = pk2(v1[0], v1[1]); w.w = pk2(v1[2], v1[3]); *(GAS u32x4*)p = w; }
struct EpiP1 {
    static constexpr bool PERM = true, AFTER_DRAIN = false;
    bf16* ZA; bf16* PB; float* outK; float* outV; bf16* KB;
    __device__ __forceinline__ void operator()(f32x4 (&acc)[2][2][4][2], const Unit& u, int wr, int wc, int fr, int fq) const {
        if (u.pm < 64) {
            const int row0 = u.pm * 256 + wr * 64 + fr; const bool act = u.pn < 4;
            gbf16* base = act ? (gbf16*)ZA : (gbf16*)PB; const int ldc = act ? 1024 : DSH; const int col0 = (act ? u.pn : u.pn - 4) * 256 + wc * 32 + 8 * fq;
#pragma unroll
            for (int ai = 0; ai < 2; ++ai)
#pragma unroll
                for (int m = 0; m < 4; ++m) { gbf16* rowp = base + (size_t)(row0 + ai * 128 + m * 16) * ldc + col0;
#pragma unroll
                    for (int bj = 0; bj < 2; ++bj) { f32x4 v0 = acc[ai][bj][m][0], v1 = acc[ai][bj][m][1];
                        if (act) { f32x2 a = pg8::gelu_pk((f32x2){v0[0], v0[1]}), b = pg8::gelu_pk((f32x2){v0[2], v0[3]}), c = pg8::gelu_pk((f32x2){v1[0], v1[1]}), d = pg8::gelu_pk((f32x2){v1[2], v1[3]});
                            v0 = (f32x4){a.x, a.y, b.x, b.y}; v1 = (f32x4){c.x, c.y, d.x, d.y}; }
                        st16(rowp + bj * 128, v0, v1); } }
        } else {
            const int row0 = (u.pm - 65) * 256 + wr * 64 + fr; const int ct = u.pn - 11; const bool isK = ct < 4; const int col0 = (ct & 3) * 256 + wc * 32 + 8 * fq;
            gf32* o = isK ? (gf32*)outK : (gf32*)outV;
#pragma unroll
            for (int ai = 0; ai < 2; ++ai)
#pragma unroll
                for (int m = 0; m < 4; ++m) { const size_t off = (size_t)(row0 + ai * 128 + m * 16) * 1024 + col0;
#pragma unroll
                    for (int bj = 0; bj < 2; ++bj) { const f32x4 v0 = acc[ai][bj][m][0], v1 = acc[ai][bj][m][1];
                        *(GAS f32x4*)(o + off + bj * 128) = v0; *(GAS f32x4*)(o + off + bj * 128 + 4) = v1;
                        if (isK) st16((gbf16*)KB + off + bj * 128, v0, v1); } }
        }
    }
};
__device__ __forceinline__ void ld8(const float* p, f32x4& a, f32x4& b) { a = *(const GAS f32x4*)((const gf32*)p); b = *(const GAS f32x4*)((const gf32*)p + 4); }
__device__ __forceinline__ void ld8(const bf16* p, f32x4& a, f32x4& b) { const u32x4 w = *(const GAS u32x4*)((const gbf16*)p); a = (f32x4){bf_lo(w.x), bf_hi(w.x), bf_lo(w.y), bf_hi(w.y)}; b = (f32x4){bf_lo(w.z), bf_hi(w.z), bf_lo(w.w), bf_hi(w.w)}; }
template <class BT> struct EpiRes {
    static constexpr bool PERM = true, AFTER_DRAIN = false;
    const BT* base; bf16* outb; float* rowss;
    __device__ __forceinline__ void operator()(f32x4 (&acc)[2][2][4][2], const Unit& u, int wr, int wc, int fr, int fq) const {
        const int row0 = u.pm * 256 + wr * 64 + fr, col0 = u.pn * 256 + wc * 32 + 8 * fq;
#pragma unroll
        for (int ai = 0; ai < 2; ++ai)
#pragma unroll
            for (int m = 0; m < 4; ++m) { const int r = row0 + ai * 128 + m * 16; const size_t off = (size_t)r * 1024 + col0; float ss = 0.f;
#pragma unroll
                for (int bj = 0; bj < 2; ++bj) { f32x4 b0, b1; ld8(base + off + bj * 128, b0, b1);
                    const f32x4 v0 = acc[ai][bj][m][0] + b0, v1 = acc[ai][bj][m][1] + b1;
                    st16((gbf16*)outb + off + bj * 128, v0, v1);
                    ss += (v0[0] * v0[0] + v0[1] * v0[1]) + (v0[2] * v0[2] + v0[3] * v0[3]) + (v1[0] * v1[0] + v1[1] * v1[1]) + (v1[2] * v1[2] + v1[3] * v1[3]); }
                ss += __shfl_xor(ss, 16); ss += __shfl_xor(ss, 32);
                if (fq == 0) (void)__hip_atomic_fetch_add(rowss + r, ss, __ATOMIC_RELAXED, __HIP_MEMORY_SCOPE_AGENT); }
    }
};
struct EpiFinal {
    static constexpr bool PERM = true, AFTER_DRAIN = false;
    const bf16* base; float* out; const float* gain; float* rowss; unsigned* cnt; unsigned* tmo;
    __device__ __forceinline__ void operator()(f32x4 (&acc)[2][2][4][2], const Unit& u, int wr, int wc, int fr, int fq) const {
        const int row0 = u.pm * 256 + wr * 64 + fr, col0 = u.pn * 256 + wc * 32 + 8 * fq;
#pragma unroll
        for (int ai = 0; ai < 2; ++ai)
#pragma unroll
            for (int m = 0; m < 4; ++m) { const int r = row0 + ai * 128 + m * 16; const size_t off = (size_t)r * 1024 + col0; float ss = 0.f;
#pragma unroll
                for (int bj = 0; bj < 2; ++bj) { f32x4 b0, b1; ld8(base + off + bj * 128, b0, b1);
                    const f32x4 v0 = acc[ai][bj][m][0] + b0, v1 = acc[ai][bj][m][1] + b1; acc[ai][bj][m][0] = v0; acc[ai][bj][m][1] = v1;
                    ss += (v0[0] * v0[0] + v0[1] * v0[1]) + (v0[2] * v0[2] + v0[3] * v0[3]) + (v1[0] * v1[0] + v1[1] * v1[1]) + (v1[2] * v1[2] + v1[3] * v1[3]); }
                ss += __shfl_xor(ss, 16); ss += __shfl_xor(ss, 32);
                if (fq == 0) (void)__hip_atomic_fetch_add(rowss + r, ss, __ATOMIC_RELAXED, __HIP_MEMORY_SCOPE_AGENT); }
        asm volatile("s_waitcnt vmcnt(0)" ::: "memory");
        unsigned* c = cnt + 64 * u.pm;
        if ((threadIdx.x & 63) == 0) (void)xb_add(c, 1u);
        { unsigned sp = 0; while (xb_ld(c) < 32u) { __builtin_amdgcn_s_sleep(1); if ((++sp & 255u) == 0u) { if (xb_ld(tmo)) break; if (sp > (1u << 20)) { atomicAdd(tmo, 1u); break; } } } }
        f32x4 g[2][2];
#pragma unroll
        for (int bj = 0; bj < 2; ++bj) { g[bj][0] = *(const GAS f32x4*)((const gf32*)gain + col0 + bj * 128); g[bj][1] = *(const GAS f32x4*)((const gf32*)gain + col0 + bj * 128 + 4); }
#pragma unroll
        for (int ai = 0; ai < 2; ++ai)
#pragma unroll
            for (int m = 0; m < 4; ++m) { const int r = row0 + ai * 128 + m * 16; const size_t off = (size_t)r * 1024 + col0;
                const float sc = 1.f / sqrtf(__hip_atomic_load(rowss + r, __ATOMIC_RELAXED, __HIP_MEMORY_SCOPE_AGENT) * (1.f / D) + RMS_EPS);
#pragma unroll
                for (int bj = 0; bj < 2; ++bj) { *(GAS f32x4*)((gf32*)out + off + bj * 128) = acc[ai][bj][m][0] * sc * g[bj][0]; *(GAS f32x4*)((gf32*)out + off + bj * 128 + 4) = acc[ai][bj][m][1] * sc * g[bj][1]; } }
    }
};
template <int MODE> struct EpiScale {
    static constexpr bool PERM = true, AFTER_DRAIN = false;
    bf16* O; int ldc; const float* rowss;
    __device__ __forceinline__ void operator()(f32x4 (&acc)[2][2][4][2], const Unit& u, int wr, int wc, int fr, int fq) const {
        const int row0 = u.pm * 256 + wr * 64 + fr, col0 = u.pn * 256 + wc * 32 + 8 * fq;
#pragma unroll
        for (int ai = 0; ai < 2; ++ai)
#pragma unroll
            for (int m = 0; m < 4; ++m) { const int r = row0 + ai * 128 + m * 16;
                float sc = 1.f / sqrtf(__hip_atomic_load(rowss + r, __ATOMIC_RELAXED, __HIP_MEMORY_SCOPE_AGENT) * (1.f / D) + RMS_EPS); if (MODE == 0) sc *= 0.0625f;
                gbf16* rowp = (gbf16*)O + (size_t)r * ldc + col0;
#pragma unroll
                for (int bj = 0; bj < 2; ++bj) { f32x4 v0 = acc[ai][bj][m][0] * sc, v1 = acc[ai][bj][m][1] * sc;
                    if (MODE == 1) {
#pragma unroll
                        for (int j = 0; j < 4; ++j) { const float a = fmaxf(v0[j], 0.f), b = fmaxf(v1[j], 0.f); v0[j] = a * a; v1[j] = b * b; } }
                    st16(rowp + bj * 128, v0, v1); } }
    }
};
struct EpiQS {
    static constexpr bool PERM = true, AFTER_DRAIN = false;
    bf16* QS; const float* rowss;
    __device__ __forceinline__ void operator()(f32x4 (&acc)[2][2][4][2], const Unit& u, int wr, int wc, int fr, int fq) const {
#pragma unroll
        for (int ai = 0; ai < 2; ++ai)
#pragma unroll
            for (int m = 0; m < 4; ++m) { const int rl = ai * 128 + wr * 64 + m * 16 + fr;
                const float sc = 0.0625f / sqrtf(__hip_atomic_load(rowss + u.pm * 256 + rl, __ATOMIC_RELAXED, __HIP_MEMORY_SCOPE_AGENT) * (1.f / D) + RMS_EPS);
                gbf16* rowp = (gbf16*)QS + (size_t)rl * 256 + wc * 32 + 8 * fq;
#pragma unroll
                for (int bj = 0; bj < 2; ++bj) st16(rowp + bj * 128, acc[ai][bj][m][0] * sc, acc[ai][bj][m][1] * sc); }
    }
};
struct EpiSoftmax {
    static constexpr bool PERM = true, AFTER_DRAIN = true;
    bf16* P;
    __device__ __forceinline__ void fused(f32x4 (&acc)[2][2][4][2], const Unit&, int wr, int wc, int fr, int fq, PG8_LAS unsigned char* lds, int, int) const {
        PG8_LAS float* T1 = (PG8_LAS float*)lds; PG8_LAS float* T2 = (PG8_LAS float*)(lds + 4096);
#pragma unroll
        for (int ai = 0; ai < 2; ++ai)
#pragma unroll
            for (int m = 0; m < 4; ++m) { float mx = -3.0e38f;
#pragma unroll
                for (int bj = 0; bj < 2; ++bj)
#pragma unroll
                    for (int n = 0; n < 2; ++n) { const f32x4 x = acc[ai][bj][m][n]; mx = fmaxf(mx, fmaxf(fmaxf(x[0], x[1]), fmaxf(x[2], x[3]))); }
                mx = fmaxf(mx, __shfl_xor(mx, 16)); mx = fmaxf(mx, __shfl_xor(mx, 32));
                if (fq == 0) T1[(ai * 128 + wr * 64 + m * 16 + fr) * 4 + wc] = mx; }
        asm volatile("s_waitcnt lgkmcnt(0)" ::: "memory"); __builtin_amdgcn_s_barrier(); asm volatile("" ::: "memory");
#pragma unroll
        for (int ai = 0; ai < 2; ++ai)
#pragma unroll
            for (int m = 0; m < 4; ++m) { const int row = ai * 128 + wr * 64 + m * 16 + fr; const f32x4 t = *(const PG8_LAS f32x4*)(T1 + row * 4);
                const float mxr = fmaxf(fmaxf(t[0], t[1]), fmaxf(t[2], t[3])) * 1.44269504089f; float sum = 0.f;
#pragma unroll
                for (int bj = 0; bj < 2; ++bj)
#pragma unroll
                    for (int n = 0; n < 2; ++n) { f32x4 x = acc[ai][bj][m][n];
#pragma unroll
                        for (int j = 0; j < 4; ++j) { x[j] = __builtin_amdgcn_exp2f(x[j] * 1.44269504089f - mxr); sum += x[j]; }
                        acc[ai][bj][m][n] = x; }
                sum += __shfl_xor(sum, 16); sum += __shfl_xor(sum, 32);
                if (fq == 0) T2[row * 4 + wc] = sum; }
        asm volatile("s_waitcnt lgkmcnt(0)" ::: "memory"); __builtin_amdgcn_s_barrier(); asm volatile("" ::: "memory");
#pragma unroll
        for (int ai = 0; ai < 2; ++ai)
#pragma unroll
            for (int m = 0; m < 4; ++m) { const int row = ai * 128 + wr * 64 + m * 16 + fr; const f32x4 t = *(const PG8_LAS f32x4*)(T2 + row * 4);
                const float inv = 1.f / ((t[0] + t[1]) + (t[2] + t[3]));
                gbf16* rowp = (gbf16*)P + (size_t)row * 256 + wc * 32 + 8 * fq;
#pragma unroll
                for (int bj = 0; bj < 2; ++bj) st16(rowp + bj * 128, acc[ai][bj][m][0] * inv, acc[ai][bj][m][1] * inv); }
        asm volatile("s_waitcnt vmcnt(0) lgkmcnt(0)" ::: "memory"); __builtin_amdgcn_s_barrier(); asm volatile("" ::: "memory");
    }
};
struct EpiAttnO {
    static constexpr bool PERM = true, AFTER_DRAIN = false;
    bf16* O;
    __device__ __forceinline__ void operator()(f32x4 (&acc)[2][2][4][2], const Unit&, int wr, int wc, int fr, int fq) const {
#pragma unroll
        for (int ai = 0; ai < 2; ++ai)
#pragma unroll
            for (int m = 0; m < 4; ++m) { gbf16* rowp = (gbf16*)O + (size_t)(ai * 128 + wr * 64 + m * 16 + fr) * 1024 + wc * 32 + 8 * fq;
#pragma unroll
                for (int bj = 0; bj < 2; ++bj) st16(rowp + bj * 128, acc[ai][bj][m][0], acc[ai][bj][m][1]); }
    }
};

__device__ __forceinline__ void mixer_a_tile(LAS unsigned char* lds, int tile, const bf16* ZA, const bf16* WSB, const float* gm_ln_g, const float* gm_ln_b, const float* gm_bs, bf16* MIX, float* out_cv, int tid, int wave, int lane) {
    const int h = tile & 3, bc = tile >> 2, m0 = bc * 128, fr = lane & 15, fq = lane >> 4; const bool lastc = (bc & 15) == 15;
    LAS bf16* VT = (LAS bf16*)lds;
    {   const int r = 16 * wave + (lane >> 2), cq = (lane & 3) * 32; const bf16* src = ZA + (size_t)(m0 + r) * 1024 + 512 + h * 128 + cq;
        float x[32]; float s = 0.f;
#pragma unroll
        for (int j = 0; j < 4; ++j) { const u32x4 pv = *(const u32x4*)(src + 8 * j);
            x[8 * j + 0] = bf_lo(pv.x); x[8 * j + 1] = bf_hi(pv.x); x[8 * j + 2] = bf_lo(pv.y); x[8 * j + 3] = bf_hi(pv.y); x[8 * j + 4] = bf_lo(pv.z); x[8 * j + 5] = bf_hi(pv.z); x[8 * j + 6] = bf_lo(pv.w); x[8 * j + 7] = bf_hi(pv.w); }
#pragma unroll
        for (int j = 0; j < 32; ++j) s += x[j];
        const float mean = red4(s) * (1.f / 128.f); float q = 0.f;
#pragma unroll
        for (int j = 0; j < 32; ++j) { x[j] -= mean; q += x[j] * x[j]; }
        const float rstd = 1.f / sqrtf(red4(q) * (1.f / 128.f) + LN_EPS);
#pragma unroll
        for (int j = 0; j < 8; ++j) { const f32x4 g = *(const f32x4*)(gm_ln_g + h * 128 + cq + 4 * j), bb = *(const f32x4*)(gm_ln_b + h * 128 + cq + 4 * j);
#pragma unroll
            for (int e = 0; e < 4; ++e) x[4 * j + e] = x[4 * j + e] * rstd * g[e] + bb[e]; }
        if (lastc) { float* o = out_cv + ((size_t)((bc >> 4) * 128 + r) * 4 + h) * 128 + cq;
#pragma unroll
            for (int j = 0; j < 8; ++j) *(f32x4*)(o + 4 * j) = (f32x4){x[4 * j], x[4 * j + 1], x[4 * j + 2], x[4 * j + 3]}; }
#pragma unroll
        for (int j = 0; j < 32; j += 2) { const unsigned w = pk2(x[j], x[j + 1]); VT[(cq + j) * 136 + r] = (bf16)(w & 0xffffu); VT[(cq + j + 1) * 136 + r] = (bf16)(w >> 16); }
    }
    const int t_ = 16 * wave + fr; const size_t rowo = (size_t)(m0 + t_) * 1024 + h * 128; const float bsv = gm_bs[h * 128 + t_];
    u32x2 uq[8];
#pragma unroll
    for (int n = 0; n < 8; ++n) uq[n] = *(const u32x2*)(ZA + rowo + 16 * n + 4 * fq);
    bf16x8 wsf[4];
#pragma unroll
    for (int ks = 0; ks < 4; ++ks) wsf[ks] = *(const bf16x8*)(WSB + (size_t)(h * 128 + 16 * wave + fr) * 128 + 32 * ks + 8 * fq);
    __syncthreads();
    f32x4 acc[8];
#pragma unroll
    for (int n = 0; n < 8; ++n) acc[n] = (f32x4){0.f, 0.f, 0.f, 0.f};
    const int nks = (wave >> 1) + 1;
#pragma unroll
    for (int ks = 0; ks < 4; ++ks) if (ks < nks) {
#pragma unroll
        for (int n = 0; n < 8; ++n) { const bf16x8 vf = *(const LAS bf16x8*)(VT + (16 * n + fr) * 136 + 32 * ks + 8 * fq); acc[n] = __builtin_amdgcn_mfma_f32_16x16x32_bf16(vf, wsf[ks], acc[n], 0, 0, 0); }
    }
#pragma unroll
    for (int n = 0; n < 8; ++n) *(u32x2*)(MIX + rowo + 16 * n + 4 * fq) = pk4(bf4(uq[n]) * (acc[n] + bsv));
    __syncthreads();
}


typedef short bf16x4 __attribute__((ext_vector_type(4)));
#define MFMA32(a, b, c) __builtin_amdgcn_mfma_f32_16x16x32_bf16(a, b, c, 0, 0, 0)
#define MFMA16(a, b, c) __builtin_amdgcn_mfma_f32_16x16x16bf16_1k(a, b, c, 0, 0, 0)
constexpr int CP = 72;
constexpr int L_LW = 0, L_LA = 17408, L_LG = 34816;
constexpr int L_LAB = 0, L_LAK = 9216, L_MRB = 18432, L_MRK = 27648, L_TDD = 36864;
constexpr int L_AT = 52224, L_BT = 61440, L_KT = 70656, L_RT = 79872;
constexpr int L_WT = 52224, L_APT = 61440;
constexpr int L_ATT = 89088, L_VTT = 98304, L_BHT = 107520, L_KHT = 116736;
constexpr int L_EXCH = 125952, L_PC = 128000;
constexpr size_t TASK_BYTES = 32768;

__device__ __forceinline__ float wave_sum_dpp(float x) {
    x = red16(x); const int xi = __builtin_bit_cast(int, x);
    const float a = __builtin_bit_cast(float, __builtin_amdgcn_readlane(xi, 0)), b = __builtin_bit_cast(float, __builtin_amdgcn_readlane(xi, 16)), c = __builtin_bit_cast(float, __builtin_amdgcn_readlane(xi, 32)), d = __builtin_bit_cast(float, __builtin_amdgcn_readlane(xi, 48));
    return (a + b) + (c + d);
}
__device__ __forceinline__ bf16x4 pack4(f32x4 v) { const u32x2 r = pk4(v); return __builtin_bit_cast(bf16x4, r); }
__device__ __forceinline__ bf16x8 ldsfrag(const LAS unsigned char* lds, int off, int row, int col) { return *(const LAS bf16x8*)(lds + off + (row * CP + col) * 2); }

#ifdef PROBE_CSPAN_A
#define CST(k) do { if (h == CST_H && blockIdx.x == 64 && threadIdx.x == 0) *(volatile LAS unsigned long long*)(lds + 140000 + 8 * (k)) = __builtin_amdgcn_s_memrealtime(); } while (0)
#else
#define CST(k) do { } while (0)
#endif
__device__ __forceinline__ void rwkv_chunk_prep(LAS unsigned char* lds, int bc, const bf16* PB, const bf16* ZROW, const float* mu, const bf16* W2T, const bf16* A2T, const bf16* G2T,
                                                const float* w0, const float* a0, const float* k_k, const float* k_a, const float* r_k, bf16* LAIN, unsigned char* TASKS, bf16* G, bf16* VS, float* BON,
                                                int tid, int wave, int lane) {
    const int b = bc >> 5, c = bc & 31, m0 = b * SEQ + c * 64, fr = lane & 15, fq = lane >> 4;
    {   const int r = tid >> 3, cg = (tid & 7) * 32, m = m0 + r;
        const bf16* prow = PB + (size_t)m * DSH + 1536 + cg; const bf16* qrow = ((m & (SEQ - 1)) == 0) ? ZROW : (PB + (size_t)(m - 1) * DSH + 1536 + cg);
        const int mode = cg < 64 ? 0 : (cg < 128 ? 1 : 2);
#pragma unroll
        for (int j = 0; j < 4; ++j) {
            const u32x4 pv = *(const u32x4*)(prow + 8 * j), qv = *(const u32x4*)(qrow + 8 * j);
            const f32x4 m0v = *(const f32x4*)(mu + 1536 + cg + 8 * j), m1v = *(const f32x4*)(mu + 1536 + cg + 8 * j + 4);
            float x[8];
            { const float p0 = bf_lo(pv.x), p1 = bf_hi(pv.x), p2 = bf_lo(pv.y), p3 = bf_hi(pv.y), p4 = bf_lo(pv.z), p5 = bf_hi(pv.z), p6 = bf_lo(pv.w), p7 = bf_hi(pv.w);
              const float q0 = bf_lo(qv.x), q1 = bf_hi(qv.x), q2 = bf_lo(qv.y), q3 = bf_hi(qv.y), q4 = bf_lo(qv.z), q5 = bf_hi(qv.z), q6 = bf_lo(qv.w), q7 = bf_hi(qv.w);
              x[0] = p0 + (q0 - p0) * m0v[0]; x[1] = p1 + (q1 - p1) * m0v[1]; x[2] = p2 + (q2 - p2) * m0v[2]; x[3] = p3 + (q3 - p3) * m0v[3];
              x[4] = p4 + (q4 - p4) * m1v[0]; x[5] = p5 + (q5 - p5) * m1v[1]; x[6] = p6 + (q6 - p6) * m1v[2]; x[7] = p7 + (q7 - p7) * m1v[3]; }
#pragma unroll
            for (int e = 0; e < 8; ++e) x[e] = mode == 0 ? fast_tanh(x[e]) : (mode == 1 ? x[e] : fast_sigmoid(x[e]));
            u32x4 o; o.x = pk2(x[0], x[1]); o.y = pk2(x[2], x[3]); o.z = pk2(x[4], x[5]); o.w = pk2(x[6], x[7]);
            *(u32x4*)(LAIN + r * 256 + cg + 8 * j) = o;
        }
    }
    VM_WAIT(); __syncthreads();
    bf16x8 lainW[2], lainA[2], lainG[4];
    {   const bf16* arow = LAIN + (16 * (wave >> 1) + fr) * 256 + 8 * fq;
#pragma unroll
        for (int ks = 0; ks < 2; ++ks) { lainW[ks] = *(const bf16x8*)(arow + 32 * ks); lainA[ks] = *(const bf16x8*)(arow + 64 + 32 * ks); }
#pragma unroll
        for (int ks = 0; ks < 4; ++ks) lainG[ks] = *(const bf16x8*)(arow + 128 + 32 * ks); }
#pragma unroll 1
    for (int h = 0; h < 8; ++h) {
        CST(0);
        {   const int mt = wave >> 1;
            bf16x8 wW[2][2], wA[2][2], wG[2][4];
#pragma unroll
            for (int q = 0; q < 2; ++q) { const int wrow = 64 * h + 16 * ((wave & 1) * 2 + q) + fr;
#pragma unroll
                for (int ks = 0; ks < 2; ++ks) { wW[q][ks] = *(const bf16x8*)(W2T + (size_t)wrow * 64 + 32 * ks + 8 * fq); wA[q][ks] = *(const bf16x8*)(A2T + (size_t)wrow * 64 + 32 * ks + 8 * fq); }
#pragma unroll
                for (int ks = 0; ks < 4; ++ks) wG[q][ks] = *(const bf16x8*)(G2T + (size_t)wrow * 128 + 32 * ks + 8 * fq); }
#pragma unroll
            for (int q = 0; q < 2; ++q) { const int nt = (wave & 1) * 2 + q;
                f32x4 aw = (f32x4){0.f, 0.f, 0.f, 0.f}, aa = aw, ag = aw;
#pragma unroll
                for (int ks = 0; ks < 2; ++ks) { aw = MFMA32(wW[q][ks], lainW[ks], aw); aa = MFMA32(wA[q][ks], lainA[ks], aa); }
#pragma unroll
                for (int ks = 0; ks < 4; ++ks) ag = MFMA32(wG[q][ks], lainG[ks], ag);
                const int o = ((16 * mt + fr) * 68 + 16 * nt + 4 * fq) * 4;
                *(LAS f32x4*)(lds + L_LW + o) = aw; *(LAS f32x4*)(lds + L_LA + o) = aa; *(LAS f32x4*)(lds + L_LG + o) = ag; }
        }
        __syncthreads();
        CST(1);
        {   const int ch = 64 * h + lane;
            const float mur = mu[ch], muk = mu[512 + ch], muv = mu[1024 + ch], w0c = w0[ch], a0c = a0[ch], kkc = k_k[ch], kac = k_a[ch], rkc = r_k[ch];
            float rs[8], kp[8], vs[8], av[8], bv[8], wd[8], cwl[8]; float run = 0.f;
#pragma unroll
            for (int i = 0; i < 8; ++i) { const int p = 8 * wave + i, m = m0 + p; const bf16* prow = PB + (size_t)m * DSH + ch; const bool first = (m & (SEQ - 1)) == 0; const bf16* qrow = first ? ZROW : (prow - DSH);
                const float pr = bf1(prow[0]), pk = bf1(prow[512]), pvv = bf1(prow[1024]); const float qr = bf1(qrow[0]), qk = bf1(first ? qrow[0] : qrow[512]), qv = bf1(first ? qrow[0] : qrow[1024]);
                rs[i] = pr + (qr - pr) * mur; const float ks = pk + (qk - pk) * muk; vs[i] = pvv + (qv - pvv) * muv;
                const float lw = *(const LAS float*)(lds + L_LW + (p * 68 + lane) * 4), la = *(const LAS float*)(lds + L_LA + (p * 68 + lane) * 4), lg = *(const LAS float*)(lds + L_LG + (p * 68 + lane) * 4);
                const float z = -(w0c + lw), sp = fmaxf(z, 0.f) + fast_log(1.f + fast_exp(-fabsf(z)));
                wd[i] = -fast_exp(-sp - 0.5f);
                const float as = fast_sigmoid(a0c + la);
                const float kkr = ks * kkc; const float n2 = wave_sum_dpp(kkr * kkr); const float kk = kkr * __builtin_amdgcn_rsqf(fmaxf(n2, 1e-24f));
                kp[i] = ks * (1.f + (as - 1.f) * kac); av[i] = -kk; bv[i] = kk * as;
                const float bon = wave_sum_dpp(rs[i] * kp[i] * rkc);
                run += wd[i]; cwl[i] = run;
                G[(size_t)m * DB + ch] = (bf16)(pk2(lg, 0.f) & 0xffffu); VS[(size_t)m * DB + ch] = (bf16)(pk2(vs[i], 0.f) & 0xffffu);
                if (lane == 0) BON[(size_t)m * 8 + h] = bon; }
            *(LAS float*)(lds + L_EXCH + (wave * 64 + lane) * 4) = run;
            __syncthreads();
            CST(2);
            float base = 0.f, tot = 0.f;
#pragma unroll
            for (int w2 = 0; w2 < 8; ++w2) { const float t = *(const LAS float*)(lds + L_EXCH + (w2 * 64 + lane) * 4); tot += t; if (w2 < wave) base += t; }
            float oA[8], oV[8], oBh[8], oKh[8];
#pragma unroll
            for (int i = 0; i < 8; ++i) { const int p = 8 * wave + i; const float cw = base + cwl[i];
                const float e1 = fast_exp(cw - wd[i]), e2 = fast_exp(cw), e3 = __builtin_amdgcn_rcpf(e2), e4 = fast_exp(tot - cw);
                const float At = av[i] * e1, Rt = rs[i] * e2, Bt = bv[i] * e3, Kt = kp[i] * e3;
                oA[i] = At; oV[i] = vs[i]; oBh[i] = bv[i] * e4; oKh[i] = kp[i] * e4;
                *(LAS bf16*)(lds + L_AT + (p * CP + lane) * 2) = (bf16)(pk2(At, 0.f) & 0xffffu); *(LAS bf16*)(lds + L_BT + (p * CP + lane) * 2) = (bf16)(pk2(Bt, 0.f) & 0xffffu);
                *(LAS bf16*)(lds + L_KT + (p * CP + lane) * 2) = (bf16)(pk2(Kt, 0.f) & 0xffffu); *(LAS bf16*)(lds + L_RT + (p * CP + lane) * 2) = (bf16)(pk2(Rt, 0.f) & 0xffffu); }
            { u32x4 o; const int off = (lane * CP + 8 * wave) * 2;
              o.x = pk2(oA[0], oA[1]); o.y = pk2(oA[2], oA[3]); o.z = pk2(oA[4], oA[5]); o.w = pk2(oA[6], oA[7]); *(LAS u32x4*)(lds + L_ATT + off) = o;
              o.x = pk2(oV[0], oV[1]); o.y = pk2(oV[2], oV[3]); o.z = pk2(oV[4], oV[5]); o.w = pk2(oV[6], oV[7]); *(LAS u32x4*)(lds + L_VTT + off) = o;
              o.x = pk2(oBh[0], oBh[1]); o.y = pk2(oBh[2], oBh[3]); o.z = pk2(oBh[4], oBh[5]); o.w = pk2(oBh[6], oBh[7]); *(LAS u32x4*)(lds + L_BHT + off) = o;
              o.x = pk2(oKh[0], oKh[1]); o.y = pk2(oKh[2], oKh[3]); o.z = pk2(oKh[4], oKh[5]); o.w = pk2(oKh[6], oKh[7]); *(LAS u32x4*)(lds + L_KHT + off) = o; }
            if (wave == 0) *(LAS float*)(lds + L_PC + lane * 4) = fast_exp(tot);
        }
        __syncthreads();
        CST(3);
        {   const int ty = wave >> 1;
#pragma unroll
            for (int prod = 0; prod < 4; ++prod) { const int xo = (prod & 1) ? L_KT : L_BT, yo = prod < 2 ? L_AT : L_RT, oo = prod == 0 ? L_LAB : (prod == 1 ? L_LAK : (prod == 2 ? L_MRB : L_MRK)); const bool incl = prod >= 2;
#pragma unroll
                for (int q = 0; q < 2; ++q) { const int tx = (wave & 1) * 2 + q; f32x4 acc = (f32x4){0.f, 0.f, 0.f, 0.f};
                    if (tx <= ty) {
#pragma unroll
                        for (int ks = 0; ks < 2; ++ks) acc = MFMA32(ldsfrag(lds, xo, 16 * tx + fr, 32 * ks + 8 * fq), ldsfrag(lds, yo, 16 * ty + fr, 32 * ks + 8 * fq), acc); }
                    const int i = 16 * ty + fr, j0 = 16 * tx + 4 * fq;
#pragma unroll
                    for (int e = 0; e < 4; ++e) { const int j = j0 + e; if (!(incl ? (j <= i) : (j < i))) acc[e] = 0.f; }
                    *(LAS u32x2*)(lds + oo + (i * CP + j0) * 2) = pk4(acc); } }
        }
        __syncthreads();
        CST(4);
        if (wave < 4) { const int d = wave; float t[16];
#pragma unroll
            for (int i = 0; i < 16; ++i) { const u32x4 r0 = *(const LAS u32x4*)(lds + L_LAB + ((16 * d + i) * CP + 16 * d) * 2), r1 = *(const LAS u32x4*)(lds + L_LAB + ((16 * d + i) * CP + 16 * d + 8) * 2);
                const float l[16] = {bf_lo(r0.x), bf_hi(r0.x), bf_lo(r0.y), bf_hi(r0.y), bf_lo(r0.z), bf_hi(r0.z), bf_lo(r0.w), bf_hi(r0.w), bf_lo(r1.x), bf_hi(r1.x), bf_lo(r1.y), bf_hi(r1.y), bf_lo(r1.z), bf_hi(r1.z), bf_lo(r1.w), bf_hi(r1.w)};
                float s = (i == lane) ? 1.f : 0.f;
#pragma unroll
                for (int mm = 0; mm < i; ++mm) s += l[mm] * t[mm];
                t[i] = s; }
            if (lane < 16) {
#pragma unroll
                for (int i = 0; i < 16; ++i) *(LAS bf16*)(lds + L_TDD + ((d * 16 + i) * 24 + lane) * 2) = (bf16)(pk2(t[i], 0.f) & 0xffffu); }
        }
        __syncthreads();
        CST(5);
        {   const int s = wave & 3; const bool isW = wave < 4; f32x4 acc[4];
            if (isW) {
#pragma unroll
                for (int d = 0; d < 4; ++d) { acc[d] = (f32x4){0.f, 0.f, 0.f, 0.f};
#pragma unroll
                    for (int ks = 0; ks < 2; ++ks) if (32 * ks <= 16 * d + 15) acc[d] = MFMA32(ldsfrag(lds, L_LAK, 16 * d + fr, 32 * ks + 8 * fq), ldsfrag(lds, L_VTT, 16 * s + fr, 32 * ks + 8 * fq), acc[d]); }
            } else {
#pragma unroll
                for (int d = 0; d < 4; ++d) acc[d] = bf4(*(const LAS u32x2*)(lds + L_ATT + ((16 * s + fr) * CP + 16 * d + 4 * fq) * 2));
            }
            bf16x4 xf[4]; const int oo = isW ? L_WT : L_APT;
#pragma unroll
            for (int d = 0; d < 4; ++d) {
#pragma unroll
                for (int mm = 0; mm < d; ++mm) acc[d] = MFMA16(*(const LAS bf16x4*)(lds + L_LAB + ((16 * d + fr) * CP + 16 * mm + 4 * fq) * 2), xf[mm], acc[d]);
                const f32x4 x = MFMA16(*(const LAS bf16x4*)(lds + L_TDD + ((d * 16 + fr) * 24 + 4 * fq) * 2), pack4(acc[d]), ((f32x4){0.f, 0.f, 0.f, 0.f}));
                xf[d] = pack4(x);
                *(LAS bf16x4*)(lds + oo + ((16 * s + fr) * CP + 16 * d + 4 * fq) * 2) = xf[d]; }
        }
        __syncthreads();
        CST(6);
        {   unsigned char* task = TASKS + (size_t)((b * 8 + h) * 32 + c) * TASK_BYTES; const int ty = wave >> 1;
#pragma unroll
            for (int q = 0; q < 2; ++q) { const int tx = (wave & 1) * 2 + q; const int yr = 16 * ty + fr, xc = 16 * tx + 4 * fq;
                f32x4 aM = (f32x4){0.f, 0.f, 0.f, 0.f}, aN = aM, aR = aM, aY = aM;
#pragma unroll
                for (int ks = 0; ks < 2; ++ks) { const int kc = 32 * ks + 8 * fq;
                    const bf16x8 fAP = ldsfrag(lds, L_APT, 16 * tx + fr, kc), fBHx = ldsfrag(lds, L_BHT, 16 * tx + fr, kc), fKHx = ldsfrag(lds, L_KHT, 16 * tx + fr, kc), fMRBx = ldsfrag(lds, L_MRB, 16 * tx + fr, kc), fMRKx = ldsfrag(lds, L_MRK, 16 * tx + fr, kc);
                    const bf16x8 fBHy = ldsfrag(lds, L_BHT, 16 * ty + fr, kc), fWTy = ldsfrag(lds, L_WT, 16 * ty + fr, kc), fVTy = ldsfrag(lds, L_VTT, 16 * ty + fr, kc), fMRBy = ldsfrag(lds, L_MRB, 16 * ty + fr, kc);
                    aM = MFMA32(fAP, fBHy, aM);
                    aN = MFMA32(fBHx, fWTy, aN); aN = MFMA32(fKHx, fVTy, aN);
                    aR = MFMA32(fAP, fMRBy, aR);
                    aY = MFMA32(fMRBx, fWTy, aY); aY = MFMA32(fMRKx, fVTy, aY); }
                const float pc = *(const LAS float*)(lds + L_PC + yr * 4);
#pragma unroll
                for (int e = 0; e < 4; ++e) if (xc + e == yr) aM[e] += pc;
                aR += bf4(*(const LAS u32x2*)(lds + L_RT + (yr * CP + xc) * 2));
                const size_t o = (size_t)(((ty * 64 + lane) * 4 + tx) * 8);
                *(u32x2*)(task + o) = pk4(aM); *(u32x2*)(task + 8192 + o) = pk4(aN); *(u32x2*)(task + 16384 + o) = pk4(aR); *(u32x2*)(task + 24576 + o) = pk4(aY); }
        }
        __syncthreads();
        CST(7);
    }
}

__device__ __forceinline__ void scanB_block(LAS unsigned char* lds, int bh, const unsigned char* TASKS, const bf16* G, const bf16* VS, const float* BON, const float* ln_g, const float* ln_b, bf16* MIX, float* out_wkv, int tid, int wave, int lane) {
    const int b = bh >> 3, h = bh & 7, fr = lane & 15, fq = lane >> 4;
    LAS float* YB = (LAS float*)lds;
    if (wave < 4) {
        const int s = wave;
        const GAS unsigned char* tk = (const GAS unsigned char*)TASKS + (size_t)bh * 32 * TASK_BYTES + (size_t)lane * 32;
        const GAS unsigned char* gG = (const GAS unsigned char*)G; const GAS unsigned char* gV = (const GAS unsigned char*)VS; const GAS unsigned char* gB = (const GAS unsigned char*)BON;
        struct TaskRegs { u32x4 m0[4], m1[4], r0[4], r1[4], n0, n1, y0, y1, g0, g1, v0, v1; unsigned bo; };
        TaskRegs TA, TB; bf16x4 xf[4]; f32x4 accX[4];
#pragma unroll
        for (int t = 0; t < 4; ++t) { xf[t] = (bf16x4){0, 0, 0, 0}; accX[t] = (f32x4){0.f, 0.f, 0.f, 0.f}; }
#define GLD16(dst, ptr, OFF) asm volatile("global_load_dwordx4 %0, %1, off offset:" #OFF : "=v"(dst) : "v"(ptr) : "memory")
#define LOADTASK(T, cc) do { const GAS unsigned char* tp_ = tk + (size_t)(cc) * TASK_BYTES; _Pragma("unroll") for (int t = 0; t < 4; ++t) { \
            GLD16(T.m0[t], tp_ + t * 2048, 0); GLD16(T.m1[t], tp_ + t * 2048, 16); GLD16(T.r0[t], tp_ + 16384 + t * 2048, 0); GLD16(T.r1[t], tp_ + 16384 + t * 2048, 16); } \
            GLD16(T.n0, tp_ + 8192 + s * 2048, 0); GLD16(T.n1, tp_ + 8192 + s * 2048, 16); GLD16(T.y0, tp_ + 24576 + s * 2048, 0); GLD16(T.y1, tp_ + 24576 + s * 2048, 16); \
            { const size_t mo_ = ((size_t)(b * SEQ + (cc) * 64 + 16 * s + (lane >> 3)) * DB + 64 * h + 8 * (lane & 7)) * 2; \
              GLD16(T.g0, gG + mo_, 0); GLD16(T.g1, gG + mo_ + 8 * DB * 2, 0); GLD16(T.v0, gV + mo_, 0); GLD16(T.v1, gV + mo_ + 8 * DB * 2, 0); \
              asm volatile("global_load_dword %0, %1, off" : "=v"(T.bo) : "v"(gB + ((size_t)(b * SEQ + (cc) * 64 + 16 * s + (lane & 15)) * 8 + h) * 4) : "memory"); } } while (0)
#define WAITTASK(T, N) asm volatile("s_waitcnt vmcnt(" #N ")" : "+v"(T.m0[0]), "+v"(T.m0[1]), "+v"(T.m0[2]), "+v"(T.m0[3]), "+v"(T.m1[0]), "+v"(T.m1[1]), "+v"(T.m1[2]), "+v"(T.m1[3]), \
            "+v"(T.r0[0]), "+v"(T.r0[1]), "+v"(T.r0[2]), "+v"(T.r0[3]), "+v"(T.r1[0]), "+v"(T.r1[1]), "+v"(T.r1[2]), "+v"(T.r1[3]), "+v"(T.n0), "+v"(T.n1), "+v"(T.y0), "+v"(T.y1), \
            "+v"(T.g0), "+v"(T.g1), "+v"(T.v0), "+v"(T.v1), "+v"(T.bo) :: "memory")
#define LO2(v) __builtin_bit_cast(bf16x4, (u32x2){(v).x, (v).y})
#define HI2(v) __builtin_bit_cast(bf16x4, (u32x2){(v).z, (v).w})
#define STEP(T, cc) do { f32x4 accY[4]; \
            accY[0] = bf4((u32x2){T.y0.x, T.y0.y}); accY[1] = bf4((u32x2){T.y0.z, T.y0.w}); accY[2] = bf4((u32x2){T.y1.x, T.y1.y}); accY[3] = bf4((u32x2){T.y1.z, T.y1.w}); \
            accX[0] = bf4((u32x2){T.n0.x, T.n0.y}); accX[1] = bf4((u32x2){T.n0.z, T.n0.w}); accX[2] = bf4((u32x2){T.n1.x, T.n1.y}); accX[3] = bf4((u32x2){T.n1.z, T.n1.w}); \
            _Pragma("unroll") for (int t = 0; t < 4; ++t) { \
                accY[t] = MFMA16(LO2(T.r0[t]), xf[0], accY[t]); accX[t] = MFMA16(LO2(T.m0[t]), xf[0], accX[t]); accY[t] = MFMA16(HI2(T.r0[t]), xf[1], accY[t]); accX[t] = MFMA16(HI2(T.m0[t]), xf[1], accX[t]); \
                accY[t] = MFMA16(LO2(T.r1[t]), xf[2], accY[t]); accX[t] = MFMA16(LO2(T.m1[t]), xf[2], accX[t]); accY[t] = MFMA16(HI2(T.r1[t]), xf[3], accY[t]); accX[t] = MFMA16(HI2(T.m1[t]), xf[3], accX[t]); } \
            _Pragma("unroll") for (int t = 0; t < 4; ++t) xf[t] = pack4(accX[t]); \
            LAS float* yb = YB + ((cc) & 1) * 4096; \
            _Pragma("unroll") for (int t = 0; t < 4; ++t) _Pragma("unroll") for (int e = 0; e < 4; ++e) yb[(16 * t + 4 * fq + e) * 64 + 16 * s + fr] = accY[t][e]; \
            { LAS unsigned char* gl_ = lds + 32768 + ((cc) & 1) * 8192 + ((16 * s + (lane >> 3)) * 64 + 8 * (lane & 7)) * 2; \
              *(LAS u32x4*)gl_ = T.g0; *(LAS u32x4*)(gl_ + 1024) = T.g1; *(LAS u32x4*)(gl_ + 16384) = T.v0; *(LAS u32x4*)(gl_ + 16384 + 1024) = T.v1; \
              if (lane < 16) *(LAS unsigned*)(lds + 65536 + ((cc) & 1) * 256 + (16 * s + lane) * 4) = T.bo; } \
            asm volatile("s_waitcnt lgkmcnt(0)" ::: "memory"); __builtin_amdgcn_s_barrier(); asm volatile("" ::: "memory"); } while (0)
        LOADTASK(TA, 0); LOADTASK(TB, 1);
#pragma unroll 1
        for (int c = 0; c < 32; c += 2) {
            WAITTASK(TA, 25); STEP(TA, c); LOADTASK(TA, (c + 2 < 32 ? c + 2 : 31));
            WAITTASK(TB, 25); STEP(TB, c + 1); LOADTASK(TB, (c + 3 < 32 ? c + 3 : 31));
        }
        asm volatile("s_waitcnt vmcnt(0)" ::: "memory");
#undef GLD16
#undef LOADTASK
#undef WAITTASK
#undef LO2
#undef HI2
#undef STEP
#pragma unroll
        for (int t = 0; t < 4; ++t) *(f32x4*)(out_wkv + ((size_t)bh * 64 + 16 * s + fr) * 64 + 16 * t + 4 * fq) = accX[t];
    } else {
        const int tp = tid - 256, l16 = tp & 15;
        const f32x4 lg4 = *(const f32x4*)(ln_g + 64 * h + 4 * l16), lb4 = *(const f32x4*)(ln_b + 64 * h + 4 * l16);
#pragma unroll 1
        for (int c = 0; c < 32; ++c) {
            asm volatile("" ::: "memory"); __builtin_amdgcn_s_barrier(); asm volatile("" ::: "memory");
            const LAS float* yb = YB + (c & 1) * 4096; const LAS unsigned char* gl = lds + 32768 + (c & 1) * 8192; const LAS float* bl = (const LAS float*)(lds + 65536 + (c & 1) * 256);
#pragma unroll
            for (int it = 0; it < 4; ++it) { const int tt = it * 16 + (tp >> 4); const int m = b * SEQ + c * 64 + tt;
                const f32x4 y4 = *(const LAS f32x4*)(yb + tt * 64 + 4 * l16);
                const f32x4 g4 = bf4(*(const LAS u32x2*)(gl + (tt * 64 + 4 * l16) * 2)), v4 = bf4(*(const LAS u32x2*)(gl + 16384 + (tt * 64 + 4 * l16) * 2)); const float bon = bl[tt];
                const float mean = red16((y4[0] + y4[1]) + (y4[2] + y4[3])) * (1.f / 64.f);
                const f32x4 d4 = y4 - mean;
                const float var = red16((d4[0] * d4[0] + d4[1] * d4[1]) + (d4[2] * d4[2] + d4[3] * d4[3])) * (1.f / 64.f);
                const float rstd = __builtin_amdgcn_rsqf(var + GN_EPS);
                const f32x4 o = ((d4 * rstd) * lg4 + lb4 + v4 * bon) * g4;
                *(GAS u32x2*)((gbf16*)MIX + (size_t)m * 1024 + 512 + 64 * h + 4 * l16) = pk4(o); }
        }
    }
}

template <class EpiF>
__device__ __forceinline__ void small_gemm(LAS unsigned char* lds, const bf16* A, int lda, const bf16* Bt, int N, int K, int Q, int gb, int GB, const EpiF& epi, int tid, int wave, int lane) {
    const int fr = lane & 15, fq = lane >> 4, kw = (K / Q) >> 3;
    LAS float* part = (LAS float*)lds;
    for (int item = gb; item < (N >> 4) * Q; item += GB) {
        const int strip = item / Q, q = item - strip * Q;
        f32x4 acc[8];
#pragma unroll
        for (int i = 0; i < 8; ++i) acc[i] = (f32x4){0.f, 0.f, 0.f, 0.f};
        const bf16* brow = Bt + (size_t)(16 * strip + fr) * K + q * (K / Q) + wave * kw + 8 * fq;
        const bf16* arow = A + (size_t)fr * lda + q * (K / Q) + wave * kw + 8 * fq;
#pragma unroll 4
        for (int ks = 0; ks < (kw >> 5); ++ks) {
            const bf16x8 wf = *(const bf16x8*)(brow + 32 * ks);
#pragma unroll
            for (int mt = 0; mt < 8; ++mt) { const bf16x8 af = *(const bf16x8*)(arow + (size_t)(16 * mt) * lda + 32 * ks); acc[mt] = __builtin_amdgcn_mfma_f32_16x16x32_bf16(wf, af, acc[mt], 0, 0, 0); }
        }
#pragma unroll
        for (int mt = 0; mt < 8; ++mt) *(LAS f32x4*)(part + ((wave * 128 + 16 * mt + fr) * 16 + 4 * fq)) = acc[mt];
        __syncthreads();
        {   const int token = tid >> 2, cg = tid & 3; f32x4 sm = (f32x4){0.f, 0.f, 0.f, 0.f};
#pragma unroll
            for (int w = 0; w < 8; ++w) sm += *(const LAS f32x4*)(part + ((w * 128 + token) * 16 + 4 * cg));
            epi(token, 16 * strip + 4 * cg, sm); }
        __syncthreads();
    }
}
struct SEpiProj { bf16* ZAs; float* PBs;
    __device__ __forceinline__ void operator()(int t, int c, f32x4 s) const {
        if (c < 1024) { const f32x2 a = pg8::gelu_pk((f32x2){s[0], s[1]}), b = pg8::gelu_pk((f32x2){s[2], s[3]}); *(u32x2*)(ZAs + (size_t)t * 1024 + c) = pk4((f32x4){a.x, a.y, b.x, b.y}); }
        else *(f32x4*)(PBs + (size_t)t * DSH + (c - 1024)) = s; } };
struct SEpiAtomic { float* acc;
    __device__ __forceinline__ void operator()(int t, int c, f32x4 s) const {
#pragma unroll
        for (int j = 0; j < 4; ++j) (void)__hip_atomic_fetch_add(acc + (size_t)t * 1024 + c + j, s[j], __ATOMIC_RELAXED, __HIP_MEMORY_SCOPE_AGENT); } };
template <bool WB> struct SEpiRes { const float* base; float* out; bf16* outb; float* rowss; float* out2;
    __device__ __forceinline__ void operator()(int t, int c, f32x4 s) const {
        const f32x4 v = *(const f32x4*)(base + (size_t)t * 1024 + c) + s; *(f32x4*)(out + (size_t)t * 1024 + c) = v; if (WB) *(u32x2*)(outb + (size_t)t * 1024 + c) = pk4(v); if (out2) *(f32x4*)(out2 + (size_t)t * 1024 + c) = v;
        float ss = (v[0] * v[0] + v[1] * v[1]) + (v[2] * v[2] + v[3] * v[3]); ss = red4(ss);
        if ((threadIdx.x & 3) == 0) (void)__hip_atomic_fetch_add(rowss + t, ss, __ATOMIC_RELAXED, __HIP_MEMORY_SCOPE_AGENT); } };
struct SEpiQ { float* Q; const float* rowss;
    __device__ __forceinline__ void operator()(int t, int c, f32x4 s) const {
        const float sc = 0.0625f / sqrtf(__hip_atomic_load(rowss + t, __ATOMIC_RELAXED, __HIP_MEMORY_SCOPE_AGENT) * (1.f / D) + RMS_EPS); *(f32x4*)(Q + (size_t)t * 1024 + c) = s * sc; } };
struct SEpiUp { bf16* H; const float* rowss;
    __device__ __forceinline__ void operator()(int t, int c, f32x4 s) const {
        const float sc = 1.f / sqrtf(__hip_atomic_load(rowss + t, __ATOMIC_RELAXED, __HIP_MEMORY_SCOPE_AGENT) * (1.f / D) + RMS_EPS); f32x4 v = s * sc;
#pragma unroll
        for (int j = 0; j < 4; ++j) { const float a = fmaxf(v[j], 0.f); v[j] = a * a; }
        *(u32x2*)(H + (size_t)t * FF + c) = pk4(v); } };

struct KArgs { const float* in[35]; float* out; unsigned char* ws; };
__device__ __forceinline__ void sample_mixer_token(LAS unsigned char* lds, int tok, const KArgs& KA, const bf16* ZAs, const float* PBs, bf16* MIXs, const bf16* W2T, const bf16* A2T, const bf16* G2T, int tid, int wave, int lane) {
    const float* const (&in)[35] = KA.in; float* out = KA.out;
    LAS float* red = (LAS float*)lds;
    LAS float* lin = (LAS float*)(lds + 256);
    LAS float* vec = (LAS float*)(lds + 2048);
    const int c = tid;
    {   const int hA = c >> 7; const float vz = bf1(ZAs[(size_t)tok * 1024 + 512 + c]), uz = bf1(ZAs[(size_t)tok * 1024 + c]);
        const float s1 = wave_sum(vz); if (lane == 0) red[wave] = s1;
        __syncthreads();
        const float mean = (red[2 * hA] + red[2 * hA + 1]) * (1.f / 128.f); const float dv = vz - mean;
        const float s2 = wave_sum(dv * dv); if (lane == 0) red[8 + wave] = s2;
        __syncthreads();
        const float var = (red[8 + 2 * hA] + red[8 + 2 * hA + 1]) * (1.f / 128.f);
        const float vn = dv * (1.f / sqrtf(var + LN_EPS)) * in[10][c] + in[11][c];
        out[O_CVS + (size_t)tok * 512 + c] = vn;
        const float mixed = in[12][(size_t)hA * 128 * 128] * vn + in[13][hA * 128];
        MIXs[(size_t)tok * 1024 + c] = (bf16)(pk2(uz * mixed, 0.f) & 0xffffu);
    }
    const float* pb = PBs + (size_t)tok * DSH; const float* pv = in[5] + (size_t)tok * DSH; const float* mu = in[9];
    if (tid < 256) { const int i = 1536 + tid; const float x = pb[i] + (pv[i] - pb[i]) * mu[i]; lin[tid] = tid < 64 ? fast_tanh(x) : (tid < 128 ? x : fast_sigmoid(x)); }
    __syncthreads();
    const float rs = pb[c] + (pv[c] - pb[c]) * mu[c], ks = pb[512 + c] + (pv[512 + c] - pb[512 + c]) * mu[512 + c], vs = pb[1024 + c] + (pv[1024 + c] - pb[1024 + c]) * mu[1024 + c];
    const size_t so = ((size_t)(tok * 8 + wave) * 64 + lane) * 64; const float* s0 = in[6] + so; float* s1o = out + O_WKVS + so;
    f32x4 Sx[16];
#pragma unroll
    for (int j = 0; j < 16; ++j) Sx[j] = *(const f32x4*)(s0 + 4 * j);
    float wl = in[14][c], al = in[16][c], g = 0.f;
    {   const bf16* w2r = W2T + (size_t)c * 64; const bf16* a2r = A2T + (size_t)c * 64; const bf16* g2r = G2T + (size_t)c * 128;
#define DOT8(acc, v, lp) do { const f32x4 l0_ = *(const LAS f32x4*)(lp), l1_ = *(const LAS f32x4*)((lp) + 4); \
            acc += (bf_lo((v).x) * l0_[0] + bf_hi((v).x) * l0_[1]) + (bf_lo((v).y) * l0_[2] + bf_hi((v).y) * l0_[3]) + (bf_lo((v).z) * l1_[0] + bf_hi((v).z) * l1_[1]) + (bf_lo((v).w) * l1_[2] + bf_hi((v).w) * l1_[3]); } while (0)
#pragma unroll 1
        for (int j = 0; j < 8; ++j) { const u32x4 w8 = *(const u32x4*)(w2r + 8 * j), a8 = *(const u32x4*)(a2r + 8 * j), g8 = *(const u32x4*)(g2r + 8 * j), h8 = *(const u32x4*)(g2r + 64 + 8 * j);
            DOT8(wl, w8, lin + 8 * j); DOT8(al, a8, lin + 64 + 8 * j); DOT8(g, g8, lin + 128 + 8 * j); DOT8(g, h8, lin + 192 + 8 * j); }
#undef DOT8
    }
    const float z = -wl, sp = fmaxf(z, 0.f) + fast_log(1.f + fast_exp(-fabsf(z))), w = -sp - 0.5f, dec = fast_exp(-fast_exp(w)), av = fast_sigmoid(al);
    const float kkr = ks * in[19][c]; const float nrm = sqrtf(wave_sum(kkr * kkr)); const float kk = kkr / fmaxf(nrm, 1e-12f); const float kp = ks * (1.f + (av - 1.f) * in[20][c]);
    LAS float* hv = vec + wave * 320;
    hv[lane] = dec; hv[64 + lane] = -kk; hv[128 + lane] = kk * av; hv[192 + lane] = kp; hv[256 + lane] = rs;
    __syncthreads();
    {   float sa = 0.f;
#pragma unroll
        for (int j = 0; j < 16; ++j) { const f32x4 a4 = *(const LAS f32x4*)(hv + 64 + 4 * j); sa += (Sx[j][0] * a4[0] + Sx[j][1] * a4[1]) + (Sx[j][2] * a4[2] + Sx[j][3] * a4[3]); if ((j & 3) == 3) asm volatile("" ::: "memory"); }
        float y = 0.f;
#pragma unroll
        for (int j = 0; j < 16; ++j) { const f32x4 d4 = *(const LAS f32x4*)(hv + 4 * j), b4 = *(const LAS f32x4*)(hv + 128 + 4 * j), k4 = *(const LAS f32x4*)(hv + 192 + 4 * j), r4 = *(const LAS f32x4*)(hv + 256 + 4 * j);
            const f32x4 sn = Sx[j] * d4 + (b4 * sa + k4 * vs); *(f32x4*)(s1o + 4 * j) = sn; y += (sn[0] * r4[0] + sn[1] * r4[1]) + (sn[2] * r4[2] + sn[3] * r4[3]); if ((j & 1) == 1) asm volatile("" ::: "memory"); }
        const float mean = wave_sum(y) * (1.f / 64.f), dy = y - mean, var = wave_sum(dy * dy) * (1.f / 64.f);
        const float yn = dy * (1.f / sqrtf(var + GN_EPS)) * in[22][c] + in[23][c];
        const float bon = wave_sum(rs * kp * in[21][c]) * vs;
        MIXs[(size_t)tok * 1024 + 512 + c] = (bf16)(pk2((yn + bon) * g, 0.f) & 0xffffu);
    }
    __syncthreads();
}
__device__ __forceinline__ void sample_attn_pair(LAS unsigned char* lds, int pair, const float* Qs, const float* Kc, const float* Vc, bf16* Os, int tid, int wave, int lane) {
    const int b = pair >> 2, h = pair & 3;
    LAS float* sc = (LAS float*)lds;
    LAS float* part = (LAS float*)(lds + 1024);
    const f32x4 q4 = *(const f32x4*)(Qs + (size_t)b * 1024 + h * 256 + 4 * lane);
    const float* kb = Kc + ((size_t)b * 256 * 4 + h) * 256 + 4 * lane; const float* vb = Vc + ((size_t)b * 256 * 4 + h) * 256 + 4 * lane;
    {   f32x4 kr[32];
#pragma unroll
        for (int i = 0; i < 32; ++i) kr[i] = *(const f32x4*)(kb + (size_t)(32 * wave + i) * 1024);
#pragma unroll
        for (int i = 0; i < 32; ++i) { const float p = wave_sum_dpp((q4[0] * kr[i][0] + q4[1] * kr[i][1]) + (q4[2] * kr[i][2] + q4[3] * kr[i][3])); if (lane == 0) sc[32 * wave + i] = p; } }
    f32x4 vr[32];
#pragma unroll
    for (int i = 0; i < 32; ++i) vr[i] = *(const f32x4*)(vb + (size_t)(32 * wave + i) * 1024);
    __syncthreads();
    {   const f32x4 s4 = *(const LAS f32x4*)(sc + 4 * lane); const float mx = wave_max(fmaxf(fmaxf(s4[0], s4[1]), fmaxf(s4[2], s4[3])));
        f32x4 e; float sum = 0.f;
#pragma unroll
        for (int j = 0; j < 4; ++j) { e[j] = fast_exp(s4[j] - mx); sum += e[j]; }
        sum = wave_sum(sum); const float inv = 1.f / sum;
        __syncthreads();
        if (wave == 0) *(LAS f32x4*)(sc + 4 * lane) = e * inv;
    }
    __syncthreads();
    f32x4 o = (f32x4){0.f, 0.f, 0.f, 0.f};
#pragma unroll
    for (int i = 0; i < 32; ++i) o += vr[i] * sc[32 * wave + i];
    *(LAS f32x4*)(part + wave * 256 + 4 * lane) = o;
    __syncthreads();
    if (tid < 256) { float s = 0.f;
#pragma unroll
        for (int w = 0; w < 8; ++w) s += part[w * 256 + tid];
        Os[(size_t)b * 1024 + h * 256 + tid] = (bf16)(pk2(s, 0.f) & 0xffffu); }
    __syncthreads();
}
template <int ST>
__device__ __forceinline__ void sample_stage(LAS unsigned char* lds, const KArgs& KA, int gb, int GB, int tid, int wave, int lane) {
    unsigned char* ws = KA.ws; unsigned char* sm = ws + WS_SMP; const float* const (&in)[35] = KA.in; float* out = KA.out;
    float* rs1 = (float*)ws + RS_OFF + M; float* rs2 = rs1 + RS_STRIDE;
    const bf16* XN0s = (const bf16*)(ws + WS_ACAT) + (size_t)M * 1024;
    bf16* ZAs = (bf16*)(sm + SM_ZA); bf16* MIXs = (bf16*)(sm + SM_MIX); float* X1s = (float*)(sm + SM_X1); bf16* X1Bs = (bf16*)(sm + SM_X1B); float* Qs = (float*)(sm + SM_Q); bf16* Os = (bf16*)(sm + SM_O);
    float* X2s = (float*)(sm + SM_X2); bf16* X2Bs = (bf16*)(sm + SM_X2B); bf16* HIDs = (bf16*)(sm + SM_HID); float* X3s = (float*)(sm + SM_X3);
    float* PBs = out + O_SHS;
    if constexpr (ST == 0) { SEpiProj e{ZAs, PBs}; small_gemm(lds, XN0s, 1024, (const bf16*)(ws + WS_WCAT), DIN, 1024, 1, gb, GB, e, tid, wave, lane); }
    if constexpr (ST == 1) { for (int tok = gb; tok < MS; tok += GB) sample_mixer_token(lds, tok, KA, ZAs, PBs, MIXs, (const bf16*)(ws + WS_SMALL), (const bf16*)(ws + WS_SMALL + 64 * KiB), (const bf16*)(ws + WS_SMALL + 128 * KiB), tid, wave, lane); }
    if constexpr (ST == 2) { SEpiRes<true> e{in[1], X1s, X1Bs, rs1, nullptr}; small_gemm(lds, MIXs, 1024, (const bf16*)(ws + WS_WOUT), 1024, 1024, 1, gb, GB, e, tid, wave, lane); }
    if constexpr (ST == 3) { SEpiQ e{Qs, rs1}; small_gemm(lds, X1Bs, 1024, (const bf16*)(ws + WS_WQ), 1024, 1024, 1, gb, GB, e, tid, wave, lane); }
    if constexpr (ST == 4) { for (int pair = gb; pair < MS * 4; pair += GB) sample_attn_pair(lds, pair, Qs, in[3], in[4], Os, tid, wave, lane); }
    if constexpr (ST == 5) { SEpiRes<true> e{X1s, X2s, X2Bs, rs2, X3s}; small_gemm(lds, Os, 1024, (const bf16*)(ws + WS_WO), 1024, 1024, 1, gb, GB, e, tid, wave, lane); }
    if constexpr (ST == 6) { SEpiUp e{HIDs, rs2}; small_gemm(lds, X2Bs, 1024, (const bf16*)(ws + WS_WUP), FF, 1024, 1, gb, GB, e, tid, wave, lane); }
    if constexpr (ST == 7) { SEpiAtomic e{X3s}; small_gemm(lds, HIDs, FF, (const bf16*)(ws + WS_WDN), 1024, FF, 4, gb, GB, e, tid, wave, lane); }
    if constexpr (ST == 8) {
        for (int r = gb * 8 + wave; r < MS; r += GB * 8) {
            f32x4 v[4]; float ss = 0.f;
#pragma unroll
            for (int j = 0; j < 4; ++j) { v[j] = *(const f32x4*)(X3s + (size_t)r * 1024 + 256 * j + 4 * lane); ss += (v[j][0] * v[j][0] + v[j][1] * v[j][1]) + (v[j][2] * v[j][2] + v[j][3] * v[j][3]); }
            const float sc = 1.f / sqrtf(wave_sum(ss) * (1.f / D) + RMS_EPS);
#pragma unroll
            for (int j = 0; j < 4; ++j) { const int cc = 256 * j + 4 * lane; *(f32x4*)(out + O_YS + (size_t)r * 1024 + cc) = v[j] * sc * *(const f32x4*)(in[34] + cc); } }
    }
}

__global__ void __launch_bounds__(NWAVES * 64, 2) mk_fwd(KArgs a) {
    extern __shared__ __attribute__((aligned(16))) unsigned char lds_raw[];
    LAS unsigned char* lds = (LAS unsigned char*)lds_raw;
    volatile LAS unsigned* MISC = (volatile LAS unsigned*)(lds + MISC_OFF);
    int tid = threadIdx.x, lane = tid & 63, wave = __builtin_amdgcn_readfirstlane(tid >> 6);
    const int G = gridDim.x; int bx = blockIdx.x; int vcu = (G % 8 == 0) ? (bx % 8) * (G / 8) + bx / 8 : bx;
#define LAUNDER() do { ws = a.ws; asm volatile("" : "+s"(ws)); tid = threadIdx.x; asm volatile("" : "+v"(tid)); lane = tid & 63; wave = __builtin_amdgcn_readfirstlane(tid >> 6); bx = blockIdx.x; asm volatile("" : "+s"(bx)); \
        vcu = (G % 8 == 0) ? (bx % 8) * (G / 8) + bx / 8 : bx; gw = vcu * NWAVES + wave; } while (0)
    unsigned char* ws = a.ws; float* out = a.out;
    gu32* ctl = (gu32*)(ws + WS_CTL);
    for (int u = tid; u < (LDS_BYTES - LDSCTL_OFF) / 4; u += NWAVES * 64) ((LAS unsigned*)(lds + LDSCTL_OFF))[u] = 0u;
    __syncthreads();
    XcdBarrier bar = xcd_barrier_post((unsigned*)ctl + CW_BAR, MISC + 8);
#define GRID_BAR() xcd_barrier(bar)
#ifdef PROBE_SPAN_A
#define STAMP(k) do { if (blockIdx.x == 0 && threadIdx.x == 0) *(volatile LAS unsigned long long*)(lds + LDSCTL_OFF + 64 + 8 * (k)) = __builtin_amdgcn_s_memrealtime(); } while (0)
#else
#define STAMP(k) do { } while (0)
#endif
    STAMP(0);
#ifdef PROBE_SSPAN_A
#define SST(k) do { if (blockIdx.x == 64 && threadIdx.x == 0) *(volatile LAS unsigned long long*)(lds + LDSCTL_OFF + 64 + 8 * (16 + (k))) = __builtin_amdgcn_s_memrealtime(); } while (0)
#else
#define SST(k) do { } while (0)
#endif
#define RS1 ((float*)ws + RS_OFF)
#define RS2 ((float*)ws + RS_OFF + RS_STRIDE)
#define RS3 ((float*)ws + RS_OFF + 2 * RS_STRIDE)
#define WCAT ((bf16*)(ws + WS_WCAT))
#define WOUT ((bf16*)(ws + WS_WOUT))
#define WQ ((bf16*)(ws + WS_WQ))
#define WO ((bf16*)(ws + WS_WO))
#define WUP ((bf16*)(ws + WS_WUP))
#define WDN ((bf16*)(ws + WS_WDN))
#define W2T ((bf16*)(ws + WS_SMALL))
#define A2T ((bf16*)(ws + WS_SMALL + 64 * KiB))
#define G2T ((bf16*)(ws + WS_SMALL + 128 * KiB))
#define WSB ((bf16*)(ws + WS_SMALL + 256 * KiB))
#define ZROW ((bf16*)(ws + WS_SMALL + 384 * KiB))
#define ACAT ((bf16*)(ws + WS_ACAT))
#define ZA ((bf16*)(ws + WS_ZA))
#define PB ((bf16*)(ws + WS_PB))
#define SCN ((float*)(ws + WS_SCN))
#define LAIN ((bf16*)(ws + WS_NEW))
#define OPS ((bf16*)(ws + WS_SCN))
#define TASKS (ws + WS_NEW + 8 * MiB)
#define VSB ((bf16*)(ws + WS_NEW + 72 * MiB))
#define BON ((float*)(ws + WS_NEW + 88 * MiB))
#define GB_ ((bf16*)(ws + WS_G))
#define MIX ((bf16*)(ws + WS_MIX))
#define KB ((bf16*)(ws + WS_KB))
#define VT ((bf16*)(ws + WS_VT))
#define X1B ((bf16*)(ws + WS_ZA))
#define Q ((bf16*)(ws + WS_Q))
#define OB ((bf16*)(ws + WS_OB))
#define PSCR ((bf16*)(ws + WS_PSCR))
#define X2B ((bf16*)(ws + WS_MIX))
#define HID ((bf16*)(ws + WS_HID))
    int gw = vcu * NWAVES + wave; const int NGW = G * NWAVES;

    #ifndef NOP0
    LAUNDER();
    {
        LAS float* scr = (LAS float*)(lds + wave * 16384);
        constexpr int I_IN = 16 * 88, I_SQ = 16 * 32, I_UP = 16 * 128, I_DN = 64 * 32, I_L = 16, I_G = 32;
        constexpr int NITEMS = I_IN + 5 * I_SQ + I_UP + I_DN + 2 * I_L + I_G;
        for (int it = gw; it < NITEMS; it += NGW) {
            int r = it;
            if (r < I_IN) { p0_transpose_item(a.in[8], 1024, DIN, WCAT, 0, nullptr, scr, r, lane); continue; } r -= I_IN;
            if (r < I_SQ) { p0_transpose_item(a.in[28], 1024, 1024, WCAT, DIN, nullptr, scr, r, lane); continue; } r -= I_SQ;
            if (r < I_SQ) { p0_transpose_item(a.in[29], 1024, 1024, WCAT, DIN + 1024, nullptr, scr, r, lane); continue; } r -= I_SQ;
            if (r < I_SQ) { p0_transpose_item(a.in[24], 1024, 1024, WOUT, 0, nullptr, scr, r, lane); continue; } r -= I_SQ;
            if (r < I_SQ) { p0_transpose_item(a.in[27], 1024, 1024, WQ, 0, a.in[25], scr, r, lane); continue; } r -= I_SQ;
            if (r < I_SQ) { p0_transpose_item(a.in[30], 1024, 1024, WO, 0, nullptr, scr, r, lane); continue; } r -= I_SQ;
            if (r < I_UP) { p0_transpose_item(a.in[32], 1024, FF, WUP, 0, a.in[31], scr, r, lane); continue; } r -= I_UP;
            if (r < I_DN) { p0_transpose_item(a.in[33], FF, 1024, WDN, 0, nullptr, scr, r, lane); continue; } r -= I_DN;
            if (r < I_L) { p0_transpose_item(a.in[15], 64, DB, W2T, 0, nullptr, scr, r, lane); continue; } r -= I_L;
            if (r < I_L) { p0_transpose_item(a.in[17], 64, DB, A2T, 0, nullptr, scr, r, lane); continue; } r -= I_L;
            p0_transpose_item(a.in[18], 128, DB, G2T, 0, nullptr, scr, r, lane);
        }
        for (int m = gw; m < M + MS + NBATCH * NMEM; m += 4 * NGW) {
            const float* src[4]; const float* gg[4]; bf16* dst[4]; bool ok[4];
#pragma unroll
            for (int q = 0; q < 4; ++q) { const int mm = m + q * NGW; ok[q] = mm < M + MS + NBATCH * NMEM; const int mc = ok[q] ? mm : m;
                if (mc < M) { src[q] = a.in[0] + (size_t)mc * D; gg[q] = a.in[7]; dst[q] = ACAT + (size_t)mc * D; }
                else if (mc < M + MS) { src[q] = a.in[1] + (size_t)(mc - M) * D; gg[q] = a.in[7]; dst[q] = ACAT + (size_t)mc * D; }
                else { src[q] = a.in[2] + (size_t)(mc - M - MS) * D; gg[q] = a.in[26]; dst[q] = ACAT + (size_t)(16640 + (mc - M - MS)) * D; } }
            f32x4 v[4][4]; float ss[4];
#pragma unroll
            for (int q = 0; q < 4; ++q) { ss[q] = 0.f;
#pragma unroll
                for (int j = 0; j < 4; ++j) v[q][j] = *((const f32x4*)src[q] + lane + 64 * j); }
#pragma unroll
            for (int q = 0; q < 4; ++q) {
#pragma unroll
                for (int j = 0; j < 4; ++j) ss[q] += (v[q][j].x * v[q][j].x + v[q][j].y * v[q][j].y) + (v[q][j].z * v[q][j].z + v[q][j].w * v[q][j].w);
                const float rstd = 1.f / sqrtf(wave_sum(ss[q]) * (1.f / D) + RMS_EPS);
                if (ok[q]) { unsigned long long* o8 = (unsigned long long*)dst[q] + lane;
#pragma unroll
                    for (int j = 0; j < 4; ++j) { const f32x4 g4 = *((const f32x4*)gg[q] + lane + 64 * j);
                        o8[64 * j] = (unsigned long long)pk2(v[q][j].x * rstd * g4.x, v[q][j].y * rstd * g4.y) | ((unsigned long long)pk2(v[q][j].z * rstd * g4.z, v[q][j].w * rstd * g4.w) << 32); } } }
        }
        const int gt = bx * (NWAVES * 64) + tid, NGT = G * NWAVES * 64;
        for (int i = gt; i < 4 * 128 * 128; i += NGT) { const int t = (i >> 7) & 127, s = i & 127; WSB[i] = (bf16)(pk2(s <= t ? a.in[12][i] : 0.f, 0.f) & 0xffffu); }
        for (int i = gt; i < 2048; i += NGT) ZROW[i] = 0;
    }
#endif
    GRID_BAR(); STAMP(1);

    #ifndef NOP1
    LAUNDER();
    {
        SchedP1 S{G, bx, (const char*)ACAT, (const char*)WCAT};
        EpiP1 E{ZA, PB, out + O_MK, out + O_MV, KB};
        pg8::gemm_phase<EpiP1, SchedP1, true>(lds, 1024, 1024, 1024, S, E);
        sample_stage<0>(lds, a, bx, G, tid, wave, lane);
    }
#endif
    GRID_BAR(); STAMP(2);

    #ifndef NOP2
    LAUNDER();
    {
        LAS float* scr = (LAS float*)(lds + wave * 16384);
        for (int it = gw; it < NBATCH * 128; it += NGW) { const int b = it >> 7; p0_transpose_item(out + O_MV + (size_t)b * NMEM * 1024, NMEM, 1024, VT + (size_t)b * 1024 * NMEM, 0, nullptr, scr, it & 127, lane); }
        const int gt = bx * (NWAVES * 64) + tid, NGT = G * NWAVES * 64;
        for (int i = gt; i < NBATCH * DSH; i += NGT) { const int b = i / DSH, c = i % DSH; out[O_SHP + i] = bf1(PB[(size_t)(b * SEQ + SEQ - 1) * DSH + c]); }
        __syncthreads();
        SST(10);
        for (int bc = bx; bc < M / 64; bc += G)
            rwkv_chunk_prep(lds, bc, PB, ZROW, a.in[9], W2T, A2T, G2T, a.in[14], a.in[16], a.in[19], a.in[20], a.in[21], LAIN + (size_t)bx * 16384, TASKS, GB_, VSB, BON, tid, wave, lane);
        SST(11);
#ifdef DUP2
        LAUNDER();
        for (int bc = bx; bc < M / 64; bc += G)
            rwkv_chunk_prep(lds, bc, PB, ZROW, a.in[9], W2T, A2T, G2T, a.in[14], a.in[16], a.in[19], a.in[20], a.in[21], LAIN + (size_t)bx * 16384, TASKS, GB_, VSB, BON, tid, wave, lane);
#endif
        sample_stage<1>(lds, a, bx, G, tid, wave, lane);
    }
#endif
    GRID_BAR(); STAMP(3);

    #ifndef NOP3
    LAUNDER();
    {   unsigned* subcnt = (unsigned*)ctl + CW_SUB; unsigned* tmo = (unsigned*)ctl + CW_TMO; unsigned* qatt = (unsigned*)ctl + CW_QATT; unsigned* qmix = (unsigned*)ctl + CW_QMIX;
        volatile LAS unsigned* qw = (volatile LAS unsigned*)(lds + LDSCTL_OFF + 32);
        if (bx < 64) {
            scanB_block(lds, bx, TASKS, GB_, VSB, BON, a.in[22], a.in[23], MIX, out + O_WKVP, tid, wave, lane);
#ifdef DUP3
            LAUNDER();
            scanB_block(lds, bx, TASKS, GB_, VSB, BON, a.in[22], a.in[23], MIX, out + O_WKVP, tid, wave, lane);
#endif
            STAMP(5);
            __syncthreads();
            if (tid == 0) { unsigned sp = 0; while (xb_ld(subcnt) < 384u) { __builtin_amdgcn_s_sleep(4); if ((++sp & 255u) == 0u) { if (xb_ld(tmo)) break; if (sp > (1u << 20)) { atomicAdd(tmo, 1u); break; } } }
                __builtin_amdgcn_fence(__ATOMIC_ACQUIRE, "agent"); asm volatile("s_waitcnt vmcnt(0)" ::: "memory"); }
            __syncthreads();
        } else {
            const int gb = bx - 64;
            SST(0);
#define SUBBAR_FILL(target) do { asm volatile("s_waitcnt vmcnt(0)" ::: "memory"); __syncthreads(); \
                if (tid == 0) { __builtin_amdgcn_fence(__ATOMIC_RELEASE, "agent"); asm volatile("s_waitcnt vmcnt(0)" ::: "memory"); (void)xb_add(subcnt, 1u); } \
                unsigned sp_ = 0; \
                for (;;) { __syncthreads(); if (tid == 0) { const bool dn_ = xb_ld(subcnt) >= (target) || xb_ld(tmo) != 0u; *qw = dn_ ? 0xffffffffu : xb_add(qmix, 1u); } __syncthreads(); const unsigned tile_ = *qw; \
                    if (tile_ == 0xffffffffu) break; \
                    if (tile_ < 512u) mixer_a_tile(lds, (int)tile_, ZA, WSB, a.in[10], a.in[11], a.in[13], MIX, out + O_CVP, tid, wave, lane); \
                    else { __builtin_amdgcn_s_sleep(8); if (++sp_ > (1u << 18)) { if (tid == 0) atomicAdd(tmo, 1u); } } } \
                if (tid == 0) { __builtin_amdgcn_fence(__ATOMIC_ACQUIRE, "agent"); asm volatile("s_waitcnt vmcnt(0)" ::: "memory"); } \
                __syncthreads(); } while (0)
            sample_stage<2>(lds, a, gb, 192, tid, wave, lane);
            SST(1);
            SUBBAR_FILL(192u);
            SST(2);
            sample_stage<3>(lds, a, gb, 192, tid, wave, lane);
            SST(3);
            SUBBAR_FILL(384u);
#undef SUBBAR_FILL
            SST(4);
        }
        {   const float* Qs = (const float*)(ws + WS_SMP + SM_Q); bf16* Os = (bf16*)(ws + WS_SMP + SM_O);
            for (;;) { __syncthreads(); if (tid == 0) *qw = xb_add(qatt, 1u); __syncthreads(); const unsigned pair = *qw; if (pair >= (unsigned)(MS * 4)) break;
                sample_attn_pair(lds, (int)pair, Qs, a.in[3], a.in[4], Os, tid, wave, lane); }
            SST(5);
            for (;;) { __syncthreads(); if (tid == 0) *qw = xb_add(qmix, 1u); __syncthreads(); const unsigned tile = *qw; if (tile >= 512u) break;
                mixer_a_tile(lds, (int)tile, ZA, WSB, a.in[10], a.in[11], a.in[13], MIX, out + O_CVP, tid, wave, lane); }
            SST(6);
        }
    }
#endif
    GRID_BAR(); STAMP(4);

    #ifndef NOP4
    LAUNDER();
    {
        SchedMN S; S.init(M, 1024, G, bx, MIX, 1024, WOUT, 1024);
        EpiRes<float> E{a.in[0], X1B, RS1};
        pg8::gemm_phase<EpiRes<float>, SchedMN, true>(lds, 1024, 1024, 1024, S, E);
        sample_stage<5>(lds, a, bx, G, tid, wave, lane);
    }
#endif
    GRID_BAR(); STAMP(6);

    #ifndef NOP5
    LAUNDER();
    {
        SchedMN S5; S5.init(M, 1024, G, bx, X1B, 1024, WQ, 1024);
        bf16* QS = Q + (size_t)bx * 65536; bf16* P = PSCR + (size_t)bx * 65536;
        Unit u;
        for (int i = 0; S5.next(i, u); ++i) {
            const int pm = u.pm, h = u.pn, b = pm >> 3;
            { EpiQS E{QS, RS1};
              struct SchedU { const char* A; const char* B; Unit uu; __device__ __forceinline__ bool next(int i2, Unit& o) const { if (i2) return false; o = uu; return true; } __device__ __forceinline__ const char* pa(const Unit&) const { return A; } __device__ __forceinline__ const char* pb(const Unit&) const { return B; } };
              SchedU SU{S5.pa(u), S5.pb(u), u};
              pg8::gemm_phase<EpiQS, SchedU, false>(lds, 1024, 1024, 1024, SU, E); }
            { SchedOne S{(const char*)QS, (const char*)(KB + (size_t)b * NMEM * 1024 + h * 256)}; EpiSoftmax E{P};
              pg8::gemm_phase<EpiSoftmax, SchedOne, false>(lds, 256, 256, 1024, S, E); }
            { SchedOne S{(const char*)P, (const char*)(VT + ((size_t)b * 1024 + h * 256) * NMEM)}; EpiAttnO E{OB + (size_t)pm * 256 * 1024 + h * 256};
              pg8::gemm_phase<EpiAttnO, SchedOne, false>(lds, 256, 256, 256, S, E); }
        }
        sample_stage<6>(lds, a, bx, G, tid, wave, lane);
    }
#endif
    GRID_BAR(); STAMP(8);

    #ifndef NOP7
    LAUNDER();
    {
        SchedMN S; S.init(M, 1024, G, bx, OB, 1024, WO, 1024);
        EpiRes<bf16> E{X1B, X2B, RS2};
        pg8::gemm_phase<EpiRes<bf16>, SchedMN, true>(lds, 1024, 1024, 1024, S, E);
        sample_stage<7>(lds, a, bx, G, tid, wave, lane);
    }
#endif
    GRID_BAR(); STAMP(9);

    #ifndef NOP8
    LAUNDER();
    {
        SchedMN S; S.init(M, FF, G, bx, X2B, 1024, WUP, 1024);
        EpiScale<1> E{HID, FF, RS2};
        pg8::gemm_phase<EpiScale<1>, SchedMN, true>(lds, 1024, 1024, 1024, S, E);
        sample_stage<8>(lds, a, bx, G, tid, wave, lane);
    }
#endif
    GRID_BAR(); STAMP(10);

    #ifndef NOP9
    LAUNDER();
    {
        SchedMN S; S.init(M, 1024, G, bx, HID, FF, WDN, FF);
        EpiFinal E{X2B, out + O_Y, a.in[34], RS3, (unsigned*)ctl + CW_PAN, (unsigned*)ctl + CW_TMO};
        pg8::gemm_phase<EpiFinal, SchedMN, true>(lds, FF, FF, FF, S, E);
    }
#endif
#ifdef PROBE_CSPAN_A
    if (blockIdx.x == 64 && threadIdx.x == 0) {
        const unsigned long long ta = *(volatile LAS unsigned long long*)(lds + 140000 + 8 * PROBE_CSPAN_A), tb = *(volatile LAS unsigned long long*)(lds + 140000 + 8 * PROBE_CSPAN_B);
        const unsigned long long t0 = __builtin_amdgcn_s_memrealtime(), dl = (tb - ta) * PROBE_MULT;
        while (__builtin_amdgcn_s_memrealtime() - t0 < dl) __builtin_amdgcn_s_sleep(8);
    }
#endif
#ifdef PROBE_SSPAN_A
    if (blockIdx.x == 64 && threadIdx.x == 0) {
        const unsigned long long ta = *(volatile LAS unsigned long long*)(lds + LDSCTL_OFF + 64 + 8 * (16 + PROBE_SSPAN_A)), tb = *(volatile LAS unsigned long long*)(lds + LDSCTL_OFF + 64 + 8 * (16 + PROBE_SSPAN_B));
        const unsigned long long t0 = __builtin_amdgcn_s_memrealtime(), dl = (tb - ta) * PROBE_MULT;
        while (__builtin_amdgcn_s_memrealtime() - t0 < dl) __builtin_amdgcn_s_sleep(8);
    }
#endif
#ifdef PROBE_SPAN_A
    STAMP(12);
    if (blockIdx.x == 0 && threadIdx.x == 0) {
        const unsigned long long ta = *(volatile LAS unsigned long long*)(lds + LDSCTL_OFF + 64 + 8 * PROBE_SPAN_A), tb = *(volatile LAS unsigned long long*)(lds + LDSCTL_OFF + 64 + 8 * PROBE_SPAN_B);
        const unsigned long long t0 = __builtin_amdgcn_s_memrealtime(), dl = (tb - ta) * PROBE_MULT;
        while (__builtin_amdgcn_s_memrealtime() - t0 < dl) __builtin_amdgcn_s_sleep(8);
    }
#endif
}

extern "C" void kernel_launch(void* const* d_in, const int* in_sizes, int n_in, void* d_out, int out_size, void* d_ws, size_t ws_size, hipStream_t stream) {
    static int grid = 0;
    if (grid == 0) {
        if (n_in != 35 || out_size != (int)O_END || ws_size < WS_END) { fprintf(stderr, "kernel_launch: unexpected shapes (n_in %d, out %d, ws %zu); nothing launched\n", n_in, out_size, ws_size); grid = -1; return; }
        int dev = 0, cus = 0, per_cu = 0;
        if (hipGetDevice(&dev) != hipSuccess || hipDeviceGetAttribute(&cus, hipDeviceAttributeMultiprocessorCount, dev) != hipSuccess) { fprintf(stderr, "kernel_launch: device query failed\n"); grid = -1; return; }
        if (hipFuncSetAttribute((const void*)mk_fwd, hipFuncAttributeMaxDynamicSharedMemorySize, LDS_BYTES) != hipSuccess) { fprintf(stderr, "kernel_launch: hipFuncSetAttribute failed\n"); grid = -1; return; }
        if (hipOccupancyMaxActiveBlocksPerMultiprocessor(&per_cu, (const void*)mk_fwd, NWAVES * 64, LDS_BYTES) != hipSuccess || per_cu < 1)
            fprintf(stderr, "kernel_launch: note: occupancy query reports %d workgroups per CU\n", per_cu);
        (void)hipGetLastError();
        grid = cus;
        if (grid != 256) { fprintf(stderr, "kernel_launch: built for a 256-CU device (got %d)\n", grid); grid = -1; return; }
    }
    if (grid < 0) return;
    if (hipMemsetAsync((char*)d_ws + WS_CTL, 0, CTL_ZERO_BYTES, stream) != hipSuccess) { fprintf(stderr, "kernel_launch: hipMemsetAsync failed\n"); return; }
    KArgs a{};
    for (int i = 0; i < 35; ++i) a.in[i] = (const float*)d_in[i];
    a.out = (float*)d_out; a.ws = (unsigned char*)d_ws;
    hipLaunchKernelGGL(mk_fwd, dim3(grid), dim3(NWAVES * 64), LDS_BYTES, stream, a);
    const hipError_t le = hipPeekAtLastError();
    if (le != hipSuccess) fprintf(stderr, "kernel_launch: launch failed: %s\n", hipGetErrorName(le));
}
```

```cpp
#include <hip/hip_runtime.h>
#include <cstdio>
#include <cstdint>

namespace pg8 {
#define PG8_LAS __attribute__((address_space(3)))
typedef unsigned short bf16_t;
typedef short bf16x8 __attribute__((ext_vector_type(8)));
typedef float f32x4 __attribute__((ext_vector_type(4)));
typedef float f32x2 __attribute__((ext_vector_type(2)));
typedef unsigned u32x4 __attribute__((ext_vector_type(4)));
typedef unsigned u32x2 __attribute__((ext_vector_type(2)));
constexpr int BM = 256, BK = 64, HALF = 128, HTB = HALF * BK * 2  , STAGE_BYTES = 8 * HTB;

__host__ __device__ __forceinline__ int lds_byte(int r, int c) { const int st = (r >> 4) * 2 + (c >> 5), rr = r & 15, cc = c & 31, ob = rr * 64 + cc * 2; return st * 1024 + (ob ^ (((ob >> 9) & 1) << 5)); }
__host__ __device__ __forceinline__ void stage_rc(int b, int& R, int& C) { const int st = b / 1024, sb = b % 1024, swz = sb ^ (((sb >> 9) & 1) << 5); R = (st >> 1) * 16 + swz / 64; C = (st & 1) * 32 + (swz % 64) / 2; }
__host__ __device__ __forceinline__ int perm32(int rho) { const int n = rho >> 4, i = rho & 15; return 8 * (i >> 2) + 4 * n + (i & 3); }

struct Unit { int pm, pn; };

typedef __bf16 nbf16x2 __attribute__((ext_vector_type(2)));
__device__ __forceinline__ unsigned cvt_pk_bf16(float lo, float hi) { const nbf16x2 r = __builtin_convertvector((f32x2){lo, hi}, nbf16x2); return __builtin_bit_cast(unsigned, r); }
__device__ __forceinline__ f32x2 gelu_pk(f32x2 v) {
    const f32x2 av = __builtin_elementwise_abs(v), d = av * 0.2316418882f + 1.0f;
    f32x2 t; t.x = __builtin_amdgcn_rcpf(d.x); t.y = __builtin_amdgcn_rcpf(d.y);
    f32x2 q = t * 0.5307027145f + (-0.7265760135f); q = q * t + 0.7107068705f; q = q * t + (-0.142248368f); q = q * t + 0.127414796f; q = q * t;
    const f32x2 s = (v * v) * (-0.72134752044f);
    f32x2 e; e.x = __builtin_amdgcn_exp2f(s.x); e.y = __builtin_amdgcn_exp2f(s.y);
    const f32x2 m = v * (q * e), r = v - m;
    f32x2 o; o.x = v.x < 0.f ? m.x : r.x; o.y = v.y < 0.f ? m.y : r.y; return o;
}

template <class Epi, class Sched, bool ALIGN_EPI = false>
__device__ __forceinline__ void gemm_phase(PG8_LAS unsigned char* lds, const int K, const int lda, const int ldb, const Sched& S, const Epi& E) {
    int tid_ = threadIdx.x; asm volatile("" : "+v"(tid_));
    const int tid = tid_, wid = __builtin_amdgcn_readfirstlane(tid >> 6), lane = tid & 63, wr = wid >> 2, wc = wid & 3, fr = lane & 15, fq = lane >> 4;
    const int nt = K / BK;
    unsigned voffA[2], voffB[2];
#pragma unroll
    for (int i = 0; i < 2; ++i) { int R, C; stage_rc(tid * 16 + i * 8192, R, C); const int Rb = Epi::PERM ? ((R & ~31) + perm32(R & 31)) : R;
        voffA[i] = (unsigned)(R * lda + C) * 2u; voffB[i] = (unsigned)(Rb * ldb + C) * 2u; }
    const size_t kstep = (size_t)(BK * 2);
    const size_t hstepA = (size_t)HALF * lda * 2, hstepB = (size_t)HALF * ldb * 2;
    const unsigned ldsw = (unsigned)wid * 1024u;
    const int aoff = lds_byte(wr * 64 + fr, fq * 8), boff = lds_byte(wc * 32 + fr, fq * 8);
#define PG8_SA(b, h) (((b) * 2 + (h)) * HTB)
#define PG8_SB(b, h) ((4 + (b) * 2 + (h)) * HTB)
#define PG8_STAGE(bufoff, gbase, voff) do { _Pragma("unroll") for (int _i = 0; _i < 2; ++_i) \
        __builtin_amdgcn_global_load_lds((const unsigned*)((const char*)(gbase) + (voff)[_i]), (PG8_LAS unsigned*)(lds + (bufoff) + ldsw + _i * 8192), 16, 0, 0); } while (0)
#define PG8_LDA(dst, b, h) do { _Pragma("unroll") for (int m = 0; m < 4; ++m) _Pragma("unroll") for (int k = 0; k < 2; ++k) dst[m][k] = *(const PG8_LAS bf16x8*)(lds + PG8_SA(b, h) + aoff + m * 2048 + k * 1024); } while (0)
#define PG8_LDB(dst, b, h) do { _Pragma("unroll") for (int n = 0; n < 2; ++n) _Pragma("unroll") for (int k = 0; k < 2; ++k) dst[n][k] = *(const PG8_LAS bf16x8*)(lds + PG8_SB(b, h) + boff + n * 2048 + k * 1024); } while (0)
#define PG8_MMA(ai, bj, At, Bt) do { __builtin_amdgcn_s_setprio(1); _Pragma("unroll") for (int m = 0; m < 4; ++m) _Pragma("unroll") for (int n = 0; n < 2; ++n) _Pragma("unroll") for (int k = 0; k < 2; ++k) \
        acc[ai][bj][m][n] = __builtin_amdgcn_mfma_f32_16x16x32_bf16(Bt[n][k], At[m][k], acc[ai][bj][m][n], 0, 0, 0); __builtin_amdgcn_s_setprio(0); } while (0)
#define PG8_WAIT_V(n) asm volatile("s_waitcnt vmcnt(" #n ")" ::: "memory")
#define PG8_WAIT_L(n) asm volatile("s_waitcnt lgkmcnt(" #n ")" ::: "memory")
#define PG8_BAR __builtin_amdgcn_s_barrier()
#define PG8_SCHED __builtin_amdgcn_sched_barrier(0)
    Unit cur, nxt; int ui = 0;
    if (!S.next(0, cur)) return;
    f32x4 acc[2][2][4][2];
#pragma unroll
    for (int a = 0; a < 2; ++a)
#pragma unroll
        for (int b = 0; b < 2; ++b)
#pragma unroll
            for (int m = 0; m < 4; ++m)
#pragma unroll
                for (int n = 0; n < 2; ++n) acc[a][b][m][n] = (f32x4){0.f, 0.f, 0.f, 0.f};
    bf16x8 At[4][2], B0[2][2], B1[2][2];
    const char* cA = S.pa(cur); const char* cB = S.pb(cur);
    PG8_STAGE(PG8_SB(0, 0), cB, voffB); PG8_STAGE(PG8_SB(0, 1), cB + hstepB, voffB); PG8_STAGE(PG8_SA(0, 0), cA, voffA); PG8_STAGE(PG8_SA(0, 1), cA + hstepA, voffA);
    if (wr == 1) PG8_BAR;
    PG8_WAIT_V(2); PG8_BAR;
    PG8_STAGE(PG8_SB(1, 0), cB + kstep, voffB); PG8_STAGE(PG8_SA(1, 0), cA + kstep, voffA); PG8_STAGE(PG8_SB(1, 1), cB + hstepB + kstep, voffB);
    PG8_WAIT_V(6); PG8_BAR;
    for (;;) {
        const bool has_next = S.next(ui + 1, nxt);
        const char* nA = has_next ? S.pa(nxt) : cA; const char* nB = has_next ? S.pb(nxt) : cB;
#pragma unroll 1
        for (int t = 0; t < nt; t += 2) {
            const bool last = (t == nt - 2);
            const char* a1 = cA + (size_t)(t + 1) * kstep;
            const char* a2 = last ? nA : cA + (size_t)(t + 2) * kstep; const char* b2 = last ? nB : cB + (size_t)(t + 2) * kstep;
            const char* a3 = a2 + kstep; const char* b3 = b2 + kstep;
            PG8_LDB(B0, 0, 0); PG8_LDB(B1, 0, 1); PG8_SCHED; PG8_LDA(At, 0, 0); PG8_STAGE(PG8_SA(1, 1), a1 + hstepA, voffA);
            PG8_WAIT_V(8); PG8_WAIT_L(0); PG8_BAR; PG8_MMA(0, 0, At, B0); PG8_MMA(0, 1, At, B1); PG8_BAR; PG8_SCHED;
            PG8_LDA(At, 0, 1); PG8_STAGE(PG8_SB(0, 0), b2, voffB); PG8_STAGE(PG8_SB(0, 1), b2 + hstepB, voffB); PG8_STAGE(PG8_SA(0, 0), a2, voffA);
            PG8_WAIT_V(8); PG8_WAIT_L(0); PG8_BAR; PG8_MMA(1, 0, At, B0); PG8_MMA(1, 1, At, B1); PG8_BAR; PG8_SCHED;
            PG8_LDB(B0, 1, 0); PG8_LDB(B1, 1, 1); PG8_SCHED; PG8_LDA(At, 1, 0); PG8_STAGE(PG8_SA(0, 1), a2 + hstepA, voffA);
            PG8_WAIT_V(8); PG8_WAIT_L(0); PG8_BAR; PG8_MMA(0, 0, At, B0); PG8_MMA(0, 1, At, B1); PG8_BAR; PG8_SCHED;
            PG8_LDA(At, 1, 1); PG8_STAGE(PG8_SB(1, 0), b3, voffB); PG8_STAGE(PG8_SB(1, 1), b3 + hstepB, voffB); PG8_STAGE(PG8_SA(1, 0), a3, voffA);
            PG8_WAIT_V(8); PG8_WAIT_L(0); PG8_BAR; PG8_MMA(1, 0, At, B0); PG8_MMA(1, 1, At, B1); PG8_BAR; PG8_SCHED;
        }
        if constexpr (ALIGN_EPI) { if (wr == 0) PG8_BAR; }
        if constexpr (!Epi::AFTER_DRAIN) { E(acc, cur, wr, wc, fr, fq); }
        if (!has_next) break;
#pragma unroll
        for (int a = 0; a < 2; ++a)
#pragma unroll
            for (int b = 0; b < 2; ++b)
#pragma unroll
                for (int m = 0; m < 4; ++m)
#pragma unroll
                    for (int n = 0; n < 2; ++n) acc[a][b][m][n] = (f32x4){0.f, 0.f, 0.f, 0.f};
        cur = nxt; cA = nA; cB = nB; ++ui;
        if constexpr (ALIGN_EPI) { if (wr == 1) PG8_BAR; }
    }
    PG8_WAIT_V(0);
    if constexpr (!ALIGN_EPI) { if (wr == 0) PG8_BAR; }
    PG8_BAR;
    if constexpr (Epi::AFTER_DRAIN) { E.fused(acc, cur, wr, wc, fr, fq, lds, wid, lane); }
#undef PG8_SA
#undef PG8_SB
#undef PG8_STAGE
#undef PG8_LDA
#undef PG8_LDB
#undef PG8_MMA
#undef PG8_WAIT_V
#undef PG8_WAIT_L
#undef PG8_BAR
#undef PG8_SCHED
}
}

#define GAS __attribute__((address_space(1)))
#define LAS __attribute__((address_space(3)))
typedef unsigned short bf16;
typedef float f32x4 __attribute__((ext_vector_type(4)));
typedef float f32x2 __attribute__((ext_vector_type(2)));
typedef short bf16x8 __attribute__((ext_vector_type(8)));
typedef unsigned u32x4 __attribute__((ext_vector_type(4)));
typedef unsigned u32x2 __attribute__((ext_vector_type(2)));
typedef GAS unsigned gu32;
#define RLX_AGENT __ATOMIC_RELAXED, __HIP_MEMORY_SCOPE_AGENT
#define LDS_WAIT() asm volatile("s_waitcnt lgkmcnt(0)" ::: "memory")
#define VM_WAIT() asm volatile("s_waitcnt vmcnt(0)" ::: "memory")

constexpr int NWAVES = 8;
constexpr int D = 1024, M = 16384, SEQ = 2048, NBATCH = 8, MS = 128, DIN = 2816, DSH = 1792, DB = 512, FF = 4096, NMEM = 256;
constexpr float RMS_EPS = 1e-6f, LN_EPS = 1e-5f, GN_EPS = 64e-5f;
constexpr size_t O_Y = 0, O_YS = 16777216, O_MK = 16908288, O_MV = 19005440, O_SHP = 21102592, O_WKVP = 21116928, O_CVP = 21379072, O_SHS = 21903360, O_WKVS = 22132736, O_CVS = 26327040, O_END = 26392576;
constexpr size_t MiB = 1u << 20, KiB = 1024;
constexpr size_t WS_CTL = 0, CTL_ZERO_BYTES = 1 * MiB;
constexpr size_t WS_WCAT = 2 * MiB;
constexpr size_t WS_WOUT = 12 * MiB, WS_WQ = 14 * MiB, WS_WO = 16 * MiB, WS_WUP = 18 * MiB, WS_WDN = 26 * MiB;
constexpr size_t WS_SMALL = 34 * MiB;
constexpr size_t WS_ACAT = 36 * MiB;
constexpr size_t WS_ZA = 73 * MiB;
constexpr size_t WS_PB = 105 * MiB;
constexpr size_t WS_Q = 105 * MiB, WS_OB = 137 * MiB;
constexpr size_t WS_SCN = 161 * MiB;
constexpr size_t WS_PSCR = 169 * MiB, WS_HID = 201 * MiB;
constexpr size_t WS_G = 353 * MiB;
constexpr size_t WS_MIX = 369 * MiB;
constexpr size_t WS_KB = 401 * MiB, WS_VT = 405 * MiB;
constexpr size_t WS_SMP = 409 * MiB;
constexpr size_t SM_ZA = 0, SM_MIX = 256 * KiB, SM_X1 = 512 * KiB, SM_X1B = 1024 * KiB, SM_Q = 1280 * KiB, SM_O = 1792 * KiB, SM_X2 = 2048 * KiB, SM_X2B = 2560 * KiB, SM_HID = 3072 * KiB, SM_X3 = 4096 * KiB;
constexpr size_t WS_NEW = 416 * MiB;
constexpr size_t WS_END = 505 * MiB;
constexpr int CW_TMO = 0, CW_CODE = 1, CW_BAR = 4096, CW_SUB = 8192, CW_QATT = 8256, CW_QMIX = 8320, CW_PAN = 12288;
constexpr int RS_OFF = 65536, RS_STRIDE = 16640;
constexpr int RING_BYTES = 131072, LDSCTL_OFF = RING_BYTES, MISC_OFF = LDSCTL_OFF + 320, LDS_BYTES = 147456;

__device__ __forceinline__ float bf_lo(unsigned u) { return __uint_as_float(u << 16); }
__device__ __forceinline__ float bf_hi(unsigned u) { return __uint_as_float(u & 0xffff0000u); }
__device__ __forceinline__ float bf1(bf16 v) { return __uint_as_float(((unsigned)v) << 16); }
__device__ __forceinline__ unsigned pk2(float lo, float hi) { return pg8::cvt_pk_bf16(lo, hi); }
__device__ __forceinline__ f32x4 bf4(u32x2 v) { return (f32x4){bf_lo(v.x), bf_hi(v.x), bf_lo(v.y), bf_hi(v.y)}; }
__device__ __forceinline__ u32x2 pk4(f32x4 v) { u32x2 r; r.x = pk2(v.x, v.y); r.y = pk2(v.z, v.w); return r; }
__device__ __forceinline__ float fast_exp(float x) { return __builtin_amdgcn_exp2f(x * 1.44269504089f); }
__device__ __forceinline__ float fast_log(float x) { return __builtin_amdgcn_logf(x) * 0.69314718056f; }
__device__ __forceinline__ float fast_sigmoid(float x) { return __builtin_amdgcn_rcpf(1.0f + fast_exp(-x)); }
__device__ __forceinline__ float fast_tanh(float x) { return 1.0f - 2.0f * __builtin_amdgcn_rcpf(fast_exp(2.0f * x) + 1.0f); }
template <int CTRL> __device__ __forceinline__ float dpp_mov(float x) { return __builtin_bit_cast(float, __builtin_amdgcn_mov_dpp(__builtin_bit_cast(int, x), CTRL, 0xf, 0xf, true)); }
__device__ __forceinline__ float red4(float x) { x += dpp_mov<0xB1>(x); x += dpp_mov<0x4E>(x); return x; }
__device__ __forceinline__ float red8(float x) { x = red4(x); x += dpp_mov<0x141>(x); return x; }
__device__ __forceinline__ float red16(float x) { x = red8(x); x += dpp_mov<0x128>(x); return x; }
__device__ __forceinline__ float wave_sum(float v) {
#pragma unroll
    for (int o = 1; o < 64; o <<= 1) v += __shfl_xor(v, o);
    return v;
}
__device__ __forceinline__ float wave_max(float v) {
#pragma unroll
    for (int o = 1; o < 64; o <<= 1) v = fmaxf(v, __shfl_xor(v, o));
    return v;
}

#define XB_TMO      128
#define XB_XCNT(j)  (256  + 64 * (j))
#define XB_XSUB(j)  (1280 + 64 * (j))
#define XB_XGEN(j)  (2304 + 64 * (j))
#define XB_TOP      3328
#define XB_TOPGEN   3392
#define XCD_BAR_WORDS 3456
#define XB_SPIN_CAP (1u << 18)
__device__ __forceinline__ unsigned xb_ld(unsigned* p)              { return __hip_atomic_load(p, __ATOMIC_RELAXED, __HIP_MEMORY_SCOPE_AGENT); }
__device__ __forceinline__ unsigned xb_add(unsigned* p, unsigned v) { return __hip_atomic_fetch_add(p, v, __ATOMIC_RELAXED, __HIP_MEMORY_SCOPE_AGENT); }
__device__ __forceinline__ unsigned xb_xcc_id() { return (unsigned)__builtin_amdgcn_s_getreg((3 << 11) | 20) & 0xFu; }
#define XB_SPIN(cond, bar) do { unsigned _sp = 0; while (cond) { __builtin_amdgcn_s_sleep(1); \
    if ((++_sp & 255u) == 0u) { if (xb_ld(&(bar)[XB_TMO])) break; if (_sp > XB_SPIN_CAP) { atomicAdd(&(bar)[XB_TMO], 1u); break; } } } } while (0)
struct XcdBarrier { unsigned* bar; unsigned x; volatile LAS unsigned* st; };
__device__ __forceinline__ XcdBarrier xcd_barrier_post(unsigned* bar, volatile LAS unsigned* st) {
    XcdBarrier b; b.bar = bar; b.x = xb_xcc_id(); b.st = st;
    if (threadIdx.x == 0) (void)xb_add(&bar[XB_XCNT(b.x)], 1u);
    return b;
}
__device__ __forceinline__ void xcd_barrier_complete(unsigned* bar, unsigned x, unsigned& nloc, unsigned& nx) {
    const unsigned G = gridDim.x * gridDim.y * gridDim.z;
    unsigned sum, cnt, mine, sp = 0u;
    for (;;) {
        sum = 0u; cnt = 0u; mine = 0u;
#pragma unroll
        for (unsigned j = 0; j < 16; ++j) { const unsigned c = xb_ld(&bar[XB_XCNT(j)]); sum += c; cnt += (c > 0u) ? 1u : 0u; mine = (j == x) ? c : mine; }
        if (sum == G) break;
        __builtin_amdgcn_s_sleep(1);
        if ((++sp & 255u) == 0u) { if (xb_ld(&bar[XB_TMO])) break; if (sp > XB_SPIN_CAP) { atomicAdd(&bar[XB_TMO], 1u); break; } }
    }
    nloc = mine > 0u ? mine : 1u; nx = cnt > 0u ? cnt : 1u;
}
__device__ __forceinline__ void xcd_barrier(const XcdBarrier& b) {
    asm volatile("s_waitcnt vmcnt(0)" ::: "memory");
    __syncthreads();
    if (threadIdx.x == 0) {
        unsigned* bar = b.bar;
        __builtin_amdgcn_s_waitcnt(0);
        unsigned nloc = b.st[0], nx = b.st[1];
        if (nloc == 0u) { xcd_barrier_complete(bar, b.x, nloc, nx); b.st[0] = nloc; b.st[1] = nx; }
        const unsigned old = xb_add(&bar[XB_XSUB(b.x)], 1u);
        const unsigned gen = old / nloc;
        if (old + 1u == (gen + 1u) * nloc) {
            __builtin_amdgcn_fence(__ATOMIC_RELEASE, "agent");
            asm volatile("s_waitcnt vmcnt(0)" ::: "memory");
            const unsigned og = xb_add(&bar[XB_TOP], 1u);
            const unsigned tg = og / nx;
            if (og + 1u == (tg + 1u) * nx) xb_add(&bar[XB_TOPGEN], 1u);
            else XB_SPIN(xb_ld(&bar[XB_TOPGEN]) == tg, bar);
            __builtin_amdgcn_fence(__ATOMIC_ACQUIRE, "agent");
            xb_add(&bar[XB_XGEN(b.x)], 1u);
            asm volatile("s_waitcnt vmcnt(0)" ::: "memory");
        } else {
            XB_SPIN(xb_ld(&bar[XB_XGEN(b.x)]) == gen, bar);
            __builtin_amdgcn_fence(__ATOMIC_ACQUIRE, "agent");
            asm volatile("s_waitcnt vmcnt(0)" ::: "memory");
        }
    }
    __syncthreads();
}
__device__ __forceinline__ void sub_barrier(unsigned* cnt, unsigned* tmo, unsigned target) {
    asm volatile("s_waitcnt vmcnt(0)" ::: "memory");
    __syncthreads();
    if (threadIdx.x == 0) {
        __builtin_amdgcn_fence(__ATOMIC_RELEASE, "agent");
        asm volatile("s_waitcnt vmcnt(0)" ::: "memory");
        (void)xb_add(cnt, 1u);
        unsigned sp = 0;
        while (xb_ld(cnt) < target) { __builtin_amdgcn_s_sleep(1); if ((++sp & 255u) == 0u) { if (xb_ld(tmo)) break; if (sp > (1u << 20)) { atomicAdd(tmo, 1u); break; } } }
        __builtin_amdgcn_fence(__ATOMIC_ACQUIRE, "agent");
        asm volatile("s_waitcnt vmcnt(0)" ::: "memory");
    }
    __syncthreads();
}

__device__ __forceinline__ void p0_transpose_item(const float* W, int K, int N, bf16* WT, int row_off, const float* gk, LAS float* scr, int item, int lane) {
    const int nblk = N / 32, kb = item / nblk, nb = item % nblk, k0 = 64 * kb, n0 = 32 * nb;
    f32x4 vv[8];
#pragma unroll
    for (int i = 0; i < 8; ++i) vv[i] = __builtin_nontemporal_load((const f32x4*)(W + (size_t)(k0 + 8 * i + (lane >> 3)) * N + n0 + 4 * (lane & 7)));
    if (gk) {
#pragma unroll
        for (int i = 0; i < 8; ++i) vv[i] = vv[i] * gk[k0 + 8 * i + (lane >> 3)]; }
#pragma unroll
    for (int i = 0; i < 8; ++i) { LAS float* d = scr + (8 * i + (lane >> 3)) * 33 + 4 * (lane & 7); d[0] = vv[i][0]; d[1] = vv[i][1]; d[2] = vv[i][2]; d[3] = vv[i][3]; }
    LDS_WAIT(); asm volatile("" ::: "memory");
    const int c = lane & 7;
#pragma unroll
    for (int j = 0; j < 4; ++j) { const int n = (lane >> 3) + 8 * j; const LAS float* s = scr + (8 * c) * 33 + n;
        u32x4 o; o.x = pk2(s[0 * 33], s[1 * 33]); o.y = pk2(s[2 * 33], s[3 * 33]); o.z = pk2(s[4 * 33], s[5 * 33]); o.w = pk2(s[6 * 33], s[7 * 33]);
        *(u32x4*)(WT + (size_t)(row_off + n0 + n) * K + k0 + 8 * c) = o; }
    LDS_WAIT(); asm volatile("" ::: "memory");
}
__device__ __forceinline__ void rms_row_to_bf16(const float* xrow, const float* g, bf16* orow, int lane) {
    const f32x4* xr = (const f32x4*)xrow + lane; const f32x4* gr = (const f32x4*)g + lane;
    f32x4 v[4]; float s = 0.f;
#pragma unroll
    for (int j = 0; j < 4; ++j) { v[j] = xr[64 * j]; s += (v[j].x * v[j].x + v[j].y * v[j].y) + (v[j].z * v[j].z + v[j].w * v[j].w); }
    const float rstd = 1.f / sqrtf(wave_sum(s) * (1.f / D) + RMS_EPS);
    unsigned long long* o8 = (unsigned long long*)orow + lane;
#pragma unroll
    for (int j = 0; j < 4; ++j) { const f32x4 gg = gr[64 * j]; o8[64 * j] = (unsigned long long)pk2(v[j].x * rstd * gg.x, v[j].y * rstd * gg.y) | ((unsigned long long)pk2(v[j].z * rstd * gg.z, v[j].w * rstd * gg.w) << 32); }
}

using pg8::Unit;
struct SchedMN {
    int nM, nN, nwg, G, c; const char* A; const char* Bt; size_t ta, tb;
    __device__ __forceinline__ void init(int M_, int N_, int G_, int c_, const void* A_, size_t lda, const void* Bt_, size_t ldb) { nM = M_ / 256; nN = N_ / 256; nwg = nM * nN; G = G_; c = c_; A = (const char*)A_; Bt = (const char*)Bt_; ta = 256 * lda * 2; tb = 256 * ldb * 2; }
    __device__ __forceinline__ bool next(int i, Unit& u) const {
        const long L = (long)i * G + c; if (L >= nwg) return false;
        int wgid = (int)L; { const int q = nwg / 8, r = nwg % 8, xcd = wgid % 8, off = wgid / 8; wgid = (xcd < r ? xcd * (q + 1) : r * (q + 1) + (xcd - r) * q) + off; }
        const int nig = 8 * nN, gid = wgid / nig, fm = gid * 8, gsz = (nM - fm) < 8 ? (nM - fm) : 8;
        u.pm = fm + ((wgid % nig) % gsz); u.pn = (wgid % nig) / gsz; return true;
    }
    __device__ __forceinline__ const char* pa(const Unit& u) const { return A + (size_t)u.pm * ta; }
    __device__ __forceinline__ const char* pb(const Unit& u) const { return Bt + (size_t)u.pn * tb; }
};
struct SchedP1 {
    int G, c; const char* A; const char* Bt;
    __device__ __forceinline__ bool next(int i, Unit& u) const {
        const int L = i * G + c; if (L >= 768) return false;
        const int wgid = (L % 8) * 96 + L / 8;
        if (wgid < 704) { const int nig = 88, gid = wgid / nig, w = wgid % nig; u.pm = gid * 8 + (w & 7); u.pn = w >> 3; }
        else { const int w = wgid - 704; u.pm = 65 + (w & 7); u.pn = 11 + (w >> 3); }
        return true;
    }
    __device__ __forceinline__ const char* pa(const Unit& u) const { return A + (size_t)u.pm * (256 * 1024 * 2); }
    __device__ __forceinline__ const char* pb(const Unit& u) const { return Bt + (size_t)u.pn * (256 * 1024 * 2); }
};
struct SchedOne {
    const char* A; const char* B;
    __device__ __forceinline__ bool next(int i, Unit& u) const { if (i) return false; u.pm = 0; u.pn = 0; return true; }
    __device__ __forceinline__ const char* pa(const Unit&) const { return A; }
    __device__ __forceinline__ const char* pb(const Unit&) const { return B; }
};

typedef GAS bf16 gbf16; typedef GAS float gf32;
__device__ __forceinline__ void st16(gbf16* p, f32x4 v0, f32x4 v1) { u32x4 w; w.x = pk2(v0[0], v0[1]); w.y = pk2(v0[2], v0[3]); w.z = pk2(v1[0], v1[1]); w.w = pk2(v1[2], v1[3]); *(GAS u32x4*)p = w; }
struct EpiP1 {
    static constexpr bool PERM = true, AFTER_DRAIN = false;
    bf16* ZA; bf16* PB; float* outK; float* outV; bf16* KB;
    __device__ __forceinline__ void operator()(f32x4 (&acc)[2][2][4][2], const Unit& u, int wr, int wc, int fr, int fq) const {
        if (u.pm < 64) {
            const int row0 = u.pm * 256 + wr * 64 + fr; const bool act = u.pn < 4;
            gbf16* base = act ? (gbf16*)ZA : (gbf16*)PB; const int ldc = act ? 1024 : DSH; const int col0 = (act ? u.pn : u.pn - 4) * 256 + wc * 32 + 8 * fq;
#pragma unroll
            for (int ai = 0; ai < 2; ++ai)
#pragma unroll
                for (int m = 0; m < 4; ++m) { gbf16* rowp = base + (size_t)(row0 + ai * 128 + m * 16) * ldc + col0;
#pragma unroll
                    for (int bj = 0; bj < 2; ++bj) { f32x4 v0 = acc[ai][bj][m][0], v1 = acc[ai][bj][m][1];
                        if (act) { f32x2 a = pg8::gelu_pk((f32x2){v0[0], v0[1]}), b = pg8::gelu_pk((f32x2){v0[2], v0[3]}), c = pg8::gelu_pk((f32x2){v1[0], v1[1]}), d = pg8::gelu_pk((f32x2){v1[2], v1[3]});
                            v0 = (f32x4){a.x, a.y, b.x, b.y}; v1 = (f32x4){c.x, c.y, d.x, d.y}; }
                        st16(rowp + bj * 128, v0, v1); } }
        } else {
            const int row0 = (u.pm - 65) * 256 + wr * 64 + fr; const int ct = u.pn - 11; const bool isK = ct < 4; const int col0 = (ct & 3) * 256 + wc * 32 + 8 * fq;
            gf32* o = isK ? (gf32*)outK : (gf32*)outV;
#pragma unroll
            for (int ai = 0; ai < 2; ++ai)
#pragma unroll
                for (int m = 0; m < 4; ++m) { const size_t off = (size_t)(row0 + ai * 128 + m * 16) * 1024 + col0;
#pragma unroll
                    for (int bj = 0; bj < 2; ++bj) { const f32x4 v0 = acc[ai][bj][m][0], v1 = acc[ai][bj][m][1];
                        *(GAS f32x4*)(o + off + bj * 128) = v0; *(GAS f32x4*)(o + off + bj * 128 + 4) = v1;
                        if (isK) st16((gbf16*)KB + off + bj * 128, v0, v1); } }
        }
    }
};
__device__ __forceinline__ void ld8(const float* p, f32x4& a, f32x4& b) { a = *(const GAS f32x4*)((const gf32*)p); b = *(const GAS f32x4*)((const gf32*)p + 4); }
__device__ __forceinline__ void ld8(const bf16* p, f32x4& a, f32x4& b) { const u32x4 w = *(const GAS u32x4*)((const gbf16*)p); a = (f32x4){bf_lo(w.x), bf_hi(w.x), bf_lo(w.y), bf_hi(w.y)}; b = (f32x4){bf_lo(w.z), bf_hi(w.z), bf_lo(w.w), bf_hi(w.w)}; }
template <class BT> struct EpiRes {
    static constexpr bool PERM = true, AFTER_DRAIN = false;
    const BT* base; bf16* outb; float* rowss;
    __device__ __forceinline__ void operator()(f32x4 (&acc)[2][2][4][2], const Unit& u, int wr, int wc, int fr, int fq) const {
        const int row0 = u.pm * 256 + wr * 64 + fr, col0 = u.pn * 256 + wc * 32 + 8 * fq;
#pragma unroll
        for (int ai = 0; ai < 2; ++ai)
#pragma unroll
            for (int m = 0; m < 4; ++m) { const int r = row0 + ai * 128 + m * 16; const size_t off = (size_t)r * 1024 + col0; float ss = 0.f;
#pragma unroll
                for (int bj = 0; bj < 2; ++bj) { f32x4 b0, b1; ld8(base + off + bj * 128, b0, b1);
                    const f32x4 v0 = acc[ai][bj][m][0] + b0, v1 = acc[ai][bj][m][1] + b1;
                    st16((gbf16*)outb + off + bj * 128, v0, v1);
                    ss += (v0[0] * v0[0] + v0[1] * v0[1]) + (v0[2] * v0[2] + v0[3] * v0[3]) + (v1[0] * v1[0] + v1[1] * v1[1]) + (v1[2] * v1[2] + v1[3] * v1[3]); }
                ss += __shfl_xor(ss, 16); ss += __shfl_xor(ss, 32);
                if (fq == 0) (void)__hip_atomic_fetch_add(rowss + r, ss, __ATOMIC_RELAXED, __HIP_MEMORY_SCOPE_AGENT); }
    }
};
struct EpiFinal {
    static constexpr bool PERM = true, AFTER_DRAIN = false;
    const bf16* base; float* out; const float* gain; float* rowss; unsigned* cnt; unsigned* tmo;
    __device__ __forceinline__ void operator()(f32x4 (&acc)[2][2][4][2], const Unit& u, int wr, int wc, int fr, int fq) const {
        const int row0 = u.pm * 256 + wr * 64 + fr, col0 = u.pn * 256 + wc * 32 + 8 * fq;
#pragma unroll
        for (int ai = 0; ai < 2; ++ai)
#pragma unroll
            for (int m = 0; m < 4; ++m) { const int r = row0 + ai * 128 + m * 16; const size_t off = (size_t)r * 1024 + col0; float ss = 0.f;
#pragma unroll
                for (int bj = 0; bj < 2; ++bj) { f32x4 b0, b1; ld8(base + off + bj * 128, b0, b1);
                    const f32x4 v0 = acc[ai][bj][m][0] + b0, v1 = acc[ai][bj][m][1] + b1; acc[ai][bj][m][0] = v0; acc[ai][bj][m][1] = v1;
                    ss += (v0[0] * v0[0] + v0[1] * v0[1]) + (v0[2] * v0[2] + v0[3] * v0[3]) + (v1[0] * v1[0] + v1[1] * v1[1]) + (v1[2] * v1[2] + v1[3] * v1[3]); }
                ss += __shfl_xor(ss, 16); ss += __shfl_xor(ss, 32);
                if (fq == 0) (void)__hip_atomic_fetch_add(rowss + r, ss, __ATOMIC_RELAXED, __HIP_MEMORY_SCOPE_AGENT); }
        asm volatile("s_waitcnt vmcnt(0)" ::: "memory");
        unsigned* c = cnt + 64 * u.pm;
        if ((threadIdx.x & 63) == 0) (void)xb_add(c, 1u);
        { unsigned sp = 0; while (xb_ld(c) < 32u) { __builtin_amdgcn_s_sleep(1); if ((++sp & 255u) == 0u) { if (xb_ld(tmo)) break; if (sp > (1u << 20)) { atomicAdd(tmo, 1u); break; } } } }
        f32x4 g[2][2];
#pragma unroll
        for (int bj = 0; bj < 2; ++bj) { g[bj][0] = *(const GAS f32x4*)((const gf32*)gain + col0 + bj * 128); g[bj][1] = *(const GAS f32x4*)((const gf32*)gain + col0 + bj * 128 + 4); }
#pragma unroll
        for (int ai = 0; ai < 2; ++ai)
#pragma unroll
            for (int m = 0; m < 4; ++m) { const int r = row0 + ai * 128 + m * 16; const size_t off = (size_t)r * 1024 + col0;
                const float sc = 1.f / sqrtf(__hip_atomic_load(rowss + r, __ATOMIC_RELAXED, __HIP_MEMORY_SCOPE_AGENT) * (1.f / D) + RMS_EPS);
#pragma unroll
                for (int bj = 0; bj < 2; ++bj) { __builtin_nontemporal_store(acc[ai][bj][m][0] * sc * g[bj][0], (GAS f32x4*)((gf32*)out + off + bj * 128)); __builtin_nontemporal_store(acc[ai][bj][m][1] * sc * g[bj][1], (GAS f32x4*)((gf32*)out + off + bj * 128 + 4)); } }
    }
};
template <int MODE> struct EpiScale {
    static constexpr bool PERM = true, AFTER_DRAIN = false;
    bf16* O; int ldc; const float* rowss;
    __device__ __forceinline__ void operator()(f32x4 (&acc)[2][2][4][2], const Unit& u, int wr, int wc, int fr, int fq) const {
        const int row0 = u.pm * 256 + wr * 64 + fr, col0 = u.pn * 256 + wc * 32 + 8 * fq;
#pragma unroll
        for (int ai = 0; ai < 2; ++ai)
#pragma unroll
            for (int m = 0; m < 4; ++m) { const int r = row0 + ai * 128 + m * 16;
                float sc = 1.f / sqrtf(__hip_atomic_load(rowss + r, __ATOMIC_RELAXED, __HIP_MEMORY_SCOPE_AGENT) * (1.f / D) + RMS_EPS); if (MODE == 0) sc *= 0.0625f;
                gbf16* rowp = (gbf16*)O + (size_t)r * ldc + col0;
#pragma unroll
                for (int bj = 0; bj < 2; ++bj) { f32x4 v0 = acc[ai][bj][m][0] * sc, v1 = acc[ai][bj][m][1] * sc;
                    if (MODE == 1) {
#pragma unroll
                        for (int j = 0; j < 4; ++j) { const float a = fmaxf(v0[j], 0.f), b = fmaxf(v1[j], 0.f); v0[j] = a * a; v1[j] = b * b; } }
                    st16(rowp + bj * 128, v0, v1); } }
    }
};
struct EpiQS {
    static constexpr bool PERM = true, AFTER_DRAIN = false;
    bf16* QS; const float* rowss;
    __device__ __forceinline__ void operator()(f32x4 (&acc)[2][2][4][2], const Unit& u, int wr, int wc, int fr, int fq) const {
#pragma unroll
        for (int ai = 0; ai < 2; ++ai)
#pragma unroll
            for (int m = 0; m < 4; ++m) { const int rl = ai * 128 + wr * 64 + m * 16 + fr;
                const float sc = 0.0625f / sqrtf(__hip_atomic_load(rowss + u.pm * 256 + rl, __ATOMIC_RELAXED, __HIP_MEMORY_SCOPE_AGENT) * (1.f / D) + RMS_EPS);
                gbf16* rowp = (gbf16*)QS + (size_t)rl * 256 + wc * 32 + 8 * fq;
#pragma unroll
                for (int bj = 0; bj < 2; ++bj) st16(rowp + bj * 128, acc[ai][bj][m][0] * sc, acc[ai][bj][m][1] * sc); }
    }
};
struct EpiSoftmax {
    static constexpr bool PERM = true, AFTER_DRAIN = true;
    bf16* P;
    __device__ __forceinline__ void fused(f32x4 (&acc)[2][2][4][2], const Unit&, int wr, int wc, int fr, int fq, PG8_LAS unsigned char* lds, int, int) const {
        PG8_LAS float* T1 = (PG8_LAS float*)lds; PG8_LAS float* T2 = (PG8_LAS float*)(lds + 4096);
#pragma unroll
        for (int ai = 0; ai < 2; ++ai)
#pragma unroll
            for (int m = 0; m < 4; ++m) { float mx = -3.0e38f;
#pragma unroll
                for (int bj = 0; bj < 2; ++bj)
#pragma unroll
                    for (int n = 0; n < 2; ++n) { const f32x4 x = acc[ai][bj][m][n]; mx = fmaxf(mx, fmaxf(fmaxf(x[0], x[1]), fmaxf(x[2], x[3]))); }
                mx = fmaxf(mx, __shfl_xor(mx, 16)); mx = fmaxf(mx, __shfl_xor(mx, 32));
                if (fq == 0) T1[(ai * 128 + wr * 64 + m * 16 + fr) * 4 + wc] = mx; }
        asm volatile("s_waitcnt lgkmcnt(0)" ::: "memory"); __builtin_amdgcn_s_barrier(); asm volatile("" ::: "memory");
#pragma unroll
        for (int ai = 0; ai < 2; ++ai)
#pragma unroll
            for (int m = 0; m < 4; ++m) { const int row = ai * 128 + wr * 64 + m * 16 + fr; const f32x4 t = *(const PG8_LAS f32x4*)(T1 + row * 4);
                const float mxr = fmaxf(fmaxf(t[0], t[1]), fmaxf(t[2], t[3])) * 1.44269504089f; float sum = 0.f;
#pragma unroll
                for (int bj = 0; bj < 2; ++bj)
#pragma unroll
                    for (int n = 0; n < 2; ++n) { f32x4 x = acc[ai][bj][m][n];
#pragma unroll
                        for (int j = 0; j < 4; ++j) { x[j] = __builtin_amdgcn_exp2f(x[j] * 1.44269504089f - mxr); sum += x[j]; }
                        acc[ai][bj][m][n] = x; }
                sum += __shfl_xor(sum, 16); sum += __shfl_xor(sum, 32);
                if (fq == 0) T2[row * 4 + wc] = sum; }
        asm volatile("s_waitcnt lgkmcnt(0)" ::: "memory"); __builtin_amdgcn_s_barrier(); asm volatile("" ::: "memory");
#pragma unroll
        for (int ai = 0; ai < 2; ++ai)
#pragma unroll
            for (int m = 0; m < 4; ++m) { const int row = ai * 128 + wr * 64 + m * 16 + fr; const f32x4 t = *(const PG8_LAS f32x4*)(T2 + row * 4);
                const float inv = 1.f / ((t[0] + t[1]) + (t[2] + t[3]));
                gbf16* rowp = (gbf16*)P + (size_t)row * 256 + wc * 32 + 8 * fq;
#pragma unroll
                for (int bj = 0; bj < 2; ++bj) st16(rowp + bj * 128, acc[ai][bj][m][0] * inv, acc[ai][bj][m][1] * inv); }
        asm volatile("s_waitcnt vmcnt(0) lgkmcnt(0)" ::: "memory"); __builtin_amdgcn_s_barrier(); asm volatile("" ::: "memory");
    }
};
struct EpiAttnO {
    static constexpr bool PERM = true, AFTER_DRAIN = false;
    bf16* O;
    __device__ __forceinline__ void operator()(f32x4 (&acc)[2][2][4][2], const Unit&, int wr, int wc, int fr, int fq) const {
#pragma unroll
        for (int ai = 0; ai < 2; ++ai)
#pragma unroll
            for (int m = 0; m < 4; ++m) { gbf16* rowp = (gbf16*)O + (size_t)(ai * 128 + wr * 64 + m * 16 + fr) * 1024 + wc * 32 + 8 * fq;
#pragma unroll
                for (int bj = 0; bj < 2; ++bj) st16(rowp + bj * 128, acc[ai][bj][m][0], acc[ai][bj][m][1]); }
    }
};

__device__ __forceinline__ void mixer_a_tile(LAS unsigned char* lds, int tile, const bf16* ZA, const bf16* WSB, const float* gm_ln_g, const float* gm_ln_b, const float* gm_bs, bf16* MIX, float* out_cv, int tid, int wave, int lane) {
    const int h = tile & 3, bc = tile >> 2, m0 = bc * 128, fr = lane & 15, fq = lane >> 4; const bool lastc = (bc & 15) == 15;
    LAS bf16* VT = (LAS bf16*)lds;
    {   const int r = 16 * wave + (lane >> 2), cq = (lane & 3) * 32; const bf16* src = ZA + (size_t)(m0 + r) * 1024 + 512 + h * 128 + cq;
        float x[32]; float s = 0.f;
#pragma unroll
        for (int j = 0; j < 4; ++j) { const u32x4 pv = __builtin_nontemporal_load((const u32x4*)(src + 8 * j));
            x[8 * j + 0] = bf_lo(pv.x); x[8 * j + 1] = bf_hi(pv.x); x[8 * j + 2] = bf_lo(pv.y); x[8 * j + 3] = bf_hi(pv.y); x[8 * j + 4] = bf_lo(pv.z); x[8 * j + 5] = bf_hi(pv.z); x[8 * j + 6] = bf_lo(pv.w); x[8 * j + 7] = bf_hi(pv.w); }
#pragma unroll
        for (int j = 0; j < 32; ++j) s += x[j];
        const float mean = red4(s) * (1.f / 128.f); float q = 0.f;
#pragma unroll
        for (int j = 0; j < 32; ++j) { x[j] -= mean; q += x[j] * x[j]; }
        const float rstd = 1.f / sqrtf(red4(q) * (1.f / 128.f) + LN_EPS);
#pragma unroll
        for (int j = 0; j < 8; ++j) { const f32x4 g = *(const f32x4*)(gm_ln_g + h * 128 + cq + 4 * j), bb = *(const f32x4*)(gm_ln_b + h * 128 + cq + 4 * j);
#pragma unroll
            for (int e = 0; e < 4; ++e) x[4 * j + e] = x[4 * j + e] * rstd * g[e] + bb[e]; }
        if (lastc) { float* o = out_cv + ((size_t)((bc >> 4) * 128 + r) * 4 + h) * 128 + cq;
#pragma unroll
            for (int j = 0; j < 8; ++j) *(f32x4*)(o + 4 * j) = (f32x4){x[4 * j], x[4 * j + 1], x[4 * j + 2], x[4 * j + 3]}; }
#pragma unroll
        for (int j = 0; j < 32; j += 2) { const unsigned w = pk2(x[j], x[j + 1]); VT[(cq + j) * 136 + r] = (bf16)(w & 0xffffu); VT[(cq + j + 1) * 136 + r] = (bf16)(w >> 16); }
    }
    const int t_ = 16 * wave + fr; const size_t rowo = (size_t)(m0 + t_) * 1024 + h * 128; const float bsv = gm_bs[h * 128 + t_];
    u32x2 uq[8];
#pragma unroll
    for (int n = 0; n < 8; ++n) uq[n] = *(const u32x2*)(ZA + rowo + 16 * n + 4 * fq);
    bf16x8 wsf[4];
#pragma unroll
    for (int ks = 0; ks < 4; ++ks) wsf[ks] = *(const bf16x8*)(WSB + (size_t)(h * 128 + 16 * wave + fr) * 128 + 32 * ks + 8 * fq);
    __syncthreads();
    f32x4 acc[8];
#pragma unroll
    for (int n = 0; n < 8; ++n) acc[n] = (f32x4){0.f, 0.f, 0.f, 0.f};
    const int nks = (wave >> 1) + 1;
#pragma unroll
    for (int ks = 0; ks < 4; ++ks) if (ks < nks) {
#pragma unroll
        for (int n = 0; n < 8; ++n) { const bf16x8 vf = *(const LAS bf16x8*)(VT + (16 * n + fr) * 136 + 32 * ks + 8 * fq); acc[n] = __builtin_amdgcn_mfma_f32_16x16x32_bf16(vf, wsf[ks], acc[n], 0, 0, 0); }
    }
#pragma unroll
    for (int n = 0; n < 8; ++n) *(u32x2*)(MIX + rowo + 16 * n + 4 * fq) = pk4(bf4(uq[n]) * (acc[n] + bsv));
    __syncthreads();
}


typedef short bf16x4 __attribute__((ext_vector_type(4)));
#define MFMA32(a, b, c) __builtin_amdgcn_mfma_f32_16x16x32_bf16(a, b, c, 0, 0, 0)
#define MFMA16(a, b, c) __builtin_amdgcn_mfma_f32_16x16x16bf16_1k(a, b, c, 0, 0, 0)
constexpr int CP = 72;
constexpr int L_LW = 0, L_LA = 17408, L_LG = 34816;
constexpr int L_LAB = 0, L_LAK = 9216, L_MRB = 18432, L_MRK = 27648, L_TDD = 36864;
constexpr int L_AT = 52224, L_BT = 61440, L_KT = 70656, L_RT = 79872;
constexpr int L_WT = 52224, L_APT = 61440;
constexpr int L_ATT = 89088, L_VTT = 98304, L_BHT = 107520, L_KHT = 116736;
constexpr int L_EXCH = 125952, L_PC = 128000;
constexpr size_t TASK_BYTES = 32768;

__device__ __forceinline__ float wave_sum_dpp(float x) {
    x = red16(x); const int xi = __builtin_bit_cast(int, x);
    const float a = __builtin_bit_cast(float, __builtin_amdgcn_readlane(xi, 0)), b = __builtin_bit_cast(float, __builtin_amdgcn_readlane(xi, 16)), c = __builtin_bit_cast(float, __builtin_amdgcn_readlane(xi, 32)), d = __builtin_bit_cast(float, __builtin_amdgcn_readlane(xi, 48));
    return (a + b) + (c + d);
}
__device__ __forceinline__ bf16x4 pack4(f32x4 v) { const u32x2 r = pk4(v); return __builtin_bit_cast(bf16x4, r); }
__device__ __forceinline__ bf16x8 ldsfrag(const LAS unsigned char* lds, int off, int row, int col) { return *(const LAS bf16x8*)(lds + off + (row * CP + col) * 2); }

#ifdef PROBE_CSPAN_A
#define CST(k) do { if (h == CST_H && blockIdx.x == 64 && threadIdx.x == 0) *(volatile LAS unsigned long long*)(lds + 140000 + 8 * (k)) = __builtin_amdgcn_s_memrealtime(); } while (0)
#else
#define CST(k) do { } while (0)
#endif
__device__ __forceinline__ void rwkv_chunk_prep(LAS unsigned char* lds, int bc, const bf16* PB, const bf16* ZROW, const float* mu, const bf16* W2T, const bf16* A2T, const bf16* G2T,
                                                const float* w0, const float* a0, const float* k_k, const float* k_a, const float* r_k, bf16* LAIN, unsigned char* TASKS, bf16* G, bf16* VS, float* BON,
                                                int tid, int wave, int lane) {
    const int b = bc >> 5, c = bc & 31, m0 = b * SEQ + c * 64, fr = lane & 15, fq = lane >> 4;
    {   const int r = tid >> 3, cg = (tid & 7) * 32, m = m0 + r;
        const bf16* prow = PB + (size_t)m * DSH + 1536 + cg; const bf16* qrow = ((m & (SEQ - 1)) == 0) ? ZROW : (PB + (size_t)(m - 1) * DSH + 1536 + cg);
        const int mode = cg < 64 ? 0 : (cg < 128 ? 1 : 2);
#pragma unroll
        for (int j = 0; j < 4; ++j) {
            const u32x4 pv = *(const u32x4*)(prow + 8 * j), qv = *(const u32x4*)(qrow + 8 * j);
            const f32x4 m0v = *(const f32x4*)(mu + 1536 + cg + 8 * j), m1v = *(const f32x4*)(mu + 1536 + cg + 8 * j + 4);
            float x[8];
            { const float p0 = bf_lo(pv.x), p1 = bf_hi(pv.x), p2 = bf_lo(pv.y), p3 = bf_hi(pv.y), p4 = bf_lo(pv.z), p5 = bf_hi(pv.z), p6 = bf_lo(pv.w), p7 = bf_hi(pv.w);
              const float q0 = bf_lo(qv.x), q1 = bf_hi(qv.x), q2 = bf_lo(qv.y), q3 = bf_hi(qv.y), q4 = bf_lo(qv.z), q5 = bf_hi(qv.z), q6 = bf_lo(qv.w), q7 = bf_hi(qv.w);
              x[0] = p0 + (q0 - p0) * m0v[0]; x[1] = p1 + (q1 - p1) * m0v[1]; x[2] = p2 + (q2 - p2) * m0v[2]; x[3] = p3 + (q3 - p3) * m0v[3];
              x[4] = p4 + (q4 - p4) * m1v[0]; x[5] = p5 + (q5 - p5) * m1v[1]; x[6] = p6 + (q6 - p6) * m1v[2]; x[7] = p7 + (q7 - p7) * m1v[3]; }
#pragma unroll
            for (int e = 0; e < 8; ++e) x[e] = mode == 0 ? fast_tanh(x[e]) : (mode == 1 ? x[e] : fast_sigmoid(x[e]));
            u32x4 o; o.x = pk2(x[0], x[1]); o.y = pk2(x[2], x[3]); o.z = pk2(x[4], x[5]); o.w = pk2(x[6], x[7]);
            *(u32x4*)(LAIN + r * 256 + cg + 8 * j) = o;
        }
    }
    VM_WAIT(); __syncthreads();
    bf16x8 lainW[2], lainA[2], lainG[4];
    {   const bf16* arow = LAIN + (16 * (wave >> 1) + fr) * 256 + 8 * fq;
#pragma unroll
        for (int ks = 0; ks < 2; ++ks) { lainW[ks] = *(const bf16x8*)(arow + 32 * ks); lainA[ks] = *(const bf16x8*)(arow + 64 + 32 * ks); }
#pragma unroll
        for (int ks = 0; ks < 4; ++ks) lainG[ks] = *(const bf16x8*)(arow + 128 + 32 * ks); }
#pragma unroll 1
    for (int h = 0; h < 8; ++h) {
        CST(0);
        {   const int mt = wave >> 1;
            bf16x8 wW[2][2], wA[2][2], wG[2][4];
#pragma unroll
            for (int q = 0; q < 2; ++q) { const int wrow = 64 * h + 16 * ((wave & 1) * 2 + q) + fr;
#pragma unroll
                for (int ks = 0; ks < 2; ++ks) { wW[q][ks] = *(const bf16x8*)(W2T + (size_t)wrow * 64 + 32 * ks + 8 * fq); wA[q][ks] = *(const bf16x8*)(A2T + (size_t)wrow * 64 + 32 * ks + 8 * fq); }
#pragma unroll
                for (int ks = 0; ks < 4; ++ks) wG[q][ks] = *(const bf16x8*)(G2T + (size_t)wrow * 128 + 32 * ks + 8 * fq); }
#pragma unroll
            for (int q = 0; q < 2; ++q) { const int nt = (wave & 1) * 2 + q;
                f32x4 aw = (f32x4){0.f, 0.f, 0.f, 0.f}, aa = aw, ag = aw;
#pragma unroll
                for (int ks = 0; ks < 2; ++ks) { aw = MFMA32(wW[q][ks], lainW[ks], aw); aa = MFMA32(wA[q][ks], lainA[ks], aa); }
#pragma unroll
                for (int ks = 0; ks < 4; ++ks) ag = MFMA32(wG[q][ks], lainG[ks], ag);
                const int o = ((16 * mt + fr) * 68 + 16 * nt + 4 * fq) * 4;
                *(LAS f32x4*)(lds + L_LW + o) = aw; *(LAS f32x4*)(lds + L_LA + o) = aa; *(LAS f32x4*)(lds + L_LG + o) = ag; }
        }
        __syncthreads();
        CST(1);
        {   const int ch = 64 * h + lane;
            const float mur = mu[ch], muk = mu[512 + ch], muv = mu[1024 + ch], w0c = w0[ch], a0c = a0[ch], kkc = k_k[ch], kac = k_a[ch], rkc = r_k[ch];
            float rs[8], kp[8], vs[8], av[8], bv[8], wd[8], cwl[8]; float run = 0.f;
#pragma unroll
            for (int i = 0; i < 8; ++i) { const int p = 8 * wave + i, m = m0 + p; const bf16* prow = PB + (size_t)m * DSH + ch; const bool first = (m & (SEQ - 1)) == 0; const bf16* qrow = first ? ZROW : (prow - DSH);
                const float pr = bf1(prow[0]), pk = bf1(prow[512]), pvv = bf1(prow[1024]); const float qr = bf1(qrow[0]), qk = bf1(first ? qrow[0] : qrow[512]), qv = bf1(first ? qrow[0] : qrow[1024]);
                rs[i] = pr + (qr - pr) * mur; const float ks = pk + (qk - pk) * muk; vs[i] = pvv + (qv - pvv) * muv;
                const float lw = *(const LAS float*)(lds + L_LW + (p * 68 + lane) * 4), la = *(const LAS float*)(lds + L_LA + (p * 68 + lane) * 4), lg = *(const LAS float*)(lds + L_LG + (p * 68 + lane) * 4);
                const float z = -(w0c + lw), sp = fmaxf(z, 0.f) + fast_log(1.f + fast_exp(-fabsf(z)));
                wd[i] = -fast_exp(-sp - 0.5f);
                const float as = fast_sigmoid(a0c + la);
                const float kkr = ks * kkc; const float n2 = wave_sum_dpp(kkr * kkr); const float kk = kkr * __builtin_amdgcn_rsqf(fmaxf(n2, 1e-24f));
                kp[i] = ks * (1.f + (as - 1.f) * kac); av[i] = -kk; bv[i] = kk * as;
                const float bon = wave_sum_dpp(rs[i] * kp[i] * rkc);
                run += wd[i]; cwl[i] = run;
                G[(size_t)m * DB + ch] = (bf16)(pk2(lg, 0.f) & 0xffffu); VS[(size_t)m * DB + ch] = (bf16)(pk2(vs[i], 0.f) & 0xffffu);
                if (lane == 0) BON[(size_t)m * 8 + h] = bon; }
            *(LAS float*)(lds + L_EXCH + (wave * 64 + lane) * 4) = run;
            __syncthreads();
            CST(2);
            float base = 0.f, tot = 0.f;
#pragma unroll
            for (int w2 = 0; w2 < 8; ++w2) { const float t = *(const LAS float*)(lds + L_EXCH + (w2 * 64 + lane) * 4); tot += t; if (w2 < wave) base += t; }
            float oA[8], oV[8], oBh[8], oKh[8];
#pragma unroll
            for (int i = 0; i < 8; ++i) { const int p = 8 * wave + i; const float cw = base + cwl[i];
                const float e1 = fast_exp(cw - wd[i]), e2 = fast_exp(cw), e3 = __builtin_amdgcn_rcpf(e2), e4 = fast_exp(tot - cw);
                const float At = av[i] * e1, Rt = rs[i] * e2, Bt = bv[i] * e3, Kt = kp[i] * e3;
                oA[i] = At; oV[i] = vs[i]; oBh[i] = bv[i] * e4; oKh[i] = kp[i] * e4;
                *(LAS bf16*)(lds + L_AT + (p * CP + lane) * 2) = (bf16)(pk2(At, 0.f) & 0xffffu); *(LAS bf16*)(lds + L_BT + (p * CP + lane) * 2) = (bf16)(pk2(Bt, 0.f) & 0xffffu);
                *(LAS bf16*)(lds + L_KT + (p * CP + lane) * 2) = (bf16)(pk2(Kt, 0.f) & 0xffffu); *(LAS bf16*)(lds + L_RT + (p * CP + lane) * 2) = (bf16)(pk2(Rt, 0.f) & 0xffffu); }
            { u32x4 o; const int off = (lane * CP + 8 * wave) * 2;
              o.x = pk2(oA[0], oA[1]); o.y = pk2(oA[2], oA[3]); o.z = pk2(oA[4], oA[5]); o.w = pk2(oA[6], oA[7]); *(LAS u32x4*)(lds + L_ATT + off) = o;
              o.x = pk2(oV[0], oV[1]); o.y = pk2(oV[2], oV[3]); o.z = pk2(oV[4], oV[5]); o.w = pk2(oV[6], oV[7]); *(LAS u32x4*)(lds + L_VTT + off) = o;
              o.x = pk2(oBh[0], oBh[1]); o.y = pk2(oBh[2], oBh[3]); o.z = pk2(oBh[4], oBh[5]); o.w = pk2(oBh[6], oBh[7]); *(LAS u32x4*)(lds + L_BHT + off) = o;
              o.x = pk2(oKh[0], oKh[1]); o.y = pk2(oKh[2], oKh[3]); o.z = pk2(oKh[4], oKh[5]); o.w = pk2(oKh[6], oKh[7]); *(LAS u32x4*)(lds + L_KHT + off) = o; }
            if (wave == 0) *(LAS float*)(lds + L_PC + lane * 4) = fast_exp(tot);
        }
        __syncthreads();
        CST(3);
        {   const int ty = wave >> 1;
#pragma unroll
            for (int prod = 0; prod < 4; ++prod) { const int xo = (prod & 1) ? L_KT : L_BT, yo = prod < 2 ? L_AT : L_RT, oo = prod == 0 ? L_LAB : (prod == 1 ? L_LAK : (prod == 2 ? L_MRB : L_MRK)); const bool incl = prod >= 2;
#pragma unroll
                for (int q = 0; q < 2; ++q) { const int tx = (wave & 1) * 2 + q; f32x4 acc = (f32x4){0.f, 0.f, 0.f, 0.f};
                    if (tx <= ty) {
#pragma unroll
                        for (int ks = 0; ks < 2; ++ks) acc = MFMA32(ldsfrag(lds, xo, 16 * tx + fr, 32 * ks + 8 * fq), ldsfrag(lds, yo, 16 * ty + fr, 32 * ks + 8 * fq), acc); }
                    const int i = 16 * ty + fr, j0 = 16 * tx + 4 * fq;
#pragma unroll
                    for (int e = 0; e < 4; ++e) { const int j = j0 + e; if (!(incl ? (j <= i) : (j < i))) acc[e] = 0.f; }
                    *(LAS u32x2*)(lds + oo + (i * CP + j0) * 2) = pk4(acc); } }
        }
        __syncthreads();
        CST(4);
        if (wave < 4) { const int d = wave; float t[16];
#pragma unroll
            for (int i = 0; i < 16; ++i) { const u32x4 r0 = *(const LAS u32x4*)(lds + L_LAB + ((16 * d + i) * CP + 16 * d) * 2), r1 = *(const LAS u32x4*)(lds + L_LAB + ((16 * d + i) * CP + 16 * d + 8) * 2);
                const float l[16] = {bf_lo(r0.x), bf_hi(r0.x), bf_lo(r0.y), bf_hi(r0.y), bf_lo(r0.z), bf_hi(r0.z), bf_lo(r0.w), bf_hi(r0.w), bf_lo(r1.x), bf_hi(r1.x), bf_lo(r1.y), bf_hi(r1.y), bf_lo(r1.z), bf_hi(r1.z), bf_lo(r1.w), bf_hi(r1.w)};
                float s = (i == lane) ? 1.f : 0.f;
#pragma unroll
                for (int mm = 0; mm < i; ++mm) s += l[mm] * t[mm];
                t[i] = s; }
            if (lane < 16) {
#pragma unroll
                for (int i = 0; i < 16; ++i) *(LAS bf16*)(lds + L_TDD + ((d * 16 + i) * 24 + lane) * 2) = (bf16)(pk2(t[i], 0.f) & 0xffffu); }
        }
        __syncthreads();
        CST(5);
        {   const int s = wave & 3; const bool isW = wave < 4; f32x4 acc[4];
            if (isW) {
#pragma unroll
                for (int d = 0; d < 4; ++d) { acc[d] = (f32x4){0.f, 0.f, 0.f, 0.f};
#pragma unroll
                    for (int ks = 0; ks < 2; ++ks) if (32 * ks <= 16 * d + 15) acc[d] = MFMA32(ldsfrag(lds, L_LAK, 16 * d + fr, 32 * ks + 8 * fq), ldsfrag(lds, L_VTT, 16 * s + fr, 32 * ks + 8 * fq), acc[d]); }
            } else {
#pragma unroll
                for (int d = 0; d < 4; ++d) acc[d] = bf4(*(const LAS u32x2*)(lds + L_ATT + ((16 * s + fr) * CP + 16 * d + 4 * fq) * 2));
            }
            bf16x4 xf[4]; const int oo = isW ? L_WT : L_APT;
#pragma unroll
            for (int d = 0; d < 4; ++d) {
#pragma unroll
                for (int mm = 0; mm < d; ++mm) acc[d] = MFMA16(*(const LAS bf16x4*)(lds + L_LAB + ((16 * d + fr) * CP + 16 * mm + 4 * fq) * 2), xf[mm], acc[d]);
                const f32x4 x = MFMA16(*(const LAS bf16x4*)(lds + L_TDD + ((d * 16 + fr) * 24 + 4 * fq) * 2), pack4(acc[d]), ((f32x4){0.f, 0.f, 0.f, 0.f}));
                xf[d] = pack4(x);
                *(LAS bf16x4*)(lds + oo + ((16 * s + fr) * CP + 16 * d + 4 * fq) * 2) = xf[d]; }
        }
        __syncthreads();
        CST(6);
        {   unsigned char* task = TASKS + (size_t)((b * 8 + h) * 32 + c) * TASK_BYTES; const int ty = wave >> 1;
#pragma unroll
            for (int q = 0; q < 2; ++q) { const int tx = (wave & 1) * 2 + q; const int yr = 16 * ty + fr, xc = 16 * tx + 4 * fq;
                f32x4 aM = (f32x4){0.f, 0.f, 0.f, 0.f}, aN = aM, aR = aM, aY = aM;
#pragma unroll
                for (int ks = 0; ks < 2; ++ks) { const int kc = 32 * ks + 8 * fq;
                    const bf16x8 fAP = ldsfrag(lds, L_APT, 16 * tx + fr, kc), fBHx = ldsfrag(lds, L_BHT, 16 * tx + fr, kc), fKHx = ldsfrag(lds, L_KHT, 16 * tx + fr, kc), fMRBx = ldsfrag(lds, L_MRB, 16 * tx + fr, kc), fMRKx = ldsfrag(lds, L_MRK, 16 * tx + fr, kc);
                    const bf16x8 fBHy = ldsfrag(lds, L_BHT, 16 * ty + fr, kc), fWTy = ldsfrag(lds, L_WT, 16 * ty + fr, kc), fVTy = ldsfrag(lds, L_VTT, 16 * ty + fr, kc), fMRBy = ldsfrag(lds, L_MRB, 16 * ty + fr, kc);
                    aM = MFMA32(fAP, fBHy, aM);
                    aN = MFMA32(fBHx, fWTy, aN); aN = MFMA32(fKHx, fVTy, aN);
                    aR = MFMA32(fAP, fMRBy, aR);
                    aY = MFMA32(fMRBx, fWTy, aY); aY = MFMA32(fMRKx, fVTy, aY); }
                const float pc = *(const LAS float*)(lds + L_PC + yr * 4);
#pragma unroll
                for (int e = 0; e < 4; ++e) if (xc + e == yr) aM[e] += pc;
                aR += bf4(*(const LAS u32x2*)(lds + L_RT + (yr * CP + xc) * 2));
                const size_t o = (size_t)(((ty * 64 + lane) * 4 + tx) * 8);
                *(u32x2*)(task + o) = pk4(aM); *(u32x2*)(task + 8192 + o) = pk4(aN); *(u32x2*)(task + 16384 + o) = pk4(aR); *(u32x2*)(task + 24576 + o) = pk4(aY); }
        }
        __syncthreads();
        CST(7);
    }
}

__device__ __forceinline__ void scanB_block(LAS unsigned char* lds, int bh, const unsigned char* TASKS, const bf16* G, const bf16* VS, const float* BON, const float* ln_g, const float* ln_b, bf16* MIX, float* out_wkv, int tid, int wave, int lane) {
    const int b = bh >> 3, h = bh & 7, fr = lane & 15, fq = lane >> 4;
    LAS float* YB = (LAS float*)lds;
    if (wave < 4) {
        const int s = wave;
        const GAS unsigned char* tk = (const GAS unsigned char*)TASKS + (size_t)bh * 32 * TASK_BYTES + (size_t)lane * 32;
        const GAS unsigned char* gG = (const GAS unsigned char*)G; const GAS unsigned char* gV = (const GAS unsigned char*)VS; const GAS unsigned char* gB = (const GAS unsigned char*)BON;
        struct TaskRegs { u32x4 m0[4], m1[4], r0[4], r1[4], n0, n1, y0, y1, g0, g1, v0, v1; unsigned bo; };
        TaskRegs TA, TB; bf16x4 xf[4]; f32x4 accX[4];
#pragma unroll
        for (int t = 0; t < 4; ++t) { xf[t] = (bf16x4){0, 0, 0, 0}; accX[t] = (f32x4){0.f, 0.f, 0.f, 0.f}; }
#define GLD16(dst, ptr, OFF) asm volatile("global_load_dwordx4 %0, %1, off offset:" #OFF : "=v"(dst) : "v"(ptr) : "memory")
#define LOADTASK(T, cc) do { const GAS unsigned char* tp_ = tk + (size_t)(cc) * TASK_BYTES; _Pragma("unroll") for (int t = 0; t < 4; ++t) { \
            GLD16(T.m0[t], tp_ + t * 2048, 0); GLD16(T.m1[t], tp_ + t * 2048, 16); GLD16(T.r0[t], tp_ + 16384 + t * 2048, 0); GLD16(T.r1[t], tp_ + 16384 + t * 2048, 16); } \
            GLD16(T.n0, tp_ + 8192 + s * 2048, 0); GLD16(T.n1, tp_ + 8192 + s * 2048, 16); GLD16(T.y0, tp_ + 24576 + s * 2048, 0); GLD16(T.y1, tp_ + 24576 + s * 2048, 16); \
            { const size_t mo_ = ((size_t)(b * SEQ + (cc) * 64 + 16 * s + (lane >> 3)) * DB + 64 * h + 8 * (lane & 7)) * 2; \
              GLD16(T.g0, gG + mo_, 0); GLD16(T.g1, gG + mo_ + 8 * DB * 2, 0); GLD16(T.v0, gV + mo_, 0); GLD16(T.v1, gV + mo_ + 8 * DB * 2, 0); \
              asm volatile("global_load_dword %0, %1, off" : "=v"(T.bo) : "v"(gB + ((size_t)(b * SEQ + (cc) * 64 + 16 * s + (lane & 15)) * 8 + h) * 4) : "memory"); } } while (0)
#define WAITTASK(T, N) asm volatile("s_waitcnt vmcnt(" #N ")" : "+v"(T.m0[0]), "+v"(T.m0[1]), "+v"(T.m0[2]), "+v"(T.m0[3]), "+v"(T.m1[0]), "+v"(T.m1[1]), "+v"(T.m1[2]), "+v"(T.m1[3]), \
            "+v"(T.r0[0]), "+v"(T.r0[1]), "+v"(T.r0[2]), "+v"(T.r0[3]), "+v"(T.r1[0]), "+v"(T.r1[1]), "+v"(T.r1[2]), "+v"(T.r1[3]), "+v"(T.n0), "+v"(T.n1), "+v"(T.y0), "+v"(T.y1), \
            "+v"(T.g0), "+v"(T.g1), "+v"(T.v0), "+v"(T.v1), "+v"(T.bo) :: "memory")
#define LO2(v) __builtin_bit_cast(bf16x4, (u32x2){(v).x, (v).y})
#define HI2(v) __builtin_bit_cast(bf16x4, (u32x2){(v).z, (v).w})
#define STEP(T, cc) do { f32x4 accY[4]; \
            accY[0] = bf4((u32x2){T.y0.x, T.y0.y}); accY[1] = bf4((u32x2){T.y0.z, T.y0.w}); accY[2] = bf4((u32x2){T.y1.x, T.y1.y}); accY[3] = bf4((u32x2){T.y1.z, T.y1.w}); \
            accX[0] = bf4((u32x2){T.n0.x, T.n0.y}); accX[1] = bf4((u32x2){T.n0.z, T.n0.w}); accX[2] = bf4((u32x2){T.n1.x, T.n1.y}); accX[3] = bf4((u32x2){T.n1.z, T.n1.w}); \
            _Pragma("unroll") for (int t = 0; t < 4; ++t) { \
                accY[t] = MFMA16(LO2(T.r0[t]), xf[0], accY[t]); accX[t] = MFMA16(LO2(T.m0[t]), xf[0], accX[t]); accY[t] = MFMA16(HI2(T.r0[t]), xf[1], accY[t]); accX[t] = MFMA16(HI2(T.m0[t]), xf[1], accX[t]); \
                accY[t] = MFMA16(LO2(T.r1[t]), xf[2], accY[t]); accX[t] = MFMA16(LO2(T.m1[t]), xf[2], accX[t]); accY[t] = MFMA16(HI2(T.r1[t]), xf[3], accY[t]); accX[t] = MFMA16(HI2(T.m1[t]), xf[3], accX[t]); } \
            _Pragma("unroll") for (int t = 0; t < 4; ++t) xf[t] = pack4(accX[t]); \
            LAS float* yb = YB + ((cc) & 1) * 4096; \
            _Pragma("unroll") for (int t = 0; t < 4; ++t) _Pragma("unroll") for (int e = 0; e < 4; ++e) yb[(16 * t + 4 * fq + e) * 64 + 16 * s + fr] = accY[t][e]; \
            { LAS unsigned char* gl_ = lds + 32768 + ((cc) & 1) * 8192 + ((16 * s + (lane >> 3)) * 64 + 8 * (lane & 7)) * 2; \
              *(LAS u32x4*)gl_ = T.g0; *(LAS u32x4*)(gl_ + 1024) = T.g1; *(LAS u32x4*)(gl_ + 16384) = T.v0; *(LAS u32x4*)(gl_ + 16384 + 1024) = T.v1; \
              if (lane < 16) *(LAS unsigned*)(lds + 65536 + ((cc) & 1) * 256 + (16 * s + lane) * 4) = T.bo; } \
            asm volatile("s_waitcnt lgkmcnt(0)" ::: "memory"); __builtin_amdgcn_s_barrier(); asm volatile("" ::: "memory"); } while (0)
        LOADTASK(TA, 0); LOADTASK(TB, 1);
#pragma unroll 1
        for (int c = 0; c < 32; c += 2) {
            WAITTASK(TA, 25); STEP(TA, c); LOADTASK(TA, (c + 2 < 32 ? c + 2 : 31));
            WAITTASK(TB, 25); STEP(TB, c + 1); LOADTASK(TB, (c + 3 < 32 ? c + 3 : 31));
        }
        asm volatile("s_waitcnt vmcnt(0)" ::: "memory");
#undef GLD16
#undef LOADTASK
#undef WAITTASK
#undef LO2
#undef HI2
#undef STEP
#pragma unroll
        for (int t = 0; t < 4; ++t) *(f32x4*)(out_wkv + ((size_t)bh * 64 + 16 * s + fr) * 64 + 16 * t + 4 * fq) = accX[t];
    } else {
        const int tp = tid - 256, l16 = tp & 15;
        const f32x4 lg4 = *(const f32x4*)(ln_g + 64 * h + 4 * l16), lb4 = *(const f32x4*)(ln_b + 64 * h + 4 * l16);
#pragma unroll 1
        for (int c = 0; c < 32; ++c) {
            asm volatile("" ::: "memory"); __builtin_amdgcn_s_barrier(); asm volatile("" ::: "memory");
            const LAS float* yb = YB + (c & 1) * 4096; const LAS unsigned char* gl = lds + 32768 + (c & 1) * 8192; const LAS float* bl = (const LAS float*)(lds + 65536 + (c & 1) * 256);
#pragma unroll
            for (int it = 0; it < 4; ++it) { const int tt = it * 16 + (tp >> 4); const int m = b * SEQ + c * 64 + tt;
                const f32x4 y4 = *(const LAS f32x4*)(yb + tt * 64 + 4 * l16);
                const f32x4 g4 = bf4(*(const LAS u32x2*)(gl + (tt * 64 + 4 * l16) * 2)), v4 = bf4(*(const LAS u32x2*)(gl + 16384 + (tt * 64 + 4 * l16) * 2)); const float bon = bl[tt];
                const float mean = red16((y4[0] + y4[1]) + (y4[2] + y4[3])) * (1.f / 64.f);
                const f32x4 d4 = y4 - mean;
                const float var = red16((d4[0] * d4[0] + d4[1] * d4[1]) + (d4[2] * d4[2] + d4[3] * d4[3])) * (1.f / 64.f);
                const float rstd = __builtin_amdgcn_rsqf(var + GN_EPS);
                const f32x4 o = ((d4 * rstd) * lg4 + lb4 + v4 * bon) * g4;
                *(GAS u32x2*)((gbf16*)MIX + (size_t)m * 1024 + 512 + 64 * h + 4 * l16) = pk4(o); }
        }
    }
}

template <class EpiF>
__device__ __forceinline__ void small_gemm(LAS unsigned char* lds, const bf16* A, int lda, const bf16* Bt, int N, int K, int Q, int gb, int GB, const EpiF& epi, int tid, int wave, int lane) {
    const int fr = lane & 15, fq = lane >> 4, kw = (K / Q) >> 3;
    LAS float* part = (LAS float*)lds;
    for (int item = gb; item < (N >> 4) * Q; item += GB) {
        const int strip = item / Q, q = item - strip * Q;
        f32x4 acc[8];
#pragma unroll
        for (int i = 0; i < 8; ++i) acc[i] = (f32x4){0.f, 0.f, 0.f, 0.f};
        const bf16* brow = Bt + (size_t)(16 * strip + fr) * K + q * (K / Q) + wave * kw + 8 * fq;
        const bf16* arow = A + (size_t)fr * lda + q * (K / Q) + wave * kw + 8 * fq;
#pragma unroll 4
        for (int ks = 0; ks < (kw >> 5); ++ks) {
            const bf16x8 wf = *(const bf16x8*)(brow + 32 * ks);
#pragma unroll
            for (int mt = 0; mt < 8; ++mt) { const bf16x8 af = *(const bf16x8*)(arow + (size_t)(16 * mt) * lda + 32 * ks); acc[mt] = __builtin_amdgcn_mfma_f32_16x16x32_bf16(wf, af, acc[mt], 0, 0, 0); }
        }
#pragma unroll
        for (int mt = 0; mt < 8; ++mt) *(LAS f32x4*)(part + ((wave * 128 + 16 * mt + fr) * 16 + 4 * fq)) = acc[mt];
        __syncthreads();
        {   const int token = tid >> 2, cg = tid & 3; f32x4 sm = (f32x4){0.f, 0.f, 0.f, 0.f};
#pragma unroll
            for (int w = 0; w < 8; ++w) sm += *(const LAS f32x4*)(part + ((w * 128 + token) * 16 + 4 * cg));
            epi(token, 16 * strip + 4 * cg, sm); }
        __syncthreads();
    }
}
struct SEpiProj { bf16* ZAs; float* PBs;
    __device__ __forceinline__ void operator()(int t, int c, f32x4 s) const {
        if (c < 1024) { const f32x2 a = pg8::gelu_pk((f32x2){s[0], s[1]}), b = pg8::gelu_pk((f32x2){s[2], s[3]}); *(u32x2*)(ZAs + (size_t)t * 1024 + c) = pk4((f32x4){a.x, a.y, b.x, b.y}); }
        else *(f32x4*)(PBs + (size_t)t * DSH + (c - 1024)) = s; } };
struct SEpiAtomic { float* acc;
    __device__ __forceinline__ void operator()(int t, int c, f32x4 s) const {
#pragma unroll
        for (int j = 0; j < 4; ++j) (void)__hip_atomic_fetch_add(acc + (size_t)t * 1024 + c + j, s[j], __ATOMIC_RELAXED, __HIP_MEMORY_SCOPE_AGENT); } };
template <bool WB> struct SEpiRes { const float* base; float* out; bf16* outb; float* rowss; float* out2;
    __device__ __forceinline__ void operator()(int t, int c, f32x4 s) const {
        const f32x4 v = *(const f32x4*)(base + (size_t)t * 1024 + c) + s; *(f32x4*)(out + (size_t)t * 1024 + c) = v; if (WB) *(u32x2*)(outb + (size_t)t * 1024 + c) = pk4(v); if (out2) *(f32x4*)(out2 + (size_t)t * 1024 + c) = v;
        float ss = (v[0] * v[0] + v[1] * v[1]) + (v[2] * v[2] + v[3] * v[3]); ss = red4(ss);
        if ((threadIdx.x & 3) == 0) (void)__hip_atomic_fetch_add(rowss + t, ss, __ATOMIC_RELAXED, __HIP_MEMORY_SCOPE_AGENT); } };
struct SEpiQ { float* Q; const float* rowss;
    __device__ __forceinline__ void operator()(int t, int c, f32x4 s) const {
        const float sc = 0.0625f / sqrtf(__hip_atomic_load(rowss + t, __ATOMIC_RELAXED, __HIP_MEMORY_SCOPE_AGENT) * (1.f / D) + RMS_EPS); *(f32x4*)(Q + (size_t)t * 1024 + c) = s * sc; } };
struct SEpiUp { bf16* H; const float* rowss;
    __device__ __forceinline__ void operator()(int t, int c, f32x4 s) const {
        const float sc = 1.f / sqrtf(__hip_atomic_load(rowss + t, __ATOMIC_RELAXED, __HIP_MEMORY_SCOPE_AGENT) * (1.f / D) + RMS_EPS); f32x4 v = s * sc;
#pragma unroll
        for (int j = 0; j < 4; ++j) { const float a = fmaxf(v[j], 0.f); v[j] = a * a; }
        *(u32x2*)(H + (size_t)t * FF + c) = pk4(v); } };

struct KArgs { const float* in[35]; float* out; unsigned char* ws; };
__device__ __forceinline__ void sample_mixer_token(LAS unsigned char* lds, int tok, const KArgs& KA, const bf16* ZAs, const float* PBs, bf16* MIXs, const bf16* W2T, const bf16* A2T, const bf16* G2T, int tid, int wave, int lane) {
    const float* const (&in)[35] = KA.in; float* out = KA.out;
    LAS float* red = (LAS float*)lds;
    LAS float* lin = (LAS float*)(lds + 256);
    LAS float* vec = (LAS float*)(lds + 2048);
    const int c = tid;
    {   const int hA = c >> 7; const float vz = bf1(ZAs[(size_t)tok * 1024 + 512 + c]), uz = bf1(ZAs[(size_t)tok * 1024 + c]);
        const float s1 = wave_sum(vz); if (lane == 0) red[wave] = s1;
        __syncthreads();
        const float mean = (red[2 * hA] + red[2 * hA + 1]) * (1.f / 128.f); const float dv = vz - mean;
        const float s2 = wave_sum(dv * dv); if (lane == 0) red[8 + wave] = s2;
        __syncthreads();
        const float var = (red[8 + 2 * hA] + red[8 + 2 * hA + 1]) * (1.f / 128.f);
        const float vn = dv * (1.f / sqrtf(var + LN_EPS)) * in[10][c] + in[11][c];
        out[O_CVS + (size_t)tok * 512 + c] = vn;
        const float mixed = in[12][(size_t)hA * 128 * 128] * vn + in[13][hA * 128];
        MIXs[(size_t)tok * 1024 + c] = (bf16)(pk2(uz * mixed, 0.f) & 0xffffu);
    }
    const float* pb = PBs + (size_t)tok * DSH; const float* pv = in[5] + (size_t)tok * DSH; const float* mu = in[9];
    if (tid < 256) { const int i = 1536 + tid; const float x = pb[i] + (pv[i] - pb[i]) * mu[i]; lin[tid] = tid < 64 ? fast_tanh(x) : (tid < 128 ? x : fast_sigmoid(x)); }
    __syncthreads();
    const float rs = pb[c] + (pv[c] - pb[c]) * mu[c], ks = pb[512 + c] + (pv[512 + c] - pb[512 + c]) * mu[512 + c], vs = pb[1024 + c] + (pv[1024 + c] - pb[1024 + c]) * mu[1024 + c];
    const size_t so = ((size_t)(tok * 8 + wave) * 64 + lane) * 64; const float* s0 = in[6] + so; float* s1o = out + O_WKVS + so;
    f32x4 Sx[16];
#pragma unroll
    for (int j = 0; j < 16; ++j) Sx[j] = *(const f32x4*)(s0 + 4 * j);
    float wl = in[14][c], al = in[16][c], g = 0.f;
    {   const bf16* w2r = W2T + (size_t)c * 64; const bf16* a2r = A2T + (size_t)c * 64; const bf16* g2r = G2T + (size_t)c * 128;
#define DOT8(acc, v, lp) do { const f32x4 l0_ = *(const LAS f32x4*)(lp), l1_ = *(const LAS f32x4*)((lp) + 4); \
            acc += (bf_lo((v).x) * l0_[0] + bf_hi((v).x) * l0_[1]) + (bf_lo((v).y) * l0_[2] + bf_hi((v).y) * l0_[3]) + (bf_lo((v).z) * l1_[0] + bf_hi((v).z) * l1_[1]) + (bf_lo((v).w) * l1_[2] + bf_hi((v).w) * l1_[3]); } while (0)
#pragma unroll 1
        for (int j = 0; j < 8; ++j) { const u32x4 w8 = *(const u32x4*)(w2r + 8 * j), a8 = *(const u32x4*)(a2r + 8 * j), g8 = *(const u32x4*)(g2r + 8 * j), h8 = *(const u32x4*)(g2r + 64 + 8 * j);
            DOT8(wl, w8, lin + 8 * j); DOT8(al, a8, lin + 64 + 8 * j); DOT8(g, g8, lin + 128 + 8 * j); DOT8(g, h8, lin + 192 + 8 * j); }
#undef DOT8
    }
    const float z = -wl, sp = fmaxf(z, 0.f) + fast_log(1.f + fast_exp(-fabsf(z))), w = -sp - 0.5f, dec = fast_exp(-fast_exp(w)), av = fast_sigmoid(al);
    const float kkr = ks * in[19][c]; const float nrm = sqrtf(wave_sum(kkr * kkr)); const float kk = kkr / fmaxf(nrm, 1e-12f); const float kp = ks * (1.f + (av - 1.f) * in[20][c]);
    LAS float* hv = vec + wave * 320;
    hv[lane] = dec; hv[64 + lane] = -kk; hv[128 + lane] = kk * av; hv[192 + lane] = kp; hv[256 + lane] = rs;
    __syncthreads();
    {   float sa = 0.f;
#pragma unroll
        for (int j = 0; j < 16; ++j) { const f32x4 a4 = *(const LAS f32x4*)(hv + 64 + 4 * j); sa += (Sx[j][0] * a4[0] + Sx[j][1] * a4[1]) + (Sx[j][2] * a4[2] + Sx[j][3] * a4[3]); if ((j & 3) == 3) asm volatile("" ::: "memory"); }
        float y = 0.f;
#pragma unroll
        for (int j = 0; j < 16; ++j) { const f32x4 d4 = *(const LAS f32x4*)(hv + 4 * j), b4 = *(const LAS f32x4*)(hv + 128 + 4 * j), k4 = *(const LAS f32x4*)(hv + 192 + 4 * j), r4 = *(const LAS f32x4*)(hv + 256 + 4 * j);
            const f32x4 sn = Sx[j] * d4 + (b4 * sa + k4 * vs); *(f32x4*)(s1o + 4 * j) = sn; y += (sn[0] * r4[0] + sn[1] * r4[1]) + (sn[2] * r4[2] + sn[3] * r4[3]); if ((j & 1) == 1) asm volatile("" ::: "memory"); }
        const float mean = wave_sum(y) * (1.f / 64.f), dy = y - mean, var = wave_sum(dy * dy) * (1.f / 64.f);
        const float yn = dy * (1.f / sqrtf(var + GN_EPS)) * in[22][c] + in[23][c];
        const float bon = wave_sum(rs * kp * in[21][c]) * vs;
        MIXs[(size_t)tok * 1024 + 512 + c] = (bf16)(pk2((yn + bon) * g, 0.f) & 0xffffu);
    }
    __syncthreads();
}
__device__ __forceinline__ void sample_attn_pair(LAS unsigned char* lds, int pair, const float* Qs, const float* Kc, const float* Vc, bf16* Os, int tid, int wave, int lane) {
    const int b = pair >> 2, h = pair & 3;
    LAS float* sc = (LAS float*)lds;
    LAS float* part = (LAS float*)(lds + 1024);
    const f32x4 q4 = *(const f32x4*)(Qs + (size_t)b * 1024 + h * 256 + 4 * lane);
    const float* kb = Kc + ((size_t)b * 256 * 4 + h) * 256 + 4 * lane; const float* vb = Vc + ((size_t)b * 256 * 4 + h) * 256 + 4 * lane;
    {   f32x4 kr[32];
#pragma unroll
        for (int i = 0; i < 32; ++i) kr[i] = __builtin_nontemporal_load((const f32x4*)(kb + (size_t)(32 * wave + i) * 1024));
#pragma unroll
        for (int i = 0; i < 32; ++i) { const float p = wave_sum_dpp((q4[0] * kr[i][0] + q4[1] * kr[i][1]) + (q4[2] * kr[i][2] + q4[3] * kr[i][3])); if (lane == 0) sc[32 * wave + i] = p; } }
    f32x4 vr[32];
#pragma unroll
    for (int i = 0; i < 32; ++i) vr[i] = __builtin_nontemporal_load((const f32x4*)(vb + (size_t)(32 * wave + i) * 1024));
    __syncthreads();
    {   const f32x4 s4 = *(const LAS f32x4*)(sc + 4 * lane); const float mx = wave_max(fmaxf(fmaxf(s4[0], s4[1]), fmaxf(s4[2], s4[3])));
        f32x4 e; float sum = 0.f;
#pragma unroll
        for (int j = 0; j < 4; ++j) { e[j] = fast_exp(s4[j] - mx); sum += e[j]; }
        sum = wave_sum(sum); const float inv = 1.f / sum;
        __syncthreads();
        if (wave == 0) *(LAS f32x4*)(sc + 4 * lane) = e * inv;
    }
    __syncthreads();
    f32x4 o = (f32x4){0.f, 0.f, 0.f, 0.f};
#pragma unroll
    for (int i = 0; i < 32; ++i) o += vr[i] * sc[32 * wave + i];
    *(LAS f32x4*)(part + wave * 256 + 4 * lane) = o;
    __syncthreads();
    if (tid < 256) { float s = 0.f;
#pragma unroll
        for (int w = 0; w < 8; ++w) s += part[w * 256 + tid];
        Os[(size_t)b * 1024 + h * 256 + tid] = (bf16)(pk2(s, 0.f) & 0xffffu); }
    __syncthreads();
}
template <int ST>
__device__ __forceinline__ void sample_stage(LAS unsigned char* lds, const KArgs& KA, int gb, int GB, int tid, int wave, int lane) {
    unsigned char* ws = KA.ws; unsigned char* sm = ws + WS_SMP; const float* const (&in)[35] = KA.in; float* out = KA.out;
    float* rs1 = (float*)ws + RS_OFF + M; float* rs2 = rs1 + RS_STRIDE;
    const bf16* XN0s = (const bf16*)(ws + WS_ACAT) + (size_t)M * 1024;
    bf16* ZAs = (bf16*)(sm + SM_ZA); bf16* MIXs = (bf16*)(sm + SM_MIX); float* X1s = (float*)(sm + SM_X1); bf16* X1Bs = (bf16*)(sm + SM_X1B); float* Qs = (float*)(sm + SM_Q); bf16* Os = (bf16*)(sm + SM_O);
    float* X2s = (float*)(sm + SM_X2); bf16* X2Bs = (bf16*)(sm + SM_X2B); bf16* HIDs = (bf16*)(sm + SM_HID); float* X3s = (float*)(sm + SM_X3);
    float* PBs = out + O_SHS;
    if constexpr (ST == 0) { SEpiProj e{ZAs, PBs}; small_gemm(lds, XN0s, 1024, (const bf16*)(ws + WS_WCAT), DIN, 1024, 1, gb, GB, e, tid, wave, lane); }
    if constexpr (ST == 1) { for (int tok = gb; tok < MS; tok += GB) sample_mixer_token(lds, tok, KA, ZAs, PBs, MIXs, (const bf16*)(ws + WS_SMALL), (const bf16*)(ws + WS_SMALL + 64 * KiB), (const bf16*)(ws + WS_SMALL + 128 * KiB), tid, wave, lane); }
    if constexpr (ST == 2) { SEpiRes<true> e{in[1], X1s, X1Bs, rs1, nullptr}; small_gemm(lds, MIXs, 1024, (const bf16*)(ws + WS_WOUT), 1024, 1024, 1, gb, GB, e, tid, wave, lane); }
    if constexpr (ST == 3) { SEpiQ e{Qs, rs1}; small_gemm(lds, X1Bs, 1024, (const bf16*)(ws + WS_WQ), 1024, 1024, 1, gb, GB, e, tid, wave, lane); }
    if constexpr (ST == 4) { for (int pair = gb; pair < MS * 4; pair += GB) sample_attn_pair(lds, pair, Qs, in[3], in[4], Os, tid, wave, lane); }
    if constexpr (ST == 5) { SEpiRes<true> e{X1s, X2s, X2Bs, rs2, X3s}; small_gemm(lds, Os, 1024, (const bf16*)(ws + WS_WO), 1024, 1024, 1, gb, GB, e, tid, wave, lane); }
    if constexpr (ST == 6) { SEpiUp e{HIDs, rs2}; small_gemm(lds, X2Bs, 1024, (const bf16*)(ws + WS_WUP), FF, 1024, 1, gb, GB, e, tid, wave, lane); }
    if constexpr (ST == 7) { SEpiAtomic e{X3s}; small_gemm(lds, HIDs, FF, (const bf16*)(ws + WS_WDN), 1024, FF, 4, gb, GB, e, tid, wave, lane); }
    if constexpr (ST == 8) {
        for (int r = gb * 8 + wave; r < MS; r += GB * 8) {
            f32x4 v[4]; float ss = 0.f;
#pragma unroll
            for (int j = 0; j < 4; ++j) { v[j] = *(const f32x4*)(X3s + (size_t)r * 1024 + 256 * j + 4 * lane); ss += (v[j][0] * v[j][0] + v[j][1] * v[j][1]) + (v[j][2] * v[j][2] + v[j][3] * v[j][3]); }
            const float sc = 1.f / sqrtf(wave_sum(ss) * (1.f / D) + RMS_EPS);
#pragma unroll
            for (int j = 0; j < 4; ++j) { const int cc = 256 * j + 4 * lane; *(f32x4*)(out + O_YS + (size_t)r * 1024 + cc) = v[j] * sc * *(const f32x4*)(in[34] + cc); } }
    }
}

__global__ void __launch_bounds__(NWAVES * 64, 2) mk_fwd(KArgs a) {
    extern __shared__ __attribute__((aligned(16))) unsigned char lds_raw[];
    LAS unsigned char* lds = (LAS unsigned char*)lds_raw;
    volatile LAS unsigned* MISC = (volatile LAS unsigned*)(lds + MISC_OFF);
    int tid = threadIdx.x, lane = tid & 63, wave = __builtin_amdgcn_readfirstlane(tid >> 6);
    const int G = gridDim.x; int bx = blockIdx.x; int vcu = (G % 8 == 0) ? (bx % 8) * (G / 8) + bx / 8 : bx;
#define LAUNDER() do { ws = a.ws; asm volatile("" : "+s"(ws)); tid = threadIdx.x; asm volatile("" : "+v"(tid)); lane = tid & 63; wave = __builtin_amdgcn_readfirstlane(tid >> 6); bx = blockIdx.x; asm volatile("" : "+s"(bx)); \
        vcu = (G % 8 == 0) ? (bx % 8) * (G / 8) + bx / 8 : bx; gw = vcu * NWAVES + wave; } while (0)
    unsigned char* ws = a.ws; float* out = a.out;
    gu32* ctl = (gu32*)(ws + WS_CTL);
    for (int u = tid; u < (LDS_BYTES - LDSCTL_OFF) / 4; u += NWAVES * 64) ((LAS unsigned*)(lds + LDSCTL_OFF))[u] = 0u;
    __syncthreads();
    XcdBarrier bar = xcd_barrier_post((unsigned*)ctl + CW_BAR, MISC + 8);
#define GRID_BAR() xcd_barrier(bar)
#ifdef PROBE_SPAN_A
#define STAMP(k) do { if (blockIdx.x == 0 && threadIdx.x == 0) *(volatile LAS unsigned long long*)(lds + LDSCTL_OFF + 64 + 8 * (k)) = __builtin_amdgcn_s_memrealtime(); } while (0)
#else
#define STAMP(k) do { } while (0)
#endif
    STAMP(0);
#ifdef PROBE_SSPAN_A
#define SST(k) do { if (blockIdx.x == 64 && threadIdx.x == 0) *(volatile LAS unsigned long long*)(lds + LDSCTL_OFF + 64 + 8 * (16 + (k))) = __builtin_amdgcn_s_memrealtime(); } while (0)
#else
#define SST(k) do { } while (0)
#endif
#define RS1 ((float*)ws + RS_OFF)
#define RS2 ((float*)ws + RS_OFF + RS_STRIDE)
#define RS3 ((float*)ws + RS_OFF + 2 * RS_STRIDE)
#define WCAT ((bf16*)(ws + WS_WCAT))
#define WOUT ((bf16*)(ws + WS_WOUT))
#define WQ ((bf16*)(ws + WS_WQ))
#define WO ((bf16*)(ws + WS_WO))
#define WUP ((bf16*)(ws + WS_WUP))
#define WDN ((bf16*)(ws + WS_WDN))
#define W2T ((bf16*)(ws + WS_SMALL))
#define A2T ((bf16*)(ws + WS_SMALL + 64 * KiB))
#define G2T ((bf16*)(ws + WS_SMALL + 128 * KiB))
#define WSB ((bf16*)(ws + WS_SMALL + 256 * KiB))
#define ZROW ((bf16*)(ws + WS_SMALL + 384 * KiB))
#define ACAT ((bf16*)(ws + WS_ACAT))
#define ZA ((bf16*)(ws + WS_ZA))
#define PB ((bf16*)(ws + WS_PB))
#define SCN ((float*)(ws + WS_SCN))
#define LAIN ((bf16*)(ws + WS_NEW))
#define OPS ((bf16*)(ws + WS_SCN))
#define TASKS (ws + WS_NEW + 8 * MiB)
#define VSB ((bf16*)(ws + WS_NEW + 72 * MiB))
#define BON ((float*)(ws + WS_NEW + 88 * MiB))
#define GB_ ((bf16*)(ws + WS_G))
#define MIX ((bf16*)(ws + WS_MIX))
#define KB ((bf16*)(ws + WS_KB))
#define VT ((bf16*)(ws + WS_VT))
#define X1B ((bf16*)(ws + WS_ZA))
#define Q ((bf16*)(ws + WS_Q))
#define OB ((bf16*)(ws + WS_OB))
#define PSCR ((bf16*)(ws + WS_PSCR))
#define X2B ((bf16*)(ws + WS_MIX))
#define HID ((bf16*)(ws + WS_HID))
    int gw = vcu * NWAVES + wave; const int NGW = G * NWAVES;

    #ifndef NOP0
    LAUNDER();
    {
        LAS float* scr = (LAS float*)(lds + wave * 16384);
        constexpr int I_IN = 16 * 88, I_SQ = 16 * 32, I_UP = 16 * 128, I_DN = 64 * 32, I_L = 16, I_G = 32;
        constexpr int NITEMS = I_IN + 5 * I_SQ + I_UP + I_DN + 2 * I_L + I_G;
        for (int it = gw; it < NITEMS; it += NGW) {
            int r = it;
            if (r < I_IN) { p0_transpose_item(a.in[8], 1024, DIN, WCAT, 0, nullptr, scr, r, lane); continue; } r -= I_IN;
            if (r < I_SQ) { p0_transpose_item(a.in[28], 1024, 1024, WCAT, DIN, nullptr, scr, r, lane); continue; } r -= I_SQ;
            if (r < I_SQ) { p0_transpose_item(a.in[29], 1024, 1024, WCAT, DIN + 1024, nullptr, scr, r, lane); continue; } r -= I_SQ;
            if (r < I_SQ) { p0_transpose_item(a.in[24], 1024, 1024, WOUT, 0, nullptr, scr, r, lane); continue; } r -= I_SQ;
            if (r < I_SQ) { p0_transpose_item(a.in[27], 1024, 1024, WQ, 0, a.in[25], scr, r, lane); continue; } r -= I_SQ;
            if (r < I_SQ) { p0_transpose_item(a.in[30], 1024, 1024, WO, 0, nullptr, scr, r, lane); continue; } r -= I_SQ;
            if (r < I_UP) { p0_transpose_item(a.in[32], 1024, FF, WUP, 0, a.in[31], scr, r, lane); continue; } r -= I_UP;
            if (r < I_DN) { p0_transpose_item(a.in[33], FF, 1024, WDN, 0, nullptr, scr, r, lane); continue; } r -= I_DN;
            if (r < I_L) { p0_transpose_item(a.in[15], 64, DB, W2T, 0, nullptr, scr, r, lane); continue; } r -= I_L;
            if (r < I_L) { p0_transpose_item(a.in[17], 64, DB, A2T, 0, nullptr, scr, r, lane); continue; } r -= I_L;
            p0_transpose_item(a.in[18], 128, DB, G2T, 0, nullptr, scr, r, lane);
        }
        for (int m = gw; m < M + MS + NBATCH * NMEM; m += 4 * NGW) {
            const float* src[4]; const float* gg[4]; bf16* dst[4]; bool ok[4];
#pragma unroll
            for (int q = 0; q < 4; ++q) { const int mm = m + q * NGW; ok[q] = mm < M + MS + NBATCH * NMEM; const int mc = ok[q] ? mm : m;
                if (mc < M) { src[q] = a.in[0] + (size_t)mc * D; gg[q] = a.in[7]; dst[q] = ACAT + (size_t)mc * D; }
                else if (mc < M + MS) { src[q] = a.in[1] + (size_t)(mc - M) * D; gg[q] = a.in[7]; dst[q] = ACAT + (size_t)mc * D; }
                else { src[q] = a.in[2] + (size_t)(mc - M - MS) * D; gg[q] = a.in[26]; dst[q] = ACAT + (size_t)(16640 + (mc - M - MS)) * D; } }
            f32x4 v[4][4]; float ss[4];
#pragma unroll
            for (int q = 0; q < 4; ++q) { ss[q] = 0.f;
#pragma unroll
                for (int j = 0; j < 4; ++j) v[q][j] = __builtin_nontemporal_load((const f32x4*)src[q] + lane + 64 * j); }
#pragma unroll
            for (int q = 0; q < 4; ++q) {
#pragma unroll
                for (int j = 0; j < 4; ++j) ss[q] += (v[q][j].x * v[q][j].x + v[q][j].y * v[q][j].y) + (v[q][j].z * v[q][j].z + v[q][j].w * v[q][j].w);
                const float rstd = 1.f / sqrtf(wave_sum(ss[q]) * (1.f / D) + RMS_EPS);
                if (ok[q]) { unsigned long long* o8 = (unsigned long long*)dst[q] + lane;
#pragma unroll
                    for (int j = 0; j < 4; ++j) { const f32x4 g4 = *((const f32x4*)gg[q] + lane + 64 * j);
                        o8[64 * j] = (unsigned long long)pk2(v[q][j].x * rstd * g4.x, v[q][j].y * rstd * g4.y) | ((unsigned long long)pk2(v[q][j].z * rstd * g4.z, v[q][j].w * rstd * g4.w) << 32); } } }
        }
        const int gt = bx * (NWAVES * 64) + tid, NGT = G * NWAVES * 64;
        for (int i = gt; i < 4 * 128 * 128; i += NGT) { const int t = (i >> 7) & 127, s = i & 127; WSB[i] = (bf16)(pk2(s <= t ? a.in[12][i] : 0.f, 0.f) & 0xffffu); }
        for (int i = gt; i < 2048; i += NGT) ZROW[i] = 0;
    }
#endif
    GRID_BAR(); STAMP(1);

    #ifndef NOP1
    LAUNDER();
    {
        SchedP1 S{G, bx, (const char*)ACAT, (const char*)WCAT};
        EpiP1 E{ZA, PB, out + O_MK, out + O_MV, KB};
        pg8::gemm_phase<EpiP1, SchedP1, true>(lds, 1024, 1024, 1024, S, E);
        sample_stage<0>(lds, a, bx, G, tid, wave, lane);
    }
#endif
    GRID_BAR(); STAMP(2);

    #ifndef NOP2
    LAUNDER();
    {
        LAS float* scr = (LAS float*)(lds + wave * 16384);
        for (int it = gw; it < NBATCH * 128; it += NGW) { const int b = it >> 7; p0_transpose_item(out + O_MV + (size_t)b * NMEM * 1024, NMEM, 1024, VT + (size_t)b * 1024 * NMEM, 0, nullptr, scr, it & 127, lane); }
        const int gt = bx * (NWAVES * 64) + tid, NGT = G * NWAVES * 64;
        for (int i = gt; i < NBATCH * DSH; i += NGT) { const int b = i / DSH, c = i % DSH; out[O_SHP + i] = bf1(PB[(size_t)(b * SEQ + SEQ - 1) * DSH + c]); }
        __syncthreads();
        SST(10);
        for (int bc = bx; bc < M / 64; bc += G)
            rwkv_chunk_prep(lds, bc, PB, ZROW, a.in[9], W2T, A2T, G2T, a.in[14], a.in[16], a.in[19], a.in[20], a.in[21], LAIN + (size_t)bx * 16384, TASKS, GB_, VSB, BON, tid, wave, lane);
        SST(11);
#ifdef DUP2
        LAUNDER();
        for (int bc = bx; bc < M / 64; bc += G)
            rwkv_chunk_prep(lds, bc, PB, ZROW, a.in[9], W2T, A2T, G2T, a.in[14], a.in[16], a.in[19], a.in[20], a.in[21], LAIN + (size_t)bx * 16384, TASKS, GB_, VSB, BON, tid, wave, lane);
#endif
        sample_stage<1>(lds, a, bx, G, tid, wave, lane);
    }
#endif
    GRID_BAR(); STAMP(3);

    #ifndef NOP3
    LAUNDER();
    {   unsigned* subcnt = (unsigned*)ctl + CW_SUB; unsigned* tmo = (unsigned*)ctl + CW_TMO; unsigned* qatt = (unsigned*)ctl + CW_QATT; unsigned* qmix = (unsigned*)ctl + CW_QMIX;
        volatile LAS unsigned* qw = (volatile LAS unsigned*)(lds + LDSCTL_OFF + 32);
        if (bx < 64) {
            scanB_block(lds, bx, TASKS, GB_, VSB, BON, a.in[22], a.in[23], MIX, out + O_WKVP, tid, wave, lane);
#ifdef DUP3
            LAUNDER();
            scanB_block(lds, bx, TASKS, GB_, VSB, BON, a.in[22], a.in[23], MIX, out + O_WKVP, tid, wave, lane);
#endif
            STAMP(5);
            __syncthreads();
            if (tid == 0) { unsigned sp = 0; while (xb_ld(subcnt) < 384u) { __builtin_amdgcn_s_sleep(4); if ((++sp & 255u) == 0u) { if (xb_ld(tmo)) break; if (sp > (1u << 20)) { atomicAdd(tmo, 1u); break; } } }
                __builtin_amdgcn_fence(__ATOMIC_ACQUIRE, "agent"); asm volatile("s_waitcnt vmcnt(0)" ::: "memory"); }
            __syncthreads();
        } else {
            const int gb = bx - 64;
            SST(0);
#define SUBBAR_FILL(target) do { asm volatile("s_waitcnt vmcnt(0)" ::: "memory"); __syncthreads(); \
                if (tid == 0) { __builtin_amdgcn_fence(__ATOMIC_RELEASE, "agent"); asm volatile("s_waitcnt vmcnt(0)" ::: "memory"); (void)xb_add(subcnt, 1u); } \
                unsigned sp_ = 0; \
                for (;;) { __syncthreads(); if (tid == 0) { const bool dn_ = xb_ld(subcnt) >= (target) || xb_ld(tmo) != 0u; *qw = dn_ ? 0xffffffffu : xb_add(qmix, 1u); } __syncthreads(); const unsigned tile_ = *qw; \
                    if (tile_ == 0xffffffffu) break; \
                    if (tile_ < 512u) mixer_a_tile(lds, (int)tile_, ZA, WSB, a.in[10], a.in[11], a.in[13], MIX, out + O_CVP, tid, wave, lane); \
                    else { __builtin_amdgcn_s_sleep(8); if (++sp_ > (1u << 18)) { if (tid == 0) atomicAdd(tmo, 1u); } } } \
                if (tid == 0) { __builtin_amdgcn_fence(__ATOMIC_ACQUIRE, "agent"); asm volatile("s_waitcnt vmcnt(0)" ::: "memory"); } \
                __syncthreads(); } while (0)
            sample_stage<2>(lds, a, gb, 192, tid, wave, lane);
            SST(1);
            SUBBAR_FILL(192u);
            SST(2);
            sample_stage<3>(lds, a, gb, 192, tid, wave, lane);
            SST(3);
            SUBBAR_FILL(384u);
#undef SUBBAR_FILL
            SST(4);
        }
        {   const float* Qs = (const float*)(ws + WS_SMP + SM_Q); bf16* Os = (bf16*)(ws + WS_SMP + SM_O);
            for (;;) { __syncthreads(); if (tid == 0) *qw = xb_add(qatt, 1u); __syncthreads(); const unsigned pair = *qw; if (pair >= (unsigned)(MS * 4)) break;
                sample_attn_pair(lds, (int)pair, Qs, a.in[3], a.in[4], Os, tid, wave, lane); }
            SST(5);
            for (;;) { __syncthreads(); if (tid == 0) *qw = xb_add(qmix, 1u); __syncthreads(); const unsigned tile = *qw; if (tile >= 512u) break;
                mixer_a_tile(lds, (int)tile, ZA, WSB, a.in[10], a.in[11], a.in[13], MIX, out + O_CVP, tid, wave, lane); }
            SST(6);
        }
    }
#endif
    GRID_BAR(); STAMP(4);

    #ifndef NOP4
    LAUNDER();
    {
        SchedMN S; S.init(M, 1024, G, bx, MIX, 1024, WOUT, 1024);
        EpiRes<float> E{a.in[0], X1B, RS1};
        pg8::gemm_phase<EpiRes<float>, SchedMN, true>(lds, 1024, 1024, 1024, S, E);
        sample_stage<5>(lds, a, bx, G, tid, wave, lane);
    }
#endif
    GRID_BAR(); STAMP(6);

    #ifndef NOP5
    LAUNDER();
    {
        SchedMN S5; S5.init(M, 1024, G, bx, X1B, 1024, WQ, 1024);
        bf16* QS = Q + (size_t)bx * 65536; bf16* P = PSCR + (size_t)bx * 65536;
        Unit u;
        for (int i = 0; S5.next(i, u); ++i) {
            const int pm = u.pm, h = u.pn, b = pm >> 3;
            { EpiQS E{QS, RS1};
              struct SchedU { const char* A; const char* B; Unit uu; __device__ __forceinline__ bool next(int i2, Unit& o) const { if (i2) return false; o = uu; return true; } __device__ __forceinline__ const char* pa(const Unit&) const { return A; } __device__ __forceinline__ const char* pb(const Unit&) const { return B; } };
              SchedU SU{S5.pa(u), S5.pb(u), u};
              pg8::gemm_phase<EpiQS, SchedU, false>(lds, 1024, 1024, 1024, SU, E); }
            { SchedOne S{(const char*)QS, (const char*)(KB + (size_t)b * NMEM * 1024 + h * 256)}; EpiSoftmax E{P};
              pg8::gemm_phase<EpiSoftmax, SchedOne, false>(lds, 256, 256, 1024, S, E); }
            { SchedOne S{(const char*)P, (const char*)(VT + ((size_t)b * 1024 + h * 256) * NMEM)}; EpiAttnO E{OB + (size_t)pm * 256 * 1024 + h * 256};
              pg8::gemm_phase<EpiAttnO, SchedOne, false>(lds, 256, 256, 256, S, E); }
        }
        sample_stage<6>(lds, a, bx, G, tid, wave, lane);
    }
#endif
    GRID_BAR(); STAMP(8);

    #ifndef NOP7
    LAUNDER();
    {
        SchedMN S; S.init(M, 1024, G, bx, OB, 1024, WO, 1024);
        EpiRes<bf16> E{X1B, X2B, RS2};
        pg8::gemm_phase<EpiRes<bf16>, SchedMN, true>(lds, 1024, 1024, 1024, S, E);
        sample_stage<7>(lds, a, bx, G, tid, wave, lane);
    }
#endif
    GRID_BAR(); STAMP(9);

    #ifndef NOP8
    LAUNDER();
    {
        SchedMN S; S.init(M, FF, G, bx, X2B, 1024, WUP, 1024);
        EpiScale<1> E{HID, FF, RS2};
        pg8::gemm_phase<EpiScale<1>, SchedMN, true>(lds, 1024, 1024, 1024, S, E);
        sample_stage<8>(lds, a, bx, G, tid, wave, lane);
    }
#endif
    GRID_BAR(); STAMP(10);

    #ifndef NOP9
    LAUNDER();
    {
        SchedMN S; S.init(M, 1024, G, bx, HID, FF, WDN, FF);
        EpiFinal E{X2B, out + O_Y, a.in[34], RS3, (unsigned*)ctl + CW_PAN, (unsigned*)ctl + CW_TMO};
        pg8::gemm_phase<EpiFinal, SchedMN, true>(lds, FF, FF, FF, S, E);
    }
#endif
#ifdef PROBE_CSPAN_A
    if (blockIdx.x == 64 && threadIdx.x == 0) {
        const unsigned long long ta = *(volatile LAS unsigned long long*)(lds + 140000 + 8 * PROBE_CSPAN_A), tb = *(volatile LAS unsigned long long*)(lds + 140000 + 8 * PROBE_CSPAN_B);
        const unsigned long long t0 = __builtin_amdgcn_s_memrealtime(), dl = (tb - ta) * PROBE_MULT;
        while (__builtin_amdgcn_s_memrealtime() - t0 < dl) __builtin_amdgcn_s_sleep(8);
    }
#endif
#ifdef PROBE_SSPAN_A
    if (blockIdx.x == 64 && threadIdx.x == 0) {
        const unsigned long long ta = *(volatile LAS unsigned long long*)(lds + LDSCTL_OFF + 64 + 8 * (16 + PROBE_SSPAN_A)), tb = *(volatile LAS unsigned long long*)(lds + LDSCTL_OFF + 64 + 8 * (16 + PROBE_SSPAN_B));
        const unsigned long long t0 = __builtin_amdgcn_s_memrealtime(), dl = (tb - ta) * PROBE_MULT;
        while (__builtin_amdgcn_s_memrealtime() - t0 < dl) __builtin_amdgcn_s_sleep(8);
    }
#endif
#ifdef PROBE_SPAN_A
    STAMP(12);
    if (blockIdx.x == 0 && threadIdx.x == 0) {
        const unsigned long long ta = *(volatile LAS unsigned long long*)(lds + LDSCTL_OFF + 64 + 8 * PROBE_SPAN_A), tb = *(volatile LAS unsigned long long*)(lds + LDSCTL_OFF + 64 + 8 * PROBE_SPAN_B);
        const unsigned long long t0 = __builtin_amdgcn_s_memrealtime(), dl = (tb - ta) * PROBE_MULT;
        while (__builtin_amdgcn_s_memrealtime() - t0 < dl) __builtin_amdgcn_s_sleep(8);
    }
#endif
}

extern "C" void kernel_launch(void* const* d_in, const int* in_sizes, int n_in, void* d_out, int out_size, void* d_ws, size_t ws_size, hipStream_t stream) {
    static int grid = 0;
    if (grid == 0) {
        if (n_in != 35 || out_size != (int)O_END || ws_size < WS_END) { fprintf(stderr, "kernel_launch: unexpected shapes (n_in %d, out %d, ws %zu); nothing launched\n", n_in, out_size, ws_size); grid = -1; return; }
        int dev = 0, cus = 0, per_cu = 0;
        if (hipGetDevice(&dev) != hipSuccess || hipDeviceGetAttribute(&cus, hipDeviceAttributeMultiprocessorCount, dev) != hipSuccess) { fprintf(stderr, "kernel_launch: device query failed\n"); grid = -1; return; }
        if (hipFuncSetAttribute((const void*)mk_fwd, hipFuncAttributeMaxDynamicSharedMemorySize, LDS_BYTES) != hipSuccess) { fprintf(stderr, "kernel_launch: hipFuncSetAttribute failed\n"); grid = -1; return; }
        if (hipOccupancyMaxActiveBlocksPerMultiprocessor(&per_cu, (const void*)mk_fwd, NWAVES * 64, LDS_BYTES) != hipSuccess || per_cu < 1)
            fprintf(stderr, "kernel_launch: note: occupancy query reports %d workgroups per CU\n", per_cu);
        (void)hipGetLastError();
        grid = cus;
        if (grid != 256) { fprintf(stderr, "kernel_launch: built for a 256-CU device (got %d)\n", grid); grid = -1; return; }
    }
    if (grid < 0) return;
    if (hipMemsetAsync((char*)d_ws + WS_CTL, 0, CTL_ZERO_BYTES, stream) != hipSuccess) { fprintf(stderr, "kernel_launch: hipMemsetAsync failed\n"); return; }
    KArgs a{};
    for (int i = 0; i < 35; ++i) a.in[i] = (const float*)d_in[i];
    a.out = (float*)d_out; a.ws = (unsigned char*)d_ws;
    hipLaunchKernelGGL(mk_fwd, dim3(grid), dim3(NWAVES * 64), LDS_BYTES, stream, a);
    const hipError_t le = hipPeekAtLastError();
    if (le != hipSuccess) fprintf(stderr, "kernel_launch: launch failed: %s\n", hipGetErrorName(le));
}
```

```cpp
#include <hip/hip_runtime.h>
#include <cstdio>
#include <cstdint>

namespace pg8 {
#define PG8_LAS __attribute__((address_space(3)))
typedef unsigned short bf16_t;
typedef short bf16x8 __attribute__((ext_vector_type(8)));
typedef float f32x4 __attribute__((ext_vector_type(4)));
typedef float f32x2 __attribute__((ext_vector_type(2)));
typedef unsigned u32x4 __attribute__((ext_vector_type(4)));
typedef unsigned u32x2 __attribute__((ext_vector_type(2)));
constexpr int BM = 256, BK = 64, HALF = 128, HTB = HALF * BK * 2  , STAGE_BYTES = 8 * HTB;

__host__ __device__ __forceinline__ int lds_byte(int r, int c) { const int st = (r >> 4) * 2 + (c >> 5), rr = r & 15, cc = c & 31, ob = rr * 64 + cc * 2; return st * 1024 + (ob ^ (((ob >> 9) & 1) << 5)); }
__host__ __device__ __forceinline__ void stage_rc(int b, int& R, int& C) { const int st = b / 1024, sb = b % 1024, swz = sb ^ (((sb >> 9) & 1) << 5); R = (st >> 1) * 16 + swz / 64; C = (st & 1) * 32 + (swz % 64) / 2; }
__host__ __device__ __forceinline__ int perm32(int rho) { const int n = rho >> 4, i = rho & 15; return 8 * (i >> 2) + 4 * n + (i & 3); }

struct Unit { int pm, pn; };

typedef __bf16 nbf16x2 __attribute__((ext_vector_type(2)));
__device__ __forceinline__ unsigned cvt_pk_bf16(float lo, float hi) { const nbf16x2 r = __builtin_convertvector((f32x2){lo, hi}, nbf16x2); return __builtin_bit_cast(unsigned, r); }
__device__ __forceinline__ f32x2 gelu_pk(f32x2 v) {
    const f32x2 av = __builtin_elementwise_abs(v), d = av * 0.2316418882f + 1.0f;
    f32x2 t; t.x = __builtin_amdgcn_rcpf(d.x); t.y = __builtin_amdgcn_rcpf(d.y);
    f32x2 q = t * 0.5307027145f + (-0.7265760135f); q = q * t + 0.7107068705f; q = q * t + (-0.142248368f); q = q * t + 0.127414796f; q = q * t;
    const f32x2 s = (v * v) * (-0.72134752044f);
    f32x2 e; e.x = __builtin_amdgcn_exp2f(s.x); e.y = __builtin_amdgcn_exp2f(s.y);
    const f32x2 m = v * (q * e), r = v - m;
    f32x2 o; o.x = v.x < 0.f ? m.x : r.x; o.y = v.y < 0.f ? m.y : r.y; return o;
}

template <class Epi, class Sched, bool ALIGN_EPI = false>
__device__ __forceinline__ void gemm_phase(PG8_LAS unsigned char* lds, const int K, const int lda, const int ldb, const Sched& S, const Epi& E) {
    int tid_ = threadIdx.x; asm volatile("" : "+v"(tid_));
    const int tid = tid_, wid = __builtin_amdgcn_readfirstlane(tid >> 6), lane = tid & 63, wr = wid >> 2, wc = wid & 3, fr = lane & 15, fq = lane >> 4;
    const int nt = K / BK;
    unsigned voffA[2], voffB[2];
#pragma unroll
    for (int i = 0; i < 2; ++i) { int R, C; stage_rc(tid * 16 + i * 8192, R, C); const int Rb = Epi::PERM ? ((R & ~31) + perm32(R & 31)) : R;
        voffA[i] = (unsigned)(R * lda + C) * 2u; voffB[i] = (unsigned)(Rb * ldb + C) * 2u; }
    const size_t kstep = (size_t)(BK * 2);
    const size_t hstepA = (size_t)HALF * lda * 2, hstepB = (size_t)HALF * ldb * 2;
    const unsigned ldsw = (unsigned)wid * 1024u;
    const int aoff = lds_byte(wr * 64 + fr, fq * 8), boff = lds_byte(wc * 32 + fr, fq * 8);
#define PG8_SA(b, h) (((b) * 2 + (h)) * HTB)
#define PG8_SB(b, h) ((4 + (b) * 2 + (h)) * HTB)
#define PG8_STAGE(bufoff, gbase, voff) do { _Pragma("unroll") for (int _i = 0; _i < 2; ++_i) \
        __builtin_amdgcn_global_load_lds((const unsigned*)((const char*)(gbase) + (voff)[_i]), (PG8_LAS unsigned*)(lds + (bufoff) + ldsw + _i * 8192), 16, 0, 0); } while (0)
#define PG8_LDA(dst, b, h) do { _Pragma("unroll") for (int m = 0; m < 4; ++m) _Pragma("unroll") for (int k = 0; k < 2; ++k) dst[m][k] = *(const PG8_LAS bf16x8*)(lds + PG8_SA(b, h) + aoff + m * 2048 + k * 1024); } while (0)
#define PG8_LDB(dst, b, h) do { _Pragma("unroll") for (int n = 0; n < 2; ++n) _Pragma("unroll") for (int k = 0; k < 2; ++k) dst[n][k] = *(const PG8_LAS bf16x8*)(lds + PG8_SB(b, h) + boff + n * 2048 + k * 1024); } while (0)
#define PG8_MMA(ai, bj, At, Bt) do { __builtin_amdgcn_s_setprio(1); _Pragma("unroll") for (int m = 0; m < 4; ++m) _Pragma("unroll") for (int n = 0; n < 2; ++n) _Pragma("unroll") for (int k = 0; k < 2; ++k) \
        acc[ai][bj][m][n] = __builtin_amdgcn_mfma_f32_16x16x32_bf16(Bt[n][k], At[m][k], acc[ai][bj][m][n], 0, 0, 0); __builtin_amdgcn_s_setprio(0); } while (0)
#define PG8_WAIT_V(n) asm volatile("s_waitcnt vmcnt(" #n ")" ::: "memory")
#define PG8_WAIT_L(n) asm volatile("s_waitcnt lgkmcnt(" #n ")" ::: "memory")
#define PG8_BAR __builtin_amdgcn_s_barrier()
#define PG8_SCHED __builtin_amdgcn_sched_barrier(0)
    Unit cur, nxt; int ui = 0;
    if (!S.next(0, cur)) return;
    f32x4 acc[2][2][4][2];
#pragma unroll
    for (int a = 0; a < 2; ++a)
#pragma unroll
        for (int b = 0; b < 2; ++b)
#pragma unroll
            for (int m = 0; m < 4; ++m)
#pragma unroll
                for (int n = 0; n < 2; ++n) acc[a][b][m][n] = (f32x4){0.f, 0.f, 0.f, 0.f};
    bf16x8 At[4][2], B0[2][2], B1[2][2];
    const char* cA = S.pa(cur); const char* cB = S.pb(cur);
    PG8_STAGE(PG8_SB(0, 0), cB, voffB); PG8_STAGE(PG8_SB(0, 1), cB + hstepB, voffB); PG8_STAGE(PG8_SA(0, 0), cA, voffA); PG8_STAGE(PG8_SA(0, 1), cA + hstepA, voffA);
    if (wr == 1) PG8_BAR;
    PG8_WAIT_V(2); PG8_BAR;
    PG8_STAGE(PG8_SB(1, 0), cB + kstep, voffB); PG8_STAGE(PG8_SA(1, 0), cA + kstep, voffA); PG8_STAGE(PG8_SB(1, 1), cB + hstepB + kstep, voffB);
    PG8_WAIT_V(6); PG8_BAR;
    for (;;) {
        const bool has_next = S.next(ui + 1, nxt);
        const char* nA = has_next ? S.pa(nxt) : cA; const char* nB = has_next ? S.pb(nxt) : cB;
#pragma unroll 1
        for (int t = 0; t < nt; t += 2) {
            const bool last = (t == nt - 2);
            const char* a1 = cA + (size_t)(t + 1) * kstep;
            const char* a2 = last ? nA : cA + (size_t)(t + 2) * kstep; const char* b2 = last ? nB : cB + (size_t)(t + 2) * kstep;
            const char* a3 = a2 + kstep; const char* b3 = b2 + kstep;
            PG8_LDB(B0, 0, 0); PG8_LDB(B1, 0, 1); PG8_SCHED; PG8_LDA(At, 0, 0); PG8_STAGE(PG8_SA(1, 1), a1 + hstepA, voffA);
            PG8_WAIT_V(8); PG8_WAIT_L(0); PG8_BAR; PG8_MMA(0, 0, At, B0); PG8_MMA(0, 1, At, B1); PG8_BAR; PG8_SCHED;
            PG8_LDA(At, 0, 1); PG8_STAGE(PG8_SB(0, 0), b2, voffB); PG8_STAGE(PG8_SB(0, 1), b2 + hstepB, voffB); PG8_STAGE(PG8_SA(0, 0), a2, voffA);
            PG8_WAIT_V(8); PG8_WAIT_L(0); PG8_BAR; PG8_MMA(1, 0, At, B0); PG8_MMA(1, 1, At, B1); PG8_BAR; PG8_SCHED;
            PG8_LDB(B0, 1, 0); PG8_LDB(B1, 1, 1); PG8_SCHED; PG8_LDA(At, 1, 0); PG8_STAGE(PG8_SA(0, 1), a2 + hstepA, voffA);
            PG8_WAIT_V(8); PG8_WAIT_L(0); PG8_BAR; PG8_MMA(0, 0, At, B0); PG8_MMA(0, 1, At, B1); PG8_BAR; PG8_SCHED;
            PG8_LDA(At, 1, 1); PG8_STAGE(PG8_SB(1, 0), b3, voffB); PG8_STAGE(PG8_SB(1, 1), b3 + hstepB, voffB); PG8_STAGE(PG8_SA(1, 0), a3, voffA);
            PG8_WAIT_V(8); PG8_WAIT_L(0); PG8_BAR; PG8_MMA(1, 0, At, B0); PG8_MMA(1, 1, At, B1); PG8_BAR; PG8_SCHED;
        }
        if constexpr (ALIGN_EPI) { if (wr == 0) PG8_BAR; }
        if constexpr (!Epi::AFTER_DRAIN) { E(acc, cur, wr, wc, fr, fq); }
        if (!has_next) break;
#pragma unroll
        for (int a = 0; a < 2; ++a)
#pragma unroll
            for (int b = 0; b < 2; ++b)
#pragma unroll
                for (int m = 0; m < 4; ++m)
#pragma unroll
                    for (int n = 0; n < 2; ++n) acc[a][b][m][n] = (f32x4){0.f, 0.f, 0.f, 0.f};
        cur = nxt; cA = nA; cB = nB; ++ui;
        if constexpr (ALIGN_EPI) { if (wr == 1) PG8_BAR; }
    }
    PG8_WAIT_V(0);
    if constexpr (!ALIGN_EPI) { if (wr == 0) PG8_BAR; }
    PG8_BAR;
    if constexpr (Epi::AFTER_DRAIN) { E.fused(acc, cur, wr, wc, fr, fq, lds, wid, lane); }
#undef PG8_SA
#undef PG8_SB
#undef PG8_STAGE
#undef PG8_LDA
#undef PG8_LDB
#undef PG8_MMA
#undef PG8_WAIT_V
#undef PG8_WAIT_L
#undef PG8_BAR
#undef PG8_SCHED
}
}

#define GAS __attribute__((address_space(1)))
#define LAS __attribute__((address_space(3)))
typedef unsigned short bf16;
typedef float f32x4 __attribute__((ext_vector_type(4)));
typedef float f32x2 __attribute__((ext_vector_type(2)));
typedef short bf16x8 __attribute__((ext_vector_type(8)));
typedef unsigned u32x4 __attribute__((ext_vector_type(4)));
typedef unsigned u32x2 __attribute__((ext_vector_type(2)));
typedef GAS unsigned gu32;
#define RLX_AGENT __ATOMIC_RELAXED, __HIP_MEMORY_SCOPE_AGENT
#define LDS_WAIT() asm volatile("s_waitcnt lgkmcnt(0)" ::: "memory")
#define VM_WAIT() asm volatile("s_waitcnt vmcnt(0)" ::: "memory")

constexpr int NWAVES = 8;
constexpr int D = 1024, M = 16384, SEQ = 2048, NBATCH = 8, MS = 128, DIN = 2816, DSH = 1792, DB = 512, FF = 4096, NMEM = 256;
constexpr float RMS_EPS = 1e-6f, LN_EPS = 1e-5f, GN_EPS = 64e-5f;
constexpr size_t O_Y = 0, O_YS = 16777216, O_MK = 16908288, O_MV = 19005440, O_SHP = 21102592, O_WKVP = 21116928, O_CVP = 21379072, O_SHS = 21903360, O_WKVS = 22132736, O_CVS = 26327040, O_END = 26392576;
constexpr size_t MiB = 1u << 20, KiB = 1024;
constexpr size_t WS_CTL = 0, CTL_ZERO_BYTES = 1 * MiB;
constexpr size_t WS_WCAT = 2 * MiB;
constexpr size_t WS_WOUT = 12 * MiB, WS_WQ = 14 * MiB, WS_WO = 16 * MiB, WS_WUP = 18 * MiB, WS_WDN = 26 * MiB;
constexpr size_t WS_SMALL = 34 * MiB;
constexpr size_t WS_ACAT = 36 * MiB;
constexpr size_t WS_ZA = 73 * MiB;
constexpr size_t WS_PB = 105 * MiB;
constexpr size_t WS_Q = 105 * MiB, WS_OB = 137 * MiB;
constexpr size_t WS_SCN = 161 * MiB;
constexpr size_t WS_PSCR = 169 * MiB, WS_HID = 201 * MiB;
constexpr size_t WS_G = 353 * MiB;
constexpr size_t WS_MIX = 369 * MiB;
constexpr size_t WS_KB = 401 * MiB, WS_VT = 405 * MiB;
constexpr size_t WS_SMP = 409 * MiB;
constexpr size_t SM_ZA = 0, SM_MIX = 256 * KiB, SM_X1 = 512 * KiB, SM_X1B = 1024 * KiB, SM_Q = 1280 * KiB, SM_O = 1792 * KiB, SM_X2 = 2048 * KiB, SM_X2B = 2560 * KiB, SM_HID = 3072 * KiB, SM_X3 = 4096 * KiB;
constexpr size_t WS_NEW = 416 * MiB;
constexpr size_t WS_END = 505 * MiB;
constexpr int CW_TMO = 0, CW_CODE = 1, CW_BAR = 4096, CW_SUB = 8192, CW_QATT = 8256, CW_QMIX = 8320, CW_PAN = 12288;
constexpr int RS_OFF = 65536, RS_STRIDE = 16640;
constexpr int RING_BYTES = 131072, LDSCTL_OFF = RING_BYTES, MISC_OFF = LDSCTL_OFF + 320, LDS_BYTES = 147456;

__device__ __forceinline__ float bf_lo(unsigned u) { return __uint_as_float(u << 16); }
__device__ __forceinline__ float bf_hi(unsigned u) { return __uint_as_float(u & 0xffff0000u); }
__device__ __forceinline__ float bf1(bf16 v) { return __uint_as_float(((unsigned)v) << 16); }
__device__ __forceinline__ unsigned pk2(float lo, float hi) { return pg8::cvt_pk_bf16(lo, hi); }
__device__ __forceinline__ f32x4 bf4(u32x2 v) { return (f32x4){bf_lo(v.x), bf_hi(v.x), bf_lo(v.y), bf_hi(v.y)}; }
__device__ __forceinline__ u32x2 pk4(f32x4 v) { u32x2 r; r.x = pk2(v.x, v.y); r.y = pk2(v.z, v.w); return r; }
__device__ __forceinline__ float fast_exp(float x) { return __builtin_amdgcn_exp2f(x * 1.44269504089f); }
__device__ __forceinline__ float fast_log(float x) { return __builtin_amdgcn_logf(x) * 0.69314718056f; }
__device__ __forceinline__ float fast_sigmoid(float x) { return __builtin_amdgcn_rcpf(1.0f + fast_exp(-x)); }
__device__ __forceinline__ float fast_tanh(float x) { return 1.0f - 2.0f * __builtin_amdgcn_rcpf(fast_exp(2.0f * x) + 1.0f); }
template <int CTRL> __device__ __forceinline__ float dpp_mov(float x) { return __builtin_bit_cast(float, __builtin_amdgcn_mov_dpp(__builtin_bit_cast(int, x), CTRL, 0xf, 0xf, true)); }
__device__ __forceinline__ float red4(float x) { x += dpp_mov<0xB1>(x); x += dpp_mov<0x4E>(x); return x; }
__device__ __forceinline__ float red8(float x) { x = red4(x); x += dpp_mov<0x141>(x); return x; }
__device__ __forceinline__ float red16(float x) { x = red8(x); x += dpp_mov<0x128>(x); return x; }
__device__ __forceinline__ float wave_sum(float v) {
#pragma unroll
    for (int o = 1; o < 64; o <<= 1) v += __shfl_xor(v, o);
    return v;
}
__device__ __forceinline__ float wave_max(float v) {
#pragma unroll
    for (int o = 1; o < 64; o <<= 1) v = fmaxf(v, __shfl_xor(v, o));
    return v;
}

#define XB_TMO      128
#define XB_XCNT(j)  (256  + 64 * (j))
#define XB_XSUB(j)  (1280 + 64 * (j))
#define XB_XGEN(j)  (2304 + 64 * (j))
#define XB_TOP      3328
#define XB_TOPGEN   3392
#define XCD_BAR_WORDS 3456
#define XB_SPIN_CAP (1u << 18)
__device__ __forceinline__ unsigned xb_ld(unsigned* p)              { return __hip_atomic_load(p, __ATOMIC_RELAXED, __HIP_MEMORY_SCOPE_AGENT); }
__device__ __forceinline__ unsigned xb_add(unsigned* p, unsigned v) { return __hip_atomic_fetch_add(p, v, __ATOMIC_RELAXED, __HIP_MEMORY_SCOPE_AGENT); }
__device__ __forceinline__ unsigned xb_xcc_id() { return (unsigned)__builtin_amdgcn_s_getreg((3 << 11) | 20) & 0xFu; }
#define XB_SPIN(cond, bar) do { unsigned _sp = 0; while (cond) { __builtin_amdgcn_s_sleep(1); \
    if ((++_sp & 255u) == 0u) { if (xb_ld(&(bar)[XB_TMO])) break; if (_sp > XB_SPIN_CAP) { atomicAdd(&(bar)[XB_TMO], 1u); break; } } } } while (0)
struct XcdBarrier { unsigned* bar; unsigned x; volatile LAS unsigned* st; };
__device__ __forceinline__ XcdBarrier xcd_barrier_post(unsigned* bar, volatile LAS unsigned* st) {
    XcdBarrier b; b.bar = bar; b.x = xb_xcc_id(); b.st = st;
    if (threadIdx.x == 0) (void)xb_add(&bar[XB_XCNT(b.x)], 1u);
    return b;
}
__device__ __forceinline__ void xcd_barrier_complete(unsigned* bar, unsigned x, unsigned& nloc, unsigned& nx) {
    const unsigned G = gridDim.x * gridDim.y * gridDim.z;
    unsigned sum, cnt, mine, sp = 0u;
    for (;;) {
        sum = 0u; cnt = 0u; mine = 0u;
#pragma unroll
        for (unsigned j = 0; j < 16; ++j) { const unsigned c = xb_ld(&bar[XB_XCNT(j)]); sum += c; cnt += (c > 0u) ? 1u : 0u; mine = (j == x) ? c : mine; }
        if (sum == G) break;
        __builtin_amdgcn_s_sleep(1);
        if ((++sp & 255u) == 0u) { if (xb_ld(&bar[XB_TMO])) break; if (sp > XB_SPIN_CAP) { atomicAdd(&bar[XB_TMO], 1u); break; } }
    }
    nloc = mine > 0u ? mine : 1u; nx = cnt > 0u ? cnt : 1u;
}
__device__ __forceinline__ void xcd_barrier(const XcdBarrier& b) {
    asm volatile("s_waitcnt vmcnt(0)" ::: "memory");
    __syncthreads();
    if (threadIdx.x == 0) {
        unsigned* bar = b.bar;
        __builtin_amdgcn_s_waitcnt(0);
        unsigned nloc = b.st[0], nx = b.st[1];
        if (nloc == 0u) { xcd_barrier_complete(bar, b.x, nloc, nx); b.st[0] = nloc; b.st[1] = nx; }
        const unsigned old = xb_add(&bar[XB_XSUB(b.x)], 1u);
        const unsigned gen = old / nloc;
        if (old + 1u == (gen + 1u) * nloc) {
            __builtin_amdgcn_fence(__ATOMIC_RELEASE, "agent");
            asm volatile("s_waitcnt vmcnt(0)" ::: "memory");
            const unsigned og = xb_add(&bar[XB_TOP], 1u);
            const unsigned tg = og / nx;
            if (og + 1u == (tg + 1u) * nx) xb_add(&bar[XB_TOPGEN], 1u);
            else XB_SPIN(xb_ld(&bar[XB_TOPGEN]) == tg, bar);
            __builtin_amdgcn_fence(__ATOMIC_ACQUIRE, "agent");
            xb_add(&bar[XB_XGEN(b.x)], 1u);
            asm volatile("s_waitcnt vmcnt(0)" ::: "memory");
        } else {
            XB_SPIN(xb_ld(&bar[XB_XGEN(b.x)]) == gen, bar);
            __builtin_amdgcn_fence(__ATOMIC_ACQUIRE, "agent");
            asm volatile("s_waitcnt vmcnt(0)" ::: "memory");
        }
    }
    __syncthreads();
}
__device__ __forceinline__ void sub_barrier(unsigned* cnt, unsigned* tmo, unsigned target) {
    asm volatile("s_waitcnt vmcnt(0)" ::: "memory");
    __syncthreads();
    if (threadIdx.x == 0) {
        __builtin_amdgcn_fence(__ATOMIC_RELEASE, "agent");
        asm volatile("s_waitcnt vmcnt(0)" ::: "memory");
        (void)xb_add(cnt, 1u);
        unsigned sp = 0;
        while (xb_ld(cnt) < target) { __builtin_amdgcn_s_sleep(1); if ((++sp & 255u) == 0u) { if (xb_ld(tmo)) break; if (sp > (1u << 20)) { atomicAdd(tmo, 1u); break; } } }
        __builtin_amdgcn_fence(__ATOMIC_ACQUIRE, "agent");
        asm volatile("s_waitcnt vmcnt(0)" ::: "memory");
    }
    __syncthreads();
}

__device__ __forceinline__ void p0_transpose_item(const float* W, int K, int N, bf16* WT, int row_off, const float* gk, LAS float* scr, int item, int lane) {
    const int nblk = N / 32, kb = item / nblk, nb = item % nblk, k0 = 64 * kb, n0 = 32 * nb;
    f32x4 vv[8];
#pragma unroll
    for (int i = 0; i < 8; ++i) vv[i] = __builtin_nontemporal_load((const f32x4*)(W + (size_t)(k0 + 8 * i + (lane >> 3)) * N + n0 + 4 * (lane & 7)));
    if (gk) {
#pragma unroll
        for (int i = 0; i < 8; ++i) vv[i] = vv[i] * gk[k0 + 8 * i + (lane >> 3)]; }
#pragma unroll
    for (int i = 0; i < 8; ++i) { LAS float* d = scr + (8 * i + (lane >> 3)) * 33 + 4 * (lane & 7); d[0] = vv[i][0]; d[1] = vv[i][1]; d[2] = vv[i][2]; d[3] = vv[i][3]; }
    LDS_WAIT(); asm volatile("" ::: "memory");
    const int c = lane & 7;
#pragma unroll
    for (int j = 0; j < 4; ++j) { const int n = (lane >> 3) + 8 * j; const LAS float* s = scr + (8 * c) * 33 + n;
        u32x4 o; o.x = pk2(s[0 * 33], s[1 * 33]); o.y = pk2(s[2 * 33], s[3 * 33]); o.z = pk2(s[4 * 33], s[5 * 33]); o.w = pk2(s[6 * 33], s[7 * 33]);
        *(u32x4*)(WT + (size_t)(row_off + n0 + n) * K + k0 + 8 * c) = o; }
    LDS_WAIT(); asm volatile("" ::: "memory");
}
__device__ __forceinline__ void rms_row_to_bf16(const float* xrow, const float* g, bf16* orow, int lane) {
    const f32x4* xr = (const f32x4*)xrow + lane; const f32x4* gr = (const f32x4*)g + lane;
    f32x4 v[4]; float s = 0.f;
#pragma unroll
    for (int j = 0; j < 4; ++j) { v[j] = xr[64 * j]; s += (v[j].x * v[j].x + v[j].y * v[j].y) + (v[j].z * v[j].z + v[j].w * v[j].w); }
    const float rstd = 1.f / sqrtf(wave_sum(s) * (1.f / D) + RMS_EPS);
    unsigned long long* o8 = (unsigned long long*)orow + lane;
#pragma unroll
    for (int j = 0; j < 4; ++j) { const f32x4 gg = gr[64 * j]; o8[64 * j] = (unsigned long long)pk2(v[j].x * rstd * gg.x, v[j].y * rstd * gg.y) | ((unsigned long long)pk2(v[j].z * rstd * gg.z, v[j].w * rstd * gg.w) << 32); }
}

using pg8::Unit;
struct SchedMN {
    int nM, nN, nwg, G, c; const char* A; const char* Bt; size_t ta, tb;
    __device__ __forceinline__ void init(int M_, int N_, int G_, int c_, const void* A_, size_t lda, const void* Bt_, size_t ldb) { nM = M_ / 256; nN = N_ / 256; nwg = nM * nN; G = G_; c = c_; A = (const char*)A_; Bt = (const char*)Bt_; ta = 256 * lda * 2; tb = 256 * ldb * 2; }
    __device__ __forceinline__ bool next(int i, Unit& u) const {
        const long L = (long)i * G + c; if (L >= nwg) return false;
        int wgid = (int)L; { const int q = nwg / 8, r = nwg % 8, xcd = wgid % 8, off = wgid / 8; wgid = (xcd < r ? xcd * (q + 1) : r * (q + 1) + (xcd - r) * q) + off; }
        const int nig = 8 * nN, gid = wgid / nig, fm = gid * 8, gsz = (nM - fm) < 8 ? (nM - fm) : 8;
        u.pm = fm + ((wgid % nig) % gsz); u.pn = (wgid % nig) / gsz; return true;
    }
    __device__ __forceinline__ const char* pa(const Unit& u) const { return A + (size_t)u.pm * ta; }
    __device__ __forceinline__ const char* pb(const Unit& u) const { return Bt + (size_t)u.pn * tb; }
};
struct SchedP1 {
    int G, c; const char* A; const char* Bt;
    __device__ __forceinline__ bool next(int i, Unit& u) const {
        const int L = i * G + c; if (L >= 768) return false;
        const int wgid = (L % 8) * 96 + L / 8;
        if (wgid < 704) { const int nig = 88, gid = wgid / nig, w = wgid % nig; u.pm = gid * 8 + (w & 7); u.pn = w >> 3; }
        else { const int w = wgid - 704; u.pm = 65 + (w & 7); u.pn = 11 + (w >> 3); }
        return true;
    }
    __device__ __forceinline__ const char* pa(const Unit& u) const { return A + (size_t)u.pm * (256 * 1024 * 2); }
    __device__ __forceinline__ const char* pb(const Unit& u) const { return Bt + (size_t)u.pn * (256 * 1024 * 2); }
};
struct SchedOne {
    const char* A; const char* B;
    __device__ __forceinline__ bool next(int i, Unit& u) const { if (i) return false; u.pm = 0; u.pn = 0; return true; }
    __device__ __forceinline__ const char* pa(const Unit&) const { return A; }
    __device__ __forceinline__ const char* pb(const Unit&) const { return B; }
};

typedef GAS bf16 gbf16; typedef GAS float gf32;
__device__ __forceinline__ void st16(gbf16* p, f32x4 v0, f32x4 v1) { u32x4 w; w.x = pk2(v0[0], v0[1]); w.y = pk2(v0[2], v0[3]); w.z = pk2(v1[0], v1[1]); w.w = pk2(v1[2], v1[3]); *(GAS u32x4*)p = w; }
struct EpiP1 {
    static constexpr bool PERM = true, AFTER_DRAIN = false;
    bf16* ZA; bf16* PB; float* outK; float* outV; bf16* KB;
    __device__ __forceinline__ void operator()(f32x4 (&acc)[2][2][4][2], const Unit& u, int wr, int wc, int fr, int fq) const {
        if (u.pm < 64) {
            const int row0 = u.pm * 256 + wr * 64 + fr; const bool act = u.pn < 4;
            gbf16* base = act ? (gbf16*)ZA : (gbf16*)PB; const int ldc = act ? 1024 : DSH; const int col0 = (act ? u.pn : u.pn - 4) * 256 + wc * 32 + 8 * fq;
#pragma unroll
            for (int ai = 0; ai < 2; ++ai)
#pragma unroll
                for (int m = 0; m < 4; ++m) { gbf16* rowp = base + (size_t)(row0 + ai * 128 + m * 16) * ldc + col0;
#pragma unroll
                    for (int bj = 0; bj < 2; ++bj) { f32x4 v0 = acc[ai][bj][m][0], v1 = acc[ai][bj][m][1];
                        if (act) { f32x2 a = pg8::gelu_pk((f32x2){v0[0], v0[1]}), b = pg8::gelu_pk((f32x2){v0[2], v0[3]}), c = pg8::gelu_pk((f32x2){v1[0], v1[1]}), d = pg8::gelu_pk((f32x2){v1[2], v1[3]});
                            v0 = (f32x4){a.x, a.y, b.x, b.y}; v1 = (f32x4){c.x, c.y, d.x, d.y}; }
                        st16(rowp + bj * 128, v0, v1); } }
        } else {
            const int row0 = (u.pm - 65) * 256 + wr * 64 + fr; const int ct = u.pn - 11; const bool isK = ct < 4; const int col0 = (ct & 3) * 256 + wc * 32 + 8 * fq;
            gf32* o = isK ? (gf32*)outK : (gf32*)outV;
#pragma unroll
            for (int ai = 0; ai < 2; ++ai)
#pragma unroll
                for (int m = 0; m < 4; ++m) { const size_t off = (size_t)(row0 + ai * 128 + m * 16) * 1024 + col0;
#pragma unroll
                    for (int bj = 0; bj < 2; ++bj) { const f32x4 v0 = acc[ai][bj][m][0], v1 = acc[ai][bj][m][1];
                        *(GAS f32x4*)(o + off + bj * 128) = v0; *(GAS f32x4*)(o + off + bj * 128 + 4) = v1;
                        if (isK) st16((gbf16*)KB + off + bj * 128, v0, v1); } }
        }
    }
};
__device__ __forceinline__ void ld8(const float* p, f32x4& a, f32x4& b) { a = *(const GAS f32x4*)((const gf32*)p); b = *(const GAS f32x4*)((const gf32*)p + 4); }
__device__ __forceinline__ void ld8(const bf16* p, f32x4& a, f32x4& b) { const u32x4 w = *(const GAS u32x4*)((const gbf16*)p); a = (f32x4){bf_lo(w.x), bf_hi(w.x), bf_lo(w.y), bf_hi(w.y)}; b = (f32x4){bf_lo(w.z), bf_hi(w.z), bf_lo(w.w), bf_hi(w.w)}; }
template <class BT> struct EpiRes {
    static constexpr bool PERM = true, AFTER_DRAIN = false;
    const BT* base; bf16* outb; float* rowss;
    __device__ __forceinline__ void operator()(f32x4 (&acc)[2][2][4][2], const Unit& u, int wr, int wc, int fr, int fq) const {
        const int row0 = u.pm * 256 + wr * 64 + fr, col0 = u.pn * 256 + wc * 32 + 8 * fq;
#pragma unroll
        for (int ai = 0; ai < 2; ++ai)
#pragma unroll
            for (int m = 0; m < 4; ++m) { const int r = row0 + ai * 128 + m * 16; const size_t off = (size_t)r * 1024 + col0; float ss = 0.f;
#pragma unroll
                for (int bj = 0; bj < 2; ++bj) { f32x4 b0, b1; ld8(base + off + bj * 128, b0, b1);
                    const f32x4 v0 = acc[ai][bj][m][0] + b0, v1 = acc[ai][bj][m][1] + b1;
                    st16((gbf16*)outb + off + bj * 128, v0, v1);
                    ss += (v0[0] * v0[0] + v0[1] * v0[1]) + (v0[2] * v0[2] + v0[3] * v0[3]) + (v1[0] * v1[0] + v1[1] * v1[1]) + (v1[2] * v1[2] + v1[3] * v1[3]); }
                ss += __shfl_xor(ss, 16); ss += __shfl_xor(ss, 32);
                if (fq == 0) (void)__hip_atomic_fetch_add(rowss + r, ss, __ATOMIC_RELAXED, __HIP_MEMORY_SCOPE_AGENT); }
    }
};
struct EpiFinal {
    static constexpr bool PERM = true, AFTER_DRAIN = false;
    const bf16* base; float* out; const float* gain; float* rowss; unsigned* cnt; unsigned* tmo;
    __device__ __forceinline__ void operator()(f32x4 (&acc)[2][2][4][2], const Unit& u, int wr, int wc, int fr, int fq) const {
        const int row0 = u.pm * 256 + wr * 64 + fr, col0 = u.pn * 256 + wc * 32 + 8 * fq;
#pragma unroll
        for (int ai = 0; ai < 2; ++ai)
#pragma unroll
            for (int m = 0; m < 4; ++m) { const int r = row0 + ai * 128 + m * 16; const size_t off = (size_t)r * 1024 + col0; float ss = 0.f;
#pragma unroll
                for (int bj = 0; bj < 2; ++bj) { f32x4 b0, b1; ld8(base + off + bj * 128, b0, b1);
                    const f32x4 v0 = acc[ai][bj][m][0] + b0, v1 = acc[ai][bj][m][1] + b1; acc[ai][bj][m][0] = v0; acc[ai][bj][m][1] = v1;
                    ss += (v0[0] * v0[0] + v0[1] * v0[1]) + (v0[2] * v0[2] + v0[3] * v0[3]) + (v1[0] * v1[0] + v1[1] * v1[1]) + (v1[2] * v1[2] + v1[3] * v1[3]); }
                ss += __shfl_xor(ss, 16); ss += __shfl_xor(ss, 32);
                if (fq == 0) (void)__hip_atomic_fetch_add(rowss + r, ss, __ATOMIC_RELAXED, __HIP_MEMORY_SCOPE_AGENT); }
        asm volatile("s_waitcnt vmcnt(0)" ::: "memory");
        unsigned* c = cnt + 64 * u.pm;
        if ((threadIdx.x & 63) == 0) (void)xb_add(c, 1u);
        { unsigned sp = 0; while (xb_ld(c) < 32u) { __builtin_amdgcn_s_sleep(1); if ((++sp & 255u) == 0u) { if (xb_ld(tmo)) break; if (sp > (1u << 20)) { atomicAdd(tmo, 1u); break; } } } }
        f32x4 g[2][2];
#pragma unroll
        for (int bj = 0; bj < 2; ++bj) { g[bj][0] = *(const GAS f32x4*)((const gf32*)gain + col0 + bj * 128); g[bj][1] = *(const GAS f32x4*)((const gf32*)gain + col0 + bj * 128 + 4); }
#pragma unroll
        for (int ai = 0; ai < 2; ++ai)
#pragma unroll
            for (int m = 0; m < 4; ++m) { const int r = row0 + ai * 128 + m * 16; const size_t off = (size_t)r * 1024 + col0;
                const float sc = 1.f / sqrtf(__hip_atomic_load(rowss + r, __ATOMIC_RELAXED, __HIP_MEMORY_SCOPE_AGENT) * (1.f / D) + RMS_EPS);
#pragma unroll
                for (int bj = 0; bj < 2; ++bj) { __builtin_nontemporal_store(acc[ai][bj][m][0] * sc * g[bj][0], (GAS f32x4*)((gf32*)out + off + bj * 128)); __builtin_nontemporal_store(acc[ai][bj][m][1] * sc * g[bj][1], (GAS f32x4*)((gf32*)out + off + bj * 128 + 4)); } }
    }
};
template <int MODE> struct EpiScale {
    static constexpr bool PERM = true, AFTER_DRAIN = false;
    bf16* O; int ldc; const float* rowss;
    __device__ __forceinline__ void operator()(f32x4 (&acc)[2][2][4][2], const Unit& u, int wr, int wc, int fr, int fq) const {
        const int row0 = u.pm * 256 + wr * 64 + fr, col0 = u.pn * 256 + wc * 32 + 8 * fq;
#pragma unroll
        for (int ai = 0; ai < 2; ++ai)
#pragma unroll
            for (int m = 0; m < 4; ++m) { const int r = row0 + ai * 128 + m * 16;
                float sc = 1.f / sqrtf(__hip_atomic_load(rowss + r, __ATOMIC_RELAXED, __HIP_MEMORY_SCOPE_AGENT) * (1.f / D) + RMS_EPS); if (MODE == 0) sc *= 0.0625f;
                gbf16* rowp = (gbf16*)O + (size_t)r * ldc + col0;
#pragma unroll
                for (int bj = 0; bj < 2; ++bj) { f32x4 v0 = acc[ai][bj][m][0] * sc, v1 = acc[ai][bj][m][1] * sc;
                    if (MODE == 1) {
#pragma unroll
                        for (int j = 0; j < 4; ++j) { const float a = fmaxf(v0[j], 0.f), b = fmaxf(v1[j], 0.f); v0[j] = a * a; v1[j] = b * b; } }
                    st16(rowp + bj * 128, v0, v1); } }
    }
};
struct EpiQS {
    static constexpr bool PERM = true, AFTER_DRAIN = false;
    bf16* QS; const float* rowss;
    __device__ __forceinline__ void operator()(f32x4 (&acc)[2][2][4][2], const Unit& u, int wr, int wc, int fr, int fq) const {
#pragma unroll
        for (int ai = 0; ai < 2; ++ai)
#pragma unroll
            for (int m = 0; m < 4; ++m) { const int rl = ai * 128 + wr * 64 + m * 16 + fr;
                const float sc = 0.0625f / sqrtf(__hip_atomic_load(rowss + u.pm * 256 + rl, __ATOMIC_RELAXED, __HIP_MEMORY_SCOPE_AGENT) * (1.f / D) + RMS_EPS);
                gbf16* rowp = (gbf16*)QS + (size_t)rl * 256 + wc * 32 + 8 * fq;
#pragma unroll
                for (int bj = 0; bj < 2; ++bj) st16(rowp + bj * 128, acc[ai][bj][m][0] * sc, acc[ai][bj][m][1] * sc); }
    }
};
struct EpiSoftmax {
    static constexpr bool PERM = true, AFTER_DRAIN = true;
    bf16* P;
    __device__ __forceinline__ void fused(f32x4 (&acc)[2][2][4][2], const Unit&, int wr, int wc, int fr, int fq, PG8_LAS unsigned char* lds, int, int) const {
        PG8_LAS float* T1 = (PG8_LAS float*)lds; PG8_LAS float* T2 = (PG8_LAS float*)(lds + 4096);
#pragma unroll
        for (int ai = 0; ai < 2; ++ai)
#pragma unroll
            for (int m = 0; m < 4; ++m) { float mx = -3.0e38f;
#pragma unroll
                for (int bj = 0; bj < 2; ++bj)
#pragma unroll
                    for (int n = 0; n < 2; ++n) { const f32x4 x = acc[ai][bj][m][n]; mx = fmaxf(mx, fmaxf(fmaxf(x[0], x[1]), fmaxf(x[2], x[3]))); }
                mx = fmaxf(mx, __shfl_xor(mx, 16)); mx = fmaxf(mx, __shfl_xor(mx, 32));
                if (fq == 0) T1[(ai * 128 + wr * 64 + m * 16 + fr) * 4 + wc] = mx; }
        asm volatile("s_waitcnt lgkmcnt(0)" ::: "memory"); __builtin_amdgcn_s_barrier(); asm volatile("" ::: "memory");
#pragma unroll
        for (int ai = 0; ai < 2; ++ai)
#pragma unroll
            for (int m = 0; m < 4; ++m) { const int row = ai * 128 + wr * 64 + m * 16 + fr; const f32x4 t = *(const PG8_LAS f32x4*)(T1 + row * 4);
                const float mxr = fmaxf(fmaxf(t[0], t[1]), fmaxf(t[2], t[3])) * 1.44269504089f; float sum = 0.f;
#pragma unroll
                for (int bj = 0; bj < 2; ++bj)
#pragma unroll
                    for (int n = 0; n < 2; ++n) { f32x4 x = acc[ai][bj][m][n];
#pragma unroll
                        for (int j = 0; j < 4; ++j) { x[j] = __builtin_amdgcn_exp2f(x[j] * 1.44269504089f - mxr); sum += x[j]; }
                        acc[ai][bj][m][n] = x; }
                sum += __shfl_xor(sum, 16); sum += __shfl_xor(sum, 32);
                if (fq == 0) T2[row * 4 + wc] = sum; }
        asm volatile("s_waitcnt lgkmcnt(0)" ::: "memory"); __builtin_amdgcn_s_barrier(); asm volatile("" ::: "memory");
#pragma unroll
        for (int ai = 0; ai < 2; ++ai)
#pragma unroll
            for (int m = 0; m < 4; ++m) { const int row = ai * 128 + wr * 64 + m * 16 + fr; const f32x4 t = *(const PG8_LAS f32x4*)(T2 + row * 4);
                const float inv = 1.f / ((t[0] + t[1]) + (t[2] + t[3]));
                gbf16* rowp = (gbf16*)P + (size_t)row * 256 + wc * 32 + 8 * fq;
#pragma unroll
                for (int bj = 0; bj < 2; ++bj) st16(rowp + bj * 128, acc[ai][bj][m][0] * inv, acc[ai][bj][m][1] * inv); }
        asm volatile("s_waitcnt vmcnt(0) lgkmcnt(0)" ::: "memory"); __builtin_amdgcn_s_barrier(); asm volatile("" ::: "memory");
    }
};
struct EpiAttnO {
    static constexpr bool PERM = true, AFTER_DRAIN = false;
    bf16* O;
    __device__ __forceinline__ void operator()(f32x4 (&acc)[2][2][4][2], const Unit&, int wr, int wc, int fr, int fq) const {
#pragma unroll
        for (int ai = 0; ai < 2; ++ai)
#pragma unroll
            for (int m = 0; m < 4; ++m) { gbf16* rowp = (gbf16*)O + (size_t)(ai * 128 + wr * 64 + m * 16 + fr) * 1024 + wc * 32 + 8 * fq;
#pragma unroll
                for (int bj = 0; bj < 2; ++bj) st16(rowp + bj * 128, acc[ai][bj][m][0], acc[ai][bj][m][1]); }
    }
};

__device__ __forceinline__ void mixer_a_tile(LAS unsigned char* lds, int tile, const bf16* ZA, const bf16* WSB, const float* gm_ln_g, const float* gm_ln_b, const float* gm_bs, bf16* MIX, float* out_cv, int tid, int wave, int lane) {
    const int h = tile & 3, bc = tile >> 2, m0 = bc * 128, fr = lane & 15, fq = lane >> 4; const bool lastc = (bc & 15) == 15;
    LAS bf16* VT = (LAS bf16*)lds;
    {   const int r = 16 * wave + (lane >> 2), cq = (lane & 3) * 32; const bf16* src = ZA + (size_t)(m0 + r) * 1024 + 512 + h * 128 + cq;
        float x[32]; float s = 0.f;
#pragma unroll
        for (int j = 0; j < 4; ++j) { const u32x4 pv = __builtin_nontemporal_load((const u32x4*)(src + 8 * j));
            x[8 * j + 0] = bf_lo(pv.x); x[8 * j + 1] = bf_hi(pv.x); x[8 * j + 2] = bf_lo(pv.y); x[8 * j + 3] = bf_hi(pv.y); x[8 * j + 4] = bf_lo(pv.z); x[8 * j + 5] = bf_hi(pv.z); x[8 * j + 6] = bf_lo(pv.w); x[8 * j + 7] = bf_hi(pv.w); }
#pragma unroll
        for (int j = 0; j < 32; ++j) s += x[j];
        const float mean = red4(s) * (1.f / 128.f); float q = 0.f;
#pragma unroll
        for (int j = 0; j < 32; ++j) { x[j] -= mean; q += x[j] * x[j]; }
        const float rstd = 1.f / sqrtf(red4(q) * (1.f / 128.f) + LN_EPS);
#pragma unroll
        for (int j = 0; j < 8; ++j) { const f32x4 g = *(const f32x4*)(gm_ln_g + h * 128 + cq + 4 * j), bb = *(const f32x4*)(gm_ln_b + h * 128 + cq + 4 * j);
#pragma unroll
            for (int e = 0; e < 4; ++e) x[4 * j + e] = x[4 * j + e] * rstd * g[e] + bb[e]; }
        if (lastc) { float* o = out_cv + ((size_t)((bc >> 4) * 128 + r) * 4 + h) * 128 + cq;
#pragma unroll
            for (int j = 0; j < 8; ++j) *(f32x4*)(o + 4 * j) = (f32x4){x[4 * j], x[4 * j + 1], x[4 * j + 2], x[4 * j + 3]}; }
#pragma unroll
        for (int j = 0; j < 32; j += 2) { const unsigned w = pk2(x[j], x[j + 1]); VT[(cq + j) * 136 + r] = (bf16)(w & 0xffffu); VT[(cq + j + 1) * 136 + r] = (bf16)(w >> 16); }
    }
    const int t_ = 16 * wave + fr; const size_t rowo = (size_t)(m0 + t_) * 1024 + h * 128; const float bsv = gm_bs[h * 128 + t_];
    u32x2 uq[8];
#pragma unroll
    for (int n = 0; n < 8; ++n) uq[n] = *(const u32x2*)(ZA + rowo + 16 * n + 4 * fq);
    bf16x8 wsf[4];
#pragma unroll
    for (int ks = 0; ks < 4; ++ks) wsf[ks] = *(const bf16x8*)(WSB + (size_t)(h * 128 + 16 * wave + fr) * 128 + 32 * ks + 8 * fq);
    __syncthreads();
    f32x4 acc[8];
#pragma unroll
    for (int n = 0; n < 8; ++n) acc[n] = (f32x4){0.f, 0.f, 0.f, 0.f};
    const int nks = (wave >> 1) + 1;
#pragma unroll
    for (int ks = 0; ks < 4; ++ks) if (ks < nks) {
#pragma unroll
        for (int n = 0; n < 8; ++n) { const bf16x8 vf = *(const LAS bf16x8*)(VT + (16 * n + fr) * 136 + 32 * ks + 8 * fq); acc[n] = __builtin_amdgcn_mfma_f32_16x16x32_bf16(vf, wsf[ks], acc[n], 0, 0, 0); }
    }
#pragma unroll
    for (int n = 0; n < 8; ++n) *(u32x2*)(MIX + rowo + 16 * n + 4 * fq) = pk4(bf4(uq[n]) * (acc[n] + bsv));
    __syncthreads();
}


typedef short bf16x4 __attribute__((ext_vector_type(4)));
#define MFMA32(a, b, c) __builtin_amdgcn_mfma_f32_16x16x32_bf16(a, b, c, 0, 0, 0)
#define MFMA16(a, b, c) __builtin_amdgcn_mfma_f32_16x16x16bf16_1k(a, b, c, 0, 0, 0)
constexpr int CP = 72;
constexpr int L_LW = 0, L_LA = 17408, L_LG = 34816;
constexpr int L_LAB = 0, L_LAK = 9216, L_MRB = 18432, L_MRK = 27648, L_TDD = 36864;
constexpr int L_AT = 52224, L_BT = 61440, L_KT = 70656, L_RT = 79872;
constexpr int L_WT = 52224, L_APT = 61440;
constexpr int L_ATT = 89088, L_VTT = 98304, L_BHT = 107520, L_KHT = 116736;
constexpr int L_EXCH = 125952, L_PC = 128000;
constexpr size_t TASK_BYTES = 32768;

__device__ __forceinline__ float wave_sum_dpp(float x) {
    x = red16(x); const int xi = __builtin_bit_cast(int, x);
    const float a = __builtin_bit_cast(float, __builtin_amdgcn_readlane(xi, 0)), b = __builtin_bit_cast(float, __builtin_amdgcn_readlane(xi, 16)), c = __builtin_bit_cast(float, __builtin_amdgcn_readlane(xi, 32)), d = __builtin_bit_cast(float, __builtin_amdgcn_readlane(xi, 48));
    return (a + b) + (c + d);
}
__device__ __forceinline__ bf16x4 pack4(f32x4 v) { const u32x2 r = pk4(v); return __builtin_bit_cast(bf16x4, r); }
__device__ __forceinline__ bf16x8 ldsfrag(const LAS unsigned char* lds, int off, int row, int col) { return *(const LAS bf16x8*)(lds + off + (row * CP + col) * 2); }

#ifdef PROBE_CSPAN_A
#define CST(k) do { if (h == CST_H && blockIdx.x == 64 && threadIdx.x == 0) *(volatile LAS unsigned long long*)(lds + 140000 + 8 * (k)) = __builtin_amdgcn_s_memrealtime(); } while (0)
#else
#define CST(k) do { } while (0)
#endif
__device__ __forceinline__ void rwkv_chunk_prep(LAS unsigned char* lds, int bc, const bf16* PB, const bf16* ZROW, const float* mu, const bf16* W2T, const bf16* A2T, const bf16* G2T,
                                                const float* w0, const float* a0, const float* k_k, const float* k_a, const float* r_k, bf16* LAIN, unsigned char* TASKS, bf16* G, bf16* VS, float* BON,
                                                int tid, int wave, int lane) {
    const int b = bc >> 5, c = bc & 31, m0 = b * SEQ + c * 64, fr = lane & 15, fq = lane >> 4;
    {   const int r = tid >> 3, cg = (tid & 7) * 32, m = m0 + r;
        const bf16* prow = PB + (size_t)m * DSH + 1536 + cg; const bf16* qrow = ((m & (SEQ - 1)) == 0) ? ZROW : (PB + (size_t)(m - 1) * DSH + 1536 + cg);
        const int mode = cg < 64 ? 0 : (cg < 128 ? 1 : 2);
#pragma unroll
        for (int j = 0; j < 4; ++j) {
            const u32x4 pv = *(const u32x4*)(prow + 8 * j), qv = *(const u32x4*)(qrow + 8 * j);
            const f32x4 m0v = *(const f32x4*)(mu + 1536 + cg + 8 * j), m1v = *(const f32x4*)(mu + 1536 + cg + 8 * j + 4);
            float x[8];
            { const float p0 = bf_lo(pv.x), p1 = bf_hi(pv.x), p2 = bf_lo(pv.y), p3 = bf_hi(pv.y), p4 = bf_lo(pv.z), p5 = bf_hi(pv.z), p6 = bf_lo(pv.w), p7 = bf_hi(pv.w);
              const float q0 = bf_lo(qv.x), q1 = bf_hi(qv.x), q2 = bf_lo(qv.y), q3 = bf_hi(qv.y), q4 = bf_lo(qv.z), q5 = bf_hi(qv.z), q6 = bf_lo(qv.w), q7 = bf_hi(qv.w);
              x[0] = p0 + (q0 - p0) * m0v[0]; x[1] = p1 + (q1 - p1) * m0v[1]; x[2] = p2 + (q2 - p2) * m0v[2]; x[3] = p3 + (q3 - p3) * m0v[3];
              x[4] = p4 + (q4 - p4) * m1v[0]; x[5] = p5 + (q5 - p5) * m1v[1]; x[6] = p6 + (q6 - p6) * m1v[2]; x[7] = p7 + (q7 - p7) * m1v[3]; }
#pragma unroll
            for (int e = 0; e < 8; ++e) x[e] = mode == 0 ? fast_tanh(x[e]) : (mode == 1 ? x[e] : fast_sigmoid(x[e]));
            u32x4 o; o.x = pk2(x[0], x[1]); o.y = pk2(x[2], x[3]); o.z = pk2(x[4], x[5]); o.w = pk2(x[6], x[7]);
            *(u32x4*)(LAIN + r * 256 + cg + 8 * j) = o;
        }
    }
    VM_WAIT(); __syncthreads();
    bf16x8 lainW[2], lainA[2], lainG[4];
    {   const bf16* arow = LAIN + (16 * (wave >> 1) + fr) * 256 + 8 * fq;
#pragma unroll
        for (int ks = 0; ks < 2; ++ks) { lainW[ks] = *(const bf16x8*)(arow + 32 * ks); lainA[ks] = *(const bf16x8*)(arow + 64 + 32 * ks); }
#pragma unroll
        for (int ks = 0; ks < 4; ++ks) lainG[ks] = *(const bf16x8*)(arow + 128 + 32 * ks); }
#pragma unroll 1
    for (int h = 0; h < 8; ++h) {
        CST(0);
        {   const int mt = wave >> 1;
            bf16x8 wW[2][2], wA[2][2], wG[2][4];
#pragma unroll
            for (int q = 0; q < 2; ++q) { const int wrow = 64 * h + 16 * ((wave & 1) * 2 + q) + fr;
#pragma unroll
                for (int ks = 0; ks < 2; ++ks) { wW[q][ks] = *(const bf16x8*)(W2T + (size_t)wrow * 64 + 32 * ks + 8 * fq); wA[q][ks] = *(const bf16x8*)(A2T + (size_t)wrow * 64 + 32 * ks + 8 * fq); }
#pragma unroll
                for (int ks = 0; ks < 4; ++ks) wG[q][ks] = *(const bf16x8*)(G2T + (size_t)wrow * 128 + 32 * ks + 8 * fq); }
#pragma unroll
            for (int q = 0; q < 2; ++q) { const int nt = (wave & 1) * 2 + q;
                f32x4 aw = (f32x4){0.f, 0.f, 0.f, 0.f}, aa = aw, ag = aw;
#pragma unroll
                for (int ks = 0; ks < 2; ++ks) { aw = MFMA32(wW[q][ks], lainW[ks], aw); aa = MFMA32(wA[q][ks], lainA[ks], aa); }
#pragma unroll
                for (int ks = 0; ks < 4; ++ks) ag = MFMA32(wG[q][ks], lainG[ks], ag);
                const int o = ((16 * mt + fr) * 68 + 16 * nt + 4 * fq) * 4;
                *(LAS f32x4*)(lds + L_LW + o) = aw; *(LAS f32x4*)(lds + L_LA + o) = aa; *(LAS f32x4*)(lds + L_LG + o) = ag; }
        }
        __syncthreads();
        CST(1);
        {   const int ch = 64 * h + lane;
            const float mur = mu[ch], muk = mu[512 + ch], muv = mu[1024 + ch], w0c = w0[ch], a0c = a0[ch], kkc = k_k[ch], kac = k_a[ch], rkc = r_k[ch];
            float rs[8], kp[8], vs[8], av[8], bv[8], wd[8], cwl[8]; float run = 0.f;
#pragma unroll
            for (int i = 0; i < 8; ++i) { const int p = 8 * wave + i, m = m0 + p; const bf16* prow = PB + (size_t)m * DSH + ch; const bool first = (m & (SEQ - 1)) == 0; const bf16* qrow = first ? ZROW : (prow - DSH);
                const float pr = bf1(prow[0]), pk = bf1(prow[512]), pvv = bf1(prow[1024]); const float qr = bf1(qrow[0]), qk = bf1(first ? qrow[0] : qrow[512]), qv = bf1(first ? qrow[0] : qrow[1024]);
                rs[i] = pr + (qr - pr) * mur; const float ks = pk + (qk - pk) * muk; vs[i] = pvv + (qv - pvv) * muv;
                const float lw = *(const LAS float*)(lds + L_LW + (p * 68 + lane) * 4), la = *(const LAS float*)(lds + L_LA + (p * 68 + lane) * 4), lg = *(const LAS float*)(lds + L_LG + (p * 68 + lane) * 4);
                const float z = -(w0c + lw), sp = fmaxf(z, 0.f) + fast_log(1.f + fast_exp(-fabsf(z)));
                wd[i] = -fast_exp(-sp - 0.5f);
                const float as = fast_sigmoid(a0c + la);
                const float kkr = ks * kkc; const float n2 = wave_sum_dpp(kkr * kkr); const float kk = kkr * __builtin_amdgcn_rsqf(fmaxf(n2, 1e-24f));
                kp[i] = ks * (1.f + (as - 1.f) * kac); av[i] = -kk; bv[i] = kk * as;
                const float bon = wave_sum_dpp(rs[i] * kp[i] * rkc);
                run += wd[i]; cwl[i] = run;
                G[(size_t)m * DB + ch] = (bf16)(pk2(lg, 0.f) & 0xffffu); VS[(size_t)m * DB + ch] = (bf16)(pk2(vs[i], 0.f) & 0xffffu);
                if (lane == 0) BON[(size_t)m * 8 + h] = bon; }
            *(LAS float*)(lds + L_EXCH + (wave * 64 + lane) * 4) = run;
            __syncthreads();
            CST(2);
            float base = 0.f, tot = 0.f;
#pragma unroll
            for (int w2 = 0; w2 < 8; ++w2) { const float t = *(const LAS float*)(lds + L_EXCH + (w2 * 64 + lane) * 4); tot += t; if (w2 < wave) base += t; }
            float oA[8], oV[8], oBh[8], oKh[8];
#pragma unroll
            for (int i = 0; i < 8; ++i) { const int p = 8 * wave + i; const float cw = base + cwl[i];
                const float e1 = fast_exp(cw - wd[i]), e2 = fast_exp(cw), e3 = __builtin_amdgcn_rcpf(e2), e4 = fast_exp(tot - cw);
                const float At = av[i] * e1, Rt = rs[i] * e2, Bt = bv[i] * e3, Kt = kp[i] * e3;
                oA[i] = At; oV[i] = vs[i]; oBh[i] = bv[i] * e4; oKh[i] = kp[i] * e4;
                *(LAS bf16*)(lds + L_AT + (p * CP + lane) * 2) = (bf16)(pk2(At, 0.f) & 0xffffu); *(LAS bf16*)(lds + L_BT + (p * CP + lane) * 2) = (bf16)(pk2(Bt, 0.f) & 0xffffu);
                *(LAS bf16*)(lds + L_KT + (p * CP + lane) * 2) = (bf16)(pk2(Kt, 0.f) & 0xffffu); *(LAS bf16*)(lds + L_RT + (p * CP + lane) * 2) = (bf16)(pk2(Rt, 0.f) & 0xffffu); }
            { u32x4 o; const int off = (lane * CP + 8 * wave) * 2;
              o.x = pk2(oA[0], oA[1]); o.y = pk2(oA[2], oA[3]); o.z = pk2(oA[4], oA[5]); o.w = pk2(oA[6], oA[7]); *(LAS u32x4*)(lds + L_ATT + off) = o;
              o.x = pk2(oV[0], oV[1]); o.y = pk2(oV[2], oV[3]); o.z = pk2(oV[4], oV[5]); o.w = pk2(oV[6], oV[7]); *(LAS u32x4*)(lds + L_VTT + off) = o;
              o.x = pk2(oBh[0], oBh[1]); o.y = pk2(oBh[2], oBh[3]); o.z = pk2(oBh[4], oBh[5]); o.w = pk2(oBh[6], oBh[7]); *(LAS u32x4*)(lds + L_BHT + off) = o;
              o.x = pk2(oKh[0], oKh[1]); o.y = pk2(oKh[2], oKh[3]); o.z = pk2(oKh[4], oKh[5]); o.w = pk2(oKh[6], oKh[7]); *(LAS u32x4*)(lds + L_KHT + off) = o; }
            if (wave == 0) *(LAS float*)(lds + L_PC + lane * 4) = fast_exp(tot);
        }
        __syncthreads();
        CST(3);
        {   const int ty = wave >> 1;
#pragma unroll
            for (int prod = 0; prod < 4; ++prod) { const int xo = (prod & 1) ? L_KT : L_BT, yo = prod < 2 ? L_AT : L_RT, oo = prod == 0 ? L_LAB : (prod == 1 ? L_LAK : (prod == 2 ? L_MRB : L_MRK)); const bool incl = prod >= 2;
#pragma unroll
                for (int q = 0; q < 2; ++q) { const int tx = (wave & 1) * 2 + q; f32x4 acc = (f32x4){0.f, 0.f, 0.f, 0.f};
                    if (tx <= ty) {
#pragma unroll
                        for (int ks = 0; ks < 2; ++ks) acc = MFMA32(ldsfrag(lds, xo, 16 * tx + fr, 32 * ks + 8 * fq), ldsfrag(lds, yo, 16 * ty + fr, 32 * ks + 8 * fq), acc); }
                    const int i = 16 * ty + fr, j0 = 16 * tx + 4 * fq;
#pragma unroll
                    for (int e = 0; e < 4; ++e) { const int j = j0 + e; if (!(incl ? (j <= i) : (j < i))) acc[e] = 0.f; }
                    *(LAS u32x2*)(lds + oo + (i * CP + j0) * 2) = pk4(acc); } }
        }
        __syncthreads();
        CST(4);
        if (wave < 4) { const int d = wave; float t[16];
#pragma unroll
            for (int i = 0; i < 16; ++i) { const u32x4 r0 = *(const LAS u32x4*)(lds + L_LAB + ((16 * d + i) * CP + 16 * d) * 2), r1 = *(const LAS u32x4*)(lds + L_LAB + ((16 * d + i) * CP + 16 * d + 8) * 2);
                const float l[16] = {bf_lo(r0.x), bf_hi(r0.x), bf_lo(r0.y), bf_hi(r0.y), bf_lo(r0.z), bf_hi(r0.z), bf_lo(r0.w), bf_hi(r0.w), bf_lo(r1.x), bf_hi(r1.x), bf_lo(r1.y), bf_hi(r1.y), bf_lo(r1.z), bf_hi(r1.z), bf_lo(r1.w), bf_hi(r1.w)};
                float s = (i == lane) ? 1.f : 0.f;
#pragma unroll
                for (int mm = 0; mm < i; ++mm) s += l[mm] * t[mm];
                t[i] = s; }
            if (lane < 16) {
#pragma unroll
                for (int i = 0; i < 16; ++i) *(LAS bf16*)(lds + L_TDD + ((d * 16 + i) * 24 + lane) * 2) = (bf16)(pk2(t[i], 0.f) & 0xffffu); }
        }
        __syncthreads();
        CST(5);
        {   const int s = wave & 3; const bool isW = wave < 4; f32x4 acc[4];
            if (isW) {
#pragma unroll
                for (int d = 0; d < 4; ++d) { acc[d] = (f32x4){0.f, 0.f, 0.f, 0.f};
#pragma unroll
                    for (int ks = 0; ks < 2; ++ks) if (32 * ks <= 16 * d + 15) acc[d] = MFMA32(ldsfrag(lds, L_LAK, 16 * d + fr, 32 * ks + 8 * fq), ldsfrag(lds, L_VTT, 16 * s + fr, 32 * ks + 8 * fq), acc[d]); }
            } else {
#pragma unroll
                for (int d = 0; d < 4; ++d) acc[d] = bf4(*(const LAS u32x2*)(lds + L_ATT + ((16 * s + fr) * CP + 16 * d + 4 * fq) * 2));
            }
            bf16x4 xf[4]; const int oo = isW ? L_WT : L_APT;
#pragma unroll
            for (int d = 0; d < 4; ++d) {
#pragma unroll
                for (int mm = 0; mm < d; ++mm) acc[d] = MFMA16(*(const LAS bf16x4*)(lds + L_LAB + ((16 * d + fr) * CP + 16 * mm + 4 * fq) * 2), xf[mm], acc[d]);
                const f32x4 x = MFMA16(*(const LAS bf16x4*)(lds + L_TDD + ((d * 16 + fr) * 24 + 4 * fq) * 2), pack4(acc[d]), ((f32x4){0.f, 0.f, 0.f, 0.f}));
                xf[d] = pack4(x);
                *(LAS bf16x4*)(lds + oo + ((16 * s + fr) * CP + 16 * d + 4 * fq) * 2) = xf[d]; }
        }
        __syncthreads();
        CST(6);
        {   unsigned char* task = TASKS + (size_t)((b * 8 + h) * 32 + c) * TASK_BYTES; const int ty = wave >> 1;
#pragma unroll
            for (int q = 0; q < 2; ++q) { const int tx = (wave & 1) * 2 + q; const int yr = 16 * ty + fr, xc = 16 * tx + 4 * fq;
                f32x4 aM = (f32x4){0.f, 0.f, 0.f, 0.f}, aN = aM, aR = aM, aY = aM;
#pragma unroll
                for (int ks = 0; ks < 2; ++ks) { const int kc = 32 * ks + 8 * fq;
                    const bf16x8 fAP = ldsfrag(lds, L_APT, 16 * tx + fr, kc), fBHx = ldsfrag(lds, L_BHT, 16 * tx + fr, kc), fKHx = ldsfrag(lds, L_KHT, 16 * tx + fr, kc), fMRBx = ldsfrag(lds, L_MRB, 16 * tx + fr, kc), fMRKx = ldsfrag(lds, L_MRK, 16 * tx + fr, kc);
                    const bf16x8 fBHy = ldsfrag(lds, L_BHT, 16 * ty + fr, kc), fWTy = ldsfrag(lds, L_WT, 16 * ty + fr, kc), fVTy = ldsfrag(lds, L_VTT, 16 * ty + fr, kc), fMRBy = ldsfrag(lds, L_MRB, 16 * ty + fr, kc);
                    aM = MFMA32(fAP, fBHy, aM);
                    aN = MFMA32(fBHx, fWTy, aN); aN = MFMA32(fKHx, fVTy, aN);
                    aR = MFMA32(fAP, fMRBy, aR);
                    aY = MFMA32(fMRBx, fWTy, aY); aY = MFMA32(fMRKx, fVTy, aY); }
                const float pc = *(const LAS float*)(lds + L_PC + yr * 4);
#pragma unroll
                for (int e = 0; e < 4; ++e) if (xc + e == yr) aM[e] += pc;
                aR += bf4(*(const LAS u32x2*)(lds + L_RT + (yr * CP + xc) * 2));
                const size_t o = (size_t)(((ty * 64 + lane) * 4 + tx) * 8);
                *(u32x2*)(task + o) = pk4(aM); *(u32x2*)(task + 8192 + o) = pk4(aN); *(u32x2*)(task + 16384 + o) = pk4(aR); *(u32x2*)(task + 24576 + o) = pk4(aY); }
        }
        __syncthreads();
        CST(7);
    }
}

__device__ __forceinline__ void scanB_block(LAS unsigned char* lds, int bh, const unsigned char* TASKS, const bf16* G, const bf16* VS, const float* BON, const float* ln_g, const float* ln_b, bf16* MIX, float* out_wkv, int tid, int wave, int lane) {
    const int b = bh >> 3, h = bh & 7, fr = lane & 15, fq = lane >> 4;
    LAS float* YB = (LAS float*)lds;
    if (wave < 4) {
        const int s = wave;
        const GAS unsigned char* tk = (const GAS unsigned char*)TASKS + (size_t)bh * 32 * TASK_BYTES + (size_t)lane * 32;
        const GAS unsigned char* gG = (const GAS unsigned char*)G; const GAS unsigned char* gV = (const GAS unsigned char*)VS; const GAS unsigned char* gB = (const GAS unsigned char*)BON;
        struct TaskRegs { u32x4 m0[4], m1[4], r0[4], r1[4], n0, n1, y0, y1, g0, g1, v0, v1; unsigned bo; };
        TaskRegs TA, TB; bf16x4 xf[4]; f32x4 accX[4];
#pragma unroll
        for (int t = 0; t < 4; ++t) { xf[t] = (bf16x4){0, 0, 0, 0}; accX[t] = (f32x4){0.f, 0.f, 0.f, 0.f}; }
#define GLD16(dst, ptr, OFF) asm volatile("global_load_dwordx4 %0, %1, off offset:" #OFF : "=v"(dst) : "v"(ptr) : "memory")
#define GLD16NT(dst, ptr) asm volatile("global_load_dwordx4 %0, %1, off nt" : "=v"(dst) : "v"(ptr) : "memory")
#define LOADTASK(T, cc) do { const GAS unsigned char* tp_ = tk + (size_t)(cc) * TASK_BYTES; _Pragma("unroll") for (int t = 0; t < 4; ++t) { \
            GLD16(T.m0[t], tp_ + t * 2048, 0); GLD16(T.m1[t], tp_ + t * 2048, 16); GLD16(T.r0[t], tp_ + 16384 + t * 2048, 0); GLD16(T.r1[t], tp_ + 16384 + t * 2048, 16); } \
            GLD16(T.n0, tp_ + 8192 + s * 2048, 0); GLD16(T.n1, tp_ + 8192 + s * 2048, 16); GLD16(T.y0, tp_ + 24576 + s * 2048, 0); GLD16(T.y1, tp_ + 24576 + s * 2048, 16); \
            { const size_t mo_ = ((size_t)(b * SEQ + (cc) * 64 + 16 * s + (lane >> 3)) * DB + 64 * h + 8 * (lane & 7)) * 2; \
              GLD16NT(T.g0, gG + mo_); GLD16NT(T.g1, gG + mo_ + 8 * DB * 2); GLD16NT(T.v0, gV + mo_); GLD16NT(T.v1, gV + mo_ + 8 * DB * 2); \
              asm volatile("global_load_dword %0, %1, off" : "=v"(T.bo) : "v"(gB + ((size_t)(b * SEQ + (cc) * 64 + 16 * s + (lane & 15)) * 8 + h) * 4) : "memory"); } } while (0)
#define WAITTASK(T, N) asm volatile("s_waitcnt vmcnt(" #N ")" : "+v"(T.m0[0]), "+v"(T.m0[1]), "+v"(T.m0[2]), "+v"(T.m0[3]), "+v"(T.m1[0]), "+v"(T.m1[1]), "+v"(T.m1[2]), "+v"(T.m1[3]), \
            "+v"(T.r0[0]), "+v"(T.r0[1]), "+v"(T.r0[2]), "+v"(T.r0[3]), "+v"(T.r1[0]), "+v"(T.r1[1]), "+v"(T.r1[2]), "+v"(T.r1[3]), "+v"(T.n0), "+v"(T.n1), "+v"(T.y0), "+v"(T.y1), \
            "+v"(T.g0), "+v"(T.g1), "+v"(T.v0), "+v"(T.v1), "+v"(T.bo) :: "memory")
#define LO2(v) __builtin_bit_cast(bf16x4, (u32x2){(v).x, (v).y})
#define HI2(v) __builtin_bit_cast(bf16x4, (u32x2){(v).z, (v).w})
#define STEP(T, cc) do { f32x4 accY[4]; \
            accY[0] = bf4((u32x2){T.y0.x, T.y0.y}); accY[1] = bf4((u32x2){T.y0.z, T.y0.w}); accY[2] = bf4((u32x2){T.y1.x, T.y1.y}); accY[3] = bf4((u32x2){T.y1.z, T.y1.w}); \
            accX[0] = bf4((u32x2){T.n0.x, T.n0.y}); accX[1] = bf4((u32x2){T.n0.z, T.n0.w}); accX[2] = bf4((u32x2){T.n1.x, T.n1.y}); accX[3] = bf4((u32x2){T.n1.z, T.n1.w}); \
            _Pragma("unroll") for (int t = 0; t < 4; ++t) { \
                accY[t] = MFMA16(LO2(T.r0[t]), xf[0], accY[t]); accX[t] = MFMA16(LO2(T.m0[t]), xf[0], accX[t]); accY[t] = MFMA16(HI2(T.r0[t]), xf[1], accY[t]); accX[t] = MFMA16(HI2(T.m0[t]), xf[1], accX[t]); \
                accY[t] = MFMA16(LO2(T.r1[t]), xf[2], accY[t]); accX[t] = MFMA16(LO2(T.m1[t]), xf[2], accX[t]); accY[t] = MFMA16(HI2(T.r1[t]), xf[3], accY[t]); accX[t] = MFMA16(HI2(T.m1[t]), xf[3], accX[t]); } \
            _Pragma("unroll") for (int t = 0; t < 4; ++t) xf[t] = pack4(accX[t]); \
            LAS float* yb = YB + ((cc) & 1) * 4096; \
            _Pragma("unroll") for (int t = 0; t < 4; ++t) _Pragma("unroll") for (int e = 0; e < 4; ++e) yb[(16 * t + 4 * fq + e) * 64 + 16 * s + fr] = accY[t][e]; \
            { LAS unsigned char* gl_ = lds + 32768 + ((cc) & 1) * 8192 + ((16 * s + (lane >> 3)) * 64 + 8 * (lane & 7)) * 2; \
              *(LAS u32x4*)gl_ = T.g0; *(LAS u32x4*)(gl_ + 1024) = T.g1; *(LAS u32x4*)(gl_ + 16384) = T.v0; *(LAS u32x4*)(gl_ + 16384 + 1024) = T.v1; \
              if (lane < 16) *(LAS unsigned*)(lds + 65536 + ((cc) & 1) * 256 + (16 * s + lane) * 4) = T.bo; } \
            asm volatile("s_waitcnt lgkmcnt(0)" ::: "memory"); __builtin_amdgcn_s_barrier(); asm volatile("" ::: "memory"); } while (0)
        LOADTASK(TA, 0); LOADTASK(TB, 1);
#pragma unroll 1
        for (int c = 0; c < 32; c += 2) {
            WAITTASK(TA, 25); STEP(TA, c); LOADTASK(TA, (c + 2 < 32 ? c + 2 : 31));
            WAITTASK(TB, 25); STEP(TB, c + 1); LOADTASK(TB, (c + 3 < 32 ? c + 3 : 31));
        }
        asm volatile("s_waitcnt vmcnt(0)" ::: "memory");
#undef GLD16
#undef GLD16NT
#undef LOADTASK
#undef WAITTASK
#undef LO2
#undef HI2
#undef STEP
#pragma unroll
        for (int t = 0; t < 4; ++t) *(f32x4*)(out_wkv + ((size_t)bh * 64 + 16 * s + fr) * 64 + 16 * t + 4 * fq) = accX[t];
    } else {
        const int tp = tid - 256, l16 = tp & 15;
        const f32x4 lg4 = *(const f32x4*)(ln_g + 64 * h + 4 * l16), lb4 = *(const f32x4*)(ln_b + 64 * h + 4 * l16);
#pragma unroll 1
        for (int c = 0; c < 32; ++c) {
            asm volatile("" ::: "memory"); __builtin_amdgcn_s_barrier(); asm volatile("" ::: "memory");
            const LAS float* yb = YB + (c & 1) * 4096; const LAS unsigned char* gl = lds + 32768 + (c & 1) * 8192; const LAS float* bl = (const LAS float*)(lds + 65536 + (c & 1) * 256);
#pragma unroll
            for (int it = 0; it < 4; ++it) { const int tt = it * 16 + (tp >> 4); const int m = b * SEQ + c * 64 + tt;
                const f32x4 y4 = *(const LAS f32x4*)(yb + tt * 64 + 4 * l16);
                const f32x4 g4 = bf4(*(const LAS u32x2*)(gl + (tt * 64 + 4 * l16) * 2)), v4 = bf4(*(const LAS u32x2*)(gl + 16384 + (tt * 64 + 4 * l16) * 2)); const float bon = bl[tt];
                const float mean = red16((y4[0] + y4[1]) + (y4[2] + y4[3])) * (1.f / 64.f);
                const f32x4 d4 = y4 - mean;
                const float var = red16((d4[0] * d4[0] + d4[1] * d4[1]) + (d4[2] * d4[2] + d4[3] * d4[3])) * (1.f / 64.f);
                const float rstd = __builtin_amdgcn_rsqf(var + GN_EPS);
                const f32x4 o = ((d4 * rstd) * lg4 + lb4 + v4 * bon) * g4;
                *(GAS u32x2*)((gbf16*)MIX + (size_t)m * 1024 + 512 + 64 * h + 4 * l16) = pk4(o); }
        }
    }
}

template <class EpiF>
__device__ __forceinline__ void small_gemm(LAS unsigned char* lds, const bf16* A, int lda, const bf16* Bt, int N, int K, int Q, int gb, int GB, const EpiF& epi, int tid, int wave, int lane) {
    const int fr = lane & 15, fq = lane >> 4, kw = (K / Q) >> 3;
    LAS float* part = (LAS float*)lds;
    for (int item = gb; item < (N >> 4) * Q; item += GB) {
        const int strip = item / Q, q = item - strip * Q;
        f32x4 acc[8];
#pragma unroll
        for (int i = 0; i < 8; ++i) acc[i] = (f32x4){0.f, 0.f, 0.f, 0.f};
        const bf16* brow = Bt + (size_t)(16 * strip + fr) * K + q * (K / Q) + wave * kw + 8 * fq;
        const bf16* arow = A + (size_t)fr * lda + q * (K / Q) + wave * kw + 8 * fq;
#pragma unroll 4
        for (int ks = 0; ks < (kw >> 5); ++ks) {
            const bf16x8 wf = *(const bf16x8*)(brow + 32 * ks);
#pragma unroll
            for (int mt = 0; mt < 8; ++mt) { const bf16x8 af = *(const bf16x8*)(arow + (size_t)(16 * mt) * lda + 32 * ks); acc[mt] = __builtin_amdgcn_mfma_f32_16x16x32_bf16(wf, af, acc[mt], 0, 0, 0); }
        }
#pragma unroll
        for (int mt = 0; mt < 8; ++mt) *(LAS f32x4*)(part + ((wave * 128 + 16 * mt + fr) * 16 + 4 * fq)) = acc[mt];
        __syncthreads();
        {   const int token = tid >> 2, cg = tid & 3; f32x4 sm = (f32x4){0.f, 0.f, 0.f, 0.f};
#pragma unroll
            for (int w = 0; w < 8; ++w) sm += *(const LAS f32x4*)(part + ((w * 128 + token) * 16 + 4 * cg));
            epi(token, 16 * strip + 4 * cg, sm); }
        __syncthreads();
    }
}
struct SEpiProj { bf16* ZAs; float* PBs;
    __device__ __forceinline__ void operator()(int t, int c, f32x4 s) const {
        if (c < 1024) { const f32x2 a = pg8::gelu_pk((f32x2){s[0], s[1]}), b = pg8::gelu_pk((f32x2){s[2], s[3]}); *(u32x2*)(ZAs + (size_t)t * 1024 + c) = pk4((f32x4){a.x, a.y, b.x, b.y}); }
        else *(f32x4*)(PBs + (size_t)t * DSH + (c - 1024)) = s; } };
struct SEpiAtomic { float* acc;
    __device__ __forceinline__ void operator()(int t, int c, f32x4 s) const {
#pragma unroll
        for (int j = 0; j < 4; ++j) (void)__hip_atomic_fetch_add(acc + (size_t)t * 1024 + c + j, s[j], __ATOMIC_RELAXED, __HIP_MEMORY_SCOPE_AGENT); } };
template <bool WB> struct SEpiRes { const float* base; float* out; bf16* outb; float* rowss; float* out2;
    __device__ __forceinline__ void operator()(int t, int c, f32x4 s) const {
        const f32x4 v = *(const f32x4*)(base + (size_t)t * 1024 + c) + s; *(f32x4*)(out + (size_t)t * 1024 + c) = v; if (WB) *(u32x2*)(outb + (size_t)t * 1024 + c) = pk4(v); if (out2) *(f32x4*)(out2 + (size_t)t * 1024 + c) = v;
        float ss = (v[0] * v[0] + v[1] * v[1]) + (v[2] * v[2] + v[3] * v[3]); ss = red4(ss);
        if ((threadIdx.x & 3) == 0) (void)__hip_atomic_fetch_add(rowss + t, ss, __ATOMIC_RELAXED, __HIP_MEMORY_SCOPE_AGENT); } };
struct SEpiQ { float* Q; const float* rowss;
    __device__ __forceinline__ void operator()(int t, int c, f32x4 s) const {
        const float sc = 0.0625f / sqrtf(__hip_atomic_load(rowss + t, __ATOMIC_RELAXED, __HIP_MEMORY_SCOPE_AGENT) * (1.f / D) + RMS_EPS); *(f32x4*)(Q + (size_t)t * 1024 + c) = s * sc; } };
struct SEpiUp { bf16* H; const float* rowss;
    __device__ __forceinline__ void operator()(int t, int c, f32x4 s) const {
        const float sc = 1.f / sqrtf(__hip_atomic_load(rowss + t, __ATOMIC_RELAXED, __HIP_MEMORY_SCOPE_AGENT) * (1.f / D) + RMS_EPS); f32x4 v = s * sc;
#pragma unroll
        for (int j = 0; j < 4; ++j) { const float a = fmaxf(v[j], 0.f); v[j] = a * a; }
        *(u32x2*)(H + (size_t)t * FF + c) = pk4(v); } };

struct KArgs { const float* in[35]; float* out; unsigned char* ws; };
__device__ __forceinline__ void sample_mixer_token(LAS unsigned char* lds, int tok, const KArgs& KA, const bf16* ZAs, const float* PBs, bf16* MIXs, const bf16* W2T, const bf16* A2T, const bf16* G2T, int tid, int wave, int lane) {
    const float* const (&in)[35] = KA.in; float* out = KA.out;
    LAS float* red = (LAS float*)lds;
    LAS float* lin = (LAS float*)(lds + 256);
    LAS float* vec = (LAS float*)(lds + 2048);
    const int c = tid;
    {   const int hA = c >> 7; const float vz = bf1(ZAs[(size_t)tok * 1024 + 512 + c]), uz = bf1(ZAs[(size_t)tok * 1024 + c]);
        const float s1 = wave_sum(vz); if (lane == 0) red[wave] = s1;
        __syncthreads();
        const float mean = (red[2 * hA] + red[2 * hA + 1]) * (1.f / 128.f); const float dv = vz - mean;
        const float s2 = wave_sum(dv * dv); if (lane == 0) red[8 + wave] = s2;
        __syncthreads();
        const float var = (red[8 + 2 * hA] + red[8 + 2 * hA + 1]) * (1.f / 128.f);
        const float vn = dv * (1.f / sqrtf(var + LN_EPS)) * in[10][c] + in[11][c];
        out[O_CVS + (size_t)tok * 512 + c] = vn;
        const float mixed = in[12][(size_t)hA * 128 * 128] * vn + in[13][hA * 128];
        MIXs[(size_t)tok * 1024 + c] = (bf16)(pk2(uz * mixed, 0.f) & 0xffffu);
    }
    const float* pb = PBs + (size_t)tok * DSH; const float* pv = in[5] + (size_t)tok * DSH; const float* mu = in[9];
    if (tid < 256) { const int i = 1536 + tid; const float x = pb[i] + (pv[i] - pb[i]) * mu[i]; lin[tid] = tid < 64 ? fast_tanh(x) : (tid < 128 ? x : fast_sigmoid(x)); }
    __syncthreads();
    const float rs = pb[c] + (pv[c] - pb[c]) * mu[c], ks = pb[512 + c] + (pv[512 + c] - pb[512 + c]) * mu[512 + c], vs = pb[1024 + c] + (pv[1024 + c] - pb[1024 + c]) * mu[1024 + c];
    const size_t so = ((size_t)(tok * 8 + wave) * 64 + lane) * 64; const float* s0 = in[6] + so; float* s1o = out + O_WKVS + so;
    f32x4 Sx[16];
#pragma unroll
    for (int j = 0; j < 16; ++j) Sx[j] = *(const f32x4*)(s0 + 4 * j);
    float wl = in[14][c], al = in[16][c], g = 0.f;
    {   const bf16* w2r = W2T + (size_t)c * 64; const bf16* a2r = A2T + (size_t)c * 64; const bf16* g2r = G2T + (size_t)c * 128;
#define DOT8(acc, v, lp) do { const f32x4 l0_ = *(const LAS f32x4*)(lp), l1_ = *(const LAS f32x4*)((lp) + 4); \
            acc += (bf_lo((v).x) * l0_[0] + bf_hi((v).x) * l0_[1]) + (bf_lo((v).y) * l0_[2] + bf_hi((v).y) * l0_[3]) + (bf_lo((v).z) * l1_[0] + bf_hi((v).z) * l1_[1]) + (bf_lo((v).w) * l1_[2] + bf_hi((v).w) * l1_[3]); } while (0)
#pragma unroll 1
        for (int j = 0; j < 8; ++j) { const u32x4 w8 = *(const u32x4*)(w2r + 8 * j), a8 = *(const u32x4*)(a2r + 8 * j), g8 = *(const u32x4*)(g2r + 8 * j), h8 = *(const u32x4*)(g2r + 64 + 8 * j);
            DOT8(wl, w8, lin + 8 * j); DOT8(al, a8, lin + 64 + 8 * j); DOT8(g, g8, lin + 128 + 8 * j); DOT8(g, h8, lin + 192 + 8 * j); }
#undef DOT8
    }
    const float z = -wl, sp = fmaxf(z, 0.f) + fast_log(1.f + fast_exp(-fabsf(z))), w = -sp - 0.5f, dec = fast_exp(-fast_exp(w)), av = fast_sigmoid(al);
    const float kkr = ks * in[19][c]; const float nrm = sqrtf(wave_sum(kkr * kkr)); const float kk = kkr / fmaxf(nrm, 1e-12f); const float kp = ks * (1.f + (av - 1.f) * in[20][c]);
    LAS float* hv = vec + wave * 320;
    hv[lane] = dec; hv[64 + lane] = -kk; hv[128 + lane] = kk * av; hv[192 + lane] = kp; hv[256 + lane] = rs;
    __syncthreads();
    {   float sa = 0.f;
#pragma unroll
        for (int j = 0; j < 16; ++j) { const f32x4 a4 = *(const LAS f32x4*)(hv + 64 + 4 * j); sa += (Sx[j][0] * a4[0] + Sx[j][1] * a4[1]) + (Sx[j][2] * a4[2] + Sx[j][3] * a4[3]); if ((j & 3) == 3) asm volatile("" ::: "memory"); }
        float y = 0.f;
#pragma unroll
        for (int j = 0; j < 16; ++j) { const f32x4 d4 = *(const LAS f32x4*)(hv + 4 * j), b4 = *(const LAS f32x4*)(hv + 128 + 4 * j), k4 = *(const LAS f32x4*)(hv + 192 + 4 * j), r4 = *(const LAS f32x4*)(hv + 256 + 4 * j);
            const f32x4 sn = Sx[j] * d4 + (b4 * sa + k4 * vs); *(f32x4*)(s1o + 4 * j) = sn; y += (sn[0] * r4[0] + sn[1] * r4[1]) + (sn[2] * r4[2] + sn[3] * r4[3]); if ((j & 1) == 1) asm volatile("" ::: "memory"); }
        const float mean = wave_sum(y) * (1.f / 64.f), dy = y - mean, var = wave_sum(dy * dy) * (1.f / 64.f);
        const float yn = dy * (1.f / sqrtf(var + GN_EPS)) * in[22][c] + in[23][c];
        const float bon = wave_sum(rs * kp * in[21][c]) * vs;
        MIXs[(size_t)tok * 1024 + 512 + c] = (bf16)(pk2((yn + bon) * g, 0.f) & 0xffffu);
    }
    __syncthreads();
}
__device__ __forceinline__ void sample_attn_pair(LAS unsigned char* lds, int pair, const float* Qs, const float* Kc, const float* Vc, bf16* Os, int tid, int wave, int lane) {
    const int b = pair >> 2, h = pair & 3;
    LAS float* sc = (LAS float*)lds;
    LAS float* part = (LAS float*)(lds + 1024);
    const f32x4 q4 = *(const f32x4*)(Qs + (size_t)b * 1024 + h * 256 + 4 * lane);
    const float* kb = Kc + ((size_t)b * 256 * 4 + h) * 256 + 4 * lane; const float* vb = Vc + ((size_t)b * 256 * 4 + h) * 256 + 4 * lane;
    {   f32x4 kr[32];
#pragma unroll
        for (int i = 0; i < 32; ++i) kr[i] = __builtin_nontemporal_load((const f32x4*)(kb + (size_t)(32 * wave + i) * 1024));
#pragma unroll
        for (int i = 0; i < 32; ++i) { const float p = wave_sum_dpp((q4[0] * kr[i][0] + q4[1] * kr[i][1]) + (q4[2] * kr[i][2] + q4[3] * kr[i][3])); if (lane == 0) sc[32 * wave + i] = p; } }
    f32x4 vr[32];
#pragma unroll
    for (int i = 0; i < 32; ++i) vr[i] = __builtin_nontemporal_load((const f32x4*)(vb + (size_t)(32 * wave + i) * 1024));
    __syncthreads();
    {   const f32x4 s4 = *(const LAS f32x4*)(sc + 4 * lane); const float mx = wave_max(fmaxf(fmaxf(s4[0], s4[1]), fmaxf(s4[2], s4[3])));
        f32x4 e; float sum = 0.f;
#pragma unroll
        for (int j = 0; j < 4; ++j) { e[j] = fast_exp(s4[j] - mx); sum += e[j]; }
        sum = wave_sum(sum); const float inv = 1.f / sum;
        __syncthreads();
        if (wave == 0) *(LAS f32x4*)(sc + 4 * lane) = e * inv;
    }
    __syncthreads();
    f32x4 o = (f32x4){0.f, 0.f, 0.f, 0.f};
#pragma unroll
    for (int i = 0; i < 32; ++i) o += vr[i] * sc[32 * wave + i];
    *(LAS f32x4*)(part + wave * 256 + 4 * lane) = o;
    __syncthreads();
    if (tid < 256) { float s = 0.f;
#pragma unroll
        for (int w = 0; w < 8; ++w) s += part[w * 256 + tid];
        Os[(size_t)b * 1024 + h * 256 + tid] = (bf16)(pk2(s, 0.f) & 0xffffu); }
    __syncthreads();
}
template <int ST>
__device__ __forceinline__ void sample_stage(LAS unsigned char* lds, const KArgs& KA, int gb, int GB, int tid, int wave, int lane) {
    unsigned char* ws = KA.ws; unsigned char* sm = ws + WS_SMP; const float* const (&in)[35] = KA.in; float* out = KA.out;
    float* rs1 = (float*)ws + RS_OFF + M; float* rs2 = rs1 + RS_STRIDE;
    const bf16* XN0s = (const bf16*)(ws + WS_ACAT) + (size_t)M * 1024;
    bf16* ZAs = (bf16*)(sm + SM_ZA); bf16* MIXs = (bf16*)(sm + SM_MIX); float* X1s = (float*)(sm + SM_X1); bf16* X1Bs = (bf16*)(sm + SM_X1B); float* Qs = (float*)(sm + SM_Q); bf16* Os = (bf16*)(sm + SM_O);
    float* X2s = (float*)(sm + SM_X2); bf16* X2Bs = (bf16*)(sm + SM_X2B); bf16* HIDs = (bf16*)(sm + SM_HID); float* X3s = (float*)(sm + SM_X3);
    float* PBs = out + O_SHS;
    if constexpr (ST == 0) { SEpiProj e{ZAs, PBs}; small_gemm(lds, XN0s, 1024, (const bf16*)(ws + WS_WCAT), DIN, 1024, 1, gb, GB, e, tid, wave, lane); }
    if constexpr (ST == 1) { for (int tok = gb; tok < MS; tok += GB) sample_mixer_token(lds, tok, KA, ZAs, PBs, MIXs, (const bf16*)(ws + WS_SMALL), (const bf16*)(ws + WS_SMALL + 64 * KiB), (const bf16*)(ws + WS_SMALL + 128 * KiB), tid, wave, lane); }
    if constexpr (ST == 2) { SEpiRes<true> e{in[1], X1s, X1Bs, rs1, nullptr}; small_gemm(lds, MIXs, 1024, (const bf16*)(ws + WS_WOUT), 1024, 1024, 1, gb, GB, e, tid, wave, lane); }
    if constexpr (ST == 3) { SEpiQ e{Qs, rs1}; small_gemm(lds, X1Bs, 1024, (const bf16*)(ws + WS_WQ), 1024, 1024, 1, gb, GB, e, tid, wave, lane); }
    if constexpr (ST == 4) { for (int pair = gb; pair < MS * 4; pair += GB) sample_attn_pair(lds, pair, Qs, in[3], in[4], Os, tid, wave, lane); }
    if constexpr (ST == 5) { SEpiRes<true> e{X1s, X2s, X2Bs, rs2, X3s}; small_gemm(lds, Os, 1024, (const bf16*)(ws + WS_WO), 1024, 1024, 1, gb, GB, e, tid, wave, lane); }
    if constexpr (ST == 6) { SEpiUp e{HIDs, rs2}; small_gemm(lds, X2Bs, 1024, (const bf16*)(ws + WS_WUP), FF, 1024, 1, gb, GB, e, tid, wave, lane); }
    if constexpr (ST == 7) { SEpiAtomic e{X3s}; small_gemm(lds, HIDs, FF, (const bf16*)(ws + WS_WDN), 1024, FF, 4, gb, GB, e, tid, wave, lane); }
    if constexpr (ST == 8) {
        for (int r = gb * 8 + wave; r < MS; r += GB * 8) {
            f32x4 v[4]; float ss = 0.f;
#pragma unroll
            for (int j = 0; j < 4; ++j) { v[j] = *(const f32x4*)(X3s + (size_t)r * 1024 + 256 * j + 4 * lane); ss += (v[j][0] * v[j][0] + v[j][1] * v[j][1]) + (v[j][2] * v[j][2] + v[j][3] * v[j][3]); }
            const float sc = 1.f / sqrtf(wave_sum(ss) * (1.f / D) + RMS_EPS);
#pragma unroll
            for (int j = 0; j < 4; ++j) { const int cc = 256 * j + 4 * lane; *(f32x4*)(out + O_YS + (size_t)r * 1024 + cc) = v[j] * sc * *(const f32x4*)(in[34] + cc); } }
    }
}

__global__ void __launch_bounds__(NWAVES * 64, 2) mk_fwd(KArgs a) {
    extern __shared__ __attribute__((aligned(16))) unsigned char lds_raw[];
    LAS unsigned char* lds = (LAS unsigned char*)lds_raw;
    volatile LAS unsigned* MISC = (volatile LAS unsigned*)(lds + MISC_OFF);
    int tid = threadIdx.x, lane = tid & 63, wave = __builtin_amdgcn_readfirstlane(tid >> 6);
    const int G = gridDim.x; int bx = blockIdx.x; int vcu = (G % 8 == 0) ? (bx % 8) * (G / 8) + bx / 8 : bx;
#define LAUNDER() do { ws = a.ws; asm volatile("" : "+s"(ws)); tid = threadIdx.x; asm volatile("" : "+v"(tid)); lane = tid & 63; wave = __builtin_amdgcn_readfirstlane(tid >> 6); bx = blockIdx.x; asm volatile("" : "+s"(bx)); \
        vcu = (G % 8 == 0) ? (bx % 8) * (G / 8) + bx / 8 : bx; gw = vcu * NWAVES + wave; } while (0)
    unsigned char* ws = a.ws; float* out = a.out;
    gu32* ctl = (gu32*)(ws + WS_CTL);
    for (int u = tid; u < (LDS_BYTES - LDSCTL_OFF) / 4; u += NWAVES * 64) ((LAS unsigned*)(lds + LDSCTL_OFF))[u] = 0u;
    __syncthreads();
    XcdBarrier bar = xcd_barrier_post((unsigned*)ctl + CW_BAR, MISC + 8);
#define GRID_BAR() xcd_barrier(bar)
#ifdef PROBE_SPAN_A
#define STAMP(k) do { if (blockIdx.x == 0 && threadIdx.x == 0) *(volatile LAS unsigned long long*)(lds + LDSCTL_OFF + 64 + 8 * (k)) = __builtin_amdgcn_s_memrealtime(); } while (0)
#else
#define STAMP(k) do { } while (0)
#endif
    STAMP(0);
#ifdef PROBE_SSPAN_A
#define SST(k) do { if (blockIdx.x == 64 && threadIdx.x == 0) *(volatile LAS unsigned long long*)(lds + LDSCTL_OFF + 64 + 8 * (16 + (k))) = __builtin_amdgcn_s_memrealtime(); } while (0)
#else
#define SST(k) do { } while (0)
#endif
#define RS1 ((float*)ws + RS_OFF)
#define RS2 ((float*)ws + RS_OFF + RS_STRIDE)
#define RS3 ((float*)ws + RS_OFF + 2 * RS_STRIDE)
#define WCAT ((bf16*)(ws + WS_WCAT))
#define WOUT ((bf16*)(ws + WS_WOUT))
#define WQ ((bf16*)(ws + WS_WQ))
#define WO ((bf16*)(ws + WS_WO))
#define WUP ((bf16*)(ws + WS_WUP))
#define WDN ((bf16*)(ws + WS_WDN))
#define W2T ((bf16*)(ws + WS_SMALL))
#define A2T ((bf16*)(ws + WS_SMALL + 64 * KiB))
#define G2T ((bf16*)(ws + WS_SMALL + 128 * KiB))
#define WSB ((bf16*)(ws + WS_SMALL + 256 * KiB))
#define ZROW ((bf16*)(ws + WS_SMALL + 384 * KiB))
#define ACAT ((bf16*)(ws + WS_ACAT))
#define ZA ((bf16*)(ws + WS_ZA))
#define PB ((bf16*)(ws + WS_PB))
#define SCN ((float*)(ws + WS_SCN))
#define LAIN ((bf16*)(ws + WS_NEW))
#define OPS ((bf16*)(ws + WS_SCN))
#define TASKS (ws + WS_NEW + 8 * MiB)
#define VSB ((bf16*)(ws + WS_NEW + 72 * MiB))
#define BON ((float*)(ws + WS_NEW + 88 * MiB))
#define GB_ ((bf16*)(ws + WS_G))
#define MIX ((bf16*)(ws + WS_MIX))
#define KB ((bf16*)(ws + WS_KB))
#define VT ((bf16*)(ws + WS_VT))
#define X1B ((bf16*)(ws + WS_ZA))
#define Q ((bf16*)(ws + WS_Q))
#define OB ((bf16*)(ws + WS_OB))
#define PSCR ((bf16*)(ws + WS_PSCR))
#define X2B ((bf16*)(ws + WS_MIX))
#define HID ((bf16*)(ws + WS_HID))
    int gw = vcu * NWAVES + wave; const int NGW = G * NWAVES;

    #ifndef NOP0
    LAUNDER();
    {
        LAS float* scr = (LAS float*)(lds + wave * 16384);
        constexpr int I_IN = 16 * 88, I_SQ = 16 * 32, I_UP = 16 * 128, I_DN = 64 * 32, I_L = 16, I_G = 32;
        constexpr int NITEMS = I_IN + 5 * I_SQ + I_UP + I_DN + 2 * I_L + I_G;
        for (int it = gw; it < NITEMS; it += NGW) {
            int r = it;
            if (r < I_IN) { p0_transpose_item(a.in[8], 1024, DIN, WCAT, 0, nullptr, scr, r, lane); continue; } r -= I_IN;
            if (r < I_SQ) { p0_transpose_item(a.in[28], 1024, 1024, WCAT, DIN, nullptr, scr, r, lane); continue; } r -= I_SQ;
            if (r < I_SQ) { p0_transpose_item(a.in[29], 1024, 1024, WCAT, DIN + 1024, nullptr, scr, r, lane); continue; } r -= I_SQ;
            if (r < I_SQ) { p0_transpose_item(a.in[24], 1024, 1024, WOUT, 0, nullptr, scr, r, lane); continue; } r -= I_SQ;
            if (r < I_SQ) { p0_transpose_item(a.in[27], 1024, 1024, WQ, 0, a.in[25], scr, r, lane); continue; } r -= I_SQ;
            if (r < I_SQ) { p0_transpose_item(a.in[30], 1024, 1024, WO, 0, nullptr, scr, r, lane); continue; } r -= I_SQ;
            if (r < I_UP) { p0_transpose_item(a.in[32], 1024, FF, WUP, 0, a.in[31], scr, r, lane); continue; } r -= I_UP;
            if (r < I_DN) { p0_transpose_item(a.in[33], FF, 1024, WDN, 0, nullptr, scr, r, lane); continue; } r -= I_DN;
            if (r < I_L) { p0_transpose_item(a.in[15], 64, DB, W2T, 0, nullptr, scr, r, lane); continue; } r -= I_L;
            if (r < I_L) { p0_transpose_item(a.in[17], 64, DB, A2T, 0, nullptr, scr, r, lane); continue; } r -= I_L;
            p0_transpose_item(a.in[18], 128, DB, G2T, 0, nullptr, scr, r, lane);
        }
        for (int m = gw; m < M + MS + NBATCH * NMEM; m += 4 * NGW) {
            const float* src[4]; const float* gg[4]; bf16* dst[4]; bool ok[4];
#pragma unroll
            for (int q = 0; q < 4; ++q) { const int mm = m + q * NGW; ok[q] = mm < M + MS + NBATCH * NMEM; const int mc = ok[q] ? mm : m;
                if (mc < M) { src[q] = a.in[0] + (size_t)mc * D; gg[q] = a.in[7]; dst[q] = ACAT + (size_t)mc * D; }
                else if (mc < M + MS) { src[q] = a.in[1] + (size_t)(mc - M) * D; gg[q] = a.in[7]; dst[q] = ACAT + (size_t)mc * D; }
                else { src[q] = a.in[2] + (size_t)(mc - M - MS) * D; gg[q] = a.in[26]; dst[q] = ACAT + (size_t)(16640 + (mc - M - MS)) * D; } }
            f32x4 v[4][4]; float ss[4];
#pragma unroll
            for (int q = 0; q < 4; ++q) { ss[q] = 0.f;
#pragma unroll
                for (int j = 0; j < 4; ++j) v[q][j] = __builtin_nontemporal_load((const f32x4*)src[q] + lane + 64 * j); }
#pragma unroll
            for (int q = 0; q < 4; ++q) {
#pragma unroll
                for (int j = 0; j < 4; ++j) ss[q] += (v[q][j].x * v[q][j].x + v[q][j].y * v[q][j].y) + (v[q][j].z * v[q][j].z + v[q][j].w * v[q][j].w);
                const float rstd = 1.f / sqrtf(wave_sum(ss[q]) * (1.f / D) + RMS_EPS);
                if (ok[q]) { unsigned long long* o8 = (unsigned long long*)dst[q] + lane;
#pragma unroll
                    for (int j = 0; j < 4; ++j) { const f32x4 g4 = *((const f32x4*)gg[q] + lane + 64 * j);
                        o8[64 * j] = (unsigned long long)pk2(v[q][j].x * rstd * g4.x, v[q][j].y * rstd * g4.y) | ((unsigned long long)pk2(v[q][j].z * rstd * g4.z, v[q][j].w * rstd * g4.w) << 32); } } }
        }
        const int gt = bx * (NWAVES * 64) + tid, NGT = G * NWAVES * 64;
        for (int i = gt; i < 4 * 128 * 128; i += NGT) { const int t = (i >> 7) & 127, s = i & 127; WSB[i] = (bf16)(pk2(s <= t ? a.in[12][i] : 0.f, 0.f) & 0xffffu); }
        for (int i = gt; i < 2048; i += NGT) ZROW[i] = 0;
    }
#endif
    GRID_BAR(); STAMP(1);

    #ifndef NOP1
    LAUNDER();
    {
        SchedP1 S{G, bx, (const char*)ACAT, (const char*)WCAT};
        EpiP1 E{ZA, PB, out + O_MK, out + O_MV, KB};
        pg8::gemm_phase<EpiP1, SchedP1, true>(lds, 1024, 1024, 1024, S, E);
        sample_stage<0>(lds, a, bx, G, tid, wave, lane);
    }
#endif
    GRID_BAR(); STAMP(2);

    #ifndef NOP2
    LAUNDER();
    {
        LAS float* scr = (LAS float*)(lds + wave * 16384);
        for (int it = gw; it < NBATCH * 128; it += NGW) { const int b = it >> 7; p0_transpose_item(out + O_MV + (size_t)b * NMEM * 1024, NMEM, 1024, VT + (size_t)b * 1024 * NMEM, 0, nullptr, scr, it & 127, lane); }
        const int gt = bx * (NWAVES * 64) + tid, NGT = G * NWAVES * 64;
        for (int i = gt; i < NBATCH * DSH; i += NGT) { const int b = i / DSH, c = i % DSH; out[O_SHP + i] = bf1(PB[(size_t)(b * SEQ + SEQ - 1) * DSH + c]); }
        __syncthreads();
        SST(10);
        for (int bc = bx; bc < M / 64; bc += G)
            rwkv_chunk_prep(lds, bc, PB, ZROW, a.in[9], W2T, A2T, G2T, a.in[14], a.in[16], a.in[19], a.in[20], a.in[21], LAIN + (size_t)bx * 16384, TASKS, GB_, VSB, BON, tid, wave, lane);
        SST(11);
#ifdef DUP2
        LAUNDER();
        for (int bc = bx; bc < M / 64; bc += G)
            rwkv_chunk_prep(lds, bc, PB, ZROW, a.in[9], W2T, A2T, G2T, a.in[14], a.in[16], a.in[19], a.in[20], a.in[21], LAIN + (size_t)bx * 16384, TASKS, GB_, VSB, BON, tid, wave, lane);
#endif
        sample_stage<1>(lds, a, bx, G, tid, wave, lane);
    }
#endif
    GRID_BAR(); STAMP(3);

    #ifndef NOP3
    LAUNDER();
    {   unsigned* subcnt = (unsigned*)ctl + CW_SUB; unsigned* tmo = (unsigned*)ctl + CW_TMO; unsigned* qatt = (unsigned*)ctl + CW_QATT; unsigned* qmix = (unsigned*)ctl + CW_QMIX;
        volatile LAS unsigned* qw = (volatile LAS unsigned*)(lds + LDSCTL_OFF + 32);
        if (bx < 64) {
            scanB_block(lds, bx, TASKS, GB_, VSB, BON, a.in[22], a.in[23], MIX, out + O_WKVP, tid, wave, lane);
#ifdef DUP3
            LAUNDER();
            scanB_block(lds, bx, TASKS, GB_, VSB, BON, a.in[22], a.in[23], MIX, out + O_WKVP, tid, wave, lane);
#endif
            STAMP(5);
            __syncthreads();
            if (tid == 0) { unsigned sp = 0; while (xb_ld(subcnt) < 384u) { __builtin_amdgcn_s_sleep(4); if ((++sp & 255u) == 0u) { if (xb_ld(tmo)) break; if (sp > (1u << 20)) { atomicAdd(tmo, 1u); break; } } }
                __builtin_amdgcn_fence(__ATOMIC_ACQUIRE, "agent"); asm volatile("s_waitcnt vmcnt(0)" ::: "memory"); }
            __syncthreads();
        } else {
            const int gb = bx - 64;
            SST(0);
#define SUBBAR_FILL(target) do { asm volatile("s_waitcnt vmcnt(0)" ::: "memory"); __syncthreads(); \
                if (tid == 0) { __builtin_amdgcn_fence(__ATOMIC_RELEASE, "agent"); asm volatile("s_waitcnt vmcnt(0)" ::: "memory"); (void)xb_add(subcnt, 1u); } \
                unsigned sp_ = 0; \
                for (;;) { __syncthreads(); if (tid == 0) { const bool dn_ = xb_ld(subcnt) >= (target) || xb_ld(tmo) != 0u; *qw = dn_ ? 0xffffffffu : xb_add(qmix, 1u); } __syncthreads(); const unsigned tile_ = *qw; \
                    if (tile_ == 0xffffffffu) break; \
                    if (tile_ < 512u) mixer_a_tile(lds, (int)tile_, ZA, WSB, a.in[10], a.in[11], a.in[13], MIX, out + O_CVP, tid, wave, lane); \
                    else { __builtin_amdgcn_s_sleep(8); if (++sp_ > (1u << 18)) { if (tid == 0) atomicAdd(tmo, 1u); } } } \
                if (tid == 0) { __builtin_amdgcn_fence(__ATOMIC_ACQUIRE, "agent"); asm volatile("s_waitcnt vmcnt(0)" ::: "memory"); } \
                __syncthreads(); } while (0)
            sample_stage<2>(lds, a, gb, 192, tid, wave, lane);
            SST(1);
            SUBBAR_FILL(192u);
            SST(2);
            sample_stage<3>(lds, a, gb, 192, tid, wave, lane);
            SST(3);
            SUBBAR_FILL(384u);
#undef SUBBAR_FILL
            SST(4);
        }
        {   const float* Qs = (const float*)(ws + WS_SMP + SM_Q); bf16* Os = (bf16*)(ws + WS_SMP + SM_O);
            for (;;) { __syncthreads(); if (tid == 0) *qw = xb_add(qatt, 1u); __syncthreads(); const unsigned pair = *qw; if (pair >= (unsigned)(MS * 4)) break;
                sample_attn_pair(lds, (int)pair, Qs, a.in[3], a.in[4], Os, tid, wave, lane); }
            SST(5);
            for (;;) { __syncthreads(); if (tid == 0) *qw = xb_add(qmix, 1u); __syncthreads(); const unsigned tile = *qw; if (tile >= 512u) break;
                mixer_a_tile(lds, (int)tile, ZA, WSB, a.in[10], a.in[11], a.in[13], MIX, out + O_CVP, tid, wave, lane); }
            SST(6);
        }
    }
#endif
    GRID_BAR(); STAMP(4);

    #ifndef NOP4
    LAUNDER();
    {
        SchedMN S; S.init(M, 1024, G, bx, MIX, 1024, WOUT, 1024);
        EpiRes<float> E{a.in[0], X1B, RS1};
        pg8::gemm_phase<EpiRes<float>, SchedMN, true>(lds, 1024, 1024, 1024, S, E);
        sample_stage<5>(lds, a, bx, G, tid, wave, lane);
    }
#endif
    GRID_BAR(); STAMP(6);

    #ifndef NOP5
    LAUNDER();
    {
        SchedMN S5; S5.init(M, 1024, G, bx, X1B, 1024, WQ, 1024);
        bf16* QS = Q + (size_t)bx * 65536; bf16* P = PSCR + (size_t)bx * 65536;
        Unit u;
        for (int i = 0; S5.next(i, u); ++i) {
            const int pm = u.pm, h = u.pn, b = pm >> 3;
            { EpiQS E{QS, RS1};
              struct SchedU { const char* A; const char* B; Unit uu; __device__ __forceinline__ bool next(int i2, Unit& o) const { if (i2) return false; o = uu; return true; } __device__ __forceinline__ const char* pa(const Unit&) const { return A; } __device__ __forceinline__ const char* pb(const Unit&) const { return B; } };
              SchedU SU{S5.pa(u), S5.pb(u), u};
              pg8::gemm_phase<EpiQS, SchedU, false>(lds, 1024, 1024, 1024, SU, E); }
            { SchedOne S{(const char*)QS, (const char*)(KB + (size_t)b * NMEM * 1024 + h * 256)}; EpiSoftmax E{P};
              pg8::gemm_phase<EpiSoftmax, SchedOne, false>(lds, 256, 256, 1024, S, E); }
            { SchedOne S{(const char*)P, (const char*)(VT + ((size_t)b * 1024 + h * 256) * NMEM)}; EpiAttnO E{OB + (size_t)pm * 256 * 1024 + h * 256};
              pg8::gemm_phase<EpiAttnO, SchedOne, false>(lds, 256, 256, 256, S, E); }
        }
        sample_stage<6>(lds, a, bx, G, tid, wave, lane);
    }
#endif
    GRID_BAR(); STAMP(8);

    #ifndef NOP7
    LAUNDER();
    {
        SchedMN S; S.init(M, 1024, G, bx, OB, 1024, WO, 1024);
        EpiRes<bf16> E{X1B, X2B, RS2};
        pg8::gemm_phase<EpiRes<bf16>, SchedMN, true>(lds, 1024, 1024, 1024, S, E);
        sample_stage<7>(lds, a, bx, G, tid, wave, lane);
    }
#endif
    GRID_BAR(); STAMP(9);

    #ifndef NOP8
    LAUNDER();
    {
        SchedMN S; S.init(M, FF, G, bx, X2B, 1024, WUP, 1024);
        EpiScale<1> E{HID, FF, RS2};
        pg8::gemm_phase<EpiScale<1>, SchedMN, true>(lds, 1024, 1024, 1024, S, E);
        sample_stage<8>(lds, a, bx, G, tid, wave, lane);
    }
#endif
    GRID_BAR(); STAMP(10);

    #ifndef NOP9
    LAUNDER();
    {
        SchedMN S; S.init(M, 1024, G, bx, HID, FF, WDN, FF);
        EpiFinal E{X2B, out + O_Y, a.in[34], RS3, (unsigned*)ctl + CW_PAN, (unsigned*)ctl + CW_TMO};
        pg8::gemm_phase<EpiFinal, SchedMN, true>(lds, FF, FF, FF, S, E);
    }
#endif
#ifdef PROBE_CSPAN_A
    if (blockIdx.x == 64 && threadIdx.x == 0) {
        const unsigned long long ta = *(volatile LAS unsigned long long*)(lds + 140000 + 8 * PROBE_CSPAN_A), tb = *(volatile LAS unsigned long long*)(lds + 140000 + 8 * PROBE_CSPAN_B);
        const unsigned long long t0 = __builtin_amdgcn_s_memrealtime(), dl = (tb - ta) * PROBE_MULT;
        while (__builtin_amdgcn_s_memrealtime() - t0 < dl) __builtin_amdgcn_s_sleep(8);
    }
#endif
#ifdef PROBE_SSPAN_A
    if (blockIdx.x == 64 && threadIdx.x == 0) {
        const unsigned long long ta = *(volatile LAS unsigned long long*)(lds + LDSCTL_OFF + 64 + 8 * (16 + PROBE_SSPAN_A)), tb = *(volatile LAS unsigned long long*)(lds + LDSCTL_OFF + 64 + 8 * (16 + PROBE_SSPAN_B));
        const unsigned long long t0 = __builtin_amdgcn_s_memrealtime(), dl = (tb - ta) * PROBE_MULT;
        while (__builtin_amdgcn_s_memrealtime() - t0 < dl) __builtin_amdgcn_s_sleep(8);
    }
#endif
#ifdef PROBE_SPAN_A
    STAMP(12);
    if (blockIdx.x == 0 && threadIdx.x == 0) {
        const unsigned long long ta = *(volatile LAS unsigned long long*)(lds + LDSCTL_OFF + 64 + 8 * PROBE_SPAN_A), tb = *(volatile LAS unsigned long long*)(lds + LDSCTL_OFF + 64 + 8 * PROBE_SPAN_B);
        const unsigned long long t0 = __builtin_amdgcn_s_memrealtime(), dl = (tb - ta) * PROBE_MULT;
        while (__builtin_amdgcn_s_memrealtime() - t0 < dl) __builtin_amdgcn_s_sleep(8);
    }
#endif
}

extern "C" void kernel_launch(void* const* d_in, const int* in_sizes, int n_in, void* d_out, int out_size, void* d_ws, size_t ws_size, hipStream_t stream) {
    static int grid = 0;
    if (grid == 0) {
        if (n_in != 35 || out_size != (int)O_END || ws_size < WS_END) { fprintf(stderr, "kernel_launch: unexpected shapes (n_in %d, out %d, ws %zu); nothing launched\n", n_in, out_size, ws_size); grid = -1; return; }
        int dev = 0, cus = 0, per_cu = 0;
        if (hipGetDevice(&dev) != hipSuccess || hipDeviceGetAttribute(&cus, hipDeviceAttributeMultiprocessorCount, dev) != hipSuccess) { fprintf(stderr, "kernel_launch: device query failed\n"); grid = -1; return; }
        if (hipFuncSetAttribute((const void*)mk_fwd, hipFuncAttributeMaxDynamicSharedMemorySize, LDS_BYTES) != hipSuccess) { fprintf(stderr, "kernel_launch: hipFuncSetAttribute failed\n"); grid = -1; return; }
        if (hipOccupancyMaxActiveBlocksPerMultiprocessor(&per_cu, (const void*)mk_fwd, NWAVES * 64, LDS_BYTES) != hipSuccess || per_cu < 1)
            fprintf(stderr, "kernel_launch: note: occupancy query reports %d workgroups per CU\n", per_cu);
        (void)hipGetLastError();
        grid = cus;
        if (grid != 256) { fprintf(stderr, "kernel_launch: built for a 256-CU device (got %d)\n", grid); grid = -1; return; }
    }
    if (grid < 0) return;
    if (hipMemsetAsync((char*)d_ws + WS_CTL, 0, CTL_ZERO_BYTES, stream) != hipSuccess) { fprintf(stderr, "kernel_launch: hipMemsetAsync failed\n"); return; }
    KArgs a{};
    for (int i = 0; i < 35; ++i) a.in[i] = (const float*)d_in[i];
    a.out = (float*)d_out; a.ws = (unsigned char*)d_ws;
    hipLaunchKernelGGL(mk_fwd, dim3(grid), dim3(NWAVES * 64), LDS_BYTES, stream, a);
    const hipError_t le = hipPeekAtLastError();
    if (le != hipSuccess) fprintf(stderr, "kernel_launch: launch failed: %s\n", hipGetErrorName(le));
}
```

```cpp
#include <hip/hip_runtime.h>
#include <cstdio>
#include <cstdint>

namespace pg8 {
#define PG8_LAS __attribute__((address_space(3)))
typedef unsigned short bf16_t;
typedef short bf16x8 __attribute__((ext_vector_type(8)));
typedef float f32x4 __attribute__((ext_vector_type(4)));
typedef float f32x2 __attribute__((ext_vector_type(2)));
typedef unsigned u32x4 __attribute__((ext_vector_type(4)));
typedef unsigned u32x2 __attribute__((ext_vector_type(2)));
constexpr int BM = 256, BK = 64, HALF = 128, HTB = HALF * BK * 2  , STAGE_BYTES = 8 * HTB;

__host__ __device__ __forceinline__ int lds_byte(int r, int c) { const int st = (r >> 4) * 2 + (c >> 5), rr = r & 15, cc = c & 31, ob = rr * 64 + cc * 2; return st * 1024 + (ob ^ (((ob >> 9) & 1) << 5)); }
__host__ __device__ __forceinline__ void stage_rc(int b, int& R, int& C) { const int st = b / 1024, sb = b % 1024, swz = sb ^ (((sb >> 9) & 1) << 5); R = (st >> 1) * 16 + swz / 64; C = (st & 1) * 32 + (swz % 64) / 2; }
__host__ __device__ __forceinline__ int perm32(int rho) { const int n = rho >> 4, i = rho & 15; return 8 * (i >> 2) + 4 * n + (i & 3); }

struct Unit { int pm, pn; };

typedef __bf16 nbf16x2 __attribute__((ext_vector_type(2)));
__device__ __forceinline__ unsigned cvt_pk_bf16(float lo, float hi) { const nbf16x2 r = __builtin_convertvector((f32x2){lo, hi}, nbf16x2); return __builtin_bit_cast(unsigned, r); }
__device__ __forceinline__ f32x2 gelu_pk(f32x2 v) {
    const f32x2 av = __builtin_elementwise_abs(v), d = av * 0.2316418882f + 1.0f;
    f32x2 t; t.x = __builtin_amdgcn_rcpf(d.x); t.y = __builtin_amdgcn_rcpf(d.y);
    f32x2 q = t * 0.5307027145f + (-0.7265760135f); q = q * t + 0.7107068705f; q = q * t + (-0.142248368f); q = q * t + 0.127414796f; q = q * t;
    const f32x2 s = (v * v) * (-0.72134752044f);
    f32x2 e; e.x = __builtin_amdgcn_exp2f(s.x); e.y = __builtin_amdgcn_exp2f(s.y);
    const f32x2 m = v * (q * e), r = v - m;
    f32x2 o; o.x = v.x < 0.f ? m.x : r.x; o.y = v.y < 0.f ? m.y : r.y; return o;
}

template <class Epi, class Sched, bool ALIGN_EPI = false>
__device__ __forceinline__ void gemm_phase(PG8_LAS unsigned char* lds, const int K, const int lda, const int ldb, const Sched& S, const Epi& E) {
    int tid_ = threadIdx.x; asm volatile("" : "+v"(tid_));
    const int tid = tid_, wid = __builtin_amdgcn_readfirstlane(tid >> 6), lane = tid & 63, wr = wid >> 2, wc = wid & 3, fr = lane & 15, fq = lane >> 4;
    const int nt = K / BK;
    unsigned voffA[2], voffB[2];
#pragma unroll
    for (int i = 0; i < 2; ++i) { int R, C; stage_rc(tid * 16 + i * 8192, R, C); const int Rb = Epi::PERM ? ((R & ~31) + perm32(R & 31)) : R;
        voffA[i] = (unsigned)(R * lda + C) * 2u; voffB[i] = (unsigned)(Rb * ldb + C) * 2u; }
    const size_t kstep = (size_t)(BK * 2);
    const size_t hstepA = (size_t)HALF * lda * 2, hstepB = (size_t)HALF * ldb * 2;
    const unsigned ldsw = (unsigned)wid * 1024u;
    const int aoff = lds_byte(wr * 64 + fr, fq * 8), boff = lds_byte(wc * 32 + fr, fq * 8);
#define PG8_SA(b, h) (((b) * 2 + (h)) * HTB)
#define PG8_SB(b, h) ((4 + (b) * 2 + (h)) * HTB)
#define PG8_STAGE(bufoff, gbase, voff) do { _Pragma("unroll") for (int _i = 0; _i < 2; ++_i) \
        __builtin_amdgcn_global_load_lds((const unsigned*)((const char*)(gbase) + (voff)[_i]), (PG8_LAS unsigned*)(lds + (bufoff) + ldsw + _i * 8192), 16, 0, 0); } while (0)
#define PG8_LDA(dst, b, h) do { _Pragma("unroll") for (int m = 0; m < 4; ++m) _Pragma("unroll") for (int k = 0; k < 2; ++k) dst[m][k] = *(const PG8_LAS bf16x8*)(lds + PG8_SA(b, h) + aoff + m * 2048 + k * 1024); } while (0)
#define PG8_LDB(dst, b, h) do { _Pragma("unroll") for (int n = 0; n < 2; ++n) _Pragma("unroll") for (int k = 0; k < 2; ++k) dst[n][k] = *(const PG8_LAS bf16x8*)(lds + PG8_SB(b, h) + boff + n * 2048 + k * 1024); } while (0)
#define PG8_MMA(ai, bj, At, Bt) do { __builtin_amdgcn_s_setprio(1); _Pragma("unroll") for (int m = 0; m < 4; ++m) _Pragma("unroll") for (int n = 0; n < 2; ++n) _Pragma("unroll") for (int k = 0; k < 2; ++k) \
        acc[ai][bj][m][n] = __builtin_amdgcn_mfma_f32_16x16x32_bf16(Bt[n][k], At[m][k], acc[ai][bj][m][n], 0, 0, 0); __builtin_amdgcn_s_setprio(0); } while (0)
#define PG8_WAIT_V(n) asm volatile("s_waitcnt vmcnt(" #n ")" ::: "memory")
#define PG8_WAIT_L(n) asm volatile("s_waitcnt lgkmcnt(" #n ")" ::: "memory")
#define PG8_BAR __builtin_amdgcn_s_barrier()
#define PG8_SCHED __builtin_amdgcn_sched_barrier(0)
    Unit cur, nxt; int ui = 0;
    if (!S.next(0, cur)) return;
    f32x4 acc[2][2][4][2];
#pragma unroll
    for (int a = 0; a < 2; ++a)
#pragma unroll
        for (int b = 0; b < 2; ++b)
#pragma unroll
            for (int m = 0; m < 4; ++m)
#pragma unroll
                for (int n = 0; n < 2; ++n) acc[a][b][m][n] = (f32x4){0.f, 0.f, 0.f, 0.f};
    bf16x8 At[4][2], B0[2][2], B1[2][2];
    const char* cA = S.pa(cur); const char* cB = S.pb(cur);
    PG8_STAGE(PG8_SB(0, 0), cB, voffB); PG8_STAGE(PG8_SB(0, 1), cB + hstepB, voffB); PG8_STAGE(PG8_SA(0, 0), cA, voffA); PG8_STAGE(PG8_SA(0, 1), cA + hstepA, voffA);
    if (wr == 1) PG8_BAR;
    PG8_WAIT_V(2); PG8_BAR;
    PG8_STAGE(PG8_SB(1, 0), cB + kstep, voffB); PG8_STAGE(PG8_SA(1, 0), cA + kstep, voffA); PG8_STAGE(PG8_SB(1, 1), cB + hstepB + kstep, voffB);
    PG8_WAIT_V(6); PG8_BAR;
    for (;;) {
        const bool has_next = S.next(ui + 1, nxt);
        const char* nA = has_next ? S.pa(nxt) : cA; const char* nB = has_next ? S.pb(nxt) : cB;
#pragma unroll 1
        for (int t = 0; t < nt; t += 2) {
            const bool last = (t == nt - 2);
            const char* a1 = cA + (size_t)(t + 1) * kstep;
            const char* a2 = last ? nA : cA + (size_t)(t + 2) * kstep; const char* b2 = last ? nB : cB + (size_t)(t + 2) * kstep;
            const char* a3 = a2 + kstep; const char* b3 = b2 + kstep;
            PG8_LDB(B0, 0, 0); PG8_LDB(B1, 0, 1); PG8_SCHED; PG8_LDA(At, 0, 0); PG8_STAGE(PG8_SA(1, 1), a1 + hstepA, voffA);
            PG8_WAIT_V(8); PG8_WAIT_L(0); PG8_BAR; PG8_MMA(0, 0, At, B0); PG8_MMA(0, 1, At, B1); PG8_BAR; PG8_SCHED;
            PG8_LDA(At, 0, 1); PG8_STAGE(PG8_SB(0, 0), b2, voffB); PG8_STAGE(PG8_SB(0, 1), b2 + hstepB, voffB); PG8_STAGE(PG8_SA(0, 0), a2, voffA);
            PG8_WAIT_V(8); PG8_WAIT_L(0); PG8_BAR; PG8_MMA(1, 0, At, B0); PG8_MMA(1, 1, At, B1); PG8_BAR; PG8_SCHED;
            PG8_LDB(B0, 1, 0); PG8_LDB(B1, 1, 1); PG8_SCHED; PG8_LDA(At, 1, 0); PG8_STAGE(PG8_SA(0, 1), a2 + hstepA, voffA);
            PG8_WAIT_V(8); PG8_WAIT_L(0); PG8_BAR; PG8_MMA(0, 0, At, B0); PG8_MMA(0, 1, At, B1); PG8_BAR; PG8_SCHED;
            PG8_LDA(At, 1, 1); PG8_STAGE(PG8_SB(1, 0), b3, voffB); PG8_STAGE(PG8_SB(1, 1), b3 + hstepB, voffB); PG8_STAGE(PG8_SA(1, 0), a3, voffA);
            PG8_WAIT_V(8); PG8_WAIT_L(0); PG8_BAR; PG8_MMA(1, 0, At, B0); PG8_MMA(1, 1, At, B1); PG8_BAR; PG8_SCHED;
        }
        if constexpr (ALIGN_EPI) { if (wr == 0) PG8_BAR; }
        if constexpr (!Epi::AFTER_DRAIN) { E(acc, cur, wr, wc, fr, fq); }
        if (!has_next) break;
#pragma unroll
        for (int a = 0; a < 2; ++a)
#pragma unroll
            for (int b = 0; b < 2; ++b)
#pragma unroll
                for (int m = 0; m < 4; ++m)
#pragma unroll
                    for (int n = 0; n < 2; ++n) acc[a][b][m][n] = (f32x4){0.f, 0.f, 0.f, 0.f};
        cur = nxt; cA = nA; cB = nB; ++ui;
        if constexpr (ALIGN_EPI) { if (wr == 1) PG8_BAR; }
    }
    PG8_WAIT_V(0);
    if constexpr (!ALIGN_EPI) { if (wr == 0) PG8_BAR; }
    PG8_BAR;
    if constexpr (Epi::AFTER_DRAIN) { E.fused(acc, cur, wr, wc, fr, fq, lds, wid, lane); }
#undef PG8_SA
#undef PG8_SB
#undef PG8_STAGE
#undef PG8_LDA
#undef PG8_LDB
#undef PG8_MMA
#undef PG8_WAIT_V
#undef PG8_WAIT_L
#undef PG8_BAR
#undef PG8_SCHED
}
}

#define GAS __attribute__((address_space(1)))
#define LAS __attribute__((address_space(3)))
typedef unsigned short bf16;
typedef float f32x4 __attribute__((ext_vector_type(4)));
typedef float f32x2 __attribute__((ext_vector_type(2)));
typedef short bf16x8 __attribute__((ext_vector_type(8)));
typedef unsigned u32x4 __attribute__((ext_vector_type(4)));
typedef unsigned u32x2 __attribute__((ext_vector_type(2)));
typedef GAS unsigned gu32;
#define RLX_AGENT __ATOMIC_RELAXED, __HIP_MEMORY_SCOPE_AGENT
#define LDS_WAIT() asm volatile("s_waitcnt lgkmcnt(0)" ::: "memory")
#define VM_WAIT() asm volatile("s_waitcnt vmcnt(0)" ::: "memory")

constexpr int NWAVES = 8;
constexpr int D = 1024, M = 16384, SEQ = 2048, NBATCH = 8, MS = 128, DIN = 2816, DSH = 1792, DB = 512, FF = 4096, NMEM = 256;
constexpr float RMS_EPS = 1e-6f, LN_EPS = 1e-5f, GN_EPS = 64e-5f;
constexpr size_t O_Y = 0, O_YS = 16777216, O_MK = 16908288, O_MV = 19005440, O_SHP = 21102592, O_WKVP = 21116928, O_CVP = 21379072, O_SHS = 21903360, O_WKVS = 22132736, O_CVS = 26327040, O_END = 26392576;
constexpr size_t MiB = 1u << 20, KiB = 1024;
constexpr size_t WS_CTL = 0, CTL_ZERO_BYTES = 1 * MiB;
constexpr size_t WS_WCAT = 2 * MiB;
constexpr size_t WS_WOUT = 12 * MiB, WS_WQ = 14 * MiB, WS_WO = 16 * MiB, WS_WUP = 18 * MiB, WS_WDN = 26 * MiB;
constexpr size_t WS_SMALL = 34 * MiB;
constexpr size_t WS_ACAT = 36 * MiB;
constexpr size_t WS_ZA = 73 * MiB;
constexpr size_t WS_PB = 105 * MiB;
constexpr size_t WS_Q = 105 * MiB, WS_OB = 137 * MiB;
constexpr size_t WS_SCN = 161 * MiB;
constexpr size_t WS_PSCR = 169 * MiB, WS_HID = 201 * MiB;
constexpr size_t WS_G = 353 * MiB;
constexpr size_t WS_MIX = 369 * MiB;
constexpr size_t WS_KB = 401 * MiB, WS_VT = 405 * MiB;
constexpr size_t WS_SMP = 409 * MiB;
constexpr size_t SM_ZA = 0, SM_MIX = 256 * KiB, SM_X1 = 512 * KiB, SM_X1B = 1024 * KiB, SM_Q = 1280 * KiB, SM_O = 1792 * KiB, SM_X2 = 2048 * KiB, SM_X2B = 2560 * KiB, SM_HID = 3072 * KiB, SM_X3 = 4096 * KiB;
constexpr size_t WS_NEW = 416 * MiB;
constexpr size_t WS_END = 505 * MiB;
constexpr int CW_TMO = 0, CW_CODE = 1, CW_BAR = 4096, CW_SUB = 8192, CW_QATT = 8256, CW_QMIX = 8320, CW_PAN = 12288;
constexpr int RS_OFF = 65536, RS_STRIDE = 16640;
constexpr int RING_BYTES = 131072, LDSCTL_OFF = RING_BYTES, MISC_OFF = LDSCTL_OFF + 320, LDS_BYTES = 147456;

__device__ __forceinline__ float bf_lo(unsigned u) { return __uint_as_float(u << 16); }
__device__ __forceinline__ float bf_hi(unsigned u) { return __uint_as_float(u & 0xffff0000u); }
__device__ __forceinline__ float bf1(bf16 v) { return __uint_as_float(((unsigned)v) << 16); }
__device__ __forceinline__ unsigned pk2(float lo, float hi) { return pg8::cvt_pk_bf16(lo, hi); }
__device__ __forceinline__ f32x4 bf4(u32x2 v) { return (f32x4){bf_lo(v.x), bf_hi(v.x), bf_lo(v.y), bf_hi(v.y)}; }
__device__ __forceinline__ u32x2 pk4(f32x4 v) { u32x2 r; r.x = pk2(v.x, v.y); r.y = pk2(v.z, v.w); return r; }
__device__ __forceinline__ float fast_exp(float x) { return __builtin_amdgcn_exp2f(x * 1.44269504089f); }
__device__ __forceinline__ float fast_log(float x) { return __builtin_amdgcn_logf(x) * 0.69314718056f; }
__device__ __forceinline__ float fast_sigmoid(float x) { return __builtin_amdgcn_rcpf(1.0f + fast_exp(-x)); }
__device__ __forceinline__ float fast_tanh(float x) { return 1.0f - 2.0f * __builtin_amdgcn_rcpf(fast_exp(2.0f * x) + 1.0f); }
template <int CTRL> __device__ __forceinline__ float dpp_mov(float x) { return __builtin_bit_cast(float, __builtin_amdgcn_mov_dpp(__builtin_bit_cast(int, x), CTRL, 0xf, 0xf, true)); }
__device__ __forceinline__ float red4(float x) { x += dpp_mov<0xB1>(x); x += dpp_mov<0x4E>(x); return x; }
__device__ __forceinline__ float red8(float x) { x = red4(x); x += dpp_mov<0x141>(x); return x; }
__device__ __forceinline__ float red16(float x) { x = red8(x); x += dpp_mov<0x128>(x); return x; }
__device__ __forceinline__ float wave_sum(float v) {
#pragma unroll
    for (int o = 1; o < 64; o <<= 1) v += __shfl_xor(v, o);
    return v;
}
__device__ __forceinline__ float wave_max(float v) {
#pragma unroll
    for (int o = 1; o < 64; o <<= 1) v = fmaxf(v, __shfl_xor(v, o));
    return v;
}

#define XB_TMO      128
#define XB_XCNT(j)  (256  + 64 * (j))
#define XB_XSUB(j)  (1280 + 64 * (j))
#define XB_XGEN(j)  (2304 + 64 * (j))
#define XB_TOP      3328
#define XB_TOPGEN   3392
#define XCD_BAR_WORDS 3456
#define XB_SPIN_CAP (1u << 18)
__device__ __forceinline__ unsigned xb_ld(unsigned* p)              { return __hip_atomic_load(p, __ATOMIC_RELAXED, __HIP_MEMORY_SCOPE_AGENT); }
__device__ __forceinline__ unsigned xb_add(unsigned* p, unsigned v) { return __hip_atomic_fetch_add(p, v, __ATOMIC_RELAXED, __HIP_MEMORY_SCOPE_AGENT); }
__device__ __forceinline__ unsigned xb_xcc_id() { return (unsigned)__builtin_amdgcn_s_getreg((3 << 11) | 20) & 0xFu; }
#define XB_SPIN(cond, bar) do { unsigned _sp = 0; while (cond) { __builtin_amdgcn_s_sleep(1); \
    if ((++_sp & 255u) == 0u) { if (xb_ld(&(bar)[XB_TMO])) break; if (_sp > XB_SPIN_CAP) { atomicAdd(&(bar)[XB_TMO], 1u); break; } } } } while (0)
struct XcdBarrier { unsigned* bar; unsigned x; volatile LAS unsigned* st; };
__device__ __forceinline__ XcdBarrier xcd_barrier_post(unsigned* bar, volatile LAS unsigned* st) {
    XcdBarrier b; b.bar = bar; b.x = xb_xcc_id(); b.st = st;
    if (threadIdx.x == 0) (void)xb_add(&bar[XB_XCNT(b.x)], 1u);
    return b;
}
__device__ __forceinline__ void xcd_barrier_complete(unsigned* bar, unsigned x, unsigned& nloc, unsigned& nx) {
    const unsigned G = gridDim.x * gridDim.y * gridDim.z;
    unsigned sum, cnt, mine, sp = 0u;
    for (;;) {
        sum = 0u; cnt = 0u; mine = 0u;
#pragma unroll
        for (unsigned j = 0; j < 16; ++j) { const unsigned c = xb_ld(&bar[XB_XCNT(j)]); sum += c; cnt += (c > 0u) ? 1u : 0u; mine = (j == x) ? c : mine; }
        if (sum == G) break;
        __builtin_amdgcn_s_sleep(1);
        if ((++sp & 255u) == 0u) { if (xb_ld(&bar[XB_TMO])) break; if (sp > XB_SPIN_CAP) { atomicAdd(&bar[XB_TMO], 1u); break; } }
    }
    nloc = mine > 0u ? mine : 1u; nx = cnt > 0u ? cnt : 1u;
}
__device__ __forceinline__ void xcd_barrier(const XcdBarrier& b) {
    asm volatile("s_waitcnt vmcnt(0)" ::: "memory");
    __syncthreads();
    if (threadIdx.x == 0) {
        unsigned* bar = b.bar;
        __builtin_amdgcn_s_waitcnt(0);
        unsigned nloc = b.st[0], nx = b.st[1];
        if (nloc == 0u) { xcd_barrier_complete(bar, b.x, nloc, nx); b.st[0] = nloc; b.st[1] = nx; }
        const unsigned old = xb_add(&bar[XB_XSUB(b.x)], 1u);
        const unsigned gen = old / nloc;
        if (old + 1u == (gen + 1u) * nloc) {
            __builtin_amdgcn_fence(__ATOMIC_RELEASE, "agent");
            asm volatile("s_waitcnt vmcnt(0)" ::: "memory");
            const unsigned og = xb_add(&bar[XB_TOP], 1u);
            const unsigned tg = og / nx;
            if (og + 1u == (tg + 1u) * nx) xb_add(&bar[XB_TOPGEN], 1u);
            else XB_SPIN(xb_ld(&bar[XB_TOPGEN]) == tg, bar);
            __builtin_amdgcn_fence(__ATOMIC_ACQUIRE, "agent");
            xb_add(&bar[XB_XGEN(b.x)], 1u);
            asm volatile("s_waitcnt vmcnt(0)" ::: "memory");
        } else {
            XB_SPIN(xb_ld(&bar[XB_XGEN(b.x)]) == gen, bar);
            __builtin_amdgcn_fence(__ATOMIC_ACQUIRE, "agent");
            asm volatile("s_waitcnt vmcnt(0)" ::: "memory");
        }
    }
    __syncthreads();
}
__device__ __forceinline__ void sub_barrier(unsigned* cnt, unsigned* tmo, unsigned target) {
    asm volatile("s_waitcnt vmcnt(0)" ::: "memory");
    __syncthreads();
    if (threadIdx.x == 0) {
        __builtin_amdgcn_fence(__ATOMIC_RELEASE, "agent");
        asm volatile("s_waitcnt vmcnt(0)" ::: "memory");
        (void)xb_add(cnt, 1u);
        unsigned sp = 0;
        while (xb_ld(cnt) < target) { __builtin_amdgcn_s_sleep(1); if ((++sp & 255u) == 0u) { if (xb_ld(tmo)) break; if (sp > (1u << 20)) { atomicAdd(tmo, 1u); break; } } }
        __builtin_amdgcn_fence(__ATOMIC_ACQUIRE, "agent");
        asm volatile("s_waitcnt vmcnt(0)" ::: "memory");
    }
    __syncthreads();
}

__device__ __forceinline__ void p0_transpose_item(const float* W, int K, int N, bf16* WT, int row_off, const float* gk, LAS float* scr, int item, int lane) {
    const int nblk = N / 32, kb = item / nblk, nb = item % nblk, k0 = 64 * kb, n0 = 32 * nb;
    f32x4 vv[8];
#pragma unroll
    for (int i = 0; i < 8; ++i) vv[i] = __builtin_nontemporal_load((const f32x4*)(W + (size_t)(k0 + 8 * i + (lane >> 3)) * N + n0 + 4 * (lane & 7)));
    if (gk) {
#pragma unroll
        for (int i = 0; i < 8; ++i) vv[i] = vv[i] * gk[k0 + 8 * i + (lane >> 3)]; }
#pragma unroll
    for (int i = 0; i < 8; ++i) { LAS float* d = scr + (8 * i + (lane >> 3)) * 33 + 4 * (lane & 7); d[0] = vv[i][0]; d[1] = vv[i][1]; d[2] = vv[i][2]; d[3] = vv[i][3]; }
    LDS_WAIT(); asm volatile("" ::: "memory");
    const int c = lane & 7;
#pragma unroll
    for (int j = 0; j < 4; ++j) { const int n = (lane >> 3) + 8 * j; const LAS float* s = scr + (8 * c) * 33 + n;
        u32x4 o; o.x = pk2(s[0 * 33], s[1 * 33]); o.y = pk2(s[2 * 33], s[3 * 33]); o.z = pk2(s[4 * 33], s[5 * 33]); o.w = pk2(s[6 * 33], s[7 * 33]);
        *(u32x4*)(WT + (size_t)(row_off + n0 + n) * K + k0 + 8 * c) = o; }
    LDS_WAIT(); asm volatile("" ::: "memory");
}
__device__ __forceinline__ void rms_row_to_bf16(const float* xrow, const float* g, bf16* orow, int lane) {
    const f32x4* xr = (const f32x4*)xrow + lane; const f32x4* gr = (const f32x4*)g + lane;
    f32x4 v[4]; float s = 0.f;
#pragma unroll
    for (int j = 0; j < 4; ++j) { v[j] = xr[64 * j]; s += (v[j].x * v[j].x + v[j].y * v[j].y) + (v[j].z * v[j].z + v[j].w * v[j].w); }
    const float rstd = 1.f / sqrtf(wave_sum(s) * (1.f / D) + RMS_EPS);
    unsigned long long* o8 = (unsigned long long*)orow + lane;
#pragma unroll
    for (int j = 0; j < 4; ++j) { const f32x4 gg = gr[64 * j]; o8[64 * j] = (unsigned long long)pk2(v[j].x * rstd * gg.x, v[j].y * rstd * gg.y) | ((unsigned long long)pk2(v[j].z * rstd * gg.z, v[j].w * rstd * gg.w) << 32); }
}

using pg8::Unit;
struct SchedMN {
    int nM, nN, nwg, G, c; const char* A; const char* Bt; size_t ta, tb;
    __device__ __forceinline__ void init(int M_, int N_, int G_, int c_, const void* A_, size_t lda, const void* Bt_, size_t ldb) { nM = M_ / 256; nN = N_ / 256; nwg = nM * nN; G = G_; c = c_; A = (const char*)A_; Bt = (const char*)Bt_; ta = 256 * lda * 2; tb = 256 * ldb * 2; }
    __device__ __forceinline__ bool next(int i, Unit& u) const {
        const long L = (long)i * G + c; if (L >= nwg) return false;
        int wgid = (int)L; { const int q = nwg / 8, r = nwg % 8, xcd = wgid % 8, off = wgid / 8; wgid = (xcd < r ? xcd * (q + 1) : r * (q + 1) + (xcd - r) * q) + off; }
        const int nig = 8 * nN, gid = wgid / nig, fm = gid * 8, gsz = (nM - fm) < 8 ? (nM - fm) : 8;
        u.pm = fm + ((wgid % nig) % gsz); u.pn = (wgid % nig) / gsz; return true;
    }
    __device__ __forceinline__ const char* pa(const Unit& u) const { return A + (size_t)u.pm * ta; }
    __device__ __forceinline__ const char* pb(const Unit& u) const { return Bt + (size_t)u.pn * tb; }
};
struct SchedP1 {
    int G, c; const char* A; const char* Bt;
    __device__ __forceinline__ bool next(int i, Unit& u) const {
        const int L = i * G + c; if (L >= 768) return false;
        const int wgid = (L % 8) * 96 + L / 8;
        if (wgid < 704) { const int nig = 88, gid = wgid / nig, w = wgid % nig; u.pm = gid * 8 + (w & 7); u.pn = w >> 3; }
        else { const int w = wgid - 704; u.pm = 65 + (w & 7); u.pn = 11 + (w >> 3); }
        return true;
    }
    __device__ __forceinline__ const char* pa(const Unit& u) const { return A + (size_t)u.pm * (256 * 1024 * 2); }
    __device__ __forceinline__ const char* pb(const Unit& u) const { return Bt + (size_t)u.pn * (256 * 1024 * 2); }
};
struct SchedOne {
    const char* A; const char* B;
    __device__ __forceinline__ bool next(int i, Unit& u) const { if (i) return false; u.pm = 0; u.pn = 0; return true; }
    __device__ __forceinline__ const char* pa(const Unit&) const { return A; }
    __device__ __forceinline__ const char* pb(const Unit&) const { return B; }
};

typedef GAS bf16 gbf16; typedef GAS float gf32;
__device__ __forceinline__ void st16(gbf16* p, f32x4 v0, f32x4 v1) { u32x4 w; w.x = pk2(v0[0], v0[1]); w.y = pk2(v0[2], v0[3]); w.z = pk2(v1[0], v1[1]); w.w = pk2(v1[2], v1[3]); *(GAS u32x4*)p = w; }
struct EpiP1 {
    static constexpr bool PERM = true, AFTER_DRAIN = false;
    bf16* ZA; bf16* PB; float* outK; float* outV; bf16* KB;
    __device__ __forceinline__ void operator()(f32x4 (&acc)[2][2][4][2], const Unit& u, int wr, int wc, int fr, int fq) const {
        if (u.pm < 64) {
            const int row0 = u.pm * 256 + wr * 64 + fr; const bool act = u.pn < 4;
            gbf16* base = act ? (gbf16*)ZA : (gbf16*)PB; const int ldc = act ? 1024 : DSH; const int col0 = (act ? u.pn : u.pn - 4) * 256 + wc * 32 + 8 * fq;
#pragma unroll
            for (int ai = 0; ai < 2; ++ai)
#pragma unroll
                for (int m = 0; m < 4; ++m) { gbf16* rowp = base + (size_t)(row0 + ai * 128 + m * 16) * ldc + col0;
#pragma unroll
                    for (int bj = 0; bj < 2; ++bj) { f32x4 v0 = acc[ai][bj][m][0], v1 = acc[ai][bj][m][1];
                        if (act) { f32x2 a = pg8::gelu_pk((f32x2){v0[0], v0[1]}), b = pg8::gelu_pk((f32x2){v0[2], v0[3]}), c = pg8::gelu_pk((f32x2){v1[0], v1[1]}), d = pg8::gelu_pk((f32x2){v1[2], v1[3]});
                            v0 = (f32x4){a.x, a.y, b.x, b.y}; v1 = (f32x4){c.x, c.y, d.x, d.y}; }
                        st16(rowp + bj * 128, v0, v1); } }
        } else {
            const int row0 = (u.pm - 65) * 256 + wr * 64 + fr; const int ct = u.pn - 11; const bool isK = ct < 4; const int col0 = (ct & 3) * 256 + wc * 32 + 8 * fq;
            gf32* o = isK ? (gf32*)outK : (gf32*)outV;
#pragma unroll
            for (int ai = 0; ai < 2; ++ai)
#pragma unroll
                for (int m = 0; m < 4; ++m) { const size_t off = (size_t)(row0 + ai * 128 + m * 16) * 1024 + col0;
#pragma unroll
                    for (int bj = 0; bj < 2; ++bj) { const f32x4 v0 = acc[ai][bj][m][0], v1 = acc[ai][bj][m][1];
                        *(GAS f32x4*)(o + off + bj * 128) = v0; *(GAS f32x4*)(o + off + bj * 128 + 4) = v1;
                        if (isK) st16((gbf16*)KB + off + bj * 128, v0, v1); } }
        }
    }
};
__device__ __forceinline__ void ld8(const float* p, f32x4& a, f32x4& b) { a = *(const GAS f32x4*)((const gf32*)p); b = *(const GAS f32x4*)((const gf32*)p + 4); }
__device__ __forceinline__ void ld8(const bf16* p, f32x4& a, f32x4& b) { const u32x4 w = *(const GAS u32x4*)((const gbf16*)p); a = (f32x4){bf_lo(w.x), bf_hi(w.x), bf_lo(w.y), bf_hi(w.y)}; b = (f32x4){bf_lo(w.z), bf_hi(w.z), bf_lo(w.w), bf_hi(w.w)}; }
template <class BT> struct EpiRes {
    static constexpr bool PERM = true, AFTER_DRAIN = false;
    const BT* base; bf16* outb; float* rowss;
    __device__ __forceinline__ void operator()(f32x4 (&acc)[2][2][4][2], const Unit& u, int wr, int wc, int fr, int fq) const {
        const int row0 = u.pm * 256 + wr * 64 + fr, col0 = u.pn * 256 + wc * 32 + 8 * fq;
#pragma unroll
        for (int ai = 0; ai < 2; ++ai)
#pragma unroll
            for (int m = 0; m < 4; ++m) { const int r = row0 + ai * 128 + m * 16; const size_t off = (size_t)r * 1024 + col0; float ss = 0.f;
#pragma unroll
                for (int bj = 0; bj < 2; ++bj) { f32x4 b0, b1; ld8(base + off + bj * 128, b0, b1);
                    const f32x4 v0 = acc[ai][bj][m][0] + b0, v1 = acc[ai][bj][m][1] + b1;
                    st16((gbf16*)outb + off + bj * 128, v0, v1);
                    ss += (v0[0] * v0[0] + v0[1] * v0[1]) + (v0[2] * v0[2] + v0[3] * v0[3]) + (v1[0] * v1[0] + v1[1] * v1[1]) + (v1[2] * v1[2] + v1[3] * v1[3]); }
                ss += __shfl_xor(ss, 16); ss += __shfl_xor(ss, 32);
                if (fq == 0) (void)__hip_atomic_fetch_add(rowss + r, ss, __ATOMIC_RELAXED, __HIP_MEMORY_SCOPE_AGENT); }
    }
};
struct EpiFinal {
    static constexpr bool PERM = true, AFTER_DRAIN = false;
    const bf16* base; float* out; const float* gain; float* rowss; unsigned* cnt; unsigned* tmo;
    __device__ __forceinline__ void operator()(f32x4 (&acc)[2][2][4][2], const Unit& u, int wr, int wc, int fr, int fq) const {
        const int row0 = u.pm * 256 + wr * 64 + fr, col0 = u.pn * 256 + wc * 32 + 8 * fq;
#pragma unroll
        for (int ai = 0; ai < 2; ++ai)
#pragma unroll
            for (int m = 0; m < 4; ++m) { const int r = row0 + ai * 128 + m * 16; const size_t off = (size_t)r * 1024 + col0; float ss = 0.f;
#pragma unroll
                for (int bj = 0; bj < 2; ++bj) { f32x4 b0, b1; ld8(base + off + bj * 128, b0, b1);
                    const f32x4 v0 = acc[ai][bj][m][0] + b0, v1 = acc[ai][bj][m][1] + b1; acc[ai][bj][m][0] = v0; acc[ai][bj][m][1] = v1;
                    ss += (v0[0] * v0[0] + v0[1] * v0[1]) + (v0[2] * v0[2] + v0[3] * v0[3]) + (v1[0] * v1[0] + v1[1] * v1[1]) + (v1[2] * v1[2] + v1[3] * v1[3]); }
                ss += __shfl_xor(ss, 16); ss += __shfl_xor(ss, 32);
                if (fq == 0) (void)__hip_atomic_fetch_add(rowss + r, ss, __ATOMIC_RELAXED, __HIP_MEMORY_SCOPE_AGENT); }
        asm volatile("s_waitcnt vmcnt(0)" ::: "memory");
        unsigned* c = cnt + 64 * u.pm;
        if ((threadIdx.x & 63) == 0) (void)xb_add(c, 1u);
        { unsigned sp = 0; while (xb_ld(c) < 32u) { __builtin_amdgcn_s_sleep(1); if ((++sp & 255u) == 0u) { if (xb_ld(tmo)) break; if (sp > (1u << 20)) { atomicAdd(tmo, 1u); break; } } } }
        f32x4 g[2][2];
#pragma unroll
        for (int bj = 0; bj < 2; ++bj) { g[bj][0] = *(const GAS f32x4*)((const gf32*)gain + col0 + bj * 128); g[bj][1] = *(const GAS f32x4*)((const gf32*)gain + col0 + bj * 128 + 4); }
#pragma unroll
        for (int ai = 0; ai < 2; ++ai)
#pragma unroll
            for (int m = 0; m < 4; ++m) { const int r = row0 + ai * 128 + m * 16; const size_t off = (size_t)r * 1024 + col0;
                const float sc = 1.f / sqrtf(__hip_atomic_load(rowss + r, __ATOMIC_RELAXED, __HIP_MEMORY_SCOPE_AGENT) * (1.f / D) + RMS_EPS);
#pragma unroll
                for (int bj = 0; bj < 2; ++bj) { __builtin_nontemporal_store(acc[ai][bj][m][0] * sc * g[bj][0], (GAS f32x4*)((gf32*)out + off + bj * 128)); __builtin_nontemporal_store(acc[ai][bj][m][1] * sc * g[bj][1], (GAS f32x4*)((gf32*)out + off + bj * 128 + 4)); } }
    }
};
template <int MODE> struct EpiScale {
    static constexpr bool PERM = true, AFTER_DRAIN = false;
    bf16* O; int ldc; const float* rowss;
    __device__ __forceinline__ void operator()(f32x4 (&acc)[2][2][4][2], const Unit& u, int wr, int wc, int fr, int fq) const {
        const int row0 = u.pm * 256 + wr * 64 + fr, col0 = u.pn * 256 + wc * 32 + 8 * fq;
#pragma unroll
        for (int ai = 0; ai < 2; ++ai)
#pragma unroll
            for (int m = 0; m < 4; ++m) { const int r = row0 + ai * 128 + m * 16;
                float sc = 1.f / sqrtf(__hip_atomic_load(rowss + r, __ATOMIC_RELAXED, __HIP_MEMORY_SCOPE_AGENT) * (1.f / D) + RMS_EPS); if (MODE == 0) sc *= 0.0625f;
                gbf16* rowp = (gbf16*)O + (size_t)r * ldc + col0;
#pragma unroll
                for (int bj = 0; bj < 2; ++bj) { f32x4 v0 = acc[ai][bj][m][0] * sc, v1 = acc[ai][bj][m][1] * sc;
                    if (MODE == 1) {
#pragma unroll
                        for (int j = 0; j < 4; ++j) { const float a = fmaxf(v0[j], 0.f), b = fmaxf(v1[j], 0.f); v0[j] = a * a; v1[j] = b * b; } }
                    st16(rowp + bj * 128, v0, v1); } }
    }
};
struct EpiQS {
    static constexpr bool PERM = true, AFTER_DRAIN = false;
    bf16* QS; const float* rowss;
    __device__ __forceinline__ void operator()(f32x4 (&acc)[2][2][4][2], const Unit& u, int wr, int wc, int fr, int fq) const {
#pragma unroll
        for (int ai = 0; ai < 2; ++ai)
#pragma unroll
            for (int m = 0; m < 4; ++m) { const int rl = ai * 128 + wr * 64 + m * 16 + fr;
                const float sc = 0.0625f / sqrtf(__hip_atomic_load(rowss + u.pm * 256 + rl, __ATOMIC_RELAXED, __HIP_MEMORY_SCOPE_AGENT) * (1.f / D) + RMS_EPS);
                gbf16* rowp = (gbf16*)QS + (size_t)rl * 256 + wc * 32 + 8 * fq;
#pragma unroll
                for (int bj = 0; bj < 2; ++bj) st16(rowp + bj * 128, acc[ai][bj][m][0] * sc, acc[ai][bj][m][1] * sc); }
    }
};
struct EpiSoftmax {
    static constexpr bool PERM = true, AFTER_DRAIN = true;
    bf16* P;
    __device__ __forceinline__ void fused(f32x4 (&acc)[2][2][4][2], const Unit&, int wr, int wc, int fr, int fq, PG8_LAS unsigned char* lds, int, int) const {
        PG8_LAS float* T1 = (PG8_LAS float*)lds; PG8_LAS float* T2 = (PG8_LAS float*)(lds + 4096);
#pragma unroll
        for (int ai = 0; ai < 2; ++ai)
#pragma unroll
            for (int m = 0; m < 4; ++m) { float mx = -3.0e38f;
#pragma unroll
                for (int bj = 0; bj < 2; ++bj)
#pragma unroll
                    for (int n = 0; n < 2; ++n) { const f32x4 x = acc[ai][bj][m][n]; mx = fmaxf(mx, fmaxf(fmaxf(x[0], x[1]), fmaxf(x[2], x[3]))); }
                mx = fmaxf(mx, __shfl_xor(mx, 16)); mx = fmaxf(mx, __shfl_xor(mx, 32));
                if (fq == 0) T1[(ai * 128 + wr * 64 + m * 16 + fr) * 4 + wc] = mx; }
        asm volatile("s_waitcnt lgkmcnt(0)" ::: "memory"); __builtin_amdgcn_s_barrier(); asm volatile("" ::: "memory");
#pragma unroll
        for (int ai = 0; ai < 2; ++ai)
#pragma unroll
            for (int m = 0; m < 4; ++m) { const int row = ai * 128 + wr * 64 + m * 16 + fr; const f32x4 t = *(const PG8_LAS f32x4*)(T1 + row * 4);
                const float mxr = fmaxf(fmaxf(t[0], t[1]), fmaxf(t[2], t[3])) * 1.44269504089f; float sum = 0.f;
#pragma unroll
                for (int bj = 0; bj < 2; ++bj)
#pragma unroll
                    for (int n = 0; n < 2; ++n) { f32x4 x = acc[ai][bj][m][n];
#pragma unroll
                        for (int j = 0; j < 4; ++j) { x[j] = __builtin_amdgcn_exp2f(x[j] * 1.44269504089f - mxr); sum += x[j]; }
                        acc[ai][bj][m][n] = x; }
                sum += __shfl_xor(sum, 16); sum += __shfl_xor(sum, 32);
                if (fq == 0) T2[row * 4 + wc] = sum; }
        asm volatile("s_waitcnt lgkmcnt(0)" ::: "memory"); __builtin_amdgcn_s_barrier(); asm volatile("" ::: "memory");
#pragma unroll
        for (int ai = 0; ai < 2; ++ai)
#pragma unroll
            for (int m = 0; m < 4; ++m) { const int row = ai * 128 + wr * 64 + m * 16 + fr; const f32x4 t = *(const PG8_LAS f32x4*)(T2 + row * 4);
                const float inv = 1.f / ((t[0] + t[1]) + (t[2] + t[3]));
                gbf16* rowp = (gbf16*)P + (size_t)row * 256 + wc * 32 + 8 * fq;
#pragma unroll
                for (int bj = 0; bj < 2; ++bj) st16(rowp + bj * 128, acc[ai][bj][m][0] * inv, acc[ai][bj][m][1] * inv); }
        asm volatile("s_waitcnt vmcnt(0) lgkmcnt(0)" ::: "memory"); __builtin_amdgcn_s_barrier(); asm volatile("" ::: "memory");
    }
};
struct EpiAttnO {
    static constexpr bool PERM = true, AFTER_DRAIN = false;
    bf16* O;
    __device__ __forceinline__ void operator()(f32x4 (&acc)[2][2][4][2], const Unit&, int wr, int wc, int fr, int fq) const {
#pragma unroll
        for (int ai = 0; ai < 2; ++ai)
#pragma unroll
            for (int m = 0; m < 4; ++m) { gbf16* rowp = (gbf16*)O + (size_t)(ai * 128 + wr * 64 + m * 16 + fr) * 1024 + wc * 32 + 8 * fq;
#pragma unroll
                for (int bj = 0; bj < 2; ++bj) st16(rowp + bj * 128, acc[ai][bj][m][0], acc[ai][bj][m][1]); }
    }
};

__device__ __forceinline__ void mixer_a_tile(LAS unsigned char* lds, int tile, const bf16* ZA, const bf16* WSB, const float* gm_ln_g, const float* gm_ln_b, const float* gm_bs, bf16* MIX, float* out_cv, int tid, int wave, int lane) {
    const int h = tile & 3, bc = tile >> 2, m0 = bc * 128, fr = lane & 15, fq = lane >> 4; const bool lastc = (bc & 15) == 15;
    LAS bf16* VT = (LAS bf16*)lds;
    {   const int r = 16 * wave + (lane >> 2), cq = (lane & 3) * 32; const bf16* src = ZA + (size_t)(m0 + r) * 1024 + 512 + h * 128 + cq;
        float x[32]; float s = 0.f;
#pragma unroll
        for (int j = 0; j < 4; ++j) { const u32x4 pv = __builtin_nontemporal_load((const u32x4*)(src + 8 * j));
            x[8 * j + 0] = bf_lo(pv.x); x[8 * j + 1] = bf_hi(pv.x); x[8 * j + 2] = bf_lo(pv.y); x[8 * j + 3] = bf_hi(pv.y); x[8 * j + 4] = bf_lo(pv.z); x[8 * j + 5] = bf_hi(pv.z); x[8 * j + 6] = bf_lo(pv.w); x[8 * j + 7] = bf_hi(pv.w); }
#pragma unroll
        for (int j = 0; j < 32; ++j) s += x[j];
        const float mean = red4(s) * (1.f / 128.f); float q = 0.f;
#pragma unroll
        for (int j = 0; j < 32; ++j) { x[j] -= mean; q += x[j] * x[j]; }
        const float rstd = 1.f / sqrtf(red4(q) * (1.f / 128.f) + LN_EPS);
#pragma unroll
        for (int j = 0; j < 8; ++j) { const f32x4 g = *(const f32x4*)(gm_ln_g + h * 128 + cq + 4 * j), bb = *(const f32x4*)(gm_ln_b + h * 128 + cq + 4 * j);
#pragma unroll
            for (int e = 0; e < 4; ++e) x[4 * j + e] = x[4 * j + e] * rstd * g[e] + bb[e]; }
        if (lastc) { float* o = out_cv + ((size_t)((bc >> 4) * 128 + r) * 4 + h) * 128 + cq;
#pragma unroll
            for (int j = 0; j < 8; ++j) *(f32x4*)(o + 4 * j) = (f32x4){x[4 * j], x[4 * j + 1], x[4 * j + 2], x[4 * j + 3]}; }
#pragma unroll
        for (int j = 0; j < 32; j += 2) { const unsigned w = pk2(x[j], x[j + 1]); VT[(cq + j) * 136 + r] = (bf16)(w & 0xffffu); VT[(cq + j + 1) * 136 + r] = (bf16)(w >> 16); }
    }
    const int t_ = 16 * wave + fr; const size_t rowo = (size_t)(m0 + t_) * 1024 + h * 128; const float bsv = gm_bs[h * 128 + t_];
    u32x2 uq[8];
#pragma unroll
    for (int n = 0; n < 8; ++n) uq[n] = *(const u32x2*)(ZA + rowo + 16 * n + 4 * fq);
    bf16x8 wsf[4];
#pragma unroll
    for (int ks = 0; ks < 4; ++ks) wsf[ks] = *(const bf16x8*)(WSB + (size_t)(h * 128 + 16 * wave + fr) * 128 + 32 * ks + 8 * fq);
    __syncthreads();
    f32x4 acc[8];
#pragma unroll
    for (int n = 0; n < 8; ++n) acc[n] = (f32x4){0.f, 0.f, 0.f, 0.f};
    const int nks = (wave >> 1) + 1;
#pragma unroll
    for (int ks = 0; ks < 4; ++ks) if (ks < nks) {
#pragma unroll
        for (int n = 0; n < 8; ++n) { const bf16x8 vf = *(const LAS bf16x8*)(VT + (16 * n + fr) * 136 + 32 * ks + 8 * fq); acc[n] = __builtin_amdgcn_mfma_f32_16x16x32_bf16(vf, wsf[ks], acc[n], 0, 0, 0); }
    }
#pragma unroll
    for (int n = 0; n < 8; ++n) *(u32x2*)(MIX + rowo + 16 * n + 4 * fq) = pk4(bf4(uq[n]) * (acc[n] + bsv));
    __syncthreads();
}


typedef short bf16x4 __attribute__((ext_vector_type(4)));
#define MFMA32(a, b, c) __builtin_amdgcn_mfma_f32_16x16x32_bf16(a, b, c, 0, 0, 0)
#define MFMA16(a, b, c) __builtin_amdgcn_mfma_f32_16x16x16bf16_1k(a, b, c, 0, 0, 0)
constexpr int CP = 72;
constexpr int L_LW = 0, L_LA = 17408, L_LG = 34816;
constexpr int L_LAB = 0, L_LAK = 9216, L_MRB = 18432, L_MRK = 27648, L_TDD = 36864;
constexpr int L_AT = 52224, L_BT = 61440, L_KT = 70656, L_RT = 79872;
constexpr int L_WT = 52224, L_APT = 61440;
constexpr int L_ATT = 89088, L_VTT = 98304, L_BHT = 107520, L_KHT = 116736;
constexpr int L_EXCH = 125952, L_PC = 128000;
constexpr size_t TASK_BYTES = 32768;

__device__ __forceinline__ float wave_sum_dpp(float x) {
    x = red16(x); const int xi = __builtin_bit_cast(int, x);
    const float a = __builtin_bit_cast(float, __builtin_amdgcn_readlane(xi, 0)), b = __builtin_bit_cast(float, __builtin_amdgcn_readlane(xi, 16)), c = __builtin_bit_cast(float, __builtin_amdgcn_readlane(xi, 32)), d = __builtin_bit_cast(float, __builtin_amdgcn_readlane(xi, 48));
    return (a + b) + (c + d);
}
__device__ __forceinline__ bf16x4 pack4(f32x4 v) { const u32x2 r = pk4(v); return __builtin_bit_cast(bf16x4, r); }
__device__ __forceinline__ bf16x8 ldsfrag(const LAS unsigned char* lds, int off, int row, int col) { return *(const LAS bf16x8*)(lds + off + (row * CP + col) * 2); }

#ifdef PROBE_CSPAN_A
#define CST(k) do { if (h == CST_H && blockIdx.x == 64 && threadIdx.x == 0) *(volatile LAS unsigned long long*)(lds + 140000 + 8 * (k)) = __builtin_amdgcn_s_memrealtime(); } while (0)
#else
#define CST(k) do { } while (0)
#endif
__device__ __forceinline__ void rwkv_chunk_prep(LAS unsigned char* lds, int bc, const bf16* PB, const bf16* ZROW, const float* mu, const bf16* W2T, const bf16* A2T, const bf16* G2T,
                                                const float* w0, const float* a0, const float* k_k, const float* k_a, const float* r_k, bf16* LAIN, unsigned char* TASKS, bf16* G, bf16* VS, float* BON,
                                                int tid, int wave, int lane) {
    const int b = bc >> 5, c = bc & 31, m0 = b * SEQ + c * 64, fr = lane & 15, fq = lane >> 4;
    {   const int r = tid >> 3, cg = (tid & 7) * 32, m = m0 + r;
        const bf16* prow = PB + (size_t)m * DSH + 1536 + cg; const bf16* qrow = ((m & (SEQ - 1)) == 0) ? ZROW : (PB + (size_t)(m - 1) * DSH + 1536 + cg);
        const int mode = cg < 64 ? 0 : (cg < 128 ? 1 : 2);
#pragma unroll
        for (int j = 0; j < 4; ++j) {
            const u32x4 pv = *(const u32x4*)(prow + 8 * j), qv = *(const u32x4*)(qrow + 8 * j);
            const f32x4 m0v = *(const f32x4*)(mu + 1536 + cg + 8 * j), m1v = *(const f32x4*)(mu + 1536 + cg + 8 * j + 4);
            float x[8];
            { const float p0 = bf_lo(pv.x), p1 = bf_hi(pv.x), p2 = bf_lo(pv.y), p3 = bf_hi(pv.y), p4 = bf_lo(pv.z), p5 = bf_hi(pv.z), p6 = bf_lo(pv.w), p7 = bf_hi(pv.w);
              const float q0 = bf_lo(qv.x), q1 = bf_hi(qv.x), q2 = bf_lo(qv.y), q3 = bf_hi(qv.y), q4 = bf_lo(qv.z), q5 = bf_hi(qv.z), q6 = bf_lo(qv.w), q7 = bf_hi(qv.w);
              x[0] = p0 + (q0 - p0) * m0v[0]; x[1] = p1 + (q1 - p1) * m0v[1]; x[2] = p2 + (q2 - p2) * m0v[2]; x[3] = p3 + (q3 - p3) * m0v[3];
              x[4] = p4 + (q4 - p4) * m1v[0]; x[5] = p5 + (q5 - p5) * m1v[1]; x[6] = p6 + (q6 - p6) * m1v[2]; x[7] = p7 + (q7 - p7) * m1v[3]; }
#pragma unroll
            for (int e = 0; e < 8; ++e) x[e] = mode == 0 ? fast_tanh(x[e]) : (mode == 1 ? x[e] : fast_sigmoid(x[e]));
            u32x4 o; o.x = pk2(x[0], x[1]); o.y = pk2(x[2], x[3]); o.z = pk2(x[4], x[5]); o.w = pk2(x[6], x[7]);
            *(u32x4*)(LAIN + r * 256 + cg + 8 * j) = o;
        }
    }
    VM_WAIT(); __syncthreads();
    bf16x8 lainW[2], lainA[2], lainG[4];
    {   const bf16* arow = LAIN + (16 * (wave >> 1) + fr) * 256 + 8 * fq;
#pragma unroll
        for (int ks = 0; ks < 2; ++ks) { lainW[ks] = *(const bf16x8*)(arow + 32 * ks); lainA[ks] = *(const bf16x8*)(arow + 64 + 32 * ks); }
#pragma unroll
        for (int ks = 0; ks < 4; ++ks) lainG[ks] = *(const bf16x8*)(arow + 128 + 32 * ks); }
#pragma unroll 1
    for (int h = 0; h < 8; ++h) {
        CST(0);
        {   const int mt = wave >> 1;
            bf16x8 wW[2][2], wA[2][2], wG[2][4];
#pragma unroll
            for (int q = 0; q < 2; ++q) { const int wrow = 64 * h + 16 * ((wave & 1) * 2 + q) + fr;
#pragma unroll
                for (int ks = 0; ks < 2; ++ks) { wW[q][ks] = *(const bf16x8*)(W2T + (size_t)wrow * 64 + 32 * ks + 8 * fq); wA[q][ks] = *(const bf16x8*)(A2T + (size_t)wrow * 64 + 32 * ks + 8 * fq); }
#pragma unroll
                for (int ks = 0; ks < 4; ++ks) wG[q][ks] = *(const bf16x8*)(G2T + (size_t)wrow * 128 + 32 * ks + 8 * fq); }
#pragma unroll
            for (int q = 0; q < 2; ++q) { const int nt = (wave & 1) * 2 + q;
                f32x4 aw = (f32x4){0.f, 0.f, 0.f, 0.f}, aa = aw, ag = aw;
#pragma unroll
                for (int ks = 0; ks < 2; ++ks) { aw = MFMA32(wW[q][ks], lainW[ks], aw); aa = MFMA32(wA[q][ks], lainA[ks], aa); }
#pragma unroll
                for (int ks = 0; ks < 4; ++ks) ag = MFMA32(wG[q][ks], lainG[ks], ag);
                const int o = ((16 * mt + fr) * 68 + 16 * nt + 4 * fq) * 4;
                *(LAS f32x4*)(lds + L_LW + o) = aw; *(LAS f32x4*)(lds + L_LA + o) = aa; *(LAS f32x4*)(lds + L_LG + o) = ag; }
        }
        __syncthreads();
        CST(1);
        {   const int ch = 64 * h + lane;
            const float mur = mu[ch], muk = mu[512 + ch], muv = mu[1024 + ch], w0c = w0[ch], a0c = a0[ch], kkc = k_k[ch], kac = k_a[ch], rkc = r_k[ch];
            float rs[8], kp[8], vs[8], av[8], bv[8], wd[8], cwl[8]; float run = 0.f;
#pragma unroll
            for (int i = 0; i < 8; ++i) { const int p = 8 * wave + i, m = m0 + p; const bf16* prow = PB + (size_t)m * DSH + ch; const bool first = (m & (SEQ - 1)) == 0; const bf16* qrow = first ? ZROW : (prow - DSH);
                const float pr = bf1(prow[0]), pk = bf1(prow[512]), pvv = bf1(prow[1024]); const float qr = bf1(qrow[0]), qk = bf1(first ? qrow[0] : qrow[512]), qv = bf1(first ? qrow[0] : qrow[1024]);
                rs[i] = pr + (qr - pr) * mur; const float ks = pk + (qk - pk) * muk; vs[i] = pvv + (qv - pvv) * muv;
                const float lw = *(const LAS float*)(lds + L_LW + (p * 68 + lane) * 4), la = *(const LAS float*)(lds + L_LA + (p * 68 + lane) * 4), lg = *(const LAS float*)(lds + L_LG + (p * 68 + lane) * 4);
                const float z = -(w0c + lw), sp = fmaxf(z, 0.f) + fast_log(1.f + fast_exp(-fabsf(z)));
                wd[i] = -fast_exp(-sp - 0.5f);
                const float as = fast_sigmoid(a0c + la);
                const float kkr = ks * kkc; const float n2 = wave_sum_dpp(kkr * kkr); const float kk = kkr * __builtin_amdgcn_rsqf(fmaxf(n2, 1e-24f));
                kp[i] = ks * (1.f + (as - 1.f) * kac); av[i] = -kk; bv[i] = kk * as;
                const float bon = wave_sum_dpp(rs[i] * kp[i] * rkc);
                run += wd[i]; cwl[i] = run;
                G[(size_t)m * DB + ch] = (bf16)(pk2(lg, 0.f) & 0xffffu); VS[(size_t)m * DB + ch] = (bf16)(pk2(vs[i], 0.f) & 0xffffu);
                if (lane == 0) BON[(size_t)m * 8 + h] = bon; }
            *(LAS float*)(lds + L_EXCH + (wave * 64 + lane) * 4) = run;
            __syncthreads();
            CST(2);
            float base = 0.f, tot = 0.f;
#pragma unroll
            for (int w2 = 0; w2 < 8; ++w2) { const float t = *(const LAS float*)(lds + L_EXCH + (w2 * 64 + lane) * 4); tot += t; if (w2 < wave) base += t; }
            float oA[8], oV[8], oBh[8], oKh[8];
#pragma unroll
            for (int i = 0; i < 8; ++i) { const int p = 8 * wave + i; const float cw = base + cwl[i];
                const float e1 = fast_exp(cw - wd[i]), e2 = fast_exp(cw), e3 = __builtin_amdgcn_rcpf(e2), e4 = fast_exp(tot - cw);
                const float At = av[i] * e1, Rt = rs[i] * e2, Bt = bv[i] * e3, Kt = kp[i] * e3;
                oA[i] = At; oV[i] = vs[i]; oBh[i] = bv[i] * e4; oKh[i] = kp[i] * e4;
                *(LAS bf16*)(lds + L_AT + (p * CP + lane) * 2) = (bf16)(pk2(At, 0.f) & 0xffffu); *(LAS bf16*)(lds + L_BT + (p * CP + lane) * 2) = (bf16)(pk2(Bt, 0.f) & 0xffffu);
                *(LAS bf16*)(lds + L_KT + (p * CP + lane) * 2) = (bf16)(pk2(Kt, 0.f) & 0xffffu); *(LAS bf16*)(lds + L_RT + (p * CP + lane) * 2) = (bf16)(pk2(Rt, 0.f) & 0xffffu); }
            { u32x4 o; const int off = (lane * CP + 8 * wave) * 2;
              o.x = pk2(oA[0], oA[1]); o.y = pk2(oA[2], oA[3]); o.z = pk2(oA[4], oA[5]); o.w = pk2(oA[6], oA[7]); *(LAS u32x4*)(lds + L_ATT + off) = o;
              o.x = pk2(oV[0], oV[1]); o.y = pk2(oV[2], oV[3]); o.z = pk2(oV[4], oV[5]); o.w = pk2(oV[6], oV[7]); *(LAS u32x4*)(lds + L_VTT + off) = o;
              o.x = pk2(oBh[0], oBh[1]); o.y = pk2(oBh[2], oBh[3]); o.z = pk2(oBh[4], oBh[5]); o.w = pk2(oBh[6], oBh[7]); *(LAS u32x4*)(lds + L_BHT + off) = o;
              o.x = pk2(oKh[0], oKh[1]); o.y = pk2(oKh[2], oKh[3]); o.z = pk2(oKh[4], oKh[5]); o.w = pk2(oKh[6], oKh[7]); *(LAS u32x4*)(lds + L_KHT + off) = o; }
            if (wave == 0) *(LAS float*)(lds + L_PC + lane * 4) = fast_exp(tot);
        }
        __syncthreads();
        CST(3);
        {   const int ty = wave >> 1;
#pragma unroll
            for (int prod = 0; prod < 4; ++prod) { const int xo = (prod & 1) ? L_KT : L_BT, yo = prod < 2 ? L_AT : L_RT, oo = prod == 0 ? L_LAB : (prod == 1 ? L_LAK : (prod == 2 ? L_MRB : L_MRK)); const bool incl = prod >= 2;
#pragma unroll
                for (int q = 0; q < 2; ++q) { const int tx = (wave & 1) * 2 + q; f32x4 acc = (f32x4){0.f, 0.f, 0.f, 0.f};
                    if (tx <= ty) {
#pragma unroll
                        for (int ks = 0; ks < 2; ++ks) acc = MFMA32(ldsfrag(lds, xo, 16 * tx + fr, 32 * ks + 8 * fq), ldsfrag(lds, yo, 16 * ty + fr, 32 * ks + 8 * fq), acc); }
                    const int i = 16 * ty + fr, j0 = 16 * tx + 4 * fq;
#pragma unroll
                    for (int e = 0; e < 4; ++e) { const int j = j0 + e; if (!(incl ? (j <= i) : (j < i))) acc[e] = 0.f; }
                    *(LAS u32x2*)(lds + oo + (i * CP + j0) * 2) = pk4(acc); } }
        }
        __syncthreads();
        CST(4);
        if (wave < 4) { const int d = wave; float t[16];
#pragma unroll
            for (int i = 0; i < 16; ++i) { const u32x4 r0 = *(const LAS u32x4*)(lds + L_LAB + ((16 * d + i) * CP + 16 * d) * 2), r1 = *(const LAS u32x4*)(lds + L_LAB + ((16 * d + i) * CP + 16 * d + 8) * 2);
                const float l[16] = {bf_lo(r0.x), bf_hi(r0.x), bf_lo(r0.y), bf_hi(r0.y), bf_lo(r0.z), bf_hi(r0.z), bf_lo(r0.w), bf_hi(r0.w), bf_lo(r1.x), bf_hi(r1.x), bf_lo(r1.y), bf_hi(r1.y), bf_lo(r1.z), bf_hi(r1.z), bf_lo(r1.w), bf_hi(r1.w)};
                float s = (i == lane) ? 1.f : 0.f;
#pragma unroll
                for (int mm = 0; mm < i; ++mm) s += l[mm] * t[mm];
                t[i] = s; }
            if (lane < 16) {
#pragma unroll
                for (int i = 0; i < 16; ++i) *(LAS bf16*)(lds + L_TDD + ((d * 16 + i) * 24 + lane) * 2) = (bf16)(pk2(t[i], 0.f) & 0xffffu); }
        }
        __syncthreads();
        CST(5);
        {   const int s = wave & 3; const bool isW = wave < 4; f32x4 acc[4];
            if (isW) {
#pragma unroll
                for (int d = 0; d < 4; ++d) { acc[d] = (f32x4){0.f, 0.f, 0.f, 0.f};
#pragma unroll
                    for (int ks = 0; ks < 2; ++ks) if (32 * ks <= 16 * d + 15) acc[d] = MFMA32(ldsfrag(lds, L_LAK, 16 * d + fr, 32 * ks + 8 * fq), ldsfrag(lds, L_VTT, 16 * s + fr, 32 * ks + 8 * fq), acc[d]); }
            } else {
#pragma unroll
                for (int d = 0; d < 4; ++d) acc[d] = bf4(*(const LAS u32x2*)(lds + L_ATT + ((16 * s + fr) * CP + 16 * d + 4 * fq) * 2));
            }
            bf16x4 xf[4]; const int oo = isW ? L_WT : L_APT;
#pragma unroll
            for (int d = 0; d < 4; ++d) {
#pragma unroll
                for (int mm = 0; mm < d; ++mm) acc[d] = MFMA16(*(const LAS bf16x4*)(lds + L_LAB + ((16 * d + fr) * CP + 16 * mm + 4 * fq) * 2), xf[mm], acc[d]);
                const f32x4 x = MFMA16(*(const LAS bf16x4*)(lds + L_TDD + ((d * 16 + fr) * 24 + 4 * fq) * 2), pack4(acc[d]), ((f32x4){0.f, 0.f, 0.f, 0.f}));
                xf[d] = pack4(x);
                *(LAS bf16x4*)(lds + oo + ((16 * s + fr) * CP + 16 * d + 4 * fq) * 2) = xf[d]; }
        }
        __syncthreads();
        CST(6);
        {   unsigned char* task = TASKS + (size_t)((b * 8 + h) * 32 + c) * TASK_BYTES; const int ty = wave >> 1;
#pragma unroll
            for (int q = 0; q < 2; ++q) { const int tx = (wave & 1) * 2 + q; const int yr = 16 * ty + fr, xc = 16 * tx + 4 * fq;
                f32x4 aM = (f32x4){0.f, 0.f, 0.f, 0.f}, aN = aM, aR = aM, aY = aM;
#pragma unroll
                for (int ks = 0; ks < 2; ++ks) { const int kc = 32 * ks + 8 * fq;
                    const bf16x8 fAP = ldsfrag(lds, L_APT, 16 * tx + fr, kc), fBHx = ldsfrag(lds, L_BHT, 16 * tx + fr, kc), fKHx = ldsfrag(lds, L_KHT, 16 * tx + fr, kc), fMRBx = ldsfrag(lds, L_MRB, 16 * tx + fr, kc), fMRKx = ldsfrag(lds, L_MRK, 16 * tx + fr, kc);
                    const bf16x8 fBHy = ldsfrag(lds, L_BHT, 16 * ty + fr, kc), fWTy = ldsfrag(lds, L_WT, 16 * ty + fr, kc), fVTy = ldsfrag(lds, L_VTT, 16 * ty + fr, kc), fMRBy = ldsfrag(lds, L_MRB, 16 * ty + fr, kc);
                    aM = MFMA32(fAP, fBHy, aM);
                    aN = MFMA32(fBHx, fWTy, aN); aN = MFMA32(fKHx, fVTy, aN);
                    aR = MFMA32(fAP, fMRBy, aR);
                    aY = MFMA32(fMRBx, fWTy, aY); aY = MFMA32(fMRKx, fVTy, aY); }
                const float pc = *(const LAS float*)(lds + L_PC + yr * 4);
#pragma unroll
                for (int e = 0; e < 4; ++e) if (xc + e == yr) aM[e] += pc;
                aR += bf4(*(const LAS u32x2*)(lds + L_RT + (yr * CP + xc) * 2));
                const size_t o = (size_t)(((ty * 64 + lane) * 4 + tx) * 8);
                *(u32x2*)(task + o) = pk4(aM); *(u32x2*)(task + 8192 + o) = pk4(aN); *(u32x2*)(task + 16384 + o) = pk4(aR); *(u32x2*)(task + 24576 + o) = pk4(aY); }
        }
        __syncthreads();
        CST(7);
    }
}

__device__ __forceinline__ void scanB_block(LAS unsigned char* lds, int bh, const unsigned char* TASKS, const bf16* G, const bf16* VS, const float* BON, const float* ln_g, const float* ln_b, bf16* MIX, float* out_wkv, int tid, int wave, int lane) {
    const int b = bh >> 3, h = bh & 7, fr = lane & 15, fq = lane >> 4;
    LAS float* YB = (LAS float*)lds;
    if (wave < 4) {
        const int s = wave;
        const GAS unsigned char* tk = (const GAS unsigned char*)TASKS + (size_t)bh * 32 * TASK_BYTES + (size_t)lane * 32;
        const GAS unsigned char* gG = (const GAS unsigned char*)G; const GAS unsigned char* gV = (const GAS unsigned char*)VS; const GAS unsigned char* gB = (const GAS unsigned char*)BON;
        struct TaskRegs { u32x4 m0[4], m1[4], r0[4], r1[4], n0, n1, y0, y1, g0, g1, v0, v1; unsigned bo; };
        TaskRegs TA, TB; bf16x4 xf[4]; f32x4 accX[4];
#pragma unroll
        for (int t = 0; t < 4; ++t) { xf[t] = (bf16x4){0, 0, 0, 0}; accX[t] = (f32x4){0.f, 0.f, 0.f, 0.f}; }
#define GLD16(dst, ptr, OFF) asm volatile("global_load_dwordx4 %0, %1, off offset:" #OFF : "=v"(dst) : "v"(ptr) : "memory")
#define GLD16NT(dst, ptr) asm volatile("global_load_dwordx4 %0, %1, off nt" : "=v"(dst) : "v"(ptr) : "memory")
#define LOADTASK(T, cc) do { const GAS unsigned char* tp_ = tk + (size_t)(cc) * TASK_BYTES; _Pragma("unroll") for (int t = 0; t < 4; ++t) { \
            GLD16(T.m0[t], tp_ + t * 2048, 0); GLD16(T.m1[t], tp_ + t * 2048, 16); GLD16(T.r0[t], tp_ + 16384 + t * 2048, 0); GLD16(T.r1[t], tp_ + 16384 + t * 2048, 16); } \
            GLD16(T.n0, tp_ + 8192 + s * 2048, 0); GLD16(T.n1, tp_ + 8192 + s * 2048, 16); GLD16(T.y0, tp_ + 24576 + s * 2048, 0); GLD16(T.y1, tp_ + 24576 + s * 2048, 16); \
            { const size_t mo_ = ((size_t)(b * SEQ + (cc) * 64 + 16 * s + (lane >> 3)) * DB + 64 * h + 8 * (lane & 7)) * 2; \
              GLD16NT(T.g0, gG + mo_); GLD16NT(T.g1, gG + mo_ + 8 * DB * 2); GLD16NT(T.v0, gV + mo_); GLD16NT(T.v1, gV + mo_ + 8 * DB * 2); \
              asm volatile("global_load_dword %0, %1, off" : "=v"(T.bo) : "v"(gB + ((size_t)(b * SEQ + (cc) * 64 + 16 * s + (lane & 15)) * 8 + h) * 4) : "memory"); } } while (0)
#define WAITTASK(T, N) asm volatile("s_waitcnt vmcnt(" #N ")" : "+v"(T.m0[0]), "+v"(T.m0[1]), "+v"(T.m0[2]), "+v"(T.m0[3]), "+v"(T.m1[0]), "+v"(T.m1[1]), "+v"(T.m1[2]), "+v"(T.m1[3]), \
            "+v"(T.r0[0]), "+v"(T.r0[1]), "+v"(T.r0[2]), "+v"(T.r0[3]), "+v"(T.r1[0]), "+v"(T.r1[1]), "+v"(T.r1[2]), "+v"(T.r1[3]), "+v"(T.n0), "+v"(T.n1), "+v"(T.y0), "+v"(T.y1), \
            "+v"(T.g0), "+v"(T.g1), "+v"(T.v0), "+v"(T.v1), "+v"(T.bo) :: "memory")
#define LO2(v) __builtin_bit_cast(bf16x4, (u32x2){(v).x, (v).y})
#define HI2(v) __builtin_bit_cast(bf16x4, (u32x2){(v).z, (v).w})
#define STEP(T, cc) do { f32x4 accY[4]; \
            accY[0] = bf4((u32x2){T.y0.x, T.y0.y}); accY[1] = bf4((u32x2){T.y0.z, T.y0.w}); accY[2] = bf4((u32x2){T.y1.x, T.y1.y}); accY[3] = bf4((u32x2){T.y1.z, T.y1.w}); \
            accX[0] = bf4((u32x2){T.n0.x, T.n0.y}); accX[1] = bf4((u32x2){T.n0.z, T.n0.w}); accX[2] = bf4((u32x2){T.n1.x, T.n1.y}); accX[3] = bf4((u32x2){T.n1.z, T.n1.w}); \
            _Pragma("unroll") for (int t = 0; t < 4; ++t) { \
                accY[t] = MFMA16(LO2(T.r0[t]), xf[0], accY[t]); accX[t] = MFMA16(LO2(T.m0[t]), xf[0], accX[t]); accY[t] = MFMA16(HI2(T.r0[t]), xf[1], accY[t]); accX[t] = MFMA16(HI2(T.m0[t]), xf[1], accX[t]); \
                accY[t] = MFMA16(LO2(T.r1[t]), xf[2], accY[t]); accX[t] = MFMA16(LO2(T.m1[t]), xf[2], accX[t]); accY[t] = MFMA16(HI2(T.r1[t]), xf[3], accY[t]); accX[t] = MFMA16(HI2(T.m1[t]), xf[3], accX[t]); } \
            _Pragma("unroll") for (int t = 0; t < 4; ++t) xf[t] = pack4(accX[t]); \
            LAS float* yb = YB + ((cc) & 1) * 4096; \
            _Pragma("unroll") for (int t = 0; t < 4; ++t) _Pragma("unroll") for (int e = 0; e < 4; ++e) yb[(16 * t + 4 * fq + e) * 64 + 16 * s + fr] = accY[t][e]; \
            { LAS unsigned char* gl_ = lds + 32768 + ((cc) & 1) * 8192 + ((16 * s + (lane >> 3)) * 64 + 8 * (lane & 7)) * 2; \
              *(LAS u32x4*)gl_ = T.g0; *(LAS u32x4*)(gl_ + 1024) = T.g1; *(LAS u32x4*)(gl_ + 16384) = T.v0; *(LAS u32x4*)(gl_ + 16384 + 1024) = T.v1; \
              if (lane < 16) *(LAS unsigned*)(lds + 65536 + ((cc) & 1) * 256 + (16 * s + lane) * 4) = T.bo; } \
            asm volatile("s_waitcnt lgkmcnt(0)" ::: "memory"); __builtin_amdgcn_s_barrier(); asm volatile("" ::: "memory"); } while (0)
        LOADTASK(TA, 0); LOADTASK(TB, 1);
#pragma unroll 1
        for (int c = 0; c < 32; c += 2) {
            WAITTASK(TA, 25); STEP(TA, c); LOADTASK(TA, (c + 2 < 32 ? c + 2 : 31));
            WAITTASK(TB, 25); STEP(TB, c + 1); LOADTASK(TB, (c + 3 < 32 ? c + 3 : 31));
        }
        asm volatile("s_waitcnt vmcnt(0)" ::: "memory");
#undef GLD16
#undef GLD16NT
#undef LOADTASK
#undef WAITTASK
#undef LO2
#undef HI2
#undef STEP
#pragma unroll
        for (int t = 0; t < 4; ++t) *(f32x4*)(out_wkv + ((size_t)bh * 64 + 16 * s + fr) * 64 + 16 * t + 4 * fq) = accX[t];
    } else {
        const int tp = tid - 256, l16 = tp & 15;
        const f32x4 lg4 = *(const f32x4*)(ln_g + 64 * h + 4 * l16), lb4 = *(const f32x4*)(ln_b + 64 * h + 4 * l16);
#pragma unroll 1
        for (int c = 0; c < 32; ++c) {
            asm volatile("" ::: "memory"); __builtin_amdgcn_s_barrier(); asm volatile("" ::: "memory");
            const LAS float* yb = YB + (c & 1) * 4096; const LAS unsigned char* gl = lds + 32768 + (c & 1) * 8192; const LAS float* bl = (const LAS float*)(lds + 65536 + (c & 1) * 256);
#pragma unroll
            for (int it = 0; it < 4; ++it) { const int tt = it * 16 + (tp >> 4); const int m = b * SEQ + c * 64 + tt;
                const f32x4 y4 = *(const LAS f32x4*)(yb + tt * 64 + 4 * l16);
                const f32x4 g4 = bf4(*(const LAS u32x2*)(gl + (tt * 64 + 4 * l16) * 2)), v4 = bf4(*(const LAS u32x2*)(gl + 16384 + (tt * 64 + 4 * l16) * 2)); const float bon = bl[tt];
                const float mean = red16((y4[0] + y4[1]) + (y4[2] + y4[3])) * (1.f / 64.f);
                const f32x4 d4 = y4 - mean;
                const float var = red16((d4[0] * d4[0] + d4[1] * d4[1]) + (d4[2] * d4[2] + d4[3] * d4[3])) * (1.f / 64.f);
                const float rstd = __builtin_amdgcn_rsqf(var + GN_EPS);
                const f32x4 o = ((d4 * rstd) * lg4 + lb4 + v4 * bon) * g4;
                *(GAS u32x2*)((gbf16*)MIX + (size_t)m * 1024 + 512 + 64 * h + 4 * l16) = pk4(o); }
        }
    }
}

template <class EpiF>
__device__ __forceinline__ void small_gemm(LAS unsigned char* lds, const bf16* A, int lda, const bf16* Bt, int N, int K, int Q, int gb, int GB, const EpiF& epi, int tid, int wave, int lane) {
    const int fr = lane & 15, fq = lane >> 4, kw = (K / Q) >> 3;
    LAS float* part = (LAS float*)lds;
    for (int item = gb; item < (N >> 4) * Q; item += GB) {
        const int strip = item / Q, q = item - strip * Q;
        const f32x4 pf = epi.pre(tid >> 2, 16 * strip + 4 * (tid & 3));
        f32x4 acc[8];
#pragma unroll
        for (int i = 0; i < 8; ++i) acc[i] = (f32x4){0.f, 0.f, 0.f, 0.f};
        const bf16* brow = Bt + (size_t)(16 * strip + fr) * K + q * (K / Q) + wave * kw + 8 * fq;
        const bf16* arow = A + (size_t)fr * lda + q * (K / Q) + wave * kw + 8 * fq;
#pragma unroll 4
        for (int ks = 0; ks < (kw >> 5); ++ks) {
            const bf16x8 wf = *(const bf16x8*)(brow + 32 * ks);
#pragma unroll
            for (int mt = 0; mt < 8; ++mt) { const bf16x8 af = *(const bf16x8*)(arow + (size_t)(16 * mt) * lda + 32 * ks); acc[mt] = __builtin_amdgcn_mfma_f32_16x16x32_bf16(wf, af, acc[mt], 0, 0, 0); }
        }
#pragma unroll
        for (int mt = 0; mt < 8; ++mt) *(LAS f32x4*)(part + ((wave * 128 + 16 * mt + fr) * 16 + 4 * fq)) = acc[mt];
        __syncthreads();
        {   const int token = tid >> 2, cg = tid & 3; f32x4 sm = (f32x4){0.f, 0.f, 0.f, 0.f};
#pragma unroll
            for (int w = 0; w < 8; ++w) sm += *(const LAS f32x4*)(part + ((w * 128 + token) * 16 + 4 * cg));
            epi(token, 16 * strip + 4 * cg, sm, pf); }
        __syncthreads();
    }
}
struct SEpiProj { bf16* ZAs; float* PBs;
    __device__ __forceinline__ f32x4 pre(int, int) const { return (f32x4){0.f, 0.f, 0.f, 0.f}; }
    __device__ __forceinline__ void operator()(int t, int c, f32x4 s, f32x4) const {
        if (c < 1024) { const f32x2 a = pg8::gelu_pk((f32x2){s[0], s[1]}), b = pg8::gelu_pk((f32x2){s[2], s[3]}); *(u32x2*)(ZAs + (size_t)t * 1024 + c) = pk4((f32x4){a.x, a.y, b.x, b.y}); }
        else *(f32x4*)(PBs + (size_t)t * DSH + (c - 1024)) = s; } };
struct SEpiAtomic { float* acc;
    __device__ __forceinline__ f32x4 pre(int, int) const { return (f32x4){0.f, 0.f, 0.f, 0.f}; }
    __device__ __forceinline__ void operator()(int t, int c, f32x4 s, f32x4) const {
#pragma unroll
        for (int j = 0; j < 4; ++j) (void)__hip_atomic_fetch_add(acc + (size_t)t * 1024 + c + j, s[j], __ATOMIC_RELAXED, __HIP_MEMORY_SCOPE_AGENT); } };
template <bool WB> struct SEpiRes { const float* base; float* out; bf16* outb; float* rowss; float* out2;
    __device__ __forceinline__ f32x4 pre(int t, int c) const { return *(const f32x4*)(base + (size_t)t * 1024 + c); }
    __device__ __forceinline__ void operator()(int t, int c, f32x4 s, f32x4 pf) const {
        const f32x4 v = pf + s; *(f32x4*)(out + (size_t)t * 1024 + c) = v; if (WB) *(u32x2*)(outb + (size_t)t * 1024 + c) = pk4(v); if (out2) *(f32x4*)(out2 + (size_t)t * 1024 + c) = v;
        float ss = (v[0] * v[0] + v[1] * v[1]) + (v[2] * v[2] + v[3] * v[3]); ss = red4(ss);
        if ((threadIdx.x & 3) == 0) (void)__hip_atomic_fetch_add(rowss + t, ss, __ATOMIC_RELAXED, __HIP_MEMORY_SCOPE_AGENT); } };
struct SEpiQ { float* Q; const float* rowss;
    __device__ __forceinline__ f32x4 pre(int t, int) const { return (f32x4){__hip_atomic_load(rowss + t, __ATOMIC_RELAXED, __HIP_MEMORY_SCOPE_AGENT), 0.f, 0.f, 0.f}; }
    __device__ __forceinline__ void operator()(int t, int c, f32x4 s, f32x4 pf) const {
        const float sc = 0.0625f / sqrtf(pf[0] * (1.f / D) + RMS_EPS); *(f32x4*)(Q + (size_t)t * 1024 + c) = s * sc; } };
struct SEpiUp { bf16* H; const float* rowss;
    __device__ __forceinline__ f32x4 pre(int t, int) const { return (f32x4){__hip_atomic_load(rowss + t, __ATOMIC_RELAXED, __HIP_MEMORY_SCOPE_AGENT), 0.f, 0.f, 0.f}; }
    __device__ __forceinline__ void operator()(int t, int c, f32x4 s, f32x4 pf) const {
        const float sc = 1.f / sqrtf(pf[0] * (1.f / D) + RMS_EPS); f32x4 v = s * sc;
#pragma unroll
        for (int j = 0; j < 4; ++j) { const float a = fmaxf(v[j], 0.f); v[j] = a * a; }
        *(u32x2*)(H + (size_t)t * FF + c) = pk4(v); } };

struct KArgs { const float* in[35]; float* out; unsigned char* ws; };
__device__ __forceinline__ void sample_mixer_token(LAS unsigned char* lds, int tok, const KArgs& KA, const bf16* ZAs, const float* PBs, bf16* MIXs, const bf16* W2T, const bf16* A2T, const bf16* G2T, int tid, int wave, int lane) {
    const float* const (&in)[35] = KA.in; float* out = KA.out;
    LAS float* red = (LAS float*)lds;
    LAS float* lin = (LAS float*)(lds + 256);
    LAS float* vec = (LAS float*)(lds + 2048);
    const int c = tid;
    {   const int hA = c >> 7; const float vz = bf1(ZAs[(size_t)tok * 1024 + 512 + c]), uz = bf1(ZAs[(size_t)tok * 1024 + c]);
        const float s1 = wave_sum(vz); if (lane == 0) red[wave] = s1;
        __syncthreads();
        const float mean = (red[2 * hA] + red[2 * hA + 1]) * (1.f / 128.f); const float dv = vz - mean;
        const float s2 = wave_sum(dv * dv); if (lane == 0) red[8 + wave] = s2;
        __syncthreads();
        const float var = (red[8 + 2 * hA] + red[8 + 2 * hA + 1]) * (1.f / 128.f);
        const float vn = dv * (1.f / sqrtf(var + LN_EPS)) * in[10][c] + in[11][c];
        out[O_CVS + (size_t)tok * 512 + c] = vn;
        const float mixed = in[12][(size_t)hA * 128 * 128] * vn + in[13][hA * 128];
        MIXs[(size_t)tok * 1024 + c] = (bf16)(pk2(uz * mixed, 0.f) & 0xffffu);
    }
    const float* pb = PBs + (size_t)tok * DSH; const float* pv = in[5] + (size_t)tok * DSH; const float* mu = in[9];
    if (tid < 256) { const int i = 1536 + tid; const float x = pb[i] + (pv[i] - pb[i]) * mu[i]; lin[tid] = tid < 64 ? fast_tanh(x) : (tid < 128 ? x : fast_sigmoid(x)); }
    __syncthreads();
    const float rs = pb[c] + (pv[c] - pb[c]) * mu[c], ks = pb[512 + c] + (pv[512 + c] - pb[512 + c]) * mu[512 + c], vs = pb[1024 + c] + (pv[1024 + c] - pb[1024 + c]) * mu[1024 + c];
    const size_t so = ((size_t)(tok * 8 + wave) * 64 + lane) * 64; const float* s0 = in[6] + so; float* s1o = out + O_WKVS + so;
    f32x4 Sx[16];
#pragma unroll
    for (int j = 0; j < 16; ++j) Sx[j] = *(const f32x4*)(s0 + 4 * j);
    float wl = in[14][c], al = in[16][c], g = 0.f;
    {   const bf16* w2r = W2T + (size_t)c * 64; const bf16* a2r = A2T + (size_t)c * 64; const bf16* g2r = G2T + (size_t)c * 128;
#define DOT8(acc, v, lp) do { const f32x4 l0_ = *(const LAS f32x4*)(lp), l1_ = *(const LAS f32x4*)((lp) + 4); \
            acc += (bf_lo((v).x) * l0_[0] + bf_hi((v).x) * l0_[1]) + (bf_lo((v).y) * l0_[2] + bf_hi((v).y) * l0_[3]) + (bf_lo((v).z) * l1_[0] + bf_hi((v).z) * l1_[1]) + (bf_lo((v).w) * l1_[2] + bf_hi((v).w) * l1_[3]); } while (0)
#pragma unroll 1
        for (int j = 0; j < 8; ++j) { const u32x4 w8 = *(const u32x4*)(w2r + 8 * j), a8 = *(const u32x4*)(a2r + 8 * j), g8 = *(const u32x4*)(g2r + 8 * j), h8 = *(const u32x4*)(g2r + 64 + 8 * j);
            DOT8(wl, w8, lin + 8 * j); DOT8(al, a8, lin + 64 + 8 * j); DOT8(g, g8, lin + 128 + 8 * j); DOT8(g, h8, lin + 192 + 8 * j); }
#undef DOT8
    }
    const float z = -wl, sp = fmaxf(z, 0.f) + fast_log(1.f + fast_exp(-fabsf(z))), w = -sp - 0.5f, dec = fast_exp(-fast_exp(w)), av = fast_sigmoid(al);
    const float kkr = ks * in[19][c]; const float nrm = sqrtf(wave_sum(kkr * kkr)); const float kk = kkr / fmaxf(nrm, 1e-12f); const float kp = ks * (1.f + (av - 1.f) * in[20][c]);
    LAS float* hv = vec + wave * 320;
    hv[lane] = dec; hv[64 + lane] = -kk; hv[128 + lane] = kk * av; hv[192 + lane] = kp; hv[256 + lane] = rs;
    __syncthreads();
    {   float sa = 0.f;
#pragma unroll
        for (int j = 0; j < 16; ++j) { const f32x4 a4 = *(const LAS f32x4*)(hv + 64 + 4 * j); sa += (Sx[j][0] * a4[0] + Sx[j][1] * a4[1]) + (Sx[j][2] * a4[2] + Sx[j][3] * a4[3]); if ((j & 3) == 3) asm volatile("" ::: "memory"); }
        float y = 0.f;
#pragma unroll
        for (int j = 0; j < 16; ++j) { const f32x4 d4 = *(const LAS f32x4*)(hv + 4 * j), b4 = *(const LAS f32x4*)(hv + 128 + 4 * j), k4 = *(const LAS f32x4*)(hv + 192 + 4 * j), r4 = *(const LAS f32x4*)(hv + 256 + 4 * j);
            const f32x4 sn = Sx[j] * d4 + (b4 * sa + k4 * vs); *(f32x4*)(s1o + 4 * j) = sn; y += (sn[0] * r4[0] + sn[1] * r4[1]) + (sn[2] * r4[2] + sn[3] * r4[3]); if ((j & 1) == 1) asm volatile("" ::: "memory"); }
        const float mean = wave_sum(y) * (1.f / 64.f), dy = y - mean, var = wave_sum(dy * dy) * (1.f / 64.f);
        const float yn = dy * (1.f / sqrtf(var + GN_EPS)) * in[22][c] + in[23][c];
        const float bon = wave_sum(rs * kp * in[21][c]) * vs;
        MIXs[(size_t)tok * 1024 + 512 + c] = (bf16)(pk2((yn + bon) * g, 0.f) & 0xffffu);
    }
    __syncthreads();
}
__device__ __forceinline__ void sample_attn_pair(LAS unsigned char* lds, int pair, const float* Qs, const float* Kc, const float* Vc, bf16* Os, int tid, int wave, int lane) {
    const int b = pair >> 2, h = pair & 3;
    LAS float* sc = (LAS float*)lds;
    LAS float* part = (LAS float*)(lds + 1024);
    const f32x4 q4 = *(const f32x4*)(Qs + (size_t)b * 1024 + h * 256 + 4 * lane);
    const float* kb = Kc + ((size_t)b * 256 * 4 + h) * 256 + 4 * lane; const float* vb = Vc + ((size_t)b * 256 * 4 + h) * 256 + 4 * lane;
    {   f32x4 kr[32];
#pragma unroll
        for (int i = 0; i < 32; ++i) kr[i] = __builtin_nontemporal_load((const f32x4*)(kb + (size_t)(32 * wave + i) * 1024));
#pragma unroll
        for (int i = 0; i < 32; ++i) { const float p = wave_sum_dpp((q4[0] * kr[i][0] + q4[1] * kr[i][1]) + (q4[2] * kr[i][2] + q4[3] * kr[i][3])); if (lane == 0) sc[32 * wave + i] = p; } }
    f32x4 vr[32];
#pragma unroll
    for (int i = 0; i < 32; ++i) vr[i] = __builtin_nontemporal_load((const f32x4*)(vb + (size_t)(32 * wave + i) * 1024));
    __syncthreads();
    {   const f32x4 s4 = *(const LAS f32x4*)(sc + 4 * lane); const float mx = wave_max(fmaxf(fmaxf(s4[0], s4[1]), fmaxf(s4[2], s4[3])));
        f32x4 e; float sum = 0.f;
#pragma unroll
        for (int j = 0; j < 4; ++j) { e[j] = fast_exp(s4[j] - mx); sum += e[j]; }
        sum = wave_sum(sum); const float inv = 1.f / sum;
        __syncthreads();
        if (wave == 0) *(LAS f32x4*)(sc + 4 * lane) = e * inv;
    }
    __syncthreads();
    f32x4 o = (f32x4){0.f, 0.f, 0.f, 0.f};
#pragma unroll
    for (int i = 0; i < 32; ++i) o += vr[i] * sc[32 * wave + i];
    *(LAS f32x4*)(part + wave * 256 + 4 * lane) = o;
    __syncthreads();
    if (tid < 256) { float s = 0.f;
#pragma unroll
        for (int w = 0; w < 8; ++w) s += part[w * 256 + tid];
        Os[(size_t)b * 1024 + h * 256 + tid] = (bf16)(pk2(s, 0.f) & 0xffffu); }
    __syncthreads();
}
template <int ST>
__device__ __forceinline__ void sample_stage(LAS unsigned char* lds, const KArgs& KA, int gb, int GB, int tid, int wave, int lane) {
    unsigned char* ws = KA.ws; unsigned char* sm = ws + WS_SMP; const float* const (&in)[35] = KA.in; float* out = KA.out;
    float* rs1 = (float*)ws + RS_OFF + M; float* rs2 = rs1 + RS_STRIDE;
    const bf16* XN0s = (const bf16*)(ws + WS_ACAT) + (size_t)M * 1024;
    bf16* ZAs = (bf16*)(sm + SM_ZA); bf16* MIXs = (bf16*)(sm + SM_MIX); float* X1s = (float*)(sm + SM_X1); bf16* X1Bs = (bf16*)(sm + SM_X1B); float* Qs = (float*)(sm + SM_Q); bf16* Os = (bf16*)(sm + SM_O);
    float* X2s = (float*)(sm + SM_X2); bf16* X2Bs = (bf16*)(sm + SM_X2B); bf16* HIDs = (bf16*)(sm + SM_HID); float* X3s = (float*)(sm + SM_X3);
    float* PBs = out + O_SHS;
    if constexpr (ST == 0) { SEpiProj e{ZAs, PBs}; small_gemm(lds, XN0s, 1024, (const bf16*)(ws + WS_WCAT), DIN, 1024, 1, gb, GB, e, tid, wave, lane); }
    if constexpr (ST == 1) { for (int tok = gb; tok < MS; tok += GB) sample_mixer_token(lds, tok, KA, ZAs, PBs, MIXs, (const bf16*)(ws + WS_SMALL), (const bf16*)(ws + WS_SMALL + 64 * KiB), (const bf16*)(ws + WS_SMALL + 128 * KiB), tid, wave, lane); }
    if constexpr (ST == 2) { SEpiRes<true> e{in[1], X1s, X1Bs, rs1, nullptr}; small_gemm(lds, MIXs, 1024, (const bf16*)(ws + WS_WOUT), 1024, 1024, 1, gb, GB, e, tid, wave, lane); }
    if constexpr (ST == 3) { SEpiQ e{Qs, rs1}; small_gemm(lds, X1Bs, 1024, (const bf16*)(ws + WS_WQ), 1024, 1024, 1, gb, GB, e, tid, wave, lane); }
    if constexpr (ST == 4) { for (int pair = gb; pair < MS * 4; pair += GB) sample_attn_pair(lds, pair, Qs, in[3], in[4], Os, tid, wave, lane); }
    if constexpr (ST == 5) { SEpiRes<true> e{X1s, X2s, X2Bs, rs2, X3s}; small_gemm(lds, Os, 1024, (const bf16*)(ws + WS_WO), 1024, 1024, 1, gb, GB, e, tid, wave, lane); }
    if constexpr (ST == 6) { SEpiUp e{HIDs, rs2}; small_gemm(lds, X2Bs, 1024, (const bf16*)(ws + WS_WUP), FF, 1024, 1, gb, GB, e, tid, wave, lane); }
    if constexpr (ST == 7) { SEpiAtomic e{X3s}; small_gemm(lds, HIDs, FF, (const bf16*)(ws + WS_WDN), 1024, FF, 4, gb, GB, e, tid, wave, lane); }
    if constexpr (ST == 8) {
        for (int r = gb * 8 + wave; r < MS; r += GB * 8) {
            f32x4 v[4]; float ss = 0.f;
#pragma unroll
            for (int j = 0; j < 4; ++j) { v[j] = *(const f32x4*)(X3s + (size_t)r * 1024 + 256 * j + 4 * lane); ss += (v[j][0] * v[j][0] + v[j][1] * v[j][1]) + (v[j][2] * v[j][2] + v[j][3] * v[j][3]); }
            const float sc = 1.f / sqrtf(wave_sum(ss) * (1.f / D) + RMS_EPS);
#pragma unroll
            for (int j = 0; j < 4; ++j) { const int cc = 256 * j + 4 * lane; *(f32x4*)(out + O_YS + (size_t)r * 1024 + cc) = v[j] * sc * *(const f32x4*)(in[34] + cc); } }
    }
}

__global__ void __launch_bounds__(NWAVES * 64, 2) mk_fwd(KArgs a) {
    extern __shared__ __attribute__((aligned(16))) unsigned char lds_raw[];
    LAS unsigned char* lds = (LAS unsigned char*)lds_raw;
    volatile LAS unsigned* MISC = (volatile LAS unsigned*)(lds + MISC_OFF);
    int tid = threadIdx.x, lane = tid & 63, wave = __builtin_amdgcn_readfirstlane(tid >> 6);
    const int G = gridDim.x; int bx = blockIdx.x; int vcu = (G % 8 == 0) ? (bx % 8) * (G / 8) + bx / 8 : bx;
#define LAUNDER() do { ws = a.ws; asm volatile("" : "+s"(ws)); tid = threadIdx.x; asm volatile("" : "+v"(tid)); lane = tid & 63; wave = __builtin_amdgcn_readfirstlane(tid >> 6); bx = blockIdx.x; asm volatile("" : "+s"(bx)); \
        vcu = (G % 8 == 0) ? (bx % 8) * (G / 8) + bx / 8 : bx; gw = vcu * NWAVES + wave; } while (0)
    unsigned char* ws = a.ws; float* out = a.out;
    gu32* ctl = (gu32*)(ws + WS_CTL);
    for (int u = tid; u < (LDS_BYTES - LDSCTL_OFF) / 4; u += NWAVES * 64) ((LAS unsigned*)(lds + LDSCTL_OFF))[u] = 0u;
    __syncthreads();
    XcdBarrier bar = xcd_barrier_post((unsigned*)ctl + CW_BAR, MISC + 8);
#define GRID_BAR() xcd_barrier(bar)
#ifdef PROBE_SPAN_A
#define STAMP(k) do { if (blockIdx.x == 0 && threadIdx.x == 0) *(volatile LAS unsigned long long*)(lds + LDSCTL_OFF + 64 + 8 * (k)) = __builtin_amdgcn_s_memrealtime(); } while (0)
#else
#define STAMP(k) do { } while (0)
#endif
    STAMP(0);
#ifdef PROBE_SSPAN_A
#define SST(k) do { if (blockIdx.x == 64 && threadIdx.x == 0) *(volatile LAS unsigned long long*)(lds + LDSCTL_OFF + 64 + 8 * (16 + (k))) = __builtin_amdgcn_s_memrealtime(); } while (0)
#else
#define SST(k) do { } while (0)
#endif
#define RS1 ((float*)ws + RS_OFF)
#define RS2 ((float*)ws + RS_OFF + RS_STRIDE)
#define RS3 ((float*)ws + RS_OFF + 2 * RS_STRIDE)
#define WCAT ((bf16*)(ws + WS_WCAT))
#define WOUT ((bf16*)(ws + WS_WOUT))
#define WQ ((bf16*)(ws + WS_WQ))
#define WO ((bf16*)(ws + WS_WO))
#define WUP ((bf16*)(ws + WS_WUP))
#define WDN ((bf16*)(ws + WS_WDN))
#define W2T ((bf16*)(ws + WS_SMALL))
#define A2T ((bf16*)(ws + WS_SMALL + 64 * KiB))
#define G2T ((bf16*)(ws + WS_SMALL + 128 * KiB))
#define WSB ((bf16*)(ws + WS_SMALL + 256 * KiB))
#define ZROW ((bf16*)(ws + WS_SMALL + 384 * KiB))
#define ACAT ((bf16*)(ws + WS_ACAT))
#define ZA ((bf16*)(ws + WS_ZA))
#define PB ((bf16*)(ws + WS_PB))
#define SCN ((float*)(ws + WS_SCN))
#define LAIN ((bf16*)(ws + WS_NEW))
#define OPS ((bf16*)(ws + WS_SCN))
#define TASKS (ws + WS_NEW + 8 * MiB)
#define VSB ((bf16*)(ws + WS_NEW + 72 * MiB))
#define BON ((float*)(ws + WS_NEW + 88 * MiB))
#define GB_ ((bf16*)(ws + WS_G))
#define MIX ((bf16*)(ws + WS_MIX))
#define KB ((bf16*)(ws + WS_KB))
#define VT ((bf16*)(ws + WS_VT))
#define X1B ((bf16*)(ws + WS_ZA))
#define Q ((bf16*)(ws + WS_Q))
#define OB ((bf16*)(ws + WS_OB))
#define PSCR ((bf16*)(ws + WS_PSCR))
#define X2B ((bf16*)(ws + WS_MIX))
#define HID ((bf16*)(ws + WS_HID))
    int gw = vcu * NWAVES + wave; const int NGW = G * NWAVES;

    #ifndef NOP0
    LAUNDER();
    {
        LAS float* scr = (LAS float*)(lds + wave * 16384);
        constexpr int I_IN = 16 * 88, I_SQ = 16 * 32, I_UP = 16 * 128, I_DN = 64 * 32, I_L = 16, I_G = 32;
        constexpr int NITEMS = I_IN + 5 * I_SQ + I_UP + I_DN + 2 * I_L + I_G;
        for (int it = gw; it < NITEMS; it += NGW) {
            int r = it;
            if (r < I_IN) { p0_transpose_item(a.in[8], 1024, DIN, WCAT, 0, nullptr, scr, r, lane); continue; } r -= I_IN;
            if (r < I_SQ) { p0_transpose_item(a.in[28], 1024, 1024, WCAT, DIN, nullptr, scr, r, lane); continue; } r -= I_SQ;
            if (r < I_SQ) { p0_transpose_item(a.in[29], 1024, 1024, WCAT, DIN + 1024, nullptr, scr, r, lane); continue; } r -= I_SQ;
            if (r < I_SQ) { p0_transpose_item(a.in[24], 1024, 1024, WOUT, 0, nullptr, scr, r, lane); continue; } r -= I_SQ;
            if (r < I_SQ) { p0_transpose_item(a.in[27], 1024, 1024, WQ, 0, a.in[25], scr, r, lane); continue; } r -= I_SQ;
            if (r < I_SQ) { p0_transpose_item(a.in[30], 1024, 1024, WO, 0, nullptr, scr, r, lane); continue; } r -= I_SQ;
            if (r < I_UP) { p0_transpose_item(a.in[32], 1024, FF, WUP, 0, a.in[31], scr, r, lane); continue; } r -= I_UP;
            if (r < I_DN) { p0_transpose_item(a.in[33], FF, 1024, WDN, 0, nullptr, scr, r, lane); continue; } r -= I_DN;
            if (r < I_L) { p0_transpose_item(a.in[15], 64, DB, W2T, 0, nullptr, scr, r, lane); continue; } r -= I_L;
            if (r < I_L) { p0_transpose_item(a.in[17], 64, DB, A2T, 0, nullptr, scr, r, lane); continue; } r -= I_L;
            p0_transpose_item(a.in[18], 128, DB, G2T, 0, nullptr, scr, r, lane);
        }
        for (int m = gw; m < M + MS + NBATCH * NMEM; m += 4 * NGW) {
            const float* src[4]; const float* gg[4]; bf16* dst[4]; bool ok[4];
#pragma unroll
            for (int q = 0; q < 4; ++q) { const int mm = m + q * NGW; ok[q] = mm < M + MS + NBATCH * NMEM; const int mc = ok[q] ? mm : m;
                if (mc < M) { src[q] = a.in[0] + (size_t)mc * D; gg[q] = a.in[7]; dst[q] = ACAT + (size_t)mc * D; }
                else if (mc < M + MS) { src[q] = a.in[1] + (size_t)(mc - M) * D; gg[q] = a.in[7]; dst[q] = ACAT + (size_t)mc * D; }
                else { src[q] = a.in[2] + (size_t)(mc - M - MS) * D; gg[q] = a.in[26]; dst[q] = ACAT + (size_t)(16640 + (mc - M - MS)) * D; } }
            f32x4 v[4][4]; float ss[4];
#pragma unroll
            for (int q = 0; q < 4; ++q) { ss[q] = 0.f;
#pragma unroll
                for (int j = 0; j < 4; ++j) v[q][j] = __builtin_nontemporal_load((const f32x4*)src[q] + lane + 64 * j); }
#pragma unroll
            for (int q = 0; q < 4; ++q) {
#pragma unroll
                for (int j = 0; j < 4; ++j) ss[q] += (v[q][j].x * v[q][j].x + v[q][j].y * v[q][j].y) + (v[q][j].z * v[q][j].z + v[q][j].w * v[q][j].w);
                const float rstd = 1.f / sqrtf(wave_sum(ss[q]) * (1.f / D) + RMS_EPS);
                if (ok[q]) { unsigned long long* o8 = (unsigned long long*)dst[q] + lane;
#pragma unroll
                    for (int j = 0; j < 4; ++j) { const f32x4 g4 = *((const f32x4*)gg[q] + lane + 64 * j);
                        o8[64 * j] = (unsigned long long)pk2(v[q][j].x * rstd * g4.x, v[q][j].y * rstd * g4.y) | ((unsigned long long)pk2(v[q][j].z * rstd * g4.z, v[q][j].w * rstd * g4.w) << 32); } } }
        }
        const int gt = bx * (NWAVES * 64) + tid, NGT = G * NWAVES * 64;
        for (int i = gt; i < 4 * 128 * 128; i += NGT) { const int t = (i >> 7) & 127, s = i & 127; WSB[i] = (bf16)(pk2(s <= t ? a.in[12][i] : 0.f, 0.f) & 0xffffu); }
        for (int i = gt; i < 2048; i += NGT) ZROW[i] = 0;
    }
#endif
    GRID_BAR(); STAMP(1);

    #ifndef NOP1
    LAUNDER();
    {
        SchedP1 S{G, bx, (const char*)ACAT, (const char*)WCAT};
        EpiP1 E{ZA, PB, out + O_MK, out + O_MV, KB};
        pg8::gemm_phase<EpiP1, SchedP1, true>(lds, 1024, 1024, 1024, S, E);
        sample_stage<0>(lds, a, bx, G, tid, wave, lane);
    }
#endif
    GRID_BAR(); STAMP(2);

    #ifndef NOP2
    LAUNDER();
    {
        LAS float* scr = (LAS float*)(lds + wave * 16384);
        for (int it = gw; it < NBATCH * 128; it += NGW) { const int b = it >> 7; p0_transpose_item(out + O_MV + (size_t)b * NMEM * 1024, NMEM, 1024, VT + (size_t)b * 1024 * NMEM, 0, nullptr, scr, it & 127, lane); }
        const int gt = bx * (NWAVES * 64) + tid, NGT = G * NWAVES * 64;
        for (int i = gt; i < NBATCH * DSH; i += NGT) { const int b = i / DSH, c = i % DSH; out[O_SHP + i] = bf1(PB[(size_t)(b * SEQ + SEQ - 1) * DSH + c]); }
        __syncthreads();
        SST(10);
        for (int bc = bx; bc < M / 64; bc += G)
            rwkv_chunk_prep(lds, bc, PB, ZROW, a.in[9], W2T, A2T, G2T, a.in[14], a.in[16], a.in[19], a.in[20], a.in[21], LAIN + (size_t)bx * 16384, TASKS, GB_, VSB, BON, tid, wave, lane);
        SST(11);
#ifdef DUP2
        LAUNDER();
        for (int bc = bx; bc < M / 64; bc += G)
            rwkv_chunk_prep(lds, bc, PB, ZROW, a.in[9], W2T, A2T, G2T, a.in[14], a.in[16], a.in[19], a.in[20], a.in[21], LAIN + (size_t)bx * 16384, TASKS, GB_, VSB, BON, tid, wave, lane);
#endif
        sample_stage<1>(lds, a, bx, G, tid, wave, lane);
    }
#endif
    GRID_BAR(); STAMP(3);

    #ifndef NOP3
    LAUNDER();
    {   unsigned* subcnt = (unsigned*)ctl + CW_SUB; unsigned* tmo = (unsigned*)ctl + CW_TMO; unsigned* qatt = (unsigned*)ctl + CW_QATT; unsigned* qmix = (unsigned*)ctl + CW_QMIX;
        volatile LAS unsigned* qw = (volatile LAS unsigned*)(lds + LDSCTL_OFF + 32);
        if (bx < 64) {
            scanB_block(lds, bx, TASKS, GB_, VSB, BON, a.in[22], a.in[23], MIX, out + O_WKVP, tid, wave, lane);
#ifdef DUP3
            LAUNDER();
            scanB_block(lds, bx, TASKS, GB_, VSB, BON, a.in[22], a.in[23], MIX, out + O_WKVP, tid, wave, lane);
#endif
            STAMP(5);
            __syncthreads();
            if (tid == 0) { unsigned sp = 0; while (xb_ld(subcnt) < 384u) { __builtin_amdgcn_s_sleep(4); if ((++sp & 255u) == 0u) { if (xb_ld(tmo)) break; if (sp > (1u << 20)) { atomicAdd(tmo, 1u); break; } } }
                __builtin_amdgcn_fence(__ATOMIC_ACQUIRE, "agent"); asm volatile("s_waitcnt vmcnt(0)" ::: "memory"); }
            __syncthreads();
        } else {
            const int gb = bx - 64;
            SST(0);
#define SUBBAR_FILL(target) do { asm volatile("s_waitcnt vmcnt(0)" ::: "memory"); __syncthreads(); \
                if (tid == 0) { __builtin_amdgcn_fence(__ATOMIC_RELEASE, "agent"); asm volatile("s_waitcnt vmcnt(0)" ::: "memory"); (void)xb_add(subcnt, 1u); } \
                unsigned sp_ = 0; \
                for (;;) { __syncthreads(); if (tid == 0) { const bool dn_ = xb_ld(subcnt) >= (target) || xb_ld(tmo) != 0u; *qw = dn_ ? 0xffffffffu : xb_add(qmix, 1u); } __syncthreads(); const unsigned tile_ = *qw; \
                    if (tile_ == 0xffffffffu) break; \
                    if (tile_ < 512u) mixer_a_tile(lds, (int)tile_, ZA, WSB, a.in[10], a.in[11], a.in[13], MIX, out + O_CVP, tid, wave, lane); \
                    else { __builtin_amdgcn_s_sleep(8); if (++sp_ > (1u << 18)) { if (tid == 0) atomicAdd(tmo, 1u); } } } \
                if (tid == 0) { __builtin_amdgcn_fence(__ATOMIC_ACQUIRE, "agent"); asm volatile("s_waitcnt vmcnt(0)" ::: "memory"); } \
                __syncthreads(); } while (0)
            sample_stage<2>(lds, a, gb, 192, tid, wave, lane);
            SST(1);
            SUBBAR_FILL(192u);
            SST(2);
            sample_stage<3>(lds, a, gb, 192, tid, wave, lane);
            SST(3);
            SUBBAR_FILL(384u);
#undef SUBBAR_FILL
            SST(4);
        }
        {   const float* Qs = (const float*)(ws + WS_SMP + SM_Q); bf16* Os = (bf16*)(ws + WS_SMP + SM_O);
            for (;;) { __syncthreads(); if (tid == 0) *qw = xb_add(qatt, 1u); __syncthreads(); const unsigned pair = *qw; if (pair >= (unsigned)(MS * 4)) break;
                sample_attn_pair(lds, (int)pair, Qs, a.in[3], a.in[4], Os, tid, wave, lane); }
            SST(5);
            for (;;) { __syncthreads(); if (tid == 0) *qw = xb_add(qmix, 1u); __syncthreads(); const unsigned tile = *qw; if (tile >= 512u) break;
                mixer_a_tile(lds, (int)tile, ZA, WSB, a.in[10], a.in[11], a.in[13], MIX, out + O_CVP, tid, wave, lane); }
            SST(6);
        }
    }
#endif
    GRID_BAR(); STAMP(4);

    #ifndef NOP4
    LAUNDER();
    {
        SchedMN S; S.init(M, 1024, G, bx, MIX, 1024, WOUT, 1024);
        EpiRes<float> E{a.in[0], X1B, RS1};
        pg8::gemm_phase<EpiRes<float>, SchedMN, true>(lds, 1024, 1024, 1024, S, E);
        sample_stage<5>(lds, a, bx, G, tid, wave, lane);
    }
#endif
    GRID_BAR(); STAMP(6);

    #ifndef NOP5
    LAUNDER();
    {
        SchedMN S5; S5.init(M, 1024, G, bx, X1B, 1024, WQ, 1024);
        bf16* QS = Q + (size_t)bx * 65536; bf16* P = PSCR + (size_t)bx * 65536;
        Unit u;
        for (int i = 0; S5.next(i, u); ++i) {
            const int pm = u.pm, h = u.pn, b = pm >> 3;
            { EpiQS E{QS, RS1};
              struct SchedU { const char* A; const char* B; Unit uu; __device__ __forceinline__ bool next(int i2, Unit& o) const { if (i2) return false; o = uu; return true; } __device__ __forceinline__ const char* pa(const Unit&) const { return A; } __device__ __forceinline__ const char* pb(const Unit&) const { return B; } };
              SchedU SU{S5.pa(u), S5.pb(u), u};
              pg8::gemm_phase<EpiQS, SchedU, false>(lds, 1024, 1024, 1024, SU, E); }
            { SchedOne S{(const char*)QS, (const char*)(KB + (size_t)b * NMEM * 1024 + h * 256)}; EpiSoftmax E{P};
              pg8::gemm_phase<EpiSoftmax, SchedOne, false>(lds, 256, 256, 1024, S, E); }
            { SchedOne S{(const char*)P, (const char*)(VT + ((size_t)b * 1024 + h * 256) * NMEM)}; EpiAttnO E{OB + (size_t)pm * 256 * 1024 + h * 256};
              pg8::gemm_phase<EpiAttnO, SchedOne, false>(lds, 256, 256, 256, S, E); }
        }
        sample_stage<6>(lds, a, bx, G, tid, wave, lane);
    }
#endif
    GRID_BAR(); STAMP(8);

    #ifndef NOP7
    LAUNDER();
    {
        SchedMN S; S.init(M, 1024, G, bx, OB, 1024, WO, 1024);
        EpiRes<bf16> E{X1B, X2B, RS2};
        pg8::gemm_phase<EpiRes<bf16>, SchedMN, true>(lds, 1024, 1024, 1024, S, E);
        sample_stage<7>(lds, a, bx, G, tid, wave, lane);
    }
#endif
    GRID_BAR(); STAMP(9);

    #ifndef NOP8
    LAUNDER();
    {
        SchedMN S; S.init(M, FF, G, bx, X2B, 1024, WUP, 1024);
        EpiScale<1> E{HID, FF, RS2};
        pg8::gemm_phase<EpiScale<1>, SchedMN, true>(lds, 1024, 1024, 1024, S, E);
        sample_stage<8>(lds, a, bx, G, tid, wave, lane);
    }
#endif
    GRID_BAR(); STAMP(10);

    #ifndef NOP9
    LAUNDER();
    {
        SchedMN S; S.init(M, 1024, G, bx, HID, FF, WDN, FF);
        EpiFinal E{X2B, out + O_Y, a.in[34], RS3, (unsigned*)ctl + CW_PAN, (unsigned*)ctl + CW_TMO};
        pg8::gemm_phase<EpiFinal, SchedMN, true>(lds, FF, FF, FF, S, E);
    }
#endif
#ifdef PROBE_CSPAN_A
    if (blockIdx.x == 64 && threadIdx.x == 0) {
        const unsigned long long ta = *(volatile LAS unsigned long long*)(lds + 140000 + 8 * PROBE_CSPAN_A), tb = *(volatile LAS unsigned long long*)(lds + 140000 + 8 * PROBE_CSPAN_B);
        const unsigned long long t0 = __builtin_amdgcn_s_memrealtime(), dl = (tb - ta) * PROBE_MULT;
        while (__builtin_amdgcn_s_memrealtime() - t0 < dl) __builtin_amdgcn_s_sleep(8);
    }
#endif
#ifdef PROBE_SSPAN_A
    if (blockIdx.x == 64 && threadIdx.x == 0) {
        const unsigned long long ta = *(volatile LAS unsigned long long*)(lds + LDSCTL_OFF + 64 + 8 * (16 + PROBE_SSPAN_A)), tb = *(volatile LAS unsigned long long*)(lds + LDSCTL_OFF + 64 + 8 * (16 + PROBE_SSPAN_B));
        const unsigned long long t0 = __builtin_amdgcn_s_memrealtime(), dl = (tb - ta) * PROBE_MULT;
        while (__builtin_amdgcn_s_memrealtime() - t0 < dl) __builtin_amdgcn_s_sleep(8);
    }
#endif
#ifdef PROBE_SPAN_A
    STAMP(12);
    if (blockIdx.x == 0 && threadIdx.x == 0) {
        const unsigned long long ta = *(volatile LAS unsigned long long*)(lds + LDSCTL_OFF + 64 + 8 * PROBE_SPAN_A), tb = *(volatile LAS unsigned long long*)(lds + LDSCTL_OFF + 64 + 8 * PROBE_SPAN_B);
        const unsigned long long t0 = __builtin_amdgcn_s_memrealtime(), dl = (tb - ta) * PROBE_MULT;
        while (__builtin_amdgcn_s_memrealtime() - t0 < dl) __builtin_amdgcn_s_sleep(8);
    }
#endif
}

extern "C" void kernel_launch(void* const* d_in, const int* in_sizes, int n_in, void* d_out, int out_size, void* d_ws, size_t ws_size, hipStream_t stream) {
    static int grid = 0;
    if (grid == 0) {
        if (n_in != 35 || out_size != (int)O_END || ws_size < WS_END) { fprintf(stderr, "kernel_launch: unexpected shapes (n_in %d, out %d, ws %zu); nothing launched\n", n_in, out_size, ws_size); grid = -1; return; }
        int dev = 0, cus = 0, per_cu = 0;
        if (hipGetDevice(&dev) != hipSuccess || hipDeviceGetAttribute(&cus, hipDeviceAttributeMultiprocessorCount, dev) != hipSuccess) { fprintf(stderr, "kernel_launch: device query failed\n"); grid = -1; return; }
        if (hipFuncSetAttribute((const void*)mk_fwd, hipFuncAttributeMaxDynamicSharedMemorySize, LDS_BYTES) != hipSuccess) { fprintf(stderr, "kernel_launch: hipFuncSetAttribute failed\n"); grid = -1; return; }
        if (hipOccupancyMaxActiveBlocksPerMultiprocessor(&per_cu, (const void*)mk_fwd, NWAVES * 64, LDS_BYTES) != hipSuccess || per_cu < 1)
            fprintf(stderr, "kernel_launch: note: occupancy query reports %d workgroups per CU\n", per_cu);
        (void)hipGetLastError();
        grid = cus;
        if (grid != 256) { fprintf(stderr, "kernel_launch: built for a 256-CU device (got %d)\n", grid); grid = -1; return; }
    }
    if (grid < 0) return;
    if (hipMemsetAsync((char*)d_ws + WS_CTL, 0, CTL_ZERO_BYTES, stream) != hipSuccess) { fprintf(stderr, "kernel_launch: hipMemsetAsync failed\n"); return; }
    KArgs a{};
    for (int i = 0; i < 35; ++i) a.in[i] = (const float*)d_in[i];
    a.out = (float*)d_out; a.ws = (unsigned char*)d_ws;
    hipLaunchKernelGGL(mk_fwd, dim3(grid), dim3(NWAVES * 64), LDS_BYTES, stream, a);
    const hipError_t le = hipPeekAtLastError();
    if (le != hipSuccess) fprintf(stderr, "kernel_launch: launch failed: %s\n", hipGetErrorName(le));
}
```

```cpp
#include <hip/hip_runtime.h>
#include <cstdio>
#include <cstdint>

namespace pg8 {
#define PG8_LAS __attribute__((address_space(3)))
typedef unsigned short bf16_t;
typedef short bf16x8 __attribute__((ext_vector_type(8)));
typedef float f32x4 __attribute__((ext_vector_type(4)));
typedef float f32x2 __attribute__((ext_vector_type(2)));
typedef unsigned u32x4 __attribute__((ext_vector_type(4)));
typedef unsigned u32x2 __attribute__((ext_vector_type(2)));
constexpr int BM = 256, BK = 64, HALF = 128, HTB = HALF * BK * 2  , STAGE_BYTES = 8 * HTB;

__host__ __device__ __forceinline__ int lds_byte(int r, int c) { const int st = (r >> 4) * 2 + (c >> 5), rr = r & 15, cc = c & 31, ob = rr * 64 + cc * 2; return st * 1024 + (ob ^ (((ob >> 9) & 1) << 5)); }
__host__ __device__ __forceinline__ void stage_rc(int b, int& R, int& C) { const int st = b / 1024, sb = b % 1024, swz = sb ^ (((sb >> 9) & 1) << 5); R = (st >> 1) * 16 + swz / 64; C = (st & 1) * 32 + (swz % 64) / 2; }
__host__ __device__ __forceinline__ int perm32(int rho) { const int n = rho >> 4, i = rho & 15; return 8 * (i >> 2) + 4 * n + (i & 3); }

struct Unit { int pm, pn; };

typedef __bf16 nbf16x2 __attribute__((ext_vector_type(2)));
__device__ __forceinline__ unsigned cvt_pk_bf16(float lo, float hi) { const nbf16x2 r = __builtin_convertvector((f32x2){lo, hi}, nbf16x2); return __builtin_bit_cast(unsigned, r); }
__device__ __forceinline__ f32x2 gelu_pk(f32x2 v) {
    const f32x2 av = __builtin_elementwise_abs(v), d = av * 0.2316418882f + 1.0f;
    f32x2 t; t.x = __builtin_amdgcn_rcpf(d.x); t.y = __builtin_amdgcn_rcpf(d.y);
    f32x2 q = t * 0.5307027145f + (-0.7265760135f); q = q * t + 0.7107068705f; q = q * t + (-0.142248368f); q = q * t + 0.127414796f; q = q * t;
    const f32x2 s = (v * v) * (-0.72134752044f);
    f32x2 e; e.x = __builtin_amdgcn_exp2f(s.x); e.y = __builtin_amdgcn_exp2f(s.y);
    const f32x2 m = v * (q * e), r = v - m;
    f32x2 o; o.x = v.x < 0.f ? m.x : r.x; o.y = v.y < 0.f ? m.y : r.y; return o;
}

template <class Epi, class Sched, bool ALIGN_EPI = false>
__device__ __forceinline__ void gemm_phase(PG8_LAS unsigned char* lds, const int K, const int lda, const int ldb, const Sched& S, const Epi& E) {
    int tid_ = threadIdx.x; asm volatile("" : "+v"(tid_));
    const int tid = tid_, wid = __builtin_amdgcn_readfirstlane(tid >> 6), lane = tid & 63, wr = wid >> 2, wc = wid & 3, fr = lane & 15, fq = lane >> 4;
    const int nt = K / BK;
    unsigned voffA[2], voffB[2];
#pragma unroll
    for (int i = 0; i < 2; ++i) { int R, C; stage_rc(tid * 16 + i * 8192, R, C); const int Rb = Epi::PERM ? ((R & ~31) + perm32(R & 31)) : R;
        voffA[i] = (unsigned)(R * lda + C) * 2u; voffB[i] = (unsigned)(Rb * ldb + C) * 2u; }
    const size_t kstep = (size_t)(BK * 2);
    const size_t hstepA = (size_t)HALF * lda * 2, hstepB = (size_t)HALF * ldb * 2;
    const unsigned ldsw = (unsigned)wid * 1024u;
    const int aoff = lds_byte(wr * 64 + fr, fq * 8), boff = lds_byte(wc * 32 + fr, fq * 8);
#define PG8_SA(b, h) (((b) * 2 + (h)) * HTB)
#define PG8_SB(b, h) ((4 + (b) * 2 + (h)) * HTB)
#define PG8_STAGE(bufoff, gbase, voff) do { _Pragma("unroll") for (int _i = 0; _i < 2; ++_i) \
        __builtin_amdgcn_global_load_lds((const unsigned*)((const char*)(gbase) + (voff)[_i]), (PG8_LAS unsigned*)(lds + (bufoff) + ldsw + _i * 8192), 16, 0, 0); } while (0)
#define PG8_LDA(dst, b, h) do { _Pragma("unroll") for (int m = 0; m < 4; ++m) _Pragma("unroll") for (int k = 0; k < 2; ++k) dst[m][k] = *(const PG8_LAS bf16x8*)(lds + PG8_SA(b, h) + aoff + m * 2048 + k * 1024); } while (0)
#define PG8_LDB(dst, b, h) do { _Pragma("unroll") for (int n = 0; n < 2; ++n) _Pragma("unroll") for (int k = 0; k < 2; ++k) dst[n][k] = *(const PG8_LAS bf16x8*)(lds + PG8_SB(b, h) + boff + n * 2048 + k * 1024); } while (0)
#define PG8_MMA(ai, bj, At, Bt) do { __builtin_amdgcn_s_setprio(1); _Pragma("unroll") for (int m = 0; m < 4; ++m) _Pragma("unroll") for (int n = 0; n < 2; ++n) _Pragma("unroll") for (int k = 0; k < 2; ++k) \
        acc[ai][bj][m][n] = __builtin_amdgcn_mfma_f32_16x16x32_bf16(Bt[n][k], At[m][k], acc[ai][bj][m][n], 0, 0, 0); __builtin_amdgcn_s_setprio(0); } while (0)
#define PG8_WAIT_V(n) asm volatile("s_waitcnt vmcnt(" #n ")" ::: "memory")
#define PG8_WAIT_L(n) asm volatile("s_waitcnt lgkmcnt(" #n ")" ::: "memory")
#define PG8_BAR __builtin_amdgcn_s_barrier()
#define PG8_SCHED __builtin_amdgcn_sched_barrier(0)
    Unit cur, nxt; int ui = 0;
    if (!S.next(0, cur)) return;
    f32x4 acc[2][2][4][2];
#pragma unroll
    for (int a = 0; a < 2; ++a)
#pragma unroll
        for (int b = 0; b < 2; ++b)
#pragma unroll
            for (int m = 0; m < 4; ++m)
#pragma unroll
                for (int n = 0; n < 2; ++n) acc[a][b][m][n] = (f32x4){0.f, 0.f, 0.f, 0.f};
    bf16x8 At[4][2], B0[2][2], B1[2][2];
    const char* cA = S.pa(cur); const char* cB = S.pb(cur);
    PG8_STAGE(PG8_SB(0, 0), cB, voffB); PG8_STAGE(PG8_SB(0, 1), cB + hstepB, voffB); PG8_STAGE(PG8_SA(0, 0), cA, voffA); PG8_STAGE(PG8_SA(0, 1), cA + hstepA, voffA);
    if (wr == 1) PG8_BAR;
    PG8_WAIT_V(2); PG8_BAR;
    PG8_STAGE(PG8_SB(1, 0), cB + kstep, voffB); PG8_STAGE(PG8_SA(1, 0), cA + kstep, voffA); PG8_STAGE(PG8_SB(1, 1), cB + hstepB + kstep, voffB);
    PG8_WAIT_V(6); PG8_BAR;
    for (;;) {
        const bool has_next = S.next(ui + 1, nxt);
        const char* nA = has_next ? S.pa(nxt) : cA; const char* nB = has_next ? S.pb(nxt) : cB;
#pragma unroll 1
        for (int t = 0; t < nt; t += 2) {
            const bool last = (t == nt - 2);
            const char* a1 = cA + (size_t)(t + 1) * kstep;
            const char* a2 = last ? nA : cA + (size_t)(t + 2) * kstep; const char* b2 = last ? nB : cB + (size_t)(t + 2) * kstep;
            const char* a3 = a2 + kstep; const char* b3 = b2 + kstep;
            PG8_LDB(B0, 0, 0); PG8_LDB(B1, 0, 1); PG8_SCHED; PG8_LDA(At, 0, 0); PG8_STAGE(PG8_SA(1, 1), a1 + hstepA, voffA);
            PG8_WAIT_V(8); PG8_WAIT_L(0); PG8_BAR; PG8_MMA(0, 0, At, B0); PG8_MMA(0, 1, At, B1); PG8_BAR; PG8_SCHED;
            PG8_LDA(At, 0, 1); PG8_STAGE(PG8_SB(0, 0), b2, voffB); PG8_STAGE(PG8_SB(0, 1), b2 + hstepB, voffB); PG8_STAGE(PG8_SA(0, 0), a2, voffA);
            PG8_WAIT_V(8); PG8_WAIT_L(0); PG8_BAR; PG8_MMA(1, 0, At, B0); PG8_MMA(1, 1, At, B1); PG8_BAR; PG8_SCHED;
            PG8_LDB(B0, 1, 0); PG8_LDB(B1, 1, 1); PG8_SCHED; PG8_LDA(At, 1, 0); PG8_STAGE(PG8_SA(0, 1), a2 + hstepA, voffA);
            PG8_WAIT_V(8); PG8_WAIT_L(0); PG8_BAR; PG8_MMA(0, 0, At, B0); PG8_MMA(0, 1, At, B1); PG8_BAR; PG8_SCHED;
            PG8_LDA(At, 1, 1); PG8_STAGE(PG8_SB(1, 0), b3, voffB); PG8_STAGE(PG8_SB(1, 1), b3 + hstepB, voffB); PG8_STAGE(PG8_SA(1, 0), a3, voffA);
            PG8_WAIT_V(8); PG8_WAIT_L(0); PG8_BAR; PG8_MMA(1, 0, At, B0); PG8_MMA(1, 1, At, B1); PG8_BAR; PG8_SCHED;
        }
        if constexpr (ALIGN_EPI) { if (wr == 0) PG8_BAR; }
        if constexpr (!Epi::AFTER_DRAIN) { E(acc, cur, wr, wc, fr, fq); }
        if (!has_next) break;
#pragma unroll
        for (int a = 0; a < 2; ++a)
#pragma unroll
            for (int b = 0; b < 2; ++b)
#pragma unroll
                for (int m = 0; m < 4; ++m)
#pragma unroll
                    for (int n = 0; n < 2; ++n) acc[a][b][m][n] = (f32x4){0.f, 0.f, 0.f, 0.f};
        cur = nxt; cA = nA; cB = nB; ++ui;
        if constexpr (ALIGN_EPI) { if (wr == 1) PG8_BAR; }
    }
    PG8_WAIT_V(0);
    if constexpr (!ALIGN_EPI) { if (wr == 0) PG8_BAR; }
    PG8_BAR;
    if constexpr (Epi::AFTER_DRAIN) { E.fused(acc, cur, wr, wc, fr, fq, lds, wid, lane); }
#undef PG8_SA
#undef PG8_SB
#undef PG8_STAGE
#undef PG8_LDA
#undef PG8_LDB
#undef PG8_MMA
#undef PG8_WAIT_V
#undef PG8_WAIT_L
#undef PG8_BAR
#undef PG8_SCHED
}
}

#define GAS __attribute__((address_space(1)))
#define LAS __attribute__((address_space(3)))
typedef unsigned short bf16;
typedef float f32x4 __attribute__((ext_vector_type(4)));
typedef float f32x2 __attribute__((ext_vector_type(2)));
typedef short bf16x8 __attribute__((ext_vector_type(8)));
typedef unsigned u32x4 __attribute__((ext_vector_type(4)));
typedef unsigned u32x2 __attribute__((ext_vector_type(2)));
typedef GAS unsigned gu32;
#define RLX_AGENT __ATOMIC_RELAXED, __HIP_MEMORY_SCOPE_AGENT
#define LDS_WAIT() asm volatile("s_waitcnt lgkmcnt(0)" ::: "memory")
#define VM_WAIT() asm volatile("s_waitcnt vmcnt(0)" ::: "memory")

constexpr int NWAVES = 8;
constexpr int D = 1024, M = 16384, SEQ = 2048, NBATCH = 8, MS = 128, DIN = 2816, DSH = 1792, DB = 512, FF = 4096, NMEM = 256;
constexpr float RMS_EPS = 1e-6f, LN_EPS = 1e-5f, GN_EPS = 64e-5f;
constexpr size_t O_Y = 0, O_YS = 16777216, O_MK = 16908288, O_MV = 19005440, O_SHP = 21102592, O_WKVP = 21116928, O_CVP = 21379072, O_SHS = 21903360, O_WKVS = 22132736, O_CVS = 26327040, O_END = 26392576;
constexpr size_t MiB = 1u << 20, KiB = 1024;
constexpr size_t WS_CTL = 0, CTL_ZERO_BYTES = 1 * MiB;
constexpr size_t WS_WCAT = 2 * MiB;
constexpr size_t WS_WOUT = 12 * MiB, WS_WQ = 14 * MiB, WS_WO = 16 * MiB, WS_WUP = 18 * MiB, WS_WDN = 26 * MiB;
constexpr size_t WS_SMALL = 34 * MiB;
constexpr size_t WS_ACAT = 36 * MiB;
constexpr size_t WS_ZA = 73 * MiB;
constexpr size_t WS_PB = 105 * MiB;
constexpr size_t WS_Q = 105 * MiB, WS_OB = 137 * MiB;
constexpr size_t WS_SCN = 161 * MiB;
constexpr size_t WS_PSCR = 169 * MiB, WS_HID = 201 * MiB;
constexpr size_t WS_G = 353 * MiB;
constexpr size_t WS_MIX = 369 * MiB;
constexpr size_t WS_KB = 401 * MiB, WS_VT = 405 * MiB;
constexpr size_t WS_SMP = 409 * MiB;
constexpr size_t SM_ZA = 0, SM_MIX = 256 * KiB, SM_X1 = 512 * KiB, SM_X1B = 1024 * KiB, SM_Q = 1280 * KiB, SM_O = 1792 * KiB, SM_X2 = 2048 * KiB, SM_X2B = 2560 * KiB, SM_HID = 3072 * KiB, SM_X3 = 4096 * KiB;
constexpr size_t WS_NEW = 416 * MiB;
constexpr size_t WS_END = 505 * MiB;
constexpr int CW_TMO = 0, CW_CODE = 1, CW_BAR = 4096, CW_SUB = 8192, CW_QATT = 8256, CW_QMIX = 8320, CW_SUB2 = 8384, CW_QDN = 8448, CW_PAN = 12288;
constexpr int RS_OFF = 65536, RS_STRIDE = 16640;
constexpr int RING_BYTES = 131072, LDSCTL_OFF = RING_BYTES, MISC_OFF = LDSCTL_OFF + 320, LDS_BYTES = 163840;
constexpr int L_LWT = 131584, L_LWT2 = 128256, LWT_SPLIT = 32256;

__device__ __forceinline__ float bf_lo(unsigned u) { return __uint_as_float(u << 16); }
__device__ __forceinline__ float bf_hi(unsigned u) { return __uint_as_float(u & 0xffff0000u); }
__device__ __forceinline__ float bf1(bf16 v) { return __uint_as_float(((unsigned)v) << 16); }
__device__ __forceinline__ unsigned pk2(float lo, float hi) { return pg8::cvt_pk_bf16(lo, hi); }
__device__ __forceinline__ f32x4 bf4(u32x2 v) { return (f32x4){bf_lo(v.x), bf_hi(v.x), bf_lo(v.y), bf_hi(v.y)}; }
__device__ __forceinline__ u32x2 pk4(f32x4 v) { u32x2 r; r.x = pk2(v.x, v.y); r.y = pk2(v.z, v.w); return r; }
__device__ __forceinline__ float fast_exp(float x) { return __builtin_amdgcn_exp2f(x * 1.44269504089f); }
__device__ __forceinline__ float fast_log(float x) { return __builtin_amdgcn_logf(x) * 0.69314718056f; }
__device__ __forceinline__ float fast_sigmoid(float x) { return __builtin_amdgcn_rcpf(1.0f + fast_exp(-x)); }
__device__ __forceinline__ float fast_tanh(float x) { return 1.0f - 2.0f * __builtin_amdgcn_rcpf(fast_exp(2.0f * x) + 1.0f); }
template <int CTRL> __device__ __forceinline__ float dpp_mov(float x) { return __builtin_bit_cast(float, __builtin_amdgcn_mov_dpp(__builtin_bit_cast(int, x), CTRL, 0xf, 0xf, true)); }
__device__ __forceinline__ float red4(float x) { x += dpp_mov<0xB1>(x); x += dpp_mov<0x4E>(x); return x; }
__device__ __forceinline__ float red8(float x) { x = red4(x); x += dpp_mov<0x141>(x); return x; }
__device__ __forceinline__ float red16(float x) { x = red8(x); x += dpp_mov<0x128>(x); return x; }
__device__ __forceinline__ float wave_sum(float v) {
#pragma unroll
    for (int o = 1; o < 64; o <<= 1) v += __shfl_xor(v, o);
    return v;
}
__device__ __forceinline__ float wave_max(float v) {
#pragma unroll
    for (int o = 1; o < 64; o <<= 1) v = fmaxf(v, __shfl_xor(v, o));
    return v;
}

#define XB_TMO      128
#define XB_XCNT(j)  (256  + 64 * (j))
#define XB_XSUB(j)  (1280 + 64 * (j))
#define XB_XGEN(j)  (2304 + 64 * (j))
#define XB_TOP      3328
#define XB_TOPGEN   3392
#define XCD_BAR_WORDS 3456
#define XB_SPIN_CAP (1u << 18)
__device__ __forceinline__ unsigned xb_ld(unsigned* p)              { return __hip_atomic_load(p, __ATOMIC_RELAXED, __HIP_MEMORY_SCOPE_AGENT); }
__device__ __forceinline__ unsigned xb_add(unsigned* p, unsigned v) { return __hip_atomic_fetch_add(p, v, __ATOMIC_RELAXED, __HIP_MEMORY_SCOPE_AGENT); }
__device__ __forceinline__ unsigned xb_xcc_id() { return (unsigned)__builtin_amdgcn_s_getreg((3 << 11) | 20) & 0xFu; }
#define XB_SPIN(cond, bar) do { unsigned _sp = 0; while (cond) { __builtin_amdgcn_s_sleep(1); \
    if ((++_sp & 255u) == 0u) { if (xb_ld(&(bar)[XB_TMO])) break; if (_sp > XB_SPIN_CAP) { atomicAdd(&(bar)[XB_TMO], 1u); break; } } } } while (0)
struct XcdBarrier { unsigned* bar; unsigned x; volatile LAS unsigned* st; };
__device__ __forceinline__ XcdBarrier xcd_barrier_post(unsigned* bar, volatile LAS unsigned* st) {
    XcdBarrier b; b.bar = bar; b.x = xb_xcc_id(); b.st = st;
    if (threadIdx.x == 0) (void)xb_add(&bar[XB_XCNT(b.x)], 1u);
    return b;
}
__device__ __forceinline__ void xcd_barrier_complete(unsigned* bar, unsigned x, unsigned& nloc, unsigned& nx) {
    const unsigned G = gridDim.x * gridDim.y * gridDim.z;
    unsigned sum, cnt, mine, sp = 0u;
    for (;;) {
        sum = 0u; cnt = 0u; mine = 0u;
#pragma unroll
        for (unsigned j = 0; j < 16; ++j) { const unsigned c = xb_ld(&bar[XB_XCNT(j)]); sum += c; cnt += (c > 0u) ? 1u : 0u; mine = (j == x) ? c : mine; }
        if (sum == G) break;
        __builtin_amdgcn_s_sleep(1);
        if ((++sp & 255u) == 0u) { if (xb_ld(&bar[XB_TMO])) break; if (sp > XB_SPIN_CAP) { atomicAdd(&bar[XB_TMO], 1u); break; } }
    }
    nloc = mine > 0u ? mine : 1u; nx = cnt > 0u ? cnt : 1u;
}
__device__ __forceinline__ void xcd_barrier(const XcdBarrier& b) {
    asm volatile("s_waitcnt vmcnt(0)" ::: "memory");
    __syncthreads();
    if (threadIdx.x == 0) {
        unsigned* bar = b.bar;
        __builtin_amdgcn_s_waitcnt(0);
        unsigned nloc = b.st[0], nx = b.st[1];
        if (nloc == 0u) { xcd_barrier_complete(bar, b.x, nloc, nx); b.st[0] = nloc; b.st[1] = nx; }
        const unsigned old = xb_add(&bar[XB_XSUB(b.x)], 1u);
        const unsigned gen = old / nloc;
        if (old + 1u == (gen + 1u) * nloc) {
            __builtin_amdgcn_fence(__ATOMIC_RELEASE, "agent");
            asm volatile("s_waitcnt vmcnt(0)" ::: "memory");
            const unsigned og = xb_add(&bar[XB_TOP], 1u);
            const unsigned tg = og / nx;
            if (og + 1u == (tg + 1u) * nx) xb_add(&bar[XB_TOPGEN], 1u);
            else XB_SPIN(xb_ld(&bar[XB_TOPGEN]) == tg, bar);
            __builtin_amdgcn_fence(__ATOMIC_ACQUIRE, "agent");
            xb_add(&bar[XB_XGEN(b.x)], 1u);
            asm volatile("s_waitcnt vmcnt(0)" ::: "memory");
        } else {
            XB_SPIN(xb_ld(&bar[XB_XGEN(b.x)]) == gen, bar);
            __builtin_amdgcn_fence(__ATOMIC_ACQUIRE, "agent");
            asm volatile("s_waitcnt vmcnt(0)" ::: "memory");
        }
    }
    __syncthreads();
}
__device__ __forceinline__ bool xcd_barrier_arrive(const XcdBarrier& b, unsigned& gen) {
    unsigned* bar = b.bar;
    __builtin_amdgcn_s_waitcnt(0);
    unsigned nloc = b.st[0], nx = b.st[1];
    if (nloc == 0u) { xcd_barrier_complete(bar, b.x, nloc, nx); b.st[0] = nloc; b.st[1] = nx; }
    const unsigned old = xb_add(&bar[XB_XSUB(b.x)], 1u);
    gen = old / nloc;
    if (old + 1u == (gen + 1u) * nloc) {
        __builtin_amdgcn_fence(__ATOMIC_RELEASE, "agent");
        asm volatile("s_waitcnt vmcnt(0)" ::: "memory");
        const unsigned og = xb_add(&bar[XB_TOP], 1u);
        const unsigned tg = og / nx;
        if (og + 1u == (tg + 1u) * nx) xb_add(&bar[XB_TOPGEN], 1u);
        else XB_SPIN(xb_ld(&bar[XB_TOPGEN]) == tg, bar);
        __builtin_amdgcn_fence(__ATOMIC_ACQUIRE, "agent");
        xb_add(&bar[XB_XGEN(b.x)], 1u);
        asm volatile("s_waitcnt vmcnt(0)" ::: "memory");
        return true;
    }
    return false;
}
__device__ __forceinline__ bool xcd_barrier_poll(const XcdBarrier& b, unsigned gen) {
    if (xb_ld(&b.bar[XB_XGEN(b.x)]) == gen && xb_ld(&b.bar[XB_TMO]) == 0u) return false;
    __builtin_amdgcn_fence(__ATOMIC_ACQUIRE, "agent");
    asm volatile("s_waitcnt vmcnt(0)" ::: "memory");
    return true;
}
__device__ __forceinline__ void sub_barrier(unsigned* cnt, unsigned* tmo, unsigned target) {
    asm volatile("s_waitcnt vmcnt(0)" ::: "memory");
    __syncthreads();
    if (threadIdx.x == 0) {
        __builtin_amdgcn_fence(__ATOMIC_RELEASE, "agent");
        asm volatile("s_waitcnt vmcnt(0)" ::: "memory");
        (void)xb_add(cnt, 1u);
        unsigned sp = 0;
        while (xb_ld(cnt) < target) { __builtin_amdgcn_s_sleep(1); if ((++sp & 255u) == 0u) { if (xb_ld(tmo)) break; if (sp > (1u << 20)) { atomicAdd(tmo, 1u); break; } } }
        __builtin_amdgcn_fence(__ATOMIC_ACQUIRE, "agent");
        asm volatile("s_waitcnt vmcnt(0)" ::: "memory");
    }
    __syncthreads();
}

__device__ __forceinline__ void p0_transpose_item(const float* W, int K, int N, bf16* WT, int row_off, const float* gk, LAS float* scr, int item, int lane) {
    const int nblk = N / 32, kb = item / nblk, nb = item % nblk, k0 = 64 * kb, n0 = 32 * nb;
    f32x4 vv[8];
#pragma unroll
    for (int i = 0; i < 8; ++i) vv[i] = __builtin_nontemporal_load((const f32x4*)(W + (size_t)(k0 + 8 * i + (lane >> 3)) * N + n0 + 4 * (lane & 7)));
    if (gk) {
#pragma unroll
        for (int i = 0; i < 8; ++i) vv[i] = vv[i] * gk[k0 + 8 * i + (lane >> 3)]; }
#pragma unroll
    for (int i = 0; i < 8; ++i) { LAS float* d = scr + (8 * i + (lane >> 3)) * 33 + 4 * (lane & 7); d[0] = vv[i][0]; d[1] = vv[i][1]; d[2] = vv[i][2]; d[3] = vv[i][3]; }
    LDS_WAIT(); asm volatile("" ::: "memory");
    const int c = lane & 7;
#pragma unroll
    for (int j = 0; j < 4; ++j) { const int n = (lane >> 3) + 8 * j; const LAS float* s = scr + (8 * c) * 33 + n;
        u32x4 o; o.x = pk2(s[0 * 33], s[1 * 33]); o.y = pk2(s[2 * 33], s[3 * 33]); o.z = pk2(s[4 * 33], s[5 * 33]); o.w = pk2(s[6 * 33], s[7 * 33]);
        *(u32x4*)(WT + (size_t)(row_off + n0 + n) * K + k0 + 8 * c) = o; }
    LDS_WAIT(); asm volatile("" ::: "memory");
}
__device__ __forceinline__ void rms_row_to_bf16(const float* xrow, const float* g, bf16* orow, int lane) {
    const f32x4* xr = (const f32x4*)xrow + lane; const f32x4* gr = (const f32x4*)g + lane;
    f32x4 v[4]; float s = 0.f;
#pragma unroll
    for (int j = 0; j < 4; ++j) { v[j] = xr[64 * j]; s += (v[j].x * v[j].x + v[j].y * v[j].y) + (v[j].z * v[j].z + v[j].w * v[j].w); }
    const float rstd = 1.f / sqrtf(wave_sum(s) * (1.f / D) + RMS_EPS);
    unsigned long long* o8 = (unsigned long long*)orow + lane;
#pragma unroll
    for (int j = 0; j < 4; ++j) { const f32x4 gg = gr[64 * j]; o8[64 * j] = (unsigned long long)pk2(v[j].x * rstd * gg.x, v[j].y * rstd * gg.y) | ((unsigned long long)pk2(v[j].z * rstd * gg.z, v[j].w * rstd * gg.w) << 32); }
}

using pg8::Unit;
struct SchedMN {
    int nM, nN, nwg, G, c; const char* A; const char* Bt; size_t ta, tb;
    __device__ __forceinline__ void init(int M_, int N_, int G_, int c_, const void* A_, size_t lda, const void* Bt_, size_t ldb) { nM = M_ / 256; nN = N_ / 256; nwg = nM * nN; G = G_; c = c_; A = (const char*)A_; Bt = (const char*)Bt_; ta = 256 * lda * 2; tb = 256 * ldb * 2; }
    __device__ __forceinline__ bool next(int i, Unit& u) const {
        const long L = (long)i * G + c; if (L >= nwg) return false;
        int wgid = (int)L; { const int q = nwg / 8, r = nwg % 8, xcd = wgid % 8, off = wgid / 8; wgid = (xcd < r ? xcd * (q + 1) : r * (q + 1) + (xcd - r) * q) + off; }
        const int nig = 8 * nN, gid = wgid / nig, fm = gid * 8, gsz = (nM - fm) < 8 ? (nM - fm) : 8;
        u.pm = fm + ((wgid % nig) % gsz); u.pn = (wgid % nig) / gsz; return true;
    }
    __device__ __forceinline__ const char* pa(const Unit& u) const { return A + (size_t)u.pm * ta; }
    __device__ __forceinline__ const char* pb(const Unit& u) const { return Bt + (size_t)u.pn * tb; }
};
struct SchedP1 {
    int G, c; const char* A; const char* Bt;
    __device__ __forceinline__ bool next(int i, Unit& u) const {
        if (i >= 3) return false;
        const int x = c & 7, j = c >> 3;
        if (i < 2 || j < 24) { u.pm = 8 * x + (j & 7); u.pn = 4 * i + (j >> 3); }
        else { u.pm = 65 + x; u.pn = 11 + (j - 24); }
        return true;
    }
    __device__ __forceinline__ const char* pa(const Unit& u) const { return A + (size_t)u.pm * (256 * 1024 * 2); }
    __device__ __forceinline__ const char* pb(const Unit& u) const { return Bt + (size_t)u.pn * (256 * 1024 * 2); }
};
struct SchedOne {
    const char* A; const char* B;
    __device__ __forceinline__ bool next(int i, Unit& u) const { if (i) return false; u.pm = 0; u.pn = 0; return true; }
    __device__ __forceinline__ const char* pa(const Unit&) const { return A; }
    __device__ __forceinline__ const char* pb(const Unit&) const { return B; }
};

typedef GAS bf16 gbf16; typedef GAS float gf32;
__device__ __forceinline__ void st16(gbf16* p, f32x4 v0, f32x4 v1) { u32x4 w; w.x = pk2(v0[0], v0[1]); w.y = pk2(v0[2], v0[3]); w.z = pk2(v1[0], v1[1]); w.w = pk2(v1[2], v1[3]); *(GAS u32x4*)p = w; }
struct EpiP1 {
    static constexpr bool PERM = true, AFTER_DRAIN = false;
    bf16* ZA; bf16* PB; float* outK; float* outV; bf16* KB; bf16* VBm;
    __device__ __forceinline__ void operator()(f32x4 (&acc)[2][2][4][2], const Unit& u, int wr, int wc, int fr, int fq) const {
        if (u.pm < 64) {
            const int row0 = u.pm * 256 + wr * 64 + fr; const bool act = u.pn < 4;
            gbf16* base = act ? (gbf16*)ZA : (gbf16*)PB; const int ldc = act ? 1024 : DSH; const int col0 = (act ? u.pn : u.pn - 4) * 256 + wc * 32 + 8 * fq;
#pragma unroll
            for (int ai = 0; ai < 2; ++ai)
#pragma unroll
                for (int m = 0; m < 4; ++m) { gbf16* rowp = base + (size_t)(row0 + ai * 128 + m * 16) * ldc + col0;
#pragma unroll
                    for (int bj = 0; bj < 2; ++bj) { f32x4 v0 = acc[ai][bj][m][0], v1 = acc[ai][bj][m][1];
                        if (act) { f32x2 a = pg8::gelu_pk((f32x2){v0[0], v0[1]}), b = pg8::gelu_pk((f32x2){v0[2], v0[3]}), c = pg8::gelu_pk((f32x2){v1[0], v1[1]}), d = pg8::gelu_pk((f32x2){v1[2], v1[3]});
                            v0 = (f32x4){a.x, a.y, b.x, b.y}; v1 = (f32x4){c.x, c.y, d.x, d.y}; }
                        st16(rowp + bj * 128, v0, v1); } }
        } else {
            const int row0 = (u.pm - 65) * 256 + wr * 64 + fr; const int ct = u.pn - 11; const bool isK = ct < 4; const int col0 = (ct & 3) * 256 + wc * 32 + 8 * fq;
            gf32* o = isK ? (gf32*)outK : (gf32*)outV;
#pragma unroll
            for (int ai = 0; ai < 2; ++ai)
#pragma unroll
                for (int m = 0; m < 4; ++m) { const size_t off = (size_t)(row0 + ai * 128 + m * 16) * 1024 + col0;
#pragma unroll
                    for (int bj = 0; bj < 2; ++bj) { const f32x4 v0 = acc[ai][bj][m][0], v1 = acc[ai][bj][m][1];
                        *(GAS f32x4*)(o + off + bj * 128) = v0; *(GAS f32x4*)(o + off + bj * 128 + 4) = v1;
                        st16((gbf16*)(isK ? KB : VBm) + off + bj * 128, v0, v1); } }
        }
    }
};
__device__ __forceinline__ void ld8(const float* p, f32x4& a, f32x4& b) { a = *(const GAS f32x4*)((const gf32*)p); b = *(const GAS f32x4*)((const gf32*)p + 4); }
__device__ __forceinline__ void ld8(const bf16* p, f32x4& a, f32x4& b) { const u32x4 w = *(const GAS u32x4*)((const gbf16*)p); a = (f32x4){bf_lo(w.x), bf_hi(w.x), bf_lo(w.y), bf_hi(w.y)}; b = (f32x4){bf_lo(w.z), bf_hi(w.z), bf_lo(w.w), bf_hi(w.w)}; }
template <class BT> struct EpiRes {
    static constexpr bool PERM = true, AFTER_DRAIN = false;
    const BT* base; bf16* outb; float* rowss;
    __device__ __forceinline__ void operator()(f32x4 (&acc)[2][2][4][2], const Unit& u, int wr, int wc, int fr, int fq) const {
        const int row0 = u.pm * 256 + wr * 64 + fr, col0 = u.pn * 256 + wc * 32 + 8 * fq;
#pragma unroll
        for (int ai = 0; ai < 2; ++ai)
#pragma unroll
            for (int m = 0; m < 4; ++m) { const int r = row0 + ai * 128 + m * 16; const size_t off = (size_t)r * 1024 + col0; float ss = 0.f;
#pragma unroll
                for (int bj = 0; bj < 2; ++bj) { f32x4 b0, b1; ld8(base + off + bj * 128, b0, b1);
                    const f32x4 v0 = acc[ai][bj][m][0] + b0, v1 = acc[ai][bj][m][1] + b1;
                    st16((gbf16*)outb + off + bj * 128, v0, v1);
                    ss += (v0[0] * v0[0] + v0[1] * v0[1]) + (v0[2] * v0[2] + v0[3] * v0[3]) + (v1[0] * v1[0] + v1[1] * v1[1]) + (v1[2] * v1[2] + v1[3] * v1[3]); }
                ss += __shfl_xor(ss, 16); ss += __shfl_xor(ss, 32);
                if (fq == 0) (void)__hip_atomic_fetch_add(rowss + r, ss, __ATOMIC_RELAXED, __HIP_MEMORY_SCOPE_AGENT); }
    }
};
struct EpiResXN {
    static constexpr bool PERM = true, AFTER_DRAIN = false;
    const bf16* xn; bf16* outb; float* rowss; float inv_[2][4];
    __device__ __forceinline__ void operator()(f32x4 (&acc)[2][2][4][2], const Unit& u, int wr, int wc, int fr, int fq) const {
        const int row0 = u.pm * 256 + wr * 64 + fr, col0 = u.pn * 256 + wc * 32 + 8 * fq;
#pragma unroll
        for (int ai = 0; ai < 2; ++ai)
#pragma unroll
            for (int m = 0; m < 4; ++m) { const int r = row0 + ai * 128 + m * 16; const size_t off = (size_t)r * 1024 + col0; const float iv = inv_[ai][m]; float ss = 0.f;
#pragma unroll
                for (int bj = 0; bj < 2; ++bj) { f32x4 b0, b1; ld8(xn + off + bj * 128, b0, b1);
                    const f32x4 v0 = acc[ai][bj][m][0] + b0 * iv, v1 = acc[ai][bj][m][1] + b1 * iv;
                    st16((gbf16*)outb + off + bj * 128, v0, v1);
                    ss += (v0[0] * v0[0] + v0[1] * v0[1]) + (v0[2] * v0[2] + v0[3] * v0[3]) + (v1[0] * v1[0] + v1[1] * v1[1]) + (v1[2] * v1[2] + v1[3] * v1[3]); }
                ss += __shfl_xor(ss, 16); ss += __shfl_xor(ss, 32);
                if (fq == 0) (void)__hip_atomic_fetch_add(rowss + r, ss, __ATOMIC_RELAXED, __HIP_MEMORY_SCOPE_AGENT); }
    }
};
struct EpiFinal {
    static constexpr bool PERM = true, AFTER_DRAIN = false;
    const bf16* base; float* out; const float* gain; float* rowss; unsigned* cnt; unsigned* tmo;
    __device__ __forceinline__ void operator()(f32x4 (&acc)[2][2][4][2], const Unit& u, int wr, int wc, int fr, int fq) const {
        const int row0 = u.pm * 256 + wr * 64 + fr, col0 = u.pn * 256 + wc * 32 + 8 * fq;
#pragma unroll
        for (int ai = 0; ai < 2; ++ai)
#pragma unroll
            for (int m = 0; m < 4; ++m) { const int r = row0 + ai * 128 + m * 16; const size_t off = (size_t)r * 1024 + col0; float ss = 0.f;
#pragma unroll
                for (int bj = 0; bj < 2; ++bj) { f32x4 b0, b1; ld8(base + off + bj * 128, b0, b1);
                    const f32x4 v0 = acc[ai][bj][m][0] + b0, v1 = acc[ai][bj][m][1] + b1; acc[ai][bj][m][0] = v0; acc[ai][bj][m][1] = v1;
                    ss += (v0[0] * v0[0] + v0[1] * v0[1]) + (v0[2] * v0[2] + v0[3] * v0[3]) + (v1[0] * v1[0] + v1[1] * v1[1]) + (v1[2] * v1[2] + v1[3] * v1[3]); }
                ss += __shfl_xor(ss, 16); ss += __shfl_xor(ss, 32);
                if (fq == 0) (void)__hip_atomic_fetch_add(rowss + r, ss, __ATOMIC_RELAXED, __HIP_MEMORY_SCOPE_AGENT); }
        asm volatile("s_waitcnt vmcnt(0)" ::: "memory");
        unsigned* c = cnt + 64 * u.pm;
        if ((threadIdx.x & 63) == 0) (void)xb_add(c, 1u);
        { unsigned sp = 0; while (xb_ld(c) < 32u) { __builtin_amdgcn_s_sleep(1); if ((++sp & 255u) == 0u) { if (xb_ld(tmo)) break; if (sp > (1u << 20)) { atomicAdd(tmo, 1u); break; } } } }
        f32x4 g[2][2];
#pragma unroll
        for (int bj = 0; bj < 2; ++bj) { g[bj][0] = *(const GAS f32x4*)((const gf32*)gain + col0 + bj * 128); g[bj][1] = *(const GAS f32x4*)((const gf32*)gain + col0 + bj * 128 + 4); }
#pragma unroll
        for (int ai = 0; ai < 2; ++ai)
#pragma unroll
            for (int m = 0; m < 4; ++m) { const int r = row0 + ai * 128 + m * 16; const size_t off = (size_t)r * 1024 + col0;
                const float sc = 1.f / sqrtf(__hip_atomic_load(rowss + r, __ATOMIC_RELAXED, __HIP_MEMORY_SCOPE_AGENT) * (1.f / D) + RMS_EPS);
#pragma unroll
                for (int bj = 0; bj < 2; ++bj) { __builtin_nontemporal_store(acc[ai][bj][m][0] * sc * g[bj][0], (GAS f32x4*)((gf32*)out + off + bj * 128)); __builtin_nontemporal_store(acc[ai][bj][m][1] * sc * g[bj][1], (GAS f32x4*)((gf32*)out + off + bj * 128 + 4)); } }
    }
};
template <int MODE> struct EpiScale {
    static constexpr bool PERM = true, AFTER_DRAIN = false;
    bf16* O; int ldc; const float* rowss;
    __device__ __forceinline__ void operator()(f32x4 (&acc)[2][2][4][2], const Unit& u, int wr, int wc, int fr, int fq) const {
        const int row0 = u.pm * 256 + wr * 64 + fr, col0 = u.pn * 256 + wc * 32 + 8 * fq;
#pragma unroll
        for (int ai = 0; ai < 2; ++ai)
#pragma unroll
            for (int m = 0; m < 4; ++m) { const int r = row0 + ai * 128 + m * 16;
                float sc = 1.f / sqrtf(__hip_atomic_load(rowss + r, __ATOMIC_RELAXED, __HIP_MEMORY_SCOPE_AGENT) * (1.f / D) + RMS_EPS); if (MODE == 0) sc *= 0.0625f;
                gbf16* rowp = (gbf16*)O + (size_t)r * ldc + col0;
#pragma unroll
                for (int bj = 0; bj < 2; ++bj) { f32x4 v0 = acc[ai][bj][m][0] * sc, v1 = acc[ai][bj][m][1] * sc;
                    if (MODE == 1) {
#pragma unroll
                        for (int j = 0; j < 4; ++j) { const float a = fmaxf(v0[j], 0.f), b = fmaxf(v1[j], 0.f); v0[j] = a * a; v1[j] = b * b; } }
                    st16(rowp + bj * 128, v0, v1); } }
    }
};
struct EpiUpP {
    static constexpr bool PERM = true, AFTER_DRAIN = false;
    bf16* O; const LAS float* scl;
    __device__ __forceinline__ void operator()(f32x4 (&acc)[2][2][4][2], const Unit& u, int wr, int wc, int fr, int fq) const {
        const int row0 = u.pm * 256 + wr * 64 + fr, col0 = u.pn * 256 + wc * 32 + 8 * fq;
#pragma unroll
        for (int ai = 0; ai < 2; ++ai)
#pragma unroll
            for (int m = 0; m < 4; ++m) { const int r = row0 + ai * 128 + m * 16; const float s_ = scl[ai * 128 + wr * 64 + m * 16 + fr];
                gbf16* rowp = (gbf16*)O + (size_t)r * FF + col0;
#pragma unroll
                for (int bj = 0; bj < 2; ++bj) { f32x4 v0 = acc[ai][bj][m][0] * s_, v1 = acc[ai][bj][m][1] * s_;
#pragma unroll
                    for (int j = 0; j < 4; ++j) { const float a = fmaxf(v0[j], 0.f), b = fmaxf(v1[j], 0.f); v0[j] = a * a; v1[j] = b * b; }
                    st16(rowp + bj * 128, v0, v1); } }
    }
};
struct EpiQS {
    static constexpr bool PERM = true, AFTER_DRAIN = false;
    bf16* QS; const float* rowss;
    __device__ __forceinline__ void operator()(f32x4 (&acc)[2][2][4][2], const Unit& u, int wr, int wc, int fr, int fq) const {
#pragma unroll
        for (int ai = 0; ai < 2; ++ai)
#pragma unroll
            for (int m = 0; m < 4; ++m) { const int rl = ai * 128 + wr * 64 + m * 16 + fr;
                const float sc = 0.0625f / sqrtf(__hip_atomic_load(rowss + u.pm * 256 + rl, __ATOMIC_RELAXED, __HIP_MEMORY_SCOPE_AGENT) * (1.f / D) + RMS_EPS);
                gbf16* rowp = (gbf16*)QS + (size_t)rl * 256 + wc * 32 + 8 * fq;
#pragma unroll
                for (int bj = 0; bj < 2; ++bj) st16(rowp + bj * 128, acc[ai][bj][m][0] * sc, acc[ai][bj][m][1] * sc); }
    }
};
struct EpiSoftmax {
    static constexpr bool PERM = true, AFTER_DRAIN = true;
    bf16* P; int ldp; float rsq_[2][4];
    __device__ __forceinline__ void fused(f32x4 (&acc)[2][2][4][2], const Unit&, int wr, int wc, int fr, int fq, PG8_LAS unsigned char* lds, int, int) const {
        PG8_LAS float* T1 = (PG8_LAS float*)lds; PG8_LAS float* T2 = (PG8_LAS float*)(lds + 4096);
        float sck[2][4];
#pragma unroll
        for (int ai = 0; ai < 2; ++ai)
#pragma unroll
            for (int m = 0; m < 4; ++m) sck[ai][m] = 1.44269504089f * 0.0625f * __builtin_amdgcn_rsqf(rsq_[ai][m] * (1.f / D) + RMS_EPS);
#pragma unroll
        for (int ai = 0; ai < 2; ++ai)
#pragma unroll
            for (int m = 0; m < 4; ++m) { float mx = -3.0e38f;
#pragma unroll
                for (int bj = 0; bj < 2; ++bj)
#pragma unroll
                    for (int n = 0; n < 2; ++n) { const f32x4 x = acc[ai][bj][m][n]; mx = fmaxf(mx, fmaxf(fmaxf(x[0], x[1]), fmaxf(x[2], x[3]))); }
                mx = fmaxf(mx, __shfl_xor(mx, 16)); mx = fmaxf(mx, __shfl_xor(mx, 32));
                if (fq == 0) T1[(ai * 128 + wr * 64 + m * 16 + fr) * 4 + wc] = mx; }
        asm volatile("s_waitcnt lgkmcnt(0)" ::: "memory"); __builtin_amdgcn_s_barrier(); asm volatile("" ::: "memory");
#pragma unroll
        for (int ai = 0; ai < 2; ++ai)
#pragma unroll
            for (int m = 0; m < 4; ++m) { const int row = ai * 128 + wr * 64 + m * 16 + fr; const f32x4 t = *(const PG8_LAS f32x4*)(T1 + row * 4);
                const float kk_ = sck[ai][m]; const float mxr = fmaxf(fmaxf(t[0], t[1]), fmaxf(t[2], t[3])) * kk_; float sum = 0.f;
#pragma unroll
                for (int bj = 0; bj < 2; ++bj)
#pragma unroll
                    for (int n = 0; n < 2; ++n) { f32x4 x = acc[ai][bj][m][n];
#pragma unroll
                        for (int j = 0; j < 4; ++j) { x[j] = __builtin_amdgcn_exp2f(x[j] * kk_ - mxr); sum += x[j]; }
                        acc[ai][bj][m][n] = x; }
                sum += __shfl_xor(sum, 16); sum += __shfl_xor(sum, 32);
                if (fq == 0) T2[row * 4 + wc] = sum; }
        asm volatile("s_waitcnt lgkmcnt(0)" ::: "memory"); __builtin_amdgcn_s_barrier(); asm volatile("" ::: "memory");
#pragma unroll
        for (int ai = 0; ai < 2; ++ai)
#pragma unroll
            for (int m = 0; m < 4; ++m) { const int row = ai * 128 + wr * 64 + m * 16 + fr; const f32x4 t = *(const PG8_LAS f32x4*)(T2 + row * 4);
                const float inv = 1.f / ((t[0] + t[1]) + (t[2] + t[3]));
                gbf16* rowp = (gbf16*)P + (size_t)row * ldp + wc * 32 + 8 * fq;
#pragma unroll
                for (int bj = 0; bj < 2; ++bj) st16(rowp + bj * 128, acc[ai][bj][m][0] * inv, acc[ai][bj][m][1] * inv); }
        asm volatile("s_waitcnt vmcnt(0) lgkmcnt(0)" ::: "memory"); __builtin_amdgcn_s_barrier(); asm volatile("" ::: "memory");
    }
};
struct EpiAttnO {
    static constexpr bool PERM = true, AFTER_DRAIN = false;
    bf16* O;
    __device__ __forceinline__ void operator()(f32x4 (&acc)[2][2][4][2], const Unit&, int wr, int wc, int fr, int fq) const {
#pragma unroll
        for (int ai = 0; ai < 2; ++ai)
#pragma unroll
            for (int m = 0; m < 4; ++m) { gbf16* rowp = (gbf16*)O + (size_t)(ai * 128 + wr * 64 + m * 16 + fr) * 1024 + wc * 32 + 8 * fq;
#pragma unroll
                for (int bj = 0; bj < 2; ++bj) st16(rowp + bj * 128, acc[ai][bj][m][0], acc[ai][bj][m][1]); }
    }
};

__device__ __forceinline__ void mixer_a_tile(LAS unsigned char* lds, int tile, const bf16* ZA, const bf16* WSB, const float* gm_ln_g, const float* gm_ln_b, const float* gm_bs, bf16* MIX, float* out_cv, int tid, int wave, int lane) {
    const int h = tile & 3, bc = tile >> 2, m0 = bc * 128, fr = lane & 15, fq = lane >> 4; const bool lastc = (bc & 15) == 15;
    LAS bf16* VT = (LAS bf16*)lds;
    {   const int r = 16 * wave + (lane >> 2), cq = (lane & 3) * 32; const bf16* src = ZA + (size_t)(m0 + r) * 1024 + 512 + h * 128 + cq;
        float x[32]; float s = 0.f;
#pragma unroll
        for (int j = 0; j < 4; ++j) { const u32x4 pv = __builtin_nontemporal_load((const u32x4*)(src + 8 * j));
            x[8 * j + 0] = bf_lo(pv.x); x[8 * j + 1] = bf_hi(pv.x); x[8 * j + 2] = bf_lo(pv.y); x[8 * j + 3] = bf_hi(pv.y); x[8 * j + 4] = bf_lo(pv.z); x[8 * j + 5] = bf_hi(pv.z); x[8 * j + 6] = bf_lo(pv.w); x[8 * j + 7] = bf_hi(pv.w); }
#pragma unroll
        for (int j = 0; j < 32; ++j) s += x[j];
        const float mean = red4(s) * (1.f / 128.f); float q = 0.f;
#pragma unroll
        for (int j = 0; j < 32; ++j) { x[j] -= mean; q += x[j] * x[j]; }
        const float rstd = 1.f / sqrtf(red4(q) * (1.f / 128.f) + LN_EPS);
#pragma unroll
        for (int j = 0; j < 8; ++j) { const f32x4 g = *(const f32x4*)(gm_ln_g + h * 128 + cq + 4 * j), bb = *(const f32x4*)(gm_ln_b + h * 128 + cq + 4 * j);
#pragma unroll
            for (int e = 0; e < 4; ++e) x[4 * j + e] = x[4 * j + e] * rstd * g[e] + bb[e]; }
        if (lastc) { float* o = out_cv + ((size_t)((bc >> 4) * 128 + r) * 4 + h) * 128 + cq;
#pragma unroll
            for (int j = 0; j < 8; ++j) *(f32x4*)(o + 4 * j) = (f32x4){x[4 * j], x[4 * j + 1], x[4 * j + 2], x[4 * j + 3]}; }
#pragma unroll
        for (int j = 0; j < 32; j += 2) { const unsigned w = pk2(x[j], x[j + 1]); VT[(cq + j) * 136 + r] = (bf16)(w & 0xffffu); VT[(cq + j + 1) * 136 + r] = (bf16)(w >> 16); }
    }
    const int t_ = 16 * wave + fr; const size_t rowo = (size_t)(m0 + t_) * 1024 + h * 128; const float bsv = gm_bs[h * 128 + t_];
    u32x2 uq[8];
#pragma unroll
    for (int n = 0; n < 8; ++n) uq[n] = *(const u32x2*)(ZA + rowo + 16 * n + 4 * fq);
    bf16x8 wsf[4];
#pragma unroll
    for (int ks = 0; ks < 4; ++ks) wsf[ks] = *(const bf16x8*)(WSB + (size_t)(h * 128 + 16 * wave + fr) * 128 + 32 * ks + 8 * fq);
    __syncthreads();
    f32x4 acc[8];
#pragma unroll
    for (int n = 0; n < 8; ++n) acc[n] = (f32x4){0.f, 0.f, 0.f, 0.f};
    const int nks = (wave >> 1) + 1;
#pragma unroll
    for (int ks = 0; ks < 4; ++ks) if (ks < nks) {
#pragma unroll
        for (int n = 0; n < 8; ++n) { const bf16x8 vf = *(const LAS bf16x8*)(VT + (16 * n + fr) * 136 + 32 * ks + 8 * fq); acc[n] = __builtin_amdgcn_mfma_f32_16x16x32_bf16(vf, wsf[ks], acc[n], 0, 0, 0); }
    }
#pragma unroll
    for (int n = 0; n < 8; ++n) *(u32x2*)(MIX + rowo + 16 * n + 4 * fq) = pk4(bf4(uq[n]) * (acc[n] + bsv));
    __syncthreads();
}


typedef short bf16x4 __attribute__((ext_vector_type(4)));
#define MFMA32(a, b, c) __builtin_amdgcn_mfma_f32_16x16x32_bf16(a, b, c, 0, 0, 0)
#define MFMA16(a, b, c) __builtin_amdgcn_mfma_f32_16x16x16bf16_1k(a, b, c, 0, 0, 0)
constexpr int CP = 72;
constexpr int L_LW = 0, L_LA = 17408, L_LG = 34816;
constexpr int L_LAB = 0, L_LAK = 9216, L_MRB = 18432, L_MRK = 27648, L_TDD = 36864;
constexpr int L_AT = 52224, L_BT = 61440, L_KT = 70656, L_RT = 79872;
constexpr int L_WT = 52224, L_APT = 61440;
constexpr int L_ATT = 89088, L_VTT = 98304, L_BHT = 107520, L_KHT = 116736;
constexpr int L_EXCH = 125952, L_PC = 128000;
constexpr size_t TASK_BYTES = 32768;

__device__ __forceinline__ float wave_sum_dpp(float x) {
    x = red16(x); const int xi = __builtin_bit_cast(int, x);
    const float a = __builtin_bit_cast(float, __builtin_amdgcn_readlane(xi, 0)), b = __builtin_bit_cast(float, __builtin_amdgcn_readlane(xi, 16)), c = __builtin_bit_cast(float, __builtin_amdgcn_readlane(xi, 32)), d = __builtin_bit_cast(float, __builtin_amdgcn_readlane(xi, 48));
    return (a + b) + (c + d);
}
__device__ __forceinline__ bf16x4 pack4(f32x4 v) { const u32x2 r = pk4(v); return __builtin_bit_cast(bf16x4, r); }
__device__ __forceinline__ bf16x8 ldsfrag(const LAS unsigned char* lds, int off, int row, int col) { return *(const LAS bf16x8*)(lds + off + (row * CP + col) * 2); }

#ifdef PROBE_CSPAN_A
#define CST(k) do { if (h == CST_H && blockIdx.x == 64 && threadIdx.x == 0) *(volatile LAS unsigned long long*)(lds + LDSCTL_OFF + 288 + 8 * (k)) = __builtin_amdgcn_s_memrealtime(); } while (0)
#else
#define CST(k) do { } while (0)
#endif
#define LDS_BARRIER() do { asm volatile("s_waitcnt lgkmcnt(0)" ::: "memory"); __builtin_amdgcn_s_barrier(); asm volatile("" ::: "memory"); } while (0)
__device__ __forceinline__ void rwkv_chunk_prep(LAS unsigned char* lds, int bc, const bf16* PB, const bf16* ZROW, const float* mu, const bf16* W2T, const bf16* A2T, const bf16* G2T,
                                                const float* w0, const float* a0, const float* k_k, const float* k_a, const float* r_k, bf16* LAIN, unsigned char* TASKS, bf16* G, bf16* VS, float* BON,
                                                int tid, int wave, int lane) {
    const int b = bc >> 5, c = bc & 31, m0 = b * SEQ + c * 64, fr = lane & 15, fq = lane >> 4;
    u32x4 lwq[4];
#define LWT_ADDR(o_) (lds + ((o_) < LWT_SPLIT ? L_LWT + (o_) : L_LWT2 + ((o_) - LWT_SPLIT)))
#define LWT_LOAD(hh) do { _Pragma("unroll") for (int j_ = 0; j_ < 4; ++j_) { const int o_ = (tid + 512 * j_) * 16; \
        const bf16* src_ = o_ < 8192 ? (W2T + (size_t)(64 * (hh)) * 64 + o_ / 2) : (o_ < 16384 ? (A2T + (size_t)(64 * (hh)) * 64 + (o_ - 8192) / 2) : (G2T + (size_t)(64 * (hh)) * 128 + (o_ - 16384) / 2)); \
        lwq[j_] = *(const u32x4*)src_; } } while (0)
#define LWT_STORE() do { _Pragma("unroll") for (int j_ = 0; j_ < 4; ++j_) { const int o_ = (tid + 512 * j_) * 16; *(LAS u32x4*)LWT_ADDR(o_) = lwq[j_]; } } while (0)
    LWT_LOAD(0);
    {   const int r = tid >> 3, cg = (tid & 7) * 32, m = m0 + r;
        const bf16* prow = PB + (size_t)m * DSH + 1536 + cg; const bf16* qrow = ((m & (SEQ - 1)) == 0) ? ZROW : (PB + (size_t)(m - 1) * DSH + 1536 + cg);
        const int mode = cg < 64 ? 0 : (cg < 128 ? 1 : 2);
        u32x4 pvq[4], qvq[4]; f32x4 m0q[4], m1q[4];
#pragma unroll
        for (int j = 0; j < 4; ++j) { pvq[j] = *(const GAS u32x4*)((const gbf16*)prow + 8 * j); qvq[j] = *(const GAS u32x4*)((const gbf16*)qrow + 8 * j);
            m0q[j] = *(const GAS f32x4*)((const gf32*)mu + 1536 + cg + 8 * j); m1q[j] = *(const GAS f32x4*)((const gf32*)mu + 1536 + cg + 8 * j + 4); }
        __builtin_amdgcn_sched_barrier(0);
#pragma unroll
        for (int j = 0; j < 4; ++j) {
            const u32x4 pv = pvq[j], qv = qvq[j];
            const f32x4 m0v = m0q[j], m1v = m1q[j];
            float x[8];
            { const float p0 = bf_lo(pv.x), p1 = bf_hi(pv.x), p2 = bf_lo(pv.y), p3 = bf_hi(pv.y), p4 = bf_lo(pv.z), p5 = bf_hi(pv.z), p6 = bf_lo(pv.w), p7 = bf_hi(pv.w);
              const float q0 = bf_lo(qv.x), q1 = bf_hi(qv.x), q2 = bf_lo(qv.y), q3 = bf_hi(qv.y), q4 = bf_lo(qv.z), q5 = bf_hi(qv.z), q6 = bf_lo(qv.w), q7 = bf_hi(qv.w);
              x[0] = p0 + (q0 - p0) * m0v[0]; x[1] = p1 + (q1 - p1) * m0v[1]; x[2] = p2 + (q2 - p2) * m0v[2]; x[3] = p3 + (q3 - p3) * m0v[3];
              x[4] = p4 + (q4 - p4) * m1v[0]; x[5] = p5 + (q5 - p5) * m1v[1]; x[6] = p6 + (q6 - p6) * m1v[2]; x[7] = p7 + (q7 - p7) * m1v[3]; }
#pragma unroll
            for (int e = 0; e < 8; ++e) x[e] = mode == 0 ? fast_tanh(x[e]) : (mode == 1 ? x[e] : fast_sigmoid(x[e]));
            u32x4 o; o.x = pk2(x[0], x[1]); o.y = pk2(x[2], x[3]); o.z = pk2(x[4], x[5]); o.w = pk2(x[6], x[7]);
            *(LAS u32x4*)(lds + (r * 256 + cg + 8 * j) * 2) = o;
        }
    }
    LDS_BARRIER();
    bf16x8 lainW[2], lainA[2], lainG[4];
    {   const LAS bf16* arow = (const LAS bf16*)lds + (16 * (wave >> 1) + fr) * 256 + 8 * fq;
#pragma unroll
        for (int ks = 0; ks < 2; ++ks) { lainW[ks] = *(const LAS bf16x8*)(arow + 32 * ks); lainA[ks] = *(const LAS bf16x8*)(arow + 64 + 32 * ks); }
#pragma unroll
        for (int ks = 0; ks < 4; ++ks) lainG[ks] = *(const LAS bf16x8*)(arow + 128 + 32 * ks); }
    LWT_STORE();
    __syncthreads();
#pragma unroll 1
    for (int h = 0; h < 8; ++h) {
        CST(0);
        bf16 gpv[8][3], gqv[8][3];
        {   const int ch_ = 64 * h + lane;
#pragma unroll
            for (int i = 0; i < 8; ++i) { const int m = m0 + 8 * wave + i; const gbf16* prow = (const gbf16*)PB + (size_t)m * DSH + ch_; const bool first = (m & (SEQ - 1)) == 0; const gbf16* qrow = first ? (const gbf16*)ZROW : (prow - DSH);
                gpv[i][0] = prow[0]; gpv[i][1] = prow[512]; gpv[i][2] = prow[1024]; gqv[i][0] = qrow[0]; gqv[i][1] = first ? qrow[0] : qrow[512]; gqv[i][2] = first ? qrow[0] : qrow[1024]; }
        }
        __builtin_amdgcn_sched_barrier(0);
        {   const int mt = wave >> 1;
            bf16x8 wW[2][2], wA[2][2], wG[2][4];
#pragma unroll
            for (int q = 0; q < 2; ++q) { const int wl_ = 16 * ((wave & 1) * 2 + q) + fr;
#pragma unroll
                for (int ks = 0; ks < 2; ++ks) { wW[q][ks] = *(const LAS bf16x8*)LWT_ADDR(wl_ * 128 + (32 * ks + 8 * fq) * 2); wA[q][ks] = *(const LAS bf16x8*)LWT_ADDR(8192 + wl_ * 128 + (32 * ks + 8 * fq) * 2); }
#pragma unroll
                for (int ks = 0; ks < 4; ++ks) wG[q][ks] = *(const LAS bf16x8*)LWT_ADDR(16384 + wl_ * 256 + (32 * ks + 8 * fq) * 2); }
#pragma unroll
            for (int q = 0; q < 2; ++q) { const int nt = (wave & 1) * 2 + q;
                f32x4 aw = (f32x4){0.f, 0.f, 0.f, 0.f}, aa = aw, ag = aw;
#pragma unroll
                for (int ks = 0; ks < 2; ++ks) { aw = MFMA32(wW[q][ks], lainW[ks], aw); aa = MFMA32(wA[q][ks], lainA[ks], aa); }
#pragma unroll
                for (int ks = 0; ks < 4; ++ks) ag = MFMA32(wG[q][ks], lainG[ks], ag);
                const int o = ((16 * mt + fr) * 68 + 16 * nt + 4 * fq) * 4;
                *(LAS f32x4*)(lds + L_LW + o) = aw; *(LAS f32x4*)(lds + L_LA + o) = aa; *(LAS f32x4*)(lds + L_LG + o) = ag; }
        }
        LDS_BARRIER();
        CST(1);
        {   const int ch = 64 * h + lane;
            const float mur = mu[ch], muk = mu[512 + ch], muv = mu[1024 + ch], w0c = w0[ch], a0c = a0[ch], kkc = k_k[ch], kac = k_a[ch], rkc = r_k[ch];
            float rs[8], kp[8], vs[8], av[8], bv[8], wd[8], cwl[8]; float run = 0.f;
#pragma unroll
            for (int i = 0; i < 8; ++i) { const int p = 8 * wave + i, m = m0 + p;
                const float pr = bf1(gpv[i][0]), pk = bf1(gpv[i][1]), pvv = bf1(gpv[i][2]); const float qr = bf1(gqv[i][0]), qk = bf1(gqv[i][1]), qv = bf1(gqv[i][2]);
                rs[i] = pr + (qr - pr) * mur; const float ks = pk + (qk - pk) * muk; vs[i] = pvv + (qv - pvv) * muv;
                const float lw = *(const LAS float*)(lds + L_LW + (p * 68 + lane) * 4), la = *(const LAS float*)(lds + L_LA + (p * 68 + lane) * 4), lg = *(const LAS float*)(lds + L_LG + (p * 68 + lane) * 4);
                wd[i] = -0.60653066f * fast_sigmoid(w0c + lw);
                const float as = fast_sigmoid(a0c + la);
                const float kkr = ks * kkc; const float n2 = wave_sum_dpp(kkr * kkr); const float kk = kkr * __builtin_amdgcn_rsqf(fmaxf(n2, 1e-24f));
                kp[i] = ks * (1.f + (as - 1.f) * kac); av[i] = -kk; bv[i] = kk * as;
                const float bon = wave_sum_dpp(rs[i] * kp[i] * rkc);
                run += wd[i]; cwl[i] = run;
                ((gbf16*)G)[(size_t)m * DB + ch] = (bf16)(pk2(lg, 0.f) & 0xffffu); ((gbf16*)VS)[(size_t)m * DB + ch] = (bf16)(pk2(vs[i], 0.f) & 0xffffu);
                if (lane == 0) ((gf32*)BON)[(size_t)m * 8 + h] = bon; }
            *(LAS float*)(lds + L_EXCH + (wave * 64 + lane) * 4) = run;
            LDS_BARRIER();
            CST(2);
            float base = 0.f, tot = 0.f;
#pragma unroll
            for (int w2 = 0; w2 < 8; ++w2) { const float t = *(const LAS float*)(lds + L_EXCH + (w2 * 64 + lane) * 4); tot += t; if (w2 < wave) base += t; }
            float oA[8], oV[8], oBh[8], oKh[8]; const float ptot = fast_exp(tot);
#pragma unroll
            for (int i = 0; i < 8; ++i) { const int p = 8 * wave + i; const float cw = base + cwl[i];
                const float e1 = fast_exp(cw - wd[i]), e2 = fast_exp(cw), e3 = __builtin_amdgcn_rcpf(e2), e4 = ptot * e3;
                const float At = av[i] * e1, Rt = rs[i] * e2, Bt = bv[i] * e3, Kt = kp[i] * e3;
                oA[i] = At; oV[i] = vs[i]; oBh[i] = bv[i] * e4; oKh[i] = kp[i] * e4;
                *(LAS bf16*)(lds + L_AT + (p * CP + lane) * 2) = (bf16)(pk2(At, 0.f) & 0xffffu); *(LAS bf16*)(lds + L_BT + (p * CP + lane) * 2) = (bf16)(pk2(Bt, 0.f) & 0xffffu);
                *(LAS bf16*)(lds + L_KT + (p * CP + lane) * 2) = (bf16)(pk2(Kt, 0.f) & 0xffffu); *(LAS bf16*)(lds + L_RT + (p * CP + lane) * 2) = (bf16)(pk2(Rt, 0.f) & 0xffffu); }
            { u32x4 o; const int off = (lane * CP + 8 * wave) * 2;
              o.x = pk2(oA[0], oA[1]); o.y = pk2(oA[2], oA[3]); o.z = pk2(oA[4], oA[5]); o.w = pk2(oA[6], oA[7]); *(LAS u32x4*)(lds + L_ATT + off) = o;
              o.x = pk2(oV[0], oV[1]); o.y = pk2(oV[2], oV[3]); o.z = pk2(oV[4], oV[5]); o.w = pk2(oV[6], oV[7]); *(LAS u32x4*)(lds + L_VTT + off) = o;
              o.x = pk2(oBh[0], oBh[1]); o.y = pk2(oBh[2], oBh[3]); o.z = pk2(oBh[4], oBh[5]); o.w = pk2(oBh[6], oBh[7]); *(LAS u32x4*)(lds + L_BHT + off) = o;
              o.x = pk2(oKh[0], oKh[1]); o.y = pk2(oKh[2], oKh[3]); o.z = pk2(oKh[4], oKh[5]); o.w = pk2(oKh[6], oKh[7]); *(LAS u32x4*)(lds + L_KHT + off) = o; }
            if (wave == 0) *(LAS float*)(lds + L_PC + lane * 4) = ptot;
        }
        LDS_BARRIER();
        CST(3);
        LWT_LOAD(h < 7 ? h + 1 : 7);
        {   const int ty = wave >> 1;
#pragma unroll
            for (int prod = 0; prod < 4; ++prod) { const int xo = (prod & 1) ? L_KT : L_BT, yo = prod < 2 ? L_AT : L_RT, oo = prod == 0 ? L_LAB : (prod == 1 ? L_LAK : (prod == 2 ? L_MRB : L_MRK)); const bool incl = prod >= 2;
#pragma unroll
                for (int q = 0; q < 2; ++q) { const int tx = (wave & 1) * 2 + q; f32x4 acc = (f32x4){0.f, 0.f, 0.f, 0.f};
                    if (tx <= ty) {
#pragma unroll
                        for (int ks = 0; ks < 2; ++ks) acc = MFMA32(ldsfrag(lds, xo, 16 * tx + fr, 32 * ks + 8 * fq), ldsfrag(lds, yo, 16 * ty + fr, 32 * ks + 8 * fq), acc); }
                    const int i = 16 * ty + fr, j0 = 16 * tx + 4 * fq;
#pragma unroll
                    for (int e = 0; e < 4; ++e) { const int j = j0 + e; if (!(incl ? (j <= i) : (j < i))) acc[e] = 0.f; }
                    *(LAS u32x2*)(lds + oo + (i * CP + j0) * 2) = pk4(acc); } }
        }
        LDS_BARRIER();
        CST(4);
        if (wave < 4) { const int d = wave; float t[16];
#pragma unroll
            for (int i = 0; i < 16; ++i) { const u32x4 r0 = *(const LAS u32x4*)(lds + L_LAB + ((16 * d + i) * CP + 16 * d) * 2), r1 = *(const LAS u32x4*)(lds + L_LAB + ((16 * d + i) * CP + 16 * d + 8) * 2);
                const float l[16] = {bf_lo(r0.x), bf_hi(r0.x), bf_lo(r0.y), bf_hi(r0.y), bf_lo(r0.z), bf_hi(r0.z), bf_lo(r0.w), bf_hi(r0.w), bf_lo(r1.x), bf_hi(r1.x), bf_lo(r1.y), bf_hi(r1.y), bf_lo(r1.z), bf_hi(r1.z), bf_lo(r1.w), bf_hi(r1.w)};
                float s = (i == lane) ? 1.f : 0.f;
#pragma unroll
                for (int mm = 0; mm < i; ++mm) s += l[mm] * t[mm];
                t[i] = s; }
            if (lane < 16) {
#pragma unroll
                for (int i = 0; i < 16; ++i) *(LAS bf16*)(lds + L_TDD + ((d * 16 + i) * 24 + lane) * 2) = (bf16)(pk2(t[i], 0.f) & 0xffffu); }
        }
        LDS_BARRIER();
        CST(5);
        {   const int s = wave & 3; const bool isW = wave < 4; f32x4 acc[4];
            if (isW) {
#pragma unroll
                for (int d = 0; d < 4; ++d) { acc[d] = (f32x4){0.f, 0.f, 0.f, 0.f};
#pragma unroll
                    for (int ks = 0; ks < 2; ++ks) if (32 * ks <= 16 * d + 15) acc[d] = MFMA32(ldsfrag(lds, L_LAK, 16 * d + fr, 32 * ks + 8 * fq), ldsfrag(lds, L_VTT, 16 * s + fr, 32 * ks + 8 * fq), acc[d]); }
            } else {
#pragma unroll
                for (int d = 0; d < 4; ++d) acc[d] = bf4(*(const LAS u32x2*)(lds + L_ATT + ((16 * s + fr) * CP + 16 * d + 4 * fq) * 2));
            }
            bf16x4 xf[4]; const int oo = isW ? L_WT : L_APT;
#pragma unroll
            for (int d = 0; d < 4; ++d) {
#pragma unroll
                for (int mm = 0; mm < d; ++mm) acc[d] = MFMA16(*(const LAS bf16x4*)(lds + L_LAB + ((16 * d + fr) * CP + 16 * mm + 4 * fq) * 2), xf[mm], acc[d]);
                const f32x4 x = MFMA16(*(const LAS bf16x4*)(lds + L_TDD + ((d * 16 + fr) * 24 + 4 * fq) * 2), pack4(acc[d]), ((f32x4){0.f, 0.f, 0.f, 0.f}));
                xf[d] = pack4(x);
                *(LAS bf16x4*)(lds + oo + ((16 * s + fr) * CP + 16 * d + 4 * fq) * 2) = xf[d]; }
        }
        LDS_BARRIER();
        CST(6);
        {   unsigned char* task = TASKS + (size_t)((b * 8 + h) * 32 + c) * TASK_BYTES; const int ty = wave >> 1;
#pragma unroll
            for (int q = 0; q < 2; ++q) { const int tx = (wave & 1) * 2 + q; const int yr = 16 * ty + fr, xc = 16 * tx + 4 * fq;
                f32x4 aM = (f32x4){0.f, 0.f, 0.f, 0.f}, aN = aM, aR = aM, aY = aM;
#pragma unroll
                for (int ks = 0; ks < 2; ++ks) { const int kc = 32 * ks + 8 * fq;
                    const bf16x8 fAP = ldsfrag(lds, L_APT, 16 * tx + fr, kc), fBHx = ldsfrag(lds, L_BHT, 16 * tx + fr, kc), fKHx = ldsfrag(lds, L_KHT, 16 * tx + fr, kc), fMRBx = ldsfrag(lds, L_MRB, 16 * tx + fr, kc), fMRKx = ldsfrag(lds, L_MRK, 16 * tx + fr, kc);
                    const bf16x8 fBHy = ldsfrag(lds, L_BHT, 16 * ty + fr, kc), fWTy = ldsfrag(lds, L_WT, 16 * ty + fr, kc), fVTy = ldsfrag(lds, L_VTT, 16 * ty + fr, kc), fMRBy = ldsfrag(lds, L_MRB, 16 * ty + fr, kc);
                    aM = MFMA32(fAP, fBHy, aM);
                    aN = MFMA32(fBHx, fWTy, aN); aN = MFMA32(fKHx, fVTy, aN);
                    aR = MFMA32(fAP, fMRBy, aR);
                    aY = MFMA32(fMRBx, fWTy, aY); aY = MFMA32(fMRKx, fVTy, aY); }
                const float pc = *(const LAS float*)(lds + L_PC + yr * 4);
#pragma unroll
                for (int e = 0; e < 4; ++e) if (xc + e == yr) aM[e] += pc;
                aR += bf4(*(const LAS u32x2*)(lds + L_RT + (yr * CP + xc) * 2));
                const size_t o = (size_t)(((ty * 64 + lane) * 4 + tx) * 8);
                *(u32x2*)(task + o) = pk4(aM); *(u32x2*)(task + 8192 + o) = pk4(aN); *(u32x2*)(task + 16384 + o) = pk4(aR); *(u32x2*)(task + 24576 + o) = pk4(aY); }
        }
        LWT_STORE();
        LDS_BARRIER();
        CST(7);
    }
}

#undef LWT_ADDR
#undef LWT_LOAD
#undef LWT_STORE
__device__ __forceinline__ void scanB_block(LAS unsigned char* lds, int bh, const unsigned char* TASKS, const bf16* G, const bf16* VS, const float* BON, const float* ln_g, const float* ln_b, bf16* MIX, float* out_wkv, int tid, int wave, int lane) {
    const int b = bh >> 3, h = bh & 7, fr = lane & 15, fq = lane >> 4;
    LAS float* YB = (LAS float*)lds;
    if (wave < 4) {
        const int s = wave;
        const GAS unsigned char* tk = (const GAS unsigned char*)TASKS + (size_t)bh * 32 * TASK_BYTES + (size_t)lane * 32;
        const GAS unsigned char* gG = (const GAS unsigned char*)G; const GAS unsigned char* gV = (const GAS unsigned char*)VS; const GAS unsigned char* gB = (const GAS unsigned char*)BON;
        struct TaskRegs { u32x4 m0[4], m1[4], r0[4], r1[4], n0, n1, y0, y1, g0, g1, v0, v1; unsigned bo; };
        TaskRegs TA, TB; bf16x4 xf[4]; f32x4 accX[4];
#pragma unroll
        for (int t = 0; t < 4; ++t) { xf[t] = (bf16x4){0, 0, 0, 0}; accX[t] = (f32x4){0.f, 0.f, 0.f, 0.f}; }
#define GLD16(dst, ptr, OFF) asm volatile("global_load_dwordx4 %0, %1, off offset:" #OFF : "=v"(dst) : "v"(ptr) : "memory")
#define GLD16NT(dst, ptr) asm volatile("global_load_dwordx4 %0, %1, off nt" : "=v"(dst) : "v"(ptr) : "memory")
#define LOADTASK(T, cc) do { const GAS unsigned char* tp_ = tk + (size_t)(cc) * TASK_BYTES; _Pragma("unroll") for (int t = 0; t < 4; ++t) { \
            GLD16(T.m0[t], tp_ + t * 2048, 0); GLD16(T.m1[t], tp_ + t * 2048, 16); GLD16(T.r0[t], tp_ + 16384 + t * 2048, 0); GLD16(T.r1[t], tp_ + 16384 + t * 2048, 16); } \
            GLD16(T.n0, tp_ + 8192 + s * 2048, 0); GLD16(T.n1, tp_ + 8192 + s * 2048, 16); GLD16(T.y0, tp_ + 24576 + s * 2048, 0); GLD16(T.y1, tp_ + 24576 + s * 2048, 16); \
            { const size_t mo_ = ((size_t)(b * SEQ + (cc) * 64 + 16 * s + (lane >> 3)) * DB + 64 * h + 8 * (lane & 7)) * 2; \
              GLD16NT(T.g0, gG + mo_); GLD16NT(T.g1, gG + mo_ + 8 * DB * 2); GLD16NT(T.v0, gV + mo_); GLD16NT(T.v1, gV + mo_ + 8 * DB * 2); \
              asm volatile("global_load_dword %0, %1, off" : "=v"(T.bo) : "v"(gB + ((size_t)(b * SEQ + (cc) * 64 + 16 * s + (lane & 15)) * 8 + h) * 4) : "memory"); } } while (0)
#define WAITTASK(T, N) asm volatile("s_waitcnt vmcnt(" #N ")" : "+v"(T.m0[0]), "+v"(T.m0[1]), "+v"(T.m0[2]), "+v"(T.m0[3]), "+v"(T.m1[0]), "+v"(T.m1[1]), "+v"(T.m1[2]), "+v"(T.m1[3]), \
            "+v"(T.r0[0]), "+v"(T.r0[1]), "+v"(T.r0[2]), "+v"(T.r0[3]), "+v"(T.r1[0]), "+v"(T.r1[1]), "+v"(T.r1[2]), "+v"(T.r1[3]), "+v"(T.n0), "+v"(T.n1), "+v"(T.y0), "+v"(T.y1), \
            "+v"(T.g0), "+v"(T.g1), "+v"(T.v0), "+v"(T.v1), "+v"(T.bo) :: "memory")
#define LO2(v) __builtin_bit_cast(bf16x4, (u32x2){(v).x, (v).y})
#define HI2(v) __builtin_bit_cast(bf16x4, (u32x2){(v).z, (v).w})
#define STEP(T, cc) do { f32x4 accY[4]; \
            accY[0] = bf4((u32x2){T.y0.x, T.y0.y}); accY[1] = bf4((u32x2){T.y0.z, T.y0.w}); accY[2] = bf4((u32x2){T.y1.x, T.y1.y}); accY[3] = bf4((u32x2){T.y1.z, T.y1.w}); \
            accX[0] = bf4((u32x2){T.n0.x, T.n0.y}); accX[1] = bf4((u32x2){T.n0.z, T.n0.w}); accX[2] = bf4((u32x2){T.n1.x, T.n1.y}); accX[3] = bf4((u32x2){T.n1.z, T.n1.w}); \
            _Pragma("unroll") for (int t = 0; t < 4; ++t) { \
                accY[t] = MFMA16(LO2(T.r0[t]), xf[0], accY[t]); accX[t] = MFMA16(LO2(T.m0[t]), xf[0], accX[t]); accY[t] = MFMA16(HI2(T.r0[t]), xf[1], accY[t]); accX[t] = MFMA16(HI2(T.m0[t]), xf[1], accX[t]); \
                accY[t] = MFMA16(LO2(T.r1[t]), xf[2], accY[t]); accX[t] = MFMA16(LO2(T.m1[t]), xf[2], accX[t]); accY[t] = MFMA16(HI2(T.r1[t]), xf[3], accY[t]); accX[t] = MFMA16(HI2(T.m1[t]), xf[3], accX[t]); } \
            _Pragma("unroll") for (int t = 0; t < 4; ++t) xf[t] = pack4(accX[t]); \
            LAS float* yb = YB + ((cc) & 1) * 4096; \
            _Pragma("unroll") for (int t = 0; t < 4; ++t) _Pragma("unroll") for (int e = 0; e < 4; ++e) yb[(16 * t + 4 * fq + e) * 64 + 16 * s + fr] = accY[t][e]; \
            { LAS unsigned char* gl_ = lds + 32768 + ((cc) & 1) * 8192 + ((16 * s + (lane >> 3)) * 64 + 8 * (lane & 7)) * 2; \
              *(LAS u32x4*)gl_ = T.g0; *(LAS u32x4*)(gl_ + 1024) = T.g1; *(LAS u32x4*)(gl_ + 16384) = T.v0; *(LAS u32x4*)(gl_ + 16384 + 1024) = T.v1; \
              if (lane < 16) *(LAS unsigned*)(lds + 65536 + ((cc) & 1) * 256 + (16 * s + lane) * 4) = T.bo; } \
            asm volatile("s_waitcnt lgkmcnt(0)" ::: "memory"); __builtin_amdgcn_s_barrier(); asm volatile("" ::: "memory"); } while (0)
        LOADTASK(TA, 0); LOADTASK(TB, 1);
#pragma unroll 1
        for (int c = 0; c < 32; c += 2) {
            WAITTASK(TA, 25); STEP(TA, c); LOADTASK(TA, (c + 2 < 32 ? c + 2 : 31));
            WAITTASK(TB, 25); STEP(TB, c + 1); LOADTASK(TB, (c + 3 < 32 ? c + 3 : 31));
        }
        asm volatile("s_waitcnt vmcnt(0)" ::: "memory");
#undef GLD16
#undef GLD16NT
#undef LOADTASK
#undef WAITTASK
#undef LO2
#undef HI2
#undef STEP
#pragma unroll
        for (int t = 0; t < 4; ++t) *(f32x4*)(out_wkv + ((size_t)bh * 64 + 16 * s + fr) * 64 + 16 * t + 4 * fq) = accX[t];
    } else {
        const int tp = tid - 256, l16 = tp & 15;
        const f32x4 lg4 = *(const f32x4*)(ln_g + 64 * h + 4 * l16), lb4 = *(const f32x4*)(ln_b + 64 * h + 4 * l16);
#pragma unroll 1
        for (int c = 0; c < 32; ++c) {
            asm volatile("" ::: "memory"); __builtin_amdgcn_s_barrier(); asm volatile("" ::: "memory");
            const LAS float* yb = YB + (c & 1) * 4096; const LAS unsigned char* gl = lds + 32768 + (c & 1) * 8192; const LAS float* bl = (const LAS float*)(lds + 65536 + (c & 1) * 256);
#pragma unroll
            for (int it = 0; it < 4; ++it) { const int tt = it * 16 + (tp >> 4); const int m = b * SEQ + c * 64 + tt;
                const f32x4 y4 = *(const LAS f32x4*)(yb + tt * 64 + 4 * l16);
                const f32x4 g4 = bf4(*(const LAS u32x2*)(gl + (tt * 64 + 4 * l16) * 2)), v4 = bf4(*(const LAS u32x2*)(gl + 16384 + (tt * 64 + 4 * l16) * 2)); const float bon = bl[tt];
                const float mean = red16((y4[0] + y4[1]) + (y4[2] + y4[3])) * (1.f / 64.f);
                const f32x4 d4 = y4 - mean;
                const float var = red16((d4[0] * d4[0] + d4[1] * d4[1]) + (d4[2] * d4[2] + d4[3] * d4[3])) * (1.f / 64.f);
                const float rstd = __builtin_amdgcn_rsqf(var + GN_EPS);
                const f32x4 o = ((d4 * rstd) * lg4 + lb4 + v4 * bon) * g4;
                *(GAS u32x2*)((gbf16*)MIX + (size_t)m * 1024 + 512 + 64 * h + 4 * l16) = pk4(o); }
        }
    }
}

template <class EpiF>
__device__ __forceinline__ void small_gemm(LAS unsigned char* lds, const bf16* A, int lda, const bf16* Bt, int N, int K, int Q, int gb, int GB, const EpiF& epi, int tid, int wave, int lane) {
    const int fr = lane & 15, fq = lane >> 4, kw = (K / Q) >> 3;
    LAS float* part = (LAS float*)lds;
    for (int item = gb; item < (N >> 4) * Q; item += GB) {
        const int strip = item / Q, q = item - strip * Q;
        const f32x4 pf = epi.pre(tid >> 2, 16 * strip + 4 * (tid & 3));
        f32x4 acc[8];
#pragma unroll
        for (int i = 0; i < 8; ++i) acc[i] = (f32x4){0.f, 0.f, 0.f, 0.f};
        const GAS char* Bu = (const GAS char*)Bt + ((size_t)(16 * strip) * K + q * (K / Q) + wave * kw) * 2;
        const GAS char* Au = (const GAS char*)A + ((size_t)q * (K / Q) + wave * kw) * 2;
        const unsigned laneB = (unsigned)(fr * K + 8 * fq) * 2u, laneA = (unsigned)(fr * lda + 8 * fq) * 2u;
        bf16x8 wf[4], af[4][8];
#pragma unroll
        for (int ks = 0; ks < 4; ++ks) wf[ks] = *(const GAS bf16x8*)(Bu + laneB + 64 * ks);
#pragma unroll
        for (int mt = 0; mt < 8; ++mt) { const GAS char* Am = Au + (size_t)(16 * mt) * lda * 2;
#pragma unroll
            for (int ks = 0; ks < 4; ++ks) af[ks][mt] = *(const GAS bf16x8*)(Am + laneA + 64 * ks); }
        __builtin_amdgcn_sched_barrier(0);
#pragma unroll
        for (int ks = 0; ks < 4; ++ks)
#pragma unroll
            for (int mt = 0; mt < 8; ++mt) acc[mt] = __builtin_amdgcn_mfma_f32_16x16x32_bf16(wf[ks], af[ks][mt], acc[mt], 0, 0, 0);
#pragma unroll
        for (int mt = 0; mt < 8; ++mt) *(LAS f32x4*)(part + ((wave * 128 + 16 * mt + fr) * 16 + 4 * fq)) = acc[mt];
        __syncthreads();
        {   const int token = tid >> 2, cg = tid & 3; f32x4 sm = (f32x4){0.f, 0.f, 0.f, 0.f};
#pragma unroll
            for (int w = 0; w < 8; ++w) sm += *(const LAS f32x4*)(part + ((w * 128 + token) * 16 + 4 * cg));
            epi(token, 16 * strip + 4 * cg, sm, pf); }
        __syncthreads();
    }
}
struct SEpiProj { bf16* ZAs; float* PBs;
    __device__ __forceinline__ f32x4 pre(int, int) const { return (f32x4){0.f, 0.f, 0.f, 0.f}; }
    __device__ __forceinline__ void operator()(int t, int c, f32x4 s, f32x4) const {
        if (c < 1024) { const f32x2 a = pg8::gelu_pk((f32x2){s[0], s[1]}), b = pg8::gelu_pk((f32x2){s[2], s[3]}); *(u32x2*)(ZAs + (size_t)t * 1024 + c) = pk4((f32x4){a.x, a.y, b.x, b.y}); }
        else *(f32x4*)(PBs + (size_t)t * DSH + (c - 1024)) = s; } };
struct SEpiAtomic { float* acc;
    __device__ __forceinline__ f32x4 pre(int, int) const { return (f32x4){0.f, 0.f, 0.f, 0.f}; }
    __device__ __forceinline__ void operator()(int t, int c, f32x4 s, f32x4) const {
#pragma unroll
        for (int j = 0; j < 4; ++j) (void)__hip_atomic_fetch_add(acc + (size_t)t * 1024 + c + j, s[j], __ATOMIC_RELAXED, __HIP_MEMORY_SCOPE_AGENT); } };
template <bool WB> struct SEpiRes { const float* base; float* out; bf16* outb; float* rowss; float* out2;
    __device__ __forceinline__ f32x4 pre(int t, int c) const { return *(const f32x4*)(base + (size_t)t * 1024 + c); }
    __device__ __forceinline__ void operator()(int t, int c, f32x4 s, f32x4 pf) const {
        const f32x4 v = pf + s; *(f32x4*)(out + (size_t)t * 1024 + c) = v; if (WB) *(u32x2*)(outb + (size_t)t * 1024 + c) = pk4(v); if (out2) *(f32x4*)(out2 + (size_t)t * 1024 + c) = v;
        float ss = (v[0] * v[0] + v[1] * v[1]) + (v[2] * v[2] + v[3] * v[3]); ss = red4(ss);
        if ((threadIdx.x & 3) == 0) (void)__hip_atomic_fetch_add(rowss + t, ss, __ATOMIC_RELAXED, __HIP_MEMORY_SCOPE_AGENT); } };
struct SEpiQ { float* Q; const float* rowss;
    __device__ __forceinline__ f32x4 pre(int t, int) const { return (f32x4){__hip_atomic_load(rowss + t, __ATOMIC_RELAXED, __HIP_MEMORY_SCOPE_AGENT), 0.f, 0.f, 0.f}; }
    __device__ __forceinline__ void operator()(int t, int c, f32x4 s, f32x4 pf) const {
        const float sc = 0.0625f / sqrtf(pf[0] * (1.f / D) + RMS_EPS); *(f32x4*)(Q + (size_t)t * 1024 + c) = s * sc; } };
struct SEpiUp { bf16* H; const float* rowss;
    __device__ __forceinline__ f32x4 pre(int t, int) const { return (f32x4){__hip_atomic_load(rowss + t, __ATOMIC_RELAXED, __HIP_MEMORY_SCOPE_AGENT), 0.f, 0.f, 0.f}; }
    __device__ __forceinline__ void operator()(int t, int c, f32x4 s, f32x4 pf) const {
        const float sc = 1.f / sqrtf(pf[0] * (1.f / D) + RMS_EPS); f32x4 v = s * sc;
#pragma unroll
        for (int j = 0; j < 4; ++j) { const float a = fmaxf(v[j], 0.f); v[j] = a * a; }
        *(u32x2*)(H + (size_t)t * FF + c) = pk4(v); } };

struct KArgs { const float* in[35]; float* out; unsigned char* ws; };
#ifdef PROBE_SSPAN_A
#ifndef SST_BLK
#define SST_BLK 64
#endif
#define MST(k) do { if (blockIdx.x == SST_BLK && threadIdx.x == 0) *(volatile LAS unsigned long long*)(lds + LDSCTL_OFF + 64 + 8 * (16 + (k))) = __builtin_amdgcn_s_memrealtime(); } while (0)
#else
#define MST(k) do { } while (0)
#endif
__device__ __forceinline__ void sample_mixer_token(LAS unsigned char* lds, int tok, const KArgs& KA, const bf16* ZAs, const float* PBs, bf16* MIXs, const bf16* W2T, const bf16* A2T, const bf16* G2T, int tid, int wave, int lane) {
    const float* const (&in)[35] = KA.in; float* out = KA.out;
    LAS float* red = (LAS float*)lds;
    LAS float* lin = (LAS float*)(lds + 256);
    LAS float* vec = (LAS float*)(lds + 2048);
    const int c = tid, hA = c >> 7;
    const float* pb = PBs + (size_t)tok * DSH; const float* pv = in[5] + (size_t)tok * DSH; const float* mu = in[9];
    const float* s0w = in[6] + (size_t)(tok * 8 + wave) * 4096 + lane * 4; float* s1w = out + O_WKVS + (size_t)(tok * 8 + wave) * 4096 + lane * 4;
    f32x4 Sx[16];
#pragma unroll
    for (int i = 0; i < 16; ++i) Sx[i] = *(const f32x4*)(s0w + i * 256);
    const float vz = bf1(ZAs[(size_t)tok * 1024 + 512 + c]), uz = bf1(ZAs[(size_t)tok * 1024 + c]);
    const float lng = in[10][c], lnb = in[11][c], sw = in[12][(size_t)hA * 128 * 128], sb = in[13][hA * 128];
    const int li = 1536 + (tid & 255); const float lpb = pb[li], lpv = pv[li], lmu = mu[li];
    const float rs = pb[c] + (pv[c] - pb[c]) * mu[c], ks = pb[512 + c] + (pv[512 + c] - pb[512 + c]) * mu[512 + c], vs = pb[1024 + c] + (pv[1024 + c] - pb[1024 + c]) * mu[1024 + c];
    const float wl0 = in[14][c], al0 = in[16][c];
    const float p19 = in[19][c], p20 = in[20][c], p21 = in[21][c], p22 = in[22][c], p23 = in[23][c];
    {   const float s1 = wave_sum(vz); if (lane == 0) red[wave] = s1;
        if (tid < 256) { const float x = lpb + (lpv - lpb) * lmu; lin[tid] = tid < 64 ? fast_tanh(x) : (tid < 128 ? x : fast_sigmoid(x)); }
        __syncthreads();
        const float mean = (red[2 * hA] + red[2 * hA + 1]) * (1.f / 128.f); const float dv = vz - mean;
        const float s2 = wave_sum(dv * dv); if (lane == 0) red[8 + wave] = s2;
        __syncthreads();
        const float var = (red[8 + 2 * hA] + red[8 + 2 * hA + 1]) * (1.f / 128.f);
        const float vn = dv * (1.f / sqrtf(var + LN_EPS)) * lng + lnb;
        out[O_CVS + (size_t)tok * 512 + c] = vn;
        const float mixed = sw * vn + sb;
        MIXs[(size_t)tok * 1024 + c] = (bf16)(pk2(uz * mixed, 0.f) & 0xffffu);
    }
    MST(7);
    LAS float* lw = (LAS float*)(lds + 12288) + wave * 192;
    LAS float* vy = (LAS float*)(lds + 18432) + wave * 128;
    {   const int s8 = (lane & 7) * 8, s16 = (lane & 15) * 8;
        const f32x4 lw0 = *(const LAS f32x4*)(lin + s8), lw1 = *(const LAS f32x4*)(lin + s8 + 4), la0 = *(const LAS f32x4*)(lin + 64 + s8), la1 = *(const LAS f32x4*)(lin + 64 + s8 + 4);
        const f32x4 lg0 = *(const LAS f32x4*)(lin + 128 + s16), lg1 = *(const LAS f32x4*)(lin + 128 + s16 + 4);
        const bf16* wp = W2T + (size_t)(64 * wave) * 64 + lane * 8; const bf16* ap = A2T + (size_t)(64 * wave) * 64 + lane * 8; const bf16* gp = G2T + (size_t)(64 * wave) * 128 + lane * 8;
#define DOT8(v, l0_, l1_) ((bf_lo((v).x) * l0_[0] + bf_hi((v).x) * l0_[1]) + (bf_lo((v).y) * l0_[2] + bf_hi((v).y) * l0_[3]) + (bf_lo((v).z) * l1_[0] + bf_hi((v).z) * l1_[1]) + (bf_lo((v).w) * l1_[2] + bf_hi((v).w) * l1_[3]))
#pragma unroll 4
        for (int i = 0; i < 8; ++i) {
            const u32x4 w8 = *(const u32x4*)(wp + i * 512), a8 = *(const u32x4*)(ap + i * 512), g8 = *(const u32x4*)(gp + i * 512), h8 = *(const u32x4*)(gp + (i + 8) * 512);
            const float pw = red8(DOT8(w8, lw0, lw1)), pa = red8(DOT8(a8, la0, la1)), pg = red16(DOT8(g8, lg0, lg1)), ph = red16(DOT8(h8, lg0, lg1));
            if ((lane & 7) == 0) { lw[8 * i + (lane >> 3)] = pw; lw[64 + 8 * i + (lane >> 3)] = pa; }
            if ((lane & 15) == 0) { lw[128 + 4 * i + (lane >> 4)] = pg; lw[160 + 4 * i + (lane >> 4)] = ph; }
        }
#undef DOT8
    }
    asm volatile("s_waitcnt lgkmcnt(0)" ::: "memory");
    const float wl = wl0 + lw[lane], al = al0 + lw[64 + lane], g = lw[128 + lane];
    MST(8);
    const float dec = fast_exp(-0.60653066f * fast_sigmoid(wl)), av = fast_sigmoid(al);
    const float kkr = ks * p19; const float nrm = sqrtf(wave_sum(kkr * kkr)); const float kk = kkr / fmaxf(nrm, 1e-12f); const float kp = ks * (1.f + (av - 1.f) * p20);
    LAS float* hv = vec + wave * 320;
    hv[lane] = dec; hv[64 + lane] = -kk; hv[128 + lane] = kk * av; hv[192 + lane] = kp; hv[256 + lane] = rs; vy[lane] = vs;
    asm volatile("s_waitcnt lgkmcnt(0)" ::: "memory");
    {   const int k4 = (lane & 15) * 4, vq = lane >> 4;
        const f32x4 d4 = *(const LAS f32x4*)(hv + k4), a4 = *(const LAS f32x4*)(hv + 64 + k4), b4 = *(const LAS f32x4*)(hv + 128 + k4), kp4 = *(const LAS f32x4*)(hv + 192 + k4), r4 = *(const LAS f32x4*)(hv + 256 + k4);
#pragma unroll
        for (int i = 0; i < 16; ++i) {
            const float sa = red16((Sx[i][0] * a4[0] + Sx[i][1] * a4[1]) + (Sx[i][2] * a4[2] + Sx[i][3] * a4[3]));
            const float vsv = vy[4 * i + vq];
            const f32x4 sn = Sx[i] * d4 + (b4 * sa + kp4 * vsv);
            *(f32x4*)(s1w + i * 256) = sn;
            const float yp = red16((sn[0] * r4[0] + sn[1] * r4[1]) + (sn[2] * r4[2] + sn[3] * r4[3]));
            if ((lane & 15) == 0) vy[64 + 4 * i + vq] = yp;
        }
        asm volatile("s_waitcnt lgkmcnt(0)" ::: "memory");
        const float y = vy[64 + lane];
        const float mean = wave_sum(y) * (1.f / 64.f), dy = y - mean, var = wave_sum(dy * dy) * (1.f / 64.f);
        const float yn = dy * (1.f / sqrtf(var + GN_EPS)) * p22 + p23;
        const float bon = wave_sum(rs * kp * p21) * vs;
        MIXs[(size_t)tok * 1024 + 512 + c] = (bf16)(pk2((yn + bon) * g, 0.f) & 0xffffu);
    }
    __syncthreads();
    MST(9);
}
__device__ __forceinline__ void sample_attn_pair(LAS unsigned char* lds, int pair, const float* Qs, const float* Kc, const float* Vc, bf16* Os, int tid, int wave, int lane) {
    const int b = pair >> 2, h = pair & 3;
    LAS float* sc = (LAS float*)lds;
    LAS float* part = (LAS float*)(lds + 1024);
    const f32x4 q4 = *(const f32x4*)(Qs + (size_t)b * 1024 + h * 256 + 4 * lane);
    const float* kb = Kc + ((size_t)b * 256 * 4 + h) * 256 + 4 * lane; const float* vb = Vc + ((size_t)b * 256 * 4 + h) * 256 + 4 * lane;
    {   f32x4 kr[32];
#pragma unroll
        for (int i = 0; i < 32; ++i) kr[i] = __builtin_nontemporal_load((const f32x4*)(kb + (size_t)(32 * wave + i) * 1024));
#pragma unroll
        for (int i = 0; i < 32; ++i) { const float p = wave_sum_dpp((q4[0] * kr[i][0] + q4[1] * kr[i][1]) + (q4[2] * kr[i][2] + q4[3] * kr[i][3])); if (lane == 0) sc[32 * wave + i] = p; } }
    f32x4 vr[32];
#pragma unroll
    for (int i = 0; i < 32; ++i) vr[i] = __builtin_nontemporal_load((const f32x4*)(vb + (size_t)(32 * wave + i) * 1024));
    __syncthreads();
    {   const f32x4 s4 = *(const LAS f32x4*)(sc + 4 * lane); const float mx = wave_max(fmaxf(fmaxf(s4[0], s4[1]), fmaxf(s4[2], s4[3])));
        f32x4 e; float sum = 0.f;
#pragma unroll
        for (int j = 0; j < 4; ++j) { e[j] = fast_exp(s4[j] - mx); sum += e[j]; }
        sum = wave_sum(sum); const float inv = 1.f / sum;
        __syncthreads();
        if (wave == 0) *(LAS f32x4*)(sc + 4 * lane) = e * inv;
    }
    __syncthreads();
    f32x4 o = (f32x4){0.f, 0.f, 0.f, 0.f};
#pragma unroll
    for (int i = 0; i < 32; ++i) o += vr[i] * sc[32 * wave + i];
    *(LAS f32x4*)(part + wave * 256 + 4 * lane) = o;
    __syncthreads();
    if (tid < 256) { float s = 0.f;
#pragma unroll
        for (int w = 0; w < 8; ++w) s += part[w * 256 + tid];
        Os[(size_t)b * 1024 + h * 256 + tid] = (bf16)(pk2(s, 0.f) & 0xffffu); }
    __syncthreads();
}
template <int ST>
__device__ __forceinline__ void sample_stage(LAS unsigned char* lds, const KArgs& KA, int gb, int GB, int tid, int wave, int lane) {
    unsigned char* ws = KA.ws; unsigned char* sm = ws + WS_SMP; const float* const (&in)[35] = KA.in; float* out = KA.out;
    float* rs1 = (float*)ws + RS_OFF + M; float* rs2 = rs1 + RS_STRIDE;
    const bf16* XN0s = (const bf16*)(ws + WS_ACAT) + (size_t)M * 1024;
    bf16* ZAs = (bf16*)(sm + SM_ZA); bf16* MIXs = (bf16*)(sm + SM_MIX); float* X1s = (float*)(sm + SM_X1); bf16* X1Bs = (bf16*)(sm + SM_X1B); float* Qs = (float*)(sm + SM_Q); bf16* Os = (bf16*)(sm + SM_O);
    float* X2s = (float*)(sm + SM_X2); bf16* X2Bs = (bf16*)(sm + SM_X2B); bf16* HIDs = (bf16*)(sm + SM_HID); float* X3s = (float*)(sm + SM_X3);
    float* PBs = out + O_SHS;
    if constexpr (ST == 0) { SEpiProj e{ZAs, PBs}; small_gemm(lds, XN0s, 1024, (const bf16*)(ws + WS_WCAT), DIN, 1024, 1, gb, GB, e, tid, wave, lane); }
    if constexpr (ST == 1) { for (int tok = gb; tok < MS; tok += GB) sample_mixer_token(lds, tok, KA, ZAs, PBs, MIXs, (const bf16*)(ws + WS_SMALL), (const bf16*)(ws + WS_SMALL + 64 * KiB), (const bf16*)(ws + WS_SMALL + 128 * KiB), tid, wave, lane); }
    if constexpr (ST == 2) { SEpiRes<true> e{in[1], X1s, X1Bs, rs1, nullptr}; small_gemm(lds, MIXs, 1024, (const bf16*)(ws + WS_WOUT), 1024, 1024, 1, gb, GB, e, tid, wave, lane); }
    if constexpr (ST == 3) { SEpiQ e{Qs, rs1}; small_gemm(lds, X1Bs, 1024, (const bf16*)(ws + WS_WQ), 1024, 1024, 1, gb, GB, e, tid, wave, lane); }
    if constexpr (ST == 4) { for (int pair = gb; pair < MS * 4; pair += GB) sample_attn_pair(lds, pair, Qs, in[3], in[4], Os, tid, wave, lane); }
    if constexpr (ST == 5) { SEpiRes<true> e{X1s, X2s, X2Bs, rs2, X3s}; small_gemm(lds, Os, 1024, (const bf16*)(ws + WS_WO), 1024, 1024, 1, gb, GB, e, tid, wave, lane); }
    if constexpr (ST == 6) { SEpiUp e{HIDs, rs2}; small_gemm(lds, X2Bs, 1024, (const bf16*)(ws + WS_WUP), FF, 1024, 1, gb, GB, e, tid, wave, lane); }
    if constexpr (ST == 7) { SEpiAtomic e{X3s}; small_gemm(lds, HIDs, FF, (const bf16*)(ws + WS_WDN), 1024, FF, 4, gb, GB, e, tid, wave, lane); }
    if constexpr (ST == 8) {
        for (int r = gb * 8 + wave; r < MS; r += GB * 8) {
            f32x4 v[4]; float ss = 0.f;
#pragma unroll
            for (int j = 0; j < 4; ++j) { v[j] = *(const f32x4*)(X3s + (size_t)r * 1024 + 256 * j + 4 * lane); ss += (v[j][0] * v[j][0] + v[j][1] * v[j][1]) + (v[j][2] * v[j][2] + v[j][3] * v[j][3]); }
            const float sc = 1.f / sqrtf(wave_sum(ss) * (1.f / D) + RMS_EPS);
#pragma unroll
            for (int j = 0; j < 4; ++j) { const int cc = 256 * j + 4 * lane; *(f32x4*)(out + O_YS + (size_t)r * 1024 + cc) = v[j] * sc * *(const f32x4*)(in[34] + cc); } }
    }
}

__global__ void __launch_bounds__(NWAVES * 64, 2) mk_fwd(KArgs a) {
    extern __shared__ __attribute__((aligned(16))) unsigned char lds_raw[];
    LAS unsigned char* lds = (LAS unsigned char*)lds_raw;
    volatile LAS unsigned* MISC = (volatile LAS unsigned*)(lds + MISC_OFF);
    int tid = threadIdx.x, lane = tid & 63, wave = __builtin_amdgcn_readfirstlane(tid >> 6);
    const int G = gridDim.x; int bx = blockIdx.x; int vcu = (G % 8 == 0) ? (bx % 8) * (G / 8) + bx / 8 : bx;
#define LAUNDER() do { ws = a.ws; asm volatile("" : "+s"(ws)); tid = threadIdx.x; asm volatile("" : "+v"(tid)); lane = tid & 63; wave = __builtin_amdgcn_readfirstlane(tid >> 6); bx = blockIdx.x; asm volatile("" : "+s"(bx)); \
        vcu = (G % 8 == 0) ? (bx % 8) * (G / 8) + bx / 8 : bx; gw = vcu * NWAVES + wave; } while (0)
    unsigned char* ws = a.ws; float* out = a.out;
    gu32* ctl = (gu32*)(ws + WS_CTL);
    for (int u = tid; u < (LDS_BYTES - LDSCTL_OFF) / 4; u += NWAVES * 64) ((LAS unsigned*)(lds + LDSCTL_OFF))[u] = 0u;
    __syncthreads();
    XcdBarrier bar = xcd_barrier_post((unsigned*)ctl + CW_BAR, MISC + 8);
#define GRID_BAR() xcd_barrier(bar)
#ifdef PROBE_SPAN_A
#define STAMP(k) do { if (blockIdx.x == 0 && threadIdx.x == 0) *(volatile LAS unsigned long long*)(lds + LDSCTL_OFF + 64 + 8 * (k)) = __builtin_amdgcn_s_memrealtime(); } while (0)
#else
#define STAMP(k) do { } while (0)
#endif
    STAMP(0);
#ifdef PROBE_SSPAN_A
#ifndef SST_BLK
#define SST_BLK 64
#endif
#define SST(k) do { if (blockIdx.x == SST_BLK && threadIdx.x == 0) *(volatile LAS unsigned long long*)(lds + LDSCTL_OFF + 64 + 8 * (16 + (k))) = __builtin_amdgcn_s_memrealtime(); } while (0)
#else
#define SST(k) do { } while (0)
#endif
#define RS1 ((float*)ws + RS_OFF)
#define RS2 ((float*)ws + RS_OFF + RS_STRIDE)
#define RS3 ((float*)ws + RS_OFF + 2 * RS_STRIDE)
#define RSTD0 ((float*)ws + 131072)
#define WCAT ((bf16*)(ws + WS_WCAT))
#define WOUT ((bf16*)(ws + WS_WOUT))
#define WQ ((bf16*)(ws + WS_WQ))
#define WO ((bf16*)(ws + WS_WO))
#define WUP ((bf16*)(ws + WS_WUP))
#define WDN ((bf16*)(ws + WS_WDN))
#define W2T ((bf16*)(ws + WS_SMALL))
#define A2T ((bf16*)(ws + WS_SMALL + 64 * KiB))
#define G2T ((bf16*)(ws + WS_SMALL + 128 * KiB))
#define WSB ((bf16*)(ws + WS_SMALL + 256 * KiB))
#define ZROW ((bf16*)(ws + WS_SMALL + 384 * KiB))
#define ACAT ((bf16*)(ws + WS_ACAT))
#define ZA ((bf16*)(ws + WS_ZA))
#define PB ((bf16*)(ws + WS_PB))
#define SCN ((float*)(ws + WS_SCN))
#define LAIN ((bf16*)(ws + WS_NEW))
#define OPS ((bf16*)(ws + WS_SCN))
#define TASKS (ws + WS_NEW + 8 * MiB)
#define VSB ((bf16*)(ws + WS_NEW + 72 * MiB))
#define BON ((float*)(ws + WS_NEW + 88 * MiB))
#define GB_ ((bf16*)(ws + WS_G))
#define MIX ((bf16*)(ws + WS_MIX))
#define KB ((bf16*)(ws + WS_KB))
#define VT ((bf16*)(ws + WS_VT))
#define X1B ((bf16*)(ws + WS_ZA))
#define Q ((bf16*)(ws + WS_Q))
#define OB ((bf16*)(ws + WS_OB))
#define PSCR ((bf16*)(ws + WS_PSCR))
#define WQN ((bf16*)(ws + WS_HID))
#define VWOT ((bf16*)(ws + WS_HID + 32 * MiB))
#define VB ((bf16*)(ws + WS_VT))
#define PCAT ((bf16*)(ws + WS_OB))
#define WQK ((bf16*)(ws + WS_HID + 8 * MiB))
#define X2B ((bf16*)(ws + WS_MIX))
#define HID ((bf16*)(ws + WS_HID))
    int gw = vcu * NWAVES + wave; const int NGW = G * NWAVES;

    #ifndef NOP0
    LAUNDER();
    {
        LAS float* scr = (LAS float*)(lds + wave * 16384);
        constexpr int I_IN = 16 * 88, I_SQ = 16 * 32, I_UP = 16 * 128, I_DN = 64 * 32, I_L = 16, I_G = 32;
        constexpr int NITEMS = I_IN + 5 * I_SQ + 2 * I_L + I_G;
        for (int it = gw; it < NITEMS; it += NGW) {
            int r = it;
            if (r < I_IN) { p0_transpose_item(a.in[8], 1024, DIN, WCAT, 0, a.in[7], scr, r, lane); continue; } r -= I_IN;
            if (r < I_SQ) { p0_transpose_item(a.in[28], 1024, 1024, WCAT, DIN, nullptr, scr, r, lane); continue; } r -= I_SQ;
            if (r < I_SQ) { p0_transpose_item(a.in[29], 1024, 1024, WCAT, DIN + 1024, nullptr, scr, r, lane); continue; } r -= I_SQ;
            if (r < I_SQ) { p0_transpose_item(a.in[24], 1024, 1024, WOUT, 0, nullptr, scr, r, lane); continue; } r -= I_SQ;
            if (r < I_SQ) { p0_transpose_item(a.in[27], 1024, 1024, WQ, 0, a.in[25], scr, r, lane); continue; } r -= I_SQ;
            if (r < I_SQ) { p0_transpose_item(a.in[30], 1024, 1024, WO, 0, nullptr, scr, r, lane); continue; } r -= I_SQ;
            if (r < I_L) { p0_transpose_item(a.in[15], 64, DB, W2T, 0, nullptr, scr, r, lane); continue; } r -= I_L;
            if (r < I_L) { p0_transpose_item(a.in[17], 64, DB, A2T, 0, nullptr, scr, r, lane); continue; } r -= I_L;
            p0_transpose_item(a.in[18], 128, DB, G2T, 0, nullptr, scr, r, lane);
        }
        f32x4 gA[4], gB[4];
#pragma unroll
        for (int j = 0; j < 4; ++j) { gA[j] = *((const GAS f32x4*)(const gf32*)a.in[7] + lane + 64 * j); gB[j] = *((const GAS f32x4*)(const gf32*)a.in[26] + lane + 64 * j); }
        for (int m = gw; m < M + MS + NBATCH * NMEM; m += 4 * NGW) {
            const float* src[4]; const float* gg[4]; bf16* dst[4]; bool ok[4];
#pragma unroll
            for (int q = 0; q < 4; ++q) { const int mm = m + q * NGW; ok[q] = mm < M + MS + NBATCH * NMEM; const int mc = ok[q] ? mm : m;
                if (mc < M) { src[q] = a.in[0] + (size_t)mc * D; gg[q] = a.in[7]; dst[q] = ACAT + (size_t)mc * D; }
                else if (mc < M + MS) { src[q] = a.in[1] + (size_t)(mc - M) * D; gg[q] = a.in[7]; dst[q] = ACAT + (size_t)mc * D; }
                else { src[q] = a.in[2] + (size_t)(mc - M - MS) * D; gg[q] = a.in[26]; dst[q] = ACAT + (size_t)(16640 + (mc - M - MS)) * D; } }
            f32x4 v[4][4]; float ss[4];
#pragma unroll
            for (int q = 0; q < 4; ++q) { ss[q] = 0.f;
#pragma unroll
                for (int j = 0; j < 4; ++j) v[q][j] = __builtin_nontemporal_load((const f32x4*)src[q] + lane + 64 * j); }
#pragma unroll
            for (int q = 0; q < 4; ++q) {
#pragma unroll
                for (int j = 0; j < 4; ++j) ss[q] += (v[q][j].x * v[q][j].x + v[q][j].y * v[q][j].y) + (v[q][j].z * v[q][j].z + v[q][j].w * v[q][j].w);
                const float rstd = 1.f / sqrtf(wave_sum(ss[q]) * (1.f / D) + RMS_EPS);
                if (ok[q] && gg[q] == a.in[7] && lane == 0) { const int mm_ = m + q * NGW; if (mm_ < M) RSTD0[mm_] = rstd; }
                if (ok[q]) { unsigned long long* o8 = (unsigned long long*)dst[q] + lane;
#pragma unroll
                    for (int j = 0; j < 4; ++j) { const f32x4 g4 = gg[q] == a.in[7] ? (f32x4){1.f, 1.f, 1.f, 1.f} : gB[j];
                        o8[64 * j] = (unsigned long long)pk2(v[q][j].x * rstd * g4.x, v[q][j].y * rstd * g4.y) | ((unsigned long long)pk2(v[q][j].z * rstd * g4.z, v[q][j].w * rstd * g4.w) << 32); } } }
        }
        const int gt = bx * (NWAVES * 64) + tid, NGT = G * NWAVES * 64;
        for (int i = gt; i < 4 * 128 * 128; i += NGT) { const int t = (i >> 7) & 127, s = i & 127; WSB[i] = (bf16)(pk2(s <= t ? a.in[12][i] : 0.f, 0.f) & 0xffffu); }
        for (int i = gt; i < 2048; i += NGT) ZROW[i] = 0;
        for (int i = gt; i < 1024 * 256; i += NGT) { const f32x4 w = *((const GAS f32x4*)(const gf32*)a.in[27] + i); const float g_ = a.in[25][i >> 8]; *((GAS u32x2*)(gbf16*)WQN + i) = pk4(w * g_); }
    }
#endif
    GRID_BAR(); STAMP(1);

    #ifndef NOP1
    LAUNDER();
    {
        SchedP1 S{G, bx, (const char*)ACAT, (const char*)WCAT};
        EpiP1 E{ZA, PB, out + O_MK, out + O_MV, KB, VB};
        pg8::gemm_phase<EpiP1, SchedP1, true>(lds, 1024, 1024, 1024, S, E);
        sample_stage<0>(lds, a, bx, G, tid, wave, lane);
    }
#endif
    GRID_BAR(); STAMP(2);

    #ifndef NOP2
    LAUNDER();
    {
        unsigned* sub2 = (unsigned*)ctl + CW_SUB2; unsigned* tmo2 = (unsigned*)ctl + CW_TMO;
        SST(14);
        if (bx < MS) {
            sample_stage<1>(lds, a, bx, G, tid, wave, lane);
            asm volatile("s_waitcnt vmcnt(0)" ::: "memory"); __syncthreads();
            if (tid == 0) { __builtin_amdgcn_fence(__ATOMIC_RELEASE, "agent"); asm volatile("s_waitcnt vmcnt(0)" ::: "memory"); (void)xb_add(sub2, 1u); }
        } else if (bx >= MS + 64) {
            const int gt = (bx - MS - 64) * (NWAVES * 64) + tid, NGT = (G - MS - 64) * NWAVES * 64;
            for (int i = gt; i < NBATCH * DSH; i += NGT) { const int b = i / DSH, c = i % DSH; out[O_SHP + i] = bf1(PB[(size_t)(b * SEQ + SEQ - 1) * DSH + c]); }
        }
        __syncthreads();
        LAUNDER();
        SST(10);
        for (int bc = bx; bc < M / 64; bc += G)
            rwkv_chunk_prep(lds, bc, PB, ZROW, a.in[9], W2T, A2T, G2T, a.in[14], a.in[16], a.in[19], a.in[20], a.in[21], LAIN + (size_t)bx * 16384, TASKS, GB_, VSB, BON, tid, wave, lane);
        SST(11);
        LAUNDER();
        if (bx >= MS && bx < MS + 64) {
            __syncthreads();
            if (tid == 0) { unsigned sp = 0; while (xb_ld(sub2) < (unsigned)MS) { __builtin_amdgcn_s_sleep(1); if ((++sp & 255u) == 0u) { if (xb_ld(tmo2)) break; if (sp > (1u << 20)) { atomicAdd(tmo2, 1u); break; } } }
                __builtin_amdgcn_fence(__ATOMIC_ACQUIRE, "agent"); asm volatile("s_waitcnt vmcnt(0)" ::: "memory"); }
            __syncthreads();
            SST(12);
            sample_stage<2>(lds, a, bx - MS, 64, tid, wave, lane);
            SST(13);
        }
    }
#endif
    if (bx < MS) GRID_BAR();
    else {
        unsigned* qmix2 = (unsigned*)ctl + CW_QMIX; volatile LAS unsigned* qw2 = (volatile LAS unsigned*)(lds + LDSCTL_OFF + 32);
        LAUNDER();
        asm volatile("s_waitcnt vmcnt(0)" ::: "memory"); __syncthreads();
        unsigned gen_ = 0u; bool wait_ = false, exhausted_ = false; unsigned spn_ = 0u;
        if (tid == 0) wait_ = !xcd_barrier_arrive(bar, gen_);
        {
            const int uq_ = bx - MS, b_ = uq_ >> 4, h_ = (uq_ >> 2) & 3, dt_ = uq_ & 3;
            SchedOne SQ{(const char*)(KB + (size_t)b_ * NMEM * 1024 + h_ * 256), (const char*)(WQN + (size_t)dt_ * 256 * 1024 + h_ * 256)}; EpiAttnO EQ{WQK + (size_t)(b_ * 4 + h_) * 256 * 1024 + dt_ * 256};
            pg8::gemm_phase<EpiAttnO, SchedOne, false>(lds, 256, 1024, 1024, SQ, EQ);
            LAUNDER();
        }
        {
            const int uq_ = bx - MS, b_ = uq_ >> 4, h_ = (uq_ >> 2) & 3, nt_ = uq_ & 3;
            SchedOne SV{(const char*)(WO + (size_t)nt_ * 256 * 1024 + h_ * 256), (const char*)(VB + (size_t)b_ * NMEM * 1024 + h_ * 256)}; EpiAttnO EV{VWOT + (size_t)b_ * 1024 * 1024 + (size_t)nt_ * 256 * 1024 + h_ * 256};
            pg8::gemm_phase<EpiAttnO, SchedOne, false>(lds, 256, 1024, 1024, SV, EV);
            LAUNDER();
        }
        for (;;) {
            __syncthreads();
            if (tid == 0) { if (wait_ && xcd_barrier_poll(bar, gen_)) wait_ = false;
                unsigned t_ = 0xffffffffu;
                if (wait_) { if (!exhausted_) { t_ = xb_add(qmix2, 1u); if (t_ >= 512u) exhausted_ = true; } if (exhausted_) { t_ = 0xfffffffeu; if (++spn_ > (1u << 20)) { atomicAdd((unsigned*)ctl + CW_BAR + XB_TMO, 1u); } } }
                *qw2 = t_; }
            __syncthreads();
            const unsigned tile = *qw2;
            if (tile == 0xffffffffu) break;
            if (tile < 512u) mixer_a_tile(lds, (int)tile, ZA, WSB, a.in[10], a.in[11], a.in[13], MIX, out + O_CVP, tid, wave, lane);
            else __builtin_amdgcn_s_sleep(2);
        }
        __syncthreads();
    }
    STAMP(3);


    #ifndef NOP3
    LAUNDER();
    {   unsigned* subcnt = (unsigned*)ctl + CW_SUB; unsigned* tmo = (unsigned*)ctl + CW_TMO; unsigned* qatt = (unsigned*)ctl + CW_QATT; unsigned* qmix = (unsigned*)ctl + CW_QMIX;
        volatile LAS unsigned* qw = (volatile LAS unsigned*)(lds + LDSCTL_OFF + 32);
        if (bx < 64) {
            scanB_block(lds, bx, TASKS, GB_, VSB, BON, a.in[22], a.in[23], MIX, out + O_WKVP, tid, wave, lane);
#ifdef DUP3
            LAUNDER();
            scanB_block(lds, bx, TASKS, GB_, VSB, BON, a.in[22], a.in[23], MIX, out + O_WKVP, tid, wave, lane);
#endif
            STAMP(5);
            __syncthreads();
            if (tid == 0) { unsigned sp = 0; while (xb_ld(subcnt) < 64u) { __builtin_amdgcn_s_sleep(4); if ((++sp & 255u) == 0u) { if (xb_ld(tmo)) break; if (sp > (1u << 20)) { atomicAdd(tmo, 1u); break; } } }
                __builtin_amdgcn_fence(__ATOMIC_ACQUIRE, "agent"); asm volatile("s_waitcnt vmcnt(0)" ::: "memory"); }
            __syncthreads();
        } else {
            const int gb = bx - 64;
            SST(0);
            if (gb < 64) {
                sample_stage<3>(lds, a, gb, 192, tid, wave, lane);
                SST(3);
                asm volatile("s_waitcnt vmcnt(0)" ::: "memory"); __syncthreads();
                if (tid == 0) { __builtin_amdgcn_fence(__ATOMIC_RELEASE, "agent"); asm volatile("s_waitcnt vmcnt(0)" ::: "memory"); (void)xb_add(subcnt, 1u);
                    unsigned sp = 0; while (xb_ld(subcnt) < 64u) { __builtin_amdgcn_s_sleep(1); if ((++sp & 255u) == 0u) { if (xb_ld(tmo)) break; if (sp > (1u << 20)) { atomicAdd(tmo, 1u); break; } } } }
            }
            {   unsigned sp_ = 0;
                for (;;) { __syncthreads(); if (tid == 0) { const bool dn_ = xb_ld(subcnt) >= 64u || xb_ld(tmo) != 0u; *qw = dn_ ? 0xffffffffu : xb_add(qmix, 1u); } __syncthreads(); const unsigned tile_ = *qw;
                    if (tile_ == 0xffffffffu) break;
                    if (tile_ < 512u) mixer_a_tile(lds, (int)tile_, ZA, WSB, a.in[10], a.in[11], a.in[13], MIX, out + O_CVP, tid, wave, lane);
                    else { __builtin_amdgcn_s_sleep(8); if (++sp_ > (1u << 18)) { if (tid == 0) atomicAdd(tmo, 1u); } } }
                if (tid == 0) { __builtin_amdgcn_fence(__ATOMIC_ACQUIRE, "agent"); asm volatile("s_waitcnt vmcnt(0)" ::: "memory"); }
                __syncthreads(); }
            SST(4);
        }
        {   const float* Qs = (const float*)(ws + WS_SMP + SM_Q); bf16* Os = (bf16*)(ws + WS_SMP + SM_O);
            bool adone = false, mdone = false;
            while (!(adone && mdone)) {
                if (!adone) { __syncthreads(); if (tid == 0) *qw = xb_add(qatt, 1u); __syncthreads(); const unsigned pair = *qw;
                    if (pair >= (unsigned)(MS * 4)) adone = true; else sample_attn_pair(lds, (int)pair, Qs, a.in[3], a.in[4], Os, tid, wave, lane); }
                if (!mdone) { __syncthreads(); if (tid == 0) *qw = xb_add(qmix, 1u); __syncthreads(); const unsigned tile = *qw;
                    if (tile >= 512u) mdone = true; else mixer_a_tile(lds, (int)tile, ZA, WSB, a.in[10], a.in[11], a.in[13], MIX, out + O_CVP, tid, wave, lane); }
            }
            {   unsigned* qdn = (unsigned*)ctl + CW_QDN; LAS float* scr = (LAS float*)(lds + wave * 16384);
                for (;;) { __syncthreads(); if (tid == 0) *qw = xb_add(qdn, 1u); __syncthreads(); const unsigned g_ = *qw; if (g_ >= 256u) break;
                    p0_transpose_item(a.in[33], FF, 1024, WDN, 0, nullptr, scr, (int)g_ * 8 + wave, lane); } }
            SST(5);
            SST(6);
        }
    }
#endif
    GRID_BAR(); STAMP(4);

    #ifndef NOP4
    LAUNDER();
    {
        SchedMN S; S.init(M, 1024, G, bx, MIX, 1024, WOUT, 1024);
        EpiResXN E; E.xn = (const bf16*)(ws + WS_ACAT); E.outb = X1B; E.rowss = RS1;
        {   Unit u0; const bool has_ = S.next(0, u0); const int rb_ = (has_ ? u0.pm : 0) * 256 + ((tid >> 6) >> 2) * 64 + (lane & 15);
#pragma unroll
            for (int ai = 0; ai < 2; ++ai)
#pragma unroll
                for (int m = 0; m < 4; ++m) E.inv_[ai][m] = 1.f / ((const gf32*)RSTD0)[rb_ + ai * 128 + m * 16]; }
        pg8::gemm_phase<EpiResXN, SchedMN, true>(lds, 1024, 1024, 1024, S, E);
        if (bx < 64) sample_stage<5>(lds, a, bx, G, tid, wave, lane);
        else {
            __syncthreads();
            LAS float* scr = (LAS float*)(lds + wave * 16384);
            for (int it = (bx - 64) * NWAVES + wave; it < 16 * 128; it += (G - 64) * NWAVES) p0_transpose_item(a.in[32], 1024, FF, WUP, 0, a.in[31], scr, it, lane);
        }
    }
#endif
    GRID_BAR(); STAMP(6);

    #ifndef NOP5
    LAUNDER();
    {
        SchedMN S5; S5.init(M, 1024, G, bx, X1B, 1024, WQ, 1024);
        Unit u;
        for (int i = 0; S5.next(i, u); ++i) {
            const int pm = u.pm, h = u.pn, b = pm >> 3;
            { EpiSoftmax E; E.P = PCAT + (size_t)pm * 256 * 1024 + h * 256; E.ldp = 1024;
              {   const int wv_ = tid >> 6, rb_ = pm * 256 + (wv_ >> 2) * 64 + (lane & 15);
#pragma unroll
                  for (int ai = 0; ai < 2; ++ai)
#pragma unroll
                      for (int m = 0; m < 4; ++m) E.rsq_[ai][m] = ((const gf32*)RS1)[rb_ + ai * 128 + m * 16]; }
              struct SchedU { const char* A; const char* B; Unit uu; __device__ __forceinline__ bool next(int i2, Unit& o) const { if (i2) return false; o = uu; return true; } __device__ __forceinline__ const char* pa(const Unit&) const { return A; } __device__ __forceinline__ const char* pb(const Unit&) const { return B; } };
              SchedU SU{S5.pa(u), (const char*)(WQK + (size_t)(b * 4 + h) * 256 * 1024), u};
              pg8::gemm_phase<EpiSoftmax, SchedU, false>(lds, 1024, 1024, 1024, SU, E); }
        }
        sample_stage<6>(lds, a, bx, G, tid, wave, lane);
    }
#endif
    GRID_BAR(); STAMP(8);

    #ifndef NOP7
    LAUNDER();
    {
        struct SchedMNB : SchedMN { __device__ __forceinline__ const char* pb(const Unit& u) const { return Bt + (size_t)(u.pm >> 3) * (1024 * 1024 * 2) + (size_t)u.pn * tb; } };
        SchedMNB S; S.init(M, 1024, G, bx, PCAT, 1024, VWOT, 1024);
        EpiRes<bf16> E{X1B, X2B, RS2};
        pg8::gemm_phase<EpiRes<bf16>, SchedMNB, true>(lds, 1024, 1024, 1024, S, E);
        sample_stage<7>(lds, a, bx, G, tid, wave, lane);
    }
#endif
    GRID_BAR(); STAMP(9);

    #ifndef NOP8
    LAUNDER();
    {
        SchedMN S; S.init(M, FF, G, bx, X2B, 1024, WUP, 1024);
        EpiUpP E; E.O = HID; E.scl = (const LAS float*)(lds + L_LWT);
        {   Unit u0; (void)S.next(0, u0);
            if (tid < 256) ((LAS float*)(lds + L_LWT))[tid] = 1.f / sqrtf(((const gf32*)RS2)[u0.pm * 256 + tid] * (1.f / D) + RMS_EPS);
            __syncthreads(); }
        pg8::gemm_phase<EpiUpP, SchedMN, true>(lds, 1024, 1024, 1024, S, E);
        sample_stage<8>(lds, a, bx, G, tid, wave, lane);
    }
#endif
    GRID_BAR(); STAMP(10);

    #ifndef NOP9
    LAUNDER();
    {
        SchedMN S; S.init(M, 1024, G, bx, HID, FF, WDN, FF);
        EpiFinal E{X2B, out + O_Y, a.in[34], RS3, (unsigned*)ctl + CW_PAN, (unsigned*)ctl + CW_TMO};
        pg8::gemm_phase<EpiFinal, SchedMN, true>(lds, FF, FF, FF, S, E);
    }
#endif
#ifdef PROBE_CSPAN_A
    if (blockIdx.x == 64 && threadIdx.x == 0) {
        const unsigned long long ta = *(volatile LAS unsigned long long*)(lds + LDSCTL_OFF + 288 + 8 * PROBE_CSPAN_A), tb = *(volatile LAS unsigned long long*)(lds + LDSCTL_OFF + 288 + 8 * PROBE_CSPAN_B);
        const unsigned long long t0 = __builtin_amdgcn_s_memrealtime(), dl = (tb - ta) * PROBE_MULT;
        while (__builtin_amdgcn_s_memrealtime() - t0 < dl) __builtin_amdgcn_s_sleep(8);
    }
#endif
#ifdef PROBE_SSPAN_A
    if (blockIdx.x == SST_BLK && threadIdx.x == 0) {
        const unsigned long long ta = *(volatile LAS unsigned long long*)(lds + LDSCTL_OFF + 64 + 8 * (16 + PROBE_SSPAN_A)), tb = *(volatile LAS unsigned long long*)(lds + LDSCTL_OFF + 64 + 8 * (16 + PROBE_SSPAN_B));
        const unsigned long long t0 = __builtin_amdgcn_s_memrealtime(), dl = (tb - ta) * PROBE_MULT;
        while (__builtin_amdgcn_s_memrealtime() - t0 < dl) __builtin_amdgcn_s_sleep(8);
    }
#endif
#ifdef PROBE_SPAN_A
    STAMP(12);
    if (blockIdx.x == 0 && threadIdx.x == 0) {
        const unsigned long long ta = *(volatile LAS unsigned long long*)(lds + LDSCTL_OFF + 64 + 8 * PROBE_SPAN_A), tb = *(volatile LAS unsigned long long*)(lds + LDSCTL_OFF + 64 + 8 * PROBE_SPAN_B);
        const unsigned long long t0 = __builtin_amdgcn_s_memrealtime(), dl = (tb - ta) * PROBE_MULT;
        while (__builtin_amdgcn_s_memrealtime() - t0 < dl) __builtin_amdgcn_s_sleep(8);
    }
#endif
}

extern "C" void kernel_launch(void* const* d_in, const int* in_sizes, int n_in, void* d_out, int out_size, void* d_ws, size_t ws_size, hipStream_t stream) {
    static int grid = 0;
    if (grid == 0) {
        if (n_in != 35 || out_size != (int)O_END || ws_size < WS_END) { fprintf(stderr, "kernel_launch: unexpected shapes (n_in %d, out %d, ws %zu); nothing launched\n", n_in, out_size, ws_size); grid = -1; return; }
        int dev = 0, cus = 0, per_cu = 0;
        if (hipGetDevice(&dev) != hipSuccess || hipDeviceGetAttribute(&cus, hipDeviceAttributeMultiprocessorCount, dev) != hipSuccess) { fprintf(stderr, "kernel_launch: device query failed\n"); grid = -1; return; }
        if (hipFuncSetAttribute((const void*)mk_fwd, hipFuncAttributeMaxDynamicSharedMemorySize, LDS_BYTES) != hipSuccess) { fprintf(stderr, "kernel_launch: hipFuncSetAttribute failed\n"); grid = -1; return; }
        if (hipOccupancyMaxActiveBlocksPerMultiprocessor(&per_cu, (const void*)mk_fwd, NWAVES * 64, LDS_BYTES) != hipSuccess || per_cu < 1)
            fprintf(stderr, "kernel_launch: note: occupancy query reports %d workgroups per CU\n", per_cu);
        (void)hipGetLastError();
        grid = cus;
        if (grid != 256) { fprintf(stderr, "kernel_launch: built for a 256-CU device (got %d)\n", grid); grid = -1; return; }
    }
    if (grid < 0) return;
    if (hipMemsetAsync((char*)d_ws + WS_CTL, 0, CTL_ZERO_BYTES, stream) != hipSuccess) { fprintf(stderr, "kernel_launch: hipMemsetAsync failed\n"); return; }
    KArgs a{};
    for (int i = 0; i < 35; ++i) a.in[i] = (const float*)d_in[i];
    a.out = (float*)d_out; a.ws = (unsigned char*)d_ws;
    hipLaunchKernelGGL(mk_fwd, dim3(grid), dim3(NWAVES * 64), LDS_BYTES, stream, a);
    const hipError_t le = hipPeekAtLastError();
    if (le != hipSuccess) fprintf(stderr, "kernel_launch: launch failed: %s\n", hipGetErrorName(le));
}
```
